# Optimizing an MI355X kernel written in HIP

```python
import jax, jax.numpy as jnp
from jax import lax
import numpy as np

D_MODEL = 1024
BATCH = 2
SEQ = 16384
DEPTH = 2

CHUNK = 64
Q_BLOCK = 128
ROPE_BASE = 10000.0
EPS = 1e-6

MLA_HEADS = 8
MLA_NOPE = 64
MLA_ROPE = 32
MLA_V = 64
MLA_Q_LORA = 256
MLA_KV_LORA = 128
FOX_HEADS = 8
FOX_DIM = 64
RET_HEADS = 4
RET_QK = 256
RET_V = 512
N_GROUPS = 4
EXPERTS_PER_GROUP = 8
N_EXPERTS = N_GROUPS * EXPERTS_PER_GROUP
TOP_K = 2
D_EXPERT = 512
MOE_BLOCK = 128

N_EVEN = (DEPTH + 1) // 2
N_ODD = DEPTH // 2
EVEN_IN = MLA_Q_LORA + MLA_KV_LORA + MLA_ROPE + 3 * FOX_HEADS * FOX_DIM + FOX_HEADS
EVEN_MIX = MLA_HEADS * MLA_V + FOX_HEADS * FOX_DIM
ODD_IN = 2 * RET_HEADS * RET_QK + 2 * RET_HEADS * RET_V
ODD_MIX = RET_HEADS * RET_V

kernel_name = 'hybrid_mla_fox_retention_hmoe'


def _rms(x):
    xf = x.astype(jnp.float32)
    return xf * lax.rsqrt(jnp.mean(jnp.square(xf), axis=-1, keepdims=True) + EPS)


def rmsnorm(x, g):
    return (_rms(x) * g.astype(jnp.float32)).astype(x.dtype)


def rope(x):
    s, d = x.shape[1], x.shape[-1]
    half = d // 2
    inv = ROPE_BASE ** (-jnp.arange(half, dtype=jnp.float32) / half)
    ang = jnp.arange(s, dtype=jnp.float32)[:, None] * inv[None, :]
    cos = jnp.cos(ang)[None, :, None, :]
    sin = jnp.sin(ang)[None, :, None, :]
    xf = x.astype(jnp.float32)
    x1, x2 = xf[..., :half], xf[..., half:]
    return jnp.concatenate([x1 * cos - x2 * sin, x1 * sin + x2 * cos], axis=-1).astype(x.dtype)


def block_attention(q_a, k_a, v_a, q_b, k_b, v_b, cum):
    s = q_a.shape[2]
    n_blk = s // Q_BLOCK
    kpos = jnp.arange(s)
    scale_a = (MLA_NOPE + MLA_ROPE) ** -0.5
    scale_b = FOX_DIM ** -0.5

    def one(i):
        start = i * Q_BLOCK
        qpos = start + jnp.arange(Q_BLOCK)
        qa = lax.dynamic_slice_in_dim(q_a, start, Q_BLOCK, axis=2)
        s_a = jnp.einsum('bhqd,bhkd->bhqk', qa, k_a, preferred_element_type=jnp.float32) * scale_a
        chunk_mask = (kpos[None, :] // CHUNK) <= (qpos[:, None] // CHUNK)
        p_a = jax.nn.softmax(jnp.where(chunk_mask, s_a, -jnp.inf), axis=-1)
        o_a = jnp.einsum('bhqk,bhkd->bhqd', p_a.astype(v_a.dtype), v_a)
        qb = lax.dynamic_slice_in_dim(q_b, start, Q_BLOCK, axis=2)
        cq = lax.dynamic_slice_in_dim(cum, start, Q_BLOCK, axis=2)
        s_b = (jnp.einsum('bhqd,bhkd->bhqk', qb, k_b, preferred_element_type=jnp.float32) * scale_b
               + cq[..., :, None] - cum[..., None, :])
        causal = kpos[None, :] <= qpos[:, None]
        p_b = jax.nn.softmax(jnp.where(causal, s_b, -jnp.inf), axis=-1)
        o_b = jnp.einsum('bhqk,bhkd->bhqd', p_b.astype(v_b.dtype), v_b)
        return o_a, o_b

    o_a, o_b = lax.map(one, jnp.arange(n_blk))

    def merge(o):
        nb, b, h, qb_, d = o.shape
        return o.transpose(1, 0, 3, 2, 4).reshape(b, nb * qb_, h * d)

    return merge(o_a), merge(o_b)


def even_mixer(h, w_in, ln_q, w_uq, ln_kv, w_ukv, b_f, w_out):
    b, s, _ = h.shape
    z = h @ w_in
    cuts = np.cumsum([MLA_Q_LORA, MLA_KV_LORA, MLA_ROPE, FOX_HEADS * FOX_DIM,
                      FOX_HEADS * FOX_DIM, FOX_HEADS * FOX_DIM]).tolist()
    c_q, c_kv, k_pe, q_f, k_f, v_f, f_logit = jnp.split(z, cuts, axis=-1)
    q = (rmsnorm(c_q, ln_q) @ w_uq).reshape(b, s, MLA_HEADS, MLA_NOPE + MLA_ROPE)
    q = jnp.concatenate([q[..., :MLA_NOPE], rope(q[..., MLA_NOPE:])], axis=-1)
    kv = (rmsnorm(c_kv, ln_kv) @ w_ukv).reshape(b, s, MLA_HEADS, MLA_NOPE + MLA_V)
    k_pe = jnp.broadcast_to(rope(k_pe[:, :, None, :]), (b, s, MLA_HEADS, MLA_ROPE))
    k = jnp.concatenate([kv[..., :MLA_NOPE], k_pe], axis=-1)
    v = kv[..., MLA_NOPE:]
    log_f = jax.nn.log_sigmoid(f_logit.astype(jnp.float32) + b_f.astype(jnp.float32))
    cum = jnp.cumsum(log_f, axis=1).transpose(0, 2, 1)
    fh = lambda t: t.reshape(b, s, FOX_HEADS, FOX_DIM).transpose(0, 2, 1, 3)
    tr = lambda t: t.transpose(0, 2, 1, 3)
    o_a, o_b = block_attention(tr(q), tr(k), tr(v), fh(q_f), fh(k_f), fh(v_f), cum)
    return jnp.concatenate([o_a, o_b], axis=-1) @ w_out


def retention(q, k, v):
    b, s, h, dk = q.shape
    dv = v.shape[-1]
    n = s // CHUNK
    q, k, v = (t.astype(jnp.float32) for t in (q, k, v))
    log_g = jnp.log(1.0 - jnp.exp2(-5.0 - jnp.arange(h, dtype=jnp.float32)))
    j = jnp.arange(CHUNK, dtype=jnp.float32)
    diff = j[:, None] - j[None, :]
    dmask = jnp.where(diff >= 0, jnp.exp(jnp.maximum(diff, 0.0)[None] * log_g[:, None, None]), 0.0)
    xi = jnp.exp((j[:, None] + 1.0) * log_g[None, :])
    zeta = jnp.exp((CHUNK - 1.0 - j)[:, None] * log_g[None, :])
    g_c = jnp.exp(CHUNK * log_g)
    qc = q.reshape(b, n, CHUNK, h, dk)
    kc = k.reshape(b, n, CHUNK, h, dk)
    vc = v.reshape(b, n, CHUNK, h, dv)
    inner = jnp.einsum('bnchd,bnmhd->bnhcm', qc, kc) * dmask
    o_inner = jnp.einsum('bnhcm,bnmhe->bnche', inner, vc)

    def step(state, xs):
        qn, kn, vn = xs
        cross = jnp.einsum('bchd,bhde->bche', qn, state) * xi[None, :, :, None]
        state = g_c[None, :, None, None] * state + jnp.einsum(
            'bchd,bche->bhde', kn * zeta[None, :, :, None], vn)
        return state, cross

    state0 = jnp.zeros((b, h, dk, dv), jnp.float32)
    lead = lambda t: t.transpose(1, 0, 2, 3, 4)
    _, cross = lax.scan(step, state0, (lead(qc), lead(kc), lead(vc)))
    return (o_inner + lead(cross)).reshape(b, s, h, dv)


def odd_mixer(h, w_in, w_out):
    b, s, _ = h.shape
    z = h @ w_in
    cuts = np.cumsum([RET_HEADS * RET_QK, RET_HEADS * RET_QK, RET_HEADS * RET_V]).tolist()
    q, k, v, g = jnp.split(z, cuts, axis=-1)
    q = rope(q.reshape(b, s, RET_HEADS, RET_QK))
    k = rope(k.reshape(b, s, RET_HEADS, RET_QK)) * (RET_QK ** -0.5)
    v = v.reshape(b, s, RET_HEADS, RET_V)
    o = _rms(retention(q, k, v)).reshape(b, s, ODD_MIX)
    return (o.astype(h.dtype) * jax.nn.silu(g)) @ w_out


def expert_dispatch(xt, eid, gate, w_gate, w_up, w_down):
    t, d = xt.shape
    a = t * TOP_K
    e_flat = eid.reshape(a)
    w_flat = gate.reshape(a)
    tok = jnp.arange(a, dtype=jnp.int32) // TOP_K
    order = jnp.argsort(e_flat)
    e_s, tok_s, w_s = e_flat[order], tok[order], w_flat[order]
    counts = jnp.bincount(e_flat, length=N_EXPERTS)
    start = jnp.cumsum(counts) - counts
    padded = ((counts + MOE_BLOCK - 1) // MOE_BLOCK) * MOE_BLOCK
    pend = jnp.cumsum(padded)
    pstart = pend - padded
    dest = pstart[e_s] + (jnp.arange(a) - start[e_s])
    cap = a + N_EXPERTS * MOE_BLOCK
    n_blk = cap // MOE_BLOCK
    slot_tok = jnp.full((cap,), t, jnp.int32).at[dest].set(tok_s)
    slot_w = jnp.zeros((cap,), jnp.float32).at[dest].set(w_s)
    blk_expert = jnp.minimum(
        jnp.searchsorted(pend, jnp.arange(n_blk) * MOE_BLOCK, side='right'), N_EXPERTS - 1)
    x_pad = jnp.concatenate([xt, jnp.zeros((1, d), xt.dtype)], axis=0)
    xs = x_pad[slot_tok].reshape(n_blk, MOE_BLOCK, d)

    def run(args):
        xb, e = args
        hid = jax.nn.silu(xb @ w_gate[e]) * (xb @ w_up[e])
        return hid @ w_down[e]

    ys = lax.map(run, (xs, blk_expert)).reshape(cap, d)
    out = jax.ops.segment_sum(ys * slot_w[:, None].astype(ys.dtype), slot_tok, num_segments=t + 1)
    return out[:t]


def hier_moe(h, w_rg, b_rg, w_re, b_re, w_gate, w_up, w_down):
    b, s, d = h.shape
    t = b * s
    xt = h.reshape(t, d)
    g_logits = (xt @ w_rg).astype(jnp.float32) + b_rg.astype(jnp.float32)
    g_prob = jax.nn.softmax(g_logits, axis=-1)
    g_sel = jnp.argmax(g_logits, axis=-1).astype(jnp.int32)
    p_g = jnp.take_along_axis(g_prob, g_sel[:, None], axis=-1)
    e_all = ((xt @ w_re).astype(jnp.float32) + b_re.astype(jnp.float32)).reshape(
        t, N_GROUPS, EXPERTS_PER_GROUP)
    e_logits = jnp.take_along_axis(e_all, g_sel[:, None, None], axis=1)[:, 0]
    top_p, top_j = lax.top_k(jax.nn.softmax(e_logits, axis=-1), TOP_K)
    gate = p_g * top_p / jnp.sum(top_p, axis=-1, keepdims=True)
    eid = (g_sel[:, None] * EXPERTS_PER_GROUP + top_j).astype(jnp.int32)
    out = expert_dispatch(xt, eid, gate, w_gate, w_up, w_down)
    return out.reshape(b, s, d)


def setup_inputs(seed: int = 0) -> dict:
    key = jax.random.key(seed)
    ks = jax.random.split(key, 24)
    nrm = lambda k, shape, fan_in: jax.random.normal(k, shape, jnp.float32) * (fan_in ** -0.5)
    gain = lambda k, shape: 1.0 + 0.02 * jax.random.normal(k, shape, jnp.float32)
    return {
        'x': jax.random.normal(ks[0], (BATCH, SEQ, D_MODEL), jnp.float32),
        'ln_mix_e': gain(ks[1], (N_EVEN, D_MODEL)),
        'w_in_e': nrm(ks[2], (N_EVEN, D_MODEL, EVEN_IN), D_MODEL),
        'ln_q_e': gain(ks[3], (N_EVEN, MLA_Q_LORA)),
        'w_uq_e': nrm(ks[4], (N_EVEN, MLA_Q_LORA, MLA_HEADS * (MLA_NOPE + MLA_ROPE)), MLA_Q_LORA),
        'ln_kv_e': gain(ks[5], (N_EVEN, MLA_KV_LORA)),
        'w_ukv_e': nrm(ks[6], (N_EVEN, MLA_KV_LORA, MLA_HEADS * (MLA_NOPE + MLA_V)), MLA_KV_LORA),
        'b_f_e': 3.0 + 0.5 * jax.random.normal(ks[7], (N_EVEN, FOX_HEADS), jnp.float32),
        'w_out_e': nrm(ks[8], (N_EVEN, EVEN_MIX, D_MODEL), EVEN_MIX),
        'ln_mix_o': gain(ks[9], (N_ODD, D_MODEL)),
        'w_in_o': nrm(ks[10], (N_ODD, D_MODEL, ODD_IN), D_MODEL),
        'w_out_o': nrm(ks[11], (N_ODD, ODD_MIX, D_MODEL), ODD_MIX),
        'ln_ffn': gain(ks[12], (DEPTH, D_MODEL)),
        'w_rg': nrm(ks[13], (DEPTH, D_MODEL, N_GROUPS), D_MODEL),
        'b_rg': 0.01 * jax.random.normal(ks[14], (DEPTH, N_GROUPS), jnp.float32),
        'w_re': nrm(ks[15], (DEPTH, D_MODEL, N_EXPERTS), D_MODEL),
        'b_re': 0.01 * jax.random.normal(ks[16], (DEPTH, N_EXPERTS), jnp.float32),
        'w_gate': nrm(ks[17], (DEPTH, N_EXPERTS, D_MODEL, D_EXPERT), D_MODEL),
        'w_up': nrm(ks[18], (DEPTH, N_EXPERTS, D_MODEL, D_EXPERT), D_MODEL),
        'w_down': nrm(ks[19], (DEPTH, N_EXPERTS, D_EXPERT, D_MODEL), D_EXPERT),
        'ln_f': gain(ks[20], (D_MODEL,)),
    }


def reference(x, ln_mix_e, w_in_e, ln_q_e, w_uq_e, ln_kv_e, w_ukv_e, b_f_e, w_out_e,
              ln_mix_o, w_in_o, w_out_o, ln_ffn, w_rg, b_rg, w_re, b_re,
              w_gate, w_up, w_down, ln_f):
    for layer in range(DEPTH):
        i = layer // 2
        if layer % 2 == 0:
            x = x + even_mixer(rmsnorm(x, ln_mix_e[i]), w_in_e[i], ln_q_e[i], w_uq_e[i],
                               ln_kv_e[i], w_ukv_e[i], b_f_e[i], w_out_e[i])
        else:
            x = x + odd_mixer(rmsnorm(x, ln_mix_o[i]), w_in_o[i], w_out_o[i])
        x = x + hier_moe(rmsnorm(x, ln_ffn[layer]), w_rg[layer], b_rg[layer], w_re[layer],
                         b_re[layer], w_gate[layer], w_up[layer], w_down[layer])
    return rmsnorm(x, ln_f)
```

```cpp
#include <hip/hip_runtime.h>
#include <cstdio>
#include <cstdint>

#ifndef N_LAUNCH_MODE
#define N_LAUNCH_MODE 0
#endif

#define LAS __attribute__((address_space(3)))
#define GAS __attribute__((address_space(1)))
typedef unsigned short bf16_t;
typedef short bf16x8 __attribute__((ext_vector_type(8)));
typedef float f32x2 __attribute__((ext_vector_type(2)));
typedef float f32x4 __attribute__((ext_vector_type(4)));
typedef float f32x16 __attribute__((ext_vector_type(16)));
typedef unsigned u32x2 __attribute__((ext_vector_type(2)));
typedef unsigned u32x4 __attribute__((ext_vector_type(4)));

constexpr int T = 32768, S = 16384, D = 1024;
constexpr float EPS = 1e-6f;
constexpr float LOG2E = 1.4426950408889634f;
constexpr int CAP = 65536 + 32 * 256;
constexpr int NSEG = 16, SEGC = 16;

constexpr size_t MiB = 1u << 20;
constexpr size_t OFF_CTL = 0, CTL_BYTES = 1 * MiB;
constexpr size_t OFF_SMALL = 1 * MiB;
constexpr size_t SM_RS0 = OFF_SMALL, SM_RS1 = SM_RS0 + T * 4, SM_RS2 = SM_RS1 + T * 4, SM_PQ = SM_RS2 + T * 4, SM_PKV = SM_PQ + (size_t)T * 16,
                 SM_LF = SM_PKV + (size_t)T * 16, SM_CUM = SM_LF + (size_t)T * 32, SM_EID = SM_CUM + (size_t)T * 32  ,
                 SM_GATE = SM_EID + (size_t)T * 8, SM_RANK = SM_GATE + (size_t)T * 8, SM_TSLOT = SM_RANK + (size_t)T * 8, SM_CNT = SM_TSLOT + (size_t)T * 8,
                 SM_STOK = SM_CNT + 256 * 32 * 4, SM_SW = SM_STOK + (size_t)CAP * 4, SM_SR = SM_SW + (size_t)CAP * 4, SM_TILEE = SM_SR + (size_t)CAP * 4,
                 SM_PO = SM_TILEE + 4096, SM_END = SM_PO + (size_t)T * 64;
static_assert(SM_END <= 11 * MiB, "small region");
constexpr size_t OFF_ROPE = 11 * MiB;
constexpr size_t OFF_WMIX = 27 * MiB;
constexpr size_t W_A1 = OFF_WMIX, W_A1V = W_A1 + 3 * MiB, W_A2 = W_A1V + 1 * MiB, W_A2V = W_A2 + 768 * 1024, W_OE = W_A2V + 256 * 1024,
                 W_B1 = W_OE + 2 * MiB, W_OO = W_B1 + 12 * MiB, W_MIXEND = W_OO + 4 * MiB;
static_assert(W_MIXEND <= 51 * MiB, "mixer weights");
constexpr size_t OFF_WGU = 51 * MiB, OFF_WDN = OFF_WGU + 64 * MiB;
constexpr size_t OFF_XB = 147 * MiB;
constexpr size_t OFF_ACT = 211 * MiB;
constexpr size_t WS_NEED = OFF_ACT + 320 * MiB;
constexpr size_t A_Z = OFF_ACT, A_QF = A_Z + 32 * MiB, A_KF = A_QF + 32 * MiB, A_VTF = A_KF + 32 * MiB, A_QA = A_VTF + 32 * MiB, A_KA = A_QA + 48 * MiB, A_VTA = A_KA + 48 * MiB;
constexpr size_t A_XS = OFF_ACT, A_HID = OFF_ACT + 144 * MiB;
constexpr size_t A_QX = OFF_ACT, A_KN = A_QX + 32 * MiB, A_KZT = A_KN + 32 * MiB, A_VT = A_KZT + 32 * MiB, A_L = A_VT + 64 * MiB, A_O = A_L + 32 * MiB;
static_assert(A_O + 128 * MiB <= WS_NEED && A_HID + 72 * MiB <= WS_NEED && A_VTA + 32 * MiB <= WS_NEED, "act map");

__device__ __forceinline__ unsigned f2bf(float f) { unsigned u = __builtin_bit_cast(unsigned, f); return (u + 0x7fffu + ((u >> 16) & 1u)) >> 16; }
__device__ __forceinline__ unsigned pk2(float lo, float hi) { unsigned r; asm volatile("v_cvt_pk_bf16_f32 %0, %1, %2" : "=v"(r) : "v"(lo), "v"(hi)); return r; }
__device__ __forceinline__ float bf2f(unsigned short b) { return __builtin_bit_cast(float, ((unsigned)b) << 16); }
__device__ __forceinline__ float bflo(unsigned w) { return __builtin_bit_cast(float, w << 16); }
__device__ __forceinline__ float bfhi(unsigned w) { return __builtin_bit_cast(float, w & 0xffff0000u); }
__device__ __forceinline__ float wave_sum(float v) {
#pragma unroll
    for (int o = 1; o < 64; o <<= 1) v += __shfl_xor(v, o);
    return v;
}
__device__ __forceinline__ int lane_id_opaque() { unsigned z = 0u; asm volatile("" : "+s"(z)); int l = (int)__builtin_amdgcn_mbcnt_hi(~0u, __builtin_amdgcn_mbcnt_lo(~0u, z)); asm volatile("" : "+v"(l)); return l; }
__device__ __forceinline__ int ld_i(const int* p) { return __hip_atomic_load(p, __ATOMIC_RELAXED, __HIP_MEMORY_SCOPE_AGENT); }
__device__ __forceinline__ float rsqrt_f(float x) { return 1.0f / sqrtf(x); }

#define XB_TMO      128
#define XB_XCNT(j)  (256  + 64 * (j))
#define XB_XSUB(j)  (1280 + 64 * (j))
#define XB_XGEN(j)  (2304 + 64 * (j))
#define XB_TOP      3328
#define XB_TOPGEN   3392
#define XCD_BAR_WORDS 3456
#define XB_SPIN_CAP (1u << 18)
__device__ __forceinline__ unsigned xb_ld(unsigned* p)              { return __hip_atomic_load(p, __ATOMIC_RELAXED, __HIP_MEMORY_SCOPE_AGENT); }
__device__ __forceinline__ unsigned xb_add(unsigned* p, unsigned v) { return __hip_atomic_fetch_add(p, v, __ATOMIC_RELAXED, __HIP_MEMORY_SCOPE_AGENT); }
__device__ __forceinline__ unsigned xb_xcc_id() { return (unsigned)__builtin_amdgcn_s_getreg((3 << 11) | 20) & 0xFu; }
#define XB_SPIN(cond, bar) do { unsigned _sp = 0; while (cond) { __builtin_amdgcn_s_sleep(1); \
    if ((++_sp & 255u) == 0u) { if (xb_ld(&(bar)[XB_TMO])) break; if (_sp > XB_SPIN_CAP) { atomicAdd(&(bar)[XB_TMO], 1u); break; } } } } while (0)
struct XcdBarrier { unsigned* bar; unsigned x; volatile LAS unsigned* st; };
__device__ __forceinline__ XcdBarrier xcd_barrier_post(unsigned* bar, volatile LAS unsigned* st, bool t0) {
    XcdBarrier b; b.bar = bar; b.x = xb_xcc_id(); b.st = st;
    if (t0) (void)xb_add(&bar[XB_XCNT(b.x)], 1u);
    return b;
}
__device__ __forceinline__ void xcd_barrier_complete(unsigned* bar, unsigned x, unsigned& nloc, unsigned& nx) {
    const unsigned G = gridDim.x * gridDim.y * gridDim.z;
    unsigned sum, cnt, mine, sp = 0u;
    for (;;) {
        sum = 0u; cnt = 0u; mine = 0u;
#pragma unroll
        for (unsigned j = 0; j < 16; ++j) { const unsigned c = xb_ld(&bar[XB_XCNT(j)]); sum += c; cnt += (c > 0u) ? 1u : 0u; mine = (j == x) ? c : mine; }
        if (sum == G) break;
        __builtin_amdgcn_s_sleep(1);
        if ((++sp & 255u) == 0u) { if (xb_ld(&bar[XB_TMO])) break; if (sp > XB_SPIN_CAP) { atomicAdd(&bar[XB_TMO], 1u); break; } }
    }
    nloc = mine > 0u ? mine : 1u; nx = cnt > 0u ? cnt : 1u;
}
__device__ __forceinline__ void xcd_barrier(const XcdBarrier& b, bool t0) {
    asm volatile("s_waitcnt vmcnt(0)" ::: "memory");
    __syncthreads();
    if (t0) {
        unsigned* bar = b.bar;
        __builtin_amdgcn_s_waitcnt(0);
        unsigned nloc = b.st[0], nx = b.st[1];
        if (nloc == 0u) { xcd_barrier_complete(bar, b.x, nloc, nx); b.st[0] = nloc; b.st[1] = nx; }
        const unsigned old = xb_add(&bar[XB_XSUB(b.x)], 1u);
        const unsigned gen = old / nloc;
        if (old + 1u == (gen + 1u) * nloc) {
            __builtin_amdgcn_fence(__ATOMIC_RELEASE, "agent");
            asm volatile("s_waitcnt vmcnt(0)" ::: "memory");
            const unsigned og = xb_add(&bar[XB_TOP], 1u);
            const unsigned tg = og / nx;
            if (og + 1u == (tg + 1u) * nx) xb_add(&bar[XB_TOPGEN], 1u);
            else XB_SPIN(xb_ld(&bar[XB_TOPGEN]) == tg, bar);
            __builtin_amdgcn_fence(__ATOMIC_ACQUIRE, "agent");
            xb_add(&bar[XB_XGEN(b.x)], 1u);
            asm volatile("s_waitcnt vmcnt(0)" ::: "memory");
        } else {
            XB_SPIN(xb_ld(&bar[XB_XGEN(b.x)]) == gen, bar);
            __builtin_amdgcn_fence(__ATOMIC_ACQUIRE, "agent");
            asm volatile("s_waitcnt vmcnt(0)" ::: "memory");
        }
    }
    __syncthreads();
}

namespace pg8 {
constexpr int BM = 256, BK = 64, HALF = 128, HTB = HALF * BK * 2, STAGE_BYTES = 8 * HTB, NXCD = 8, WGM = 8;
__device__ __forceinline__ int lds_byte(int r, int c) { const int st = (r >> 4) * 2 + (c >> 5), rr = r & 15, cc = c & 31, ob = rr * 64 + cc * 2; return st * 1024 + (ob ^ (((ob >> 9) & 1) << 5)); }
__device__ __forceinline__ void stage_rc(int b, int& R, int& C) { const int st = b / 1024, sb = b % 1024, swz = sb ^ (((sb >> 9) & 1) << 5); R = (st >> 1) * 16 + swz / 64; C = (st & 1) * 32 + (swz % 64) / 2; }
__device__ __forceinline__ int perm32(int rho) { const int n = rho >> 4, i = rho & 15; return 8 * (i >> 2) + 4 * n + (i & 3); }
struct Unit { int pm, pn, aux; };
struct Dims { int lda, ldb, K; };
struct DenseOrder {
    int nM, nN, nwg, G, c;
    __device__ __forceinline__ void init(int nM_, int nN_, int G_, int c_) { nM = nM_; nN = nN_; nwg = nM * nN; G = G_; c = c_; }
    __device__ __forceinline__ bool tile(int i, Unit& u) const {
        const long L = (long)i * G + c; if (L >= nwg) return false;
        int wgid = (int)L; { const int q = nwg / NXCD, r = nwg % NXCD, xcd = wgid % NXCD, off = wgid / NXCD; wgid = (xcd < r ? xcd * (q + 1) : r * (q + 1) + (xcd - r) * q) + off; }
        const int nig = WGM * nN, gid = wgid / nig, fm = gid * WGM, gsz = (nM - fm) < WGM ? (nM - fm) : WGM;
        u.pm = fm + ((wgid % nig) % gsz); u.pn = (wgid % nig) / gsz; u.aux = 0; return true;
    }
};

template <class Epi, class Sched>
__device__ __forceinline__ void gemm_phase(int wave_, LAS unsigned char* lds, const Dims g, const Sched& S, const Epi& E) {
    const int tid = wave_ * 64 + lane_id_opaque();
    const int wid = __builtin_amdgcn_readfirstlane(tid >> 6), lane = tid & 63, wr = wid >> 2, wc = wid & 3, fr = lane & 15, fq = lane >> 4;
    const int K = g.K, nt = K / BK;
    unsigned voffA[2], voffB[2];
#pragma unroll
    for (int i = 0; i < 2; ++i) { int R, C; stage_rc(tid * 16 + i * 8192, R, C); const int Rb = Epi::PERM ? ((R & ~31) + perm32(R & 31)) : R;
        voffA[i] = (unsigned)(R * g.lda + C) * 2u; voffB[i] = (unsigned)(Rb * g.ldb + C) * 2u; }
    const size_t kstep = (size_t)(BK * 2);
    const size_t hstepA = (size_t)HALF * g.lda * 2, hstepB = (size_t)HALF * g.ldb * 2;
    const unsigned ldsw = (unsigned)wid * 1024u;
    const int aoff = lds_byte(wr * 64 + fr, fq * 8), boff = lds_byte(wc * 32 + fr, fq * 8);
#define PG8_SA(b, h) (((b) * 2 + (h)) * HTB)
#define PG8_SB(b, h) ((4 + (b) * 2 + (h)) * HTB)
#define PG8_STAGE(bufoff, gbase, voff) do { _Pragma("unroll") for (int _i = 0; _i < 2; ++_i) \
        __builtin_amdgcn_global_load_lds((const unsigned*)((const char*)(gbase) + (voff)[_i]), (LAS unsigned*)(lds + (bufoff) + ldsw + _i * 8192), 16, 0, 0); } while (0)
#define PG8_LDA(dst, b, h) do { _Pragma("unroll") for (int m = 0; m < 4; ++m) _Pragma("unroll") for (int k = 0; k < 2; ++k) dst[m][k] = *(const LAS bf16x8*)(lds + PG8_SA(b, h) + aoff + m * 2048 + k * 1024); } while (0)
#define PG8_LDB(dst, b, h) do { _Pragma("unroll") for (int n = 0; n < 2; ++n) _Pragma("unroll") for (int k = 0; k < 2; ++k) dst[n][k] = *(const LAS bf16x8*)(lds + PG8_SB(b, h) + boff + n * 2048 + k * 1024); } while (0)
#define PG8_MMA(ai, bj, At, Bt) do { __builtin_amdgcn_s_setprio(1); _Pragma("unroll") for (int m = 0; m < 4; ++m) _Pragma("unroll") for (int n = 0; n < 2; ++n) _Pragma("unroll") for (int k = 0; k < 2; ++k) \
        acc[ai][bj][m][n] = __builtin_amdgcn_mfma_f32_16x16x32_bf16(Bt[n][k], At[m][k], acc[ai][bj][m][n], 0, 0, 0); __builtin_amdgcn_s_setprio(0); } while (0)
#define PG8_WAIT_V(n) asm volatile("s_waitcnt vmcnt(" #n ")" ::: "memory")
#define PG8_WAIT_L(n) asm volatile("s_waitcnt lgkmcnt(" #n ")" ::: "memory")
#define PG8_BAR __builtin_amdgcn_s_barrier()
#define PG8_SCHED __builtin_amdgcn_sched_barrier(0)
    Unit cur, nxt; int ui = 0;
    if (!S.next(0, cur)) return;
    f32x4 acc[2][2][4][2];
#pragma unroll
    for (int a = 0; a < 2; ++a)
#pragma unroll
        for (int b = 0; b < 2; ++b)
#pragma unroll
            for (int m = 0; m < 4; ++m)
#pragma unroll
                for (int n = 0; n < 2; ++n) acc[a][b][m][n] = (f32x4){0.f, 0.f, 0.f, 0.f};
    bf16x8 At[4][2], B0[2][2], B1[2][2];
    const char* cA; const char* cB; S.ptrs(cur, cA, cB);
    PG8_STAGE(PG8_SB(0, 0), cB, voffB); PG8_STAGE(PG8_SA(0, 0), cA, voffA); PG8_STAGE(PG8_SB(0, 1), cB + hstepB, voffB); PG8_STAGE(PG8_SA(0, 1), cA + hstepA, voffA);
    if (wr == 1) PG8_BAR;
    PG8_WAIT_V(4); PG8_BAR;
    PG8_STAGE(PG8_SB(1, 0), cB + kstep, voffB); PG8_STAGE(PG8_SA(1, 0), cA + kstep, voffA); PG8_STAGE(PG8_SB(1, 1), cB + hstepB + kstep, voffB);
    PG8_WAIT_V(6); PG8_BAR;
    for (;;) {
        const bool has_next = S.next(ui + 1, nxt);
        const char* nA = cA; const char* nB = cB; if (has_next) S.ptrs(nxt, nA, nB);
        for (int t = 0; t < nt; t += 2) {
            const bool last = (t == nt - 2);
            const char* a1 = cA + (size_t)(t + 1) * kstep;
            const char* a2 = last ? nA : cA + (size_t)(t + 2) * kstep; const char* b2 = last ? nB : cB + (size_t)(t + 2) * kstep;
            const char* a3 = a2 + kstep; const char* b3 = b2 + kstep;
            PG8_LDB(B0, 0, 0); PG8_SCHED; PG8_LDA(At, 0, 0); PG8_STAGE(PG8_SA(1, 1), a1 + hstepA, voffA);
            PG8_WAIT_L(8); PG8_BAR; PG8_WAIT_L(0); PG8_MMA(0, 0, At, B0); PG8_BAR; PG8_SCHED;
            PG8_LDB(B1, 0, 1); PG8_STAGE(PG8_SB(0, 0), b2, voffB);
            PG8_BAR; PG8_WAIT_L(0); PG8_MMA(0, 1, At, B1); PG8_BAR;
            PG8_LDA(At, 0, 1); PG8_STAGE(PG8_SA(0, 0), a2, voffA);
            PG8_BAR; PG8_WAIT_L(0); PG8_MMA(1, 0, At, B0); PG8_BAR; PG8_SCHED;
            PG8_STAGE(PG8_SB(0, 1), b2 + hstepB, voffB);
            PG8_WAIT_V(6); PG8_BAR; PG8_MMA(1, 1, At, B1); PG8_BAR;
            PG8_LDB(B0, 1, 0); PG8_SCHED; PG8_LDA(At, 1, 0); PG8_STAGE(PG8_SA(0, 1), a2 + hstepA, voffA);
            PG8_WAIT_L(8); PG8_BAR; PG8_WAIT_L(0); PG8_MMA(0, 0, At, B0); PG8_BAR; PG8_SCHED;
            PG8_LDB(B1, 1, 1); PG8_STAGE(PG8_SB(1, 0), b3, voffB);
            PG8_BAR; PG8_WAIT_L(0); PG8_MMA(0, 1, At, B1); PG8_BAR;
            PG8_LDA(At, 1, 1); PG8_STAGE(PG8_SA(1, 0), a3, voffA);
            PG8_BAR; PG8_WAIT_L(0); PG8_MMA(1, 0, At, B0); PG8_BAR; PG8_SCHED;
            PG8_STAGE(PG8_SB(1, 1), b3 + hstepB, voffB);
            PG8_WAIT_V(6); PG8_BAR; PG8_MMA(1, 1, At, B1); PG8_BAR;
        }
        { int fr2 = fr, fq2 = fq; asm volatile("" : "+v"(fr2), "+v"(fq2)); E(acc, cur, wr, wc, fr2, fq2); }
        if (!has_next) break;
#pragma unroll
        for (int a = 0; a < 2; ++a)
#pragma unroll
            for (int b = 0; b < 2; ++b)
#pragma unroll
                for (int m = 0; m < 4; ++m)
#pragma unroll
                    for (int n = 0; n < 2; ++n) acc[a][b][m][n] = (f32x4){0.f, 0.f, 0.f, 0.f};
        cur = nxt; cA = nA; cB = nB; ++ui;
    }
    PG8_WAIT_V(0);
    if (wr == 0) PG8_BAR;
    PG8_BAR;
#undef PG8_SA
#undef PG8_SB
#undef PG8_STAGE
#undef PG8_LDA
#undef PG8_LDB
#undef PG8_MMA
#undef PG8_WAIT_V
#undef PG8_WAIT_L
#undef PG8_BAR
#undef PG8_SCHED
}
}
using pg8::Unit;

struct Params {
    const float* in[21];
    float* out;
    unsigned char* ws;
    int ph_lo, ph_hi;
    int use_bar, pad;
};
enum { I_X = 0, I_LN_MIX_E, I_W_IN_E, I_LN_Q, I_W_UQ, I_LN_KV, I_W_UKV, I_B_F, I_W_OUT_E, I_LN_MIX_O, I_W_IN_O, I_W_OUT_O, I_LN_FFN, I_W_RG, I_B_RG, I_W_RE, I_B_RE, I_W_GATE, I_W_UP, I_W_DOWN, I_LN_F };

#define WSP(T_, off) ((T_*)(ws_ + (off)))
typedef const Params __attribute__((address_space(4)))* KParams;
#define P_OPAQUE KParams Pk_ = (KParams)__builtin_amdgcn_kernarg_segment_ptr(); asm volatile("" : "+s"(Pk_)); const Params& P = *(const Params*)Pk_
#define WS_OPAQUE P_OPAQUE; unsigned char* ws_ = P.ws

__device__ __forceinline__ float log2_gamma(int h) { return __builtin_log2f(1.0f - __builtin_exp2f(-5.0f - (float)h)); }

struct DenseSched {
    pg8::DenseOrder O; const char* A; const char* B; size_t astep, bstep;
    __device__ __forceinline__ void init(const void* A_, int lda, const void* B_, int ldb, int nM, int nN, int G, int c) {
        O.init(nM, nN, G, c); A = (const char*)A_; B = (const char*)B_; astep = (size_t)256 * lda * 2; bstep = (size_t)256 * ldb * 2; }
    __device__ __forceinline__ bool next(int i, Unit& u) const { return O.tile(i, u); }
    __device__ __forceinline__ void ptrs(const Unit& u, const char*& a, const char*& b) const { a = A + (size_t)u.pm * astep; b = B + (size_t)u.pn * bstep; }
};
struct MoeSched {
    const char* A; const char* B; const int* tilee; size_t astep, estep, bstep; int ntile, G, c;
    __device__ __forceinline__ void init(const void* A_, int lda, const void* B_, int ldb, size_t expert_rows, const int* tilee_, int G_, int c_) {
        A = (const char*)A_; B = (const char*)B_; tilee = tilee_; astep = (size_t)256 * lda * 2; bstep = (size_t)256 * ldb * 2; estep = expert_rows * ldb * 2; G = G_; c = c_;
        ntile = __builtin_amdgcn_readfirstlane(ld_i(tilee_ + 300)); }
    __device__ __forceinline__ bool next(int i, Unit& u) const { const int L = i * G + c; if (L >= ntile * 4) return false; u.pm = L >> 2; u.pn = L & 3; u.aux = __builtin_amdgcn_readfirstlane(ld_i(tilee + (L >> 2))); return true; }
    __device__ __forceinline__ void ptrs(const Unit& u, const char*& a, const char*& b) const { a = A + (size_t)u.pm * astep; b = B + (size_t)u.aux * estep + (size_t)u.pn * bstep; }
};

typedef const f32x4 (&AccRef)[2][2][4][2];
#define EPI_LOOP_AI_M for (int ai = 0; ai < 2; ++ai) _Pragma("unroll") for (int m = 0; m < 4; ++m)
#define EPI_LOOP_BJ_N for (int bj = 0; bj < 2; ++bj) _Pragma("unroll") for (int n = 0; n < 2; ++n)

struct EpiA1a {
    static constexpr bool PERM = false;
    const float* rs0; bf16_t* Z; float* PQ; float* PKV; bf16_t* KA; float* LF; const float* bf; bf16_t* QF; bf16_t* KF; const f32x2* rope;
    __device__ __forceinline__ void operator()(AccRef acc, const Unit& u, int wr, int wc, int fr, int fq) const {
        const int row0 = u.pm * 256 + wr * 64 + fr;
        if (u.pn <= 1) {
            const int zc = u.pn * 256 + wc * 32 + 4 * fq;
#pragma unroll
            EPI_LOOP_AI_M { const int r = row0 + ai * 128 + m * 16; const float rs = rs0[r]; float ss = 0.f; f32x4 v[2][2];
#pragma unroll
                EPI_LOOP_BJ_N { v[bj][n] = acc[ai][bj][m][n] * rs; u32x2 w; w.x = pk2(v[bj][n][0], v[bj][n][1]); w.y = pk2(v[bj][n][2], v[bj][n][3]);
                    *(u32x2*)(Z + (size_t)r * 512 + zc + bj * 128 + n * 16) = w;
                    if (u.pn == 0 || bj == 0) ss += (v[bj][n][0] * v[bj][n][0] + v[bj][n][1] * v[bj][n][1]) + (v[bj][n][2] * v[bj][n][2] + v[bj][n][3] * v[bj][n][3]); }
                ss += __shfl_xor(ss, 16); ss += __shfl_xor(ss, 32);
                if (fq == 0) { if (u.pn == 0) PQ[(size_t)r * 4 + wc] = ss; else PKV[(size_t)r * 4 + wc] = ss; }
                if (u.pn == 1 && wc == 0) {
                    const int pos = r & (S - 1); const f32x4 x1 = v[1][0], x2 = v[1][1]; f32x4 o1, o2;
#pragma unroll
                    for (int j = 0; j < 4; ++j) { const f32x2 cs = rope[(size_t)pos * 128 + 8 * (4 * fq + j)]; o1[j] = x1[j] * cs.x - x2[j] * cs.y; o2[j] = x1[j] * cs.y + x2[j] * cs.x; }
                    u32x2 w1, w2; w1.x = pk2(o1[0], o1[1]); w1.y = pk2(o1[2], o1[3]); w2.x = pk2(o2[0], o2[1]); w2.y = pk2(o2[2], o2[3]);
#pragma unroll
                    for (int hh = 0; hh < 8; ++hh) { bf16_t* kp = KA + (size_t)r * 768 + hh * 96 + 64 + 4 * fq; *(u32x2*)kp = w1; *(u32x2*)(kp + 16) = w2; }
                }
                if (u.pn == 1 && wc == 1 && fq < 2) {
                    const f32x4 f = v[1][0]; f32x4 o;
#pragma unroll
                    for (int j = 0; j < 4; ++j) { const float x = f[j] + bf[4 * fq + j]; o[j] = fminf(x, 0.f) - log1pf(__expf(-fabsf(x))); }
                    *(f32x4*)(LF + (size_t)r * 8 + 4 * fq) = o;
                }
            }
        } else {
            const bool isq = u.pn < 4; bf16_t* dst = isq ? QF : KF; const int cc = (isq ? (u.pn - 2) : (u.pn - 4)) * 256 + wc * 32 + 4 * fq; const float sc = isq ? (0.125f * LOG2E) : 1.0f;
#pragma unroll
            EPI_LOOP_AI_M { const int r = row0 + ai * 128 + m * 16; const float rs = rs0[r] * sc;
#pragma unroll
                EPI_LOOP_BJ_N { const f32x4 v = acc[ai][bj][m][n] * rs; u32x2 w; w.x = pk2(v[0], v[1]); w.y = pk2(v[2], v[3]); *(u32x2*)(dst + (size_t)r * 512 + cc + bj * 128 + n * 16) = w; } }
        }
    }
};
template <int MODE> struct EpiVT {
    static constexpr bool PERM = true;
    const float* rs; bf16_t* OUT; size_t ldo;
    __device__ __forceinline__ float cs(int t) const { if (MODE == 0) return rs[t]; const f32x4 p = *(const f32x4*)(rs + (size_t)t * 4); return rsqrt_f(((p[0] + p[1]) + (p[2] + p[3])) * (1.0f / 128.0f) + EPS); }
    __device__ __forceinline__ void operator()(AccRef acc, const Unit& u, int wr, int wc, int fr, int fq) const {
        const int f0 = u.pm * 256 + wr * 64 + fr, t0 = u.pn * 256 + wc * 32 + 8 * fq;
#pragma unroll
        for (int bj = 0; bj < 2; ++bj) { float c[8];
#pragma unroll
            for (int j = 0; j < 8; ++j) c[j] = cs(t0 + bj * 128 + j);
#pragma unroll
            EPI_LOOP_AI_M { const f32x4 a = acc[ai][bj][m][0], b = acc[ai][bj][m][1]; u32x4 w;
                w.x = pk2(a[0] * c[0], a[1] * c[1]); w.y = pk2(a[2] * c[2], a[3] * c[3]); w.z = pk2(b[0] * c[4], b[1] * c[5]); w.w = pk2(b[2] * c[6], b[3] * c[7]);
                *(u32x4*)(OUT + (size_t)(f0 + ai * 128 + m * 16) * ldo + t0 + bj * 128) = w; }
            asm volatile("" ::: "memory"); }
    }
};
struct EpiA2q {
    static constexpr bool PERM = false;
    const float* PQ; bf16_t* QA; const f32x2* rope;
    __device__ __forceinline__ void operator()(AccRef acc, const Unit& u, int wr, int wc, int fr, int fq) const {
        if (wc == 3) return;
        const int row0 = u.pm * 256 + wr * 64 + fr; const float SCA = 0.10206207261596577f * LOG2E;
#pragma unroll
        EPI_LOOP_AI_M { const int r = row0 + ai * 128 + m * 16; const f32x4 p = *(const f32x4*)(PQ + (size_t)r * 4);
            const float rs = rsqrt_f(((p[0] + p[1]) + (p[2] + p[3])) * (1.0f / 256.0f) + EPS) * SCA; const int pos = r & (S - 1);
#pragma unroll
            for (int bj = 0; bj < 2; ++bj) { const int hh = 2 * u.pn + bj; bf16_t* qp = QA + (size_t)r * 768 + hh * 96 + wc * 32 + 4 * fq; f32x4 x1 = acc[ai][bj][m][0] * rs, x2 = acc[ai][bj][m][1] * rs;
                if (wc == 2) {
#pragma unroll
                    for (int j = 0; j < 4; ++j) { const f32x2 cs = rope[(size_t)pos * 128 + 8 * (4 * fq + j)]; const float a = x1[j], b = x2[j]; x1[j] = a * cs.x - b * cs.y; x2[j] = a * cs.y + b * cs.x; } }
                *(u32x2*)qp = (u32x2){pk2(x1[0], x1[1]), pk2(x1[2], x1[3])}; *(u32x2*)(qp + 16) = (u32x2){pk2(x2[0], x2[1]), pk2(x2[2], x2[3])};
                asm volatile("" ::: "memory"); } }
    }
};
struct EpiA2k {
    static constexpr bool PERM = false;
    const float* PKV; bf16_t* KA;
    __device__ __forceinline__ void operator()(AccRef acc, const Unit& u, int wr, int wc, int fr, int fq) const {
        const int row0 = u.pm * 256 + wr * 64 + fr;
#pragma unroll
        EPI_LOOP_AI_M { const int r = row0 + ai * 128 + m * 16; const f32x4 p = *(const f32x4*)(PKV + (size_t)r * 4);
            const float rs = rsqrt_f(((p[0] + p[1]) + (p[2] + p[3])) * (1.0f / 128.0f) + EPS);
#pragma unroll
            EPI_LOOP_BJ_N { const int hh = 4 * u.pn + 2 * bj + (wc >> 1), dd = 32 * (wc & 1) + 16 * n + 4 * fq; const f32x4 v = acc[ai][bj][m][n] * rs;
                *(u32x2*)(KA + (size_t)r * 768 + hh * 96 + dd) = (u32x2){pk2(v[0], v[1]), pk2(v[2], v[3])}; }
            asm volatile("" ::: "memory"); }
    }
};
struct EpiRes {
    static constexpr bool PERM = false;
    const float* base; float* outp;
    __device__ __forceinline__ void operator()(AccRef acc, const Unit& u, int wr, int wc, int fr, int fq) const {
        const int row0 = u.pm * 256 + wr * 64 + fr, col0 = u.pn * 256 + wc * 32 + 4 * fq;
#pragma unroll
        EPI_LOOP_AI_M { const size_t off = (size_t)(row0 + ai * 128 + m * 16) * D + col0;
#pragma unroll
            EPI_LOOP_BJ_N { const f32x4 b = *(const f32x4*)(base + off + bj * 128 + n * 16); *(f32x4*)(outp + off + bj * 128 + n * 16) = b + acc[ai][bj][m][n]; } }
    }
};
struct EpiB1q {
    static constexpr bool PERM = false;
    const float* rs2; bf16_t* QX; const f32x2* rope;
    __device__ __forceinline__ void operator()(AccRef acc, const Unit& u, int wr, int wc, int fr, int fq) const {
        const int row0 = u.pm * 256 + wr * 64 + fr; const float l2g = log2_gamma(u.pn);
#pragma unroll
        EPI_LOOP_AI_M { const int pos = row0 + ai * 128 + m * 16; const float rs = rs2[pos] * __builtin_exp2f((float)((pos & 63) + 1) * l2g);
#pragma unroll
            for (int n = 0; n < 2; ++n) { const int i0 = wc * 32 + 16 * n + 4 * fq; const f32x4 x1 = acc[ai][0][m][n] * rs, x2 = acc[ai][1][m][n] * rs; f32x4 o1, o2;
                const f32x4 ca = *(const f32x4*)(rope + (size_t)pos * 128 + i0), cb = *(const f32x4*)(rope + (size_t)pos * 128 + i0 + 2);
                const float cc[4] = {ca[0], ca[2], cb[0], cb[2]}, sn[4] = {ca[1], ca[3], cb[1], cb[3]};
#pragma unroll
                for (int j = 0; j < 4; ++j) { o1[j] = x1[j] * cc[j] - x2[j] * sn[j]; o2[j] = x1[j] * sn[j] + x2[j] * cc[j]; }
                u32x2 w1, w2; w1.x = pk2(o1[0], o1[1]); w1.y = pk2(o1[2], o1[3]); w2.x = pk2(o2[0], o2[1]); w2.y = pk2(o2[2], o2[3]);
                bf16_t* qp = QX + (size_t)pos * 1024 + u.pn * 256 + i0; *(u32x2*)qp = w1; *(u32x2*)(qp + 128) = w2; }
            asm volatile("" ::: "memory"); }
    }
};
__device__ __forceinline__ int rho_of_d(int d) { const int lo = d & 31; return (d & ~31) | (((lo >> 2) & 1) << 4) | ((lo >> 3) << 2) | (lo & 3); }
struct EpiB1k {
    static constexpr bool PERM = true;
    const float* rs2; bf16_t* KN; bf16_t* KZT; const f32x2* rope;
    __device__ __forceinline__ void operator()(AccRef acc, const Unit& u, int wr, int wc, int fr, int fq) const {
        const int h = u.pm, t0 = u.pn * 256 + wc * 32 + 8 * fq; const float l2g = log2_gamma(h);
#pragma unroll
        for (int bj = 0; bj < 2; ++bj)
#pragma unroll
            for (int n = 0; n < 2; ++n) { const int tb = t0 + bj * 128 + 4 * n; float rs[4], zt[4];
#pragma unroll
                for (int j = 0; j < 4; ++j) { rs[j] = rs2[tb + j] * 0.0625f; zt[j] = __builtin_exp2f((float)(63 - ((tb + j) & 63)) * l2g); }
                const int chunk = tb >> 6, c0 = tb & 63;
#pragma unroll
                for (int m = 0; m < 4; ++m) { const int d = wr * 64 + m * 16 + fr; float k1[4], k2[4];
#pragma unroll
                    for (int j = 0; j < 4; ++j) { const f32x2 cs = rope[(size_t)(tb + j) * 128 + d]; const float x1 = acc[0][bj][m][n][j] * rs[j], x2 = acc[1][bj][m][n][j] * rs[j];
                        k1[j] = x1 * cs.x - x2 * cs.y; k2[j] = x1 * cs.y + x2 * cs.x;
                        KN[(size_t)(tb + j) * 1024 + h * 256 + d] = (bf16_t)f2bf(k1[j]); KN[(size_t)(tb + j) * 1024 + h * 256 + 128 + d] = (bf16_t)f2bf(k2[j]); }
                    const int rho = rho_of_d(d); u32x2 w1, w2;
                    w1.x = pk2(k1[0] * zt[0], k1[1] * zt[1]); w1.y = pk2(k1[2] * zt[2], k1[3] * zt[3]); w2.x = pk2(k2[0] * zt[0], k2[1] * zt[1]); w2.y = pk2(k2[2] * zt[2], k2[3] * zt[3]);
                    bf16_t* zp = KZT + (((size_t)(h * 256 + chunk) * 256 + rho) * 64 + c0); *(u32x2*)zp = w1; *(u32x2*)(zp + 128 * 64) = w2;
                    asm volatile("" ::: "memory"); } }
    }
};
struct EpiB1v {
    static constexpr bool PERM = true;
    const float* rs2; bf16_t* VT;
    __device__ __forceinline__ void operator()(AccRef acc, const Unit& u, int wr, int wc, int fr, int fq) const {
        const int h = u.pm >> 1, e0 = (u.pm & 1) * 256 + wr * 64 + fr, t0 = u.pn * 256 + wc * 32 + 8 * fq;
#pragma unroll
        for (int bj = 0; bj < 2; ++bj) { const int tb = t0 + bj * 128; float c[8];
#pragma unroll
            for (int j = 0; j < 8; ++j) c[j] = rs2[tb + j];
            const int chunk = tb >> 6, c0 = tb & 63;
#pragma unroll
            EPI_LOOP_AI_M { const f32x4 a = acc[ai][bj][m][0], b = acc[ai][bj][m][1]; u32x4 w;
                w.x = pk2(a[0] * c[0], a[1] * c[1]); w.y = pk2(a[2] * c[2], a[3] * c[3]); w.z = pk2(b[0] * c[4], b[1] * c[5]); w.w = pk2(b[2] * c[6], b[3] * c[7]);
                *(u32x4*)(VT + (((size_t)(h * 256 + chunk) * 512 + e0 + ai * 128 + m * 16) * 64 + c0)) = w; } }
    }
};
struct EpiG {
    static constexpr bool PERM = true;
    const float* rs2; const float* PO; bf16_t* O;
    __device__ __forceinline__ void operator()(AccRef acc, const Unit& u, int wr, int wc, int fr, int fq) const {
        const int row0 = u.pm * 256 + wr * 64 + fr, col0 = u.pn * 256 + wc * 32 + 8 * fq, head = u.pn >> 1;
#pragma unroll
        EPI_LOOP_AI_M { const int r = row0 + ai * 128 + m * 16; const f32x4 p = *(const f32x4*)(PO + (size_t)r * 16 + head * 4);
            const float ro = rsqrt_f(((p[0] + p[1]) + (p[2] + p[3])) * (1.0f / 512.0f) + EPS), rs = rs2[r];
#pragma unroll
            for (int bj = 0; bj < 2; ++bj) { bf16_t* op = O + (size_t)r * 2048 + col0 + bj * 128; const u32x4 ov = *(const u32x4*)op; float o[8] = {bflo(ov.x), bfhi(ov.x), bflo(ov.y), bfhi(ov.y), bflo(ov.z), bfhi(ov.z), bflo(ov.w), bfhi(ov.w)}; float a[8];
#pragma unroll
                for (int j = 0; j < 8; ++j) { const float g = acc[ai][bj][m][j >> 2][j & 3] * rs; a[j] = o[j] * ro * g / (1.0f + __expf(-g)); }
                u32x4 w; w.x = pk2(a[0], a[1]); w.y = pk2(a[2], a[3]); w.z = pk2(a[4], a[5]); w.w = pk2(a[6], a[7]); *(u32x4*)op = w; }
            asm volatile("" ::: "memory"); }
    }
};
struct EpiM3 {
    static constexpr bool PERM = true;
    const float* SR; bf16_t* HID;
    __device__ __forceinline__ void operator()(AccRef acc, const Unit& u, int wr, int wc, int fr, int fq) const {
        const int row0 = u.pm * 256 + wr * 64 + fr, col0 = u.pn * 128 + wc * 32 + 8 * fq;
#pragma unroll
        EPI_LOOP_AI_M { const int r = row0 + ai * 128 + m * 16; const float rs = SR[r]; float hh[8];
#pragma unroll
            for (int j = 0; j < 8; ++j) { const float g = acc[ai][0][m][j >> 2][j & 3] * rs, up = acc[ai][1][m][j >> 2][j & 3] * rs; hh[j] = g / (1.0f + __expf(-g)) * up; }
            u32x4 w; w.x = pk2(hh[0], hh[1]); w.y = pk2(hh[2], hh[3]); w.z = pk2(hh[4], hh[5]); w.w = pk2(hh[6], hh[7]); *(u32x4*)(HID + (size_t)r * 512 + col0) = w; }
    }
};
struct EpiM4 {
    static constexpr bool PERM = true;
    const float* SW; bf16_t* YS;
    __device__ __forceinline__ void operator()(AccRef acc, const Unit& u, int wr, int wc, int fr, int fq) const {
        const int row0 = u.pm * 256 + wr * 64 + fr, col0 = u.pn * 256 + wc * 32 + 8 * fq;
#pragma unroll
        EPI_LOOP_AI_M { const int r = row0 + ai * 128 + m * 16; const float sw = SW[r];
#pragma unroll
            for (int bj = 0; bj < 2; ++bj) { const f32x4 a = acc[ai][bj][m][0] * sw, b = acc[ai][bj][m][1] * sw; u32x4 w; w.x = pk2(a[0], a[1]); w.y = pk2(a[2], a[3]); w.z = pk2(b[0], b[1]); w.w = pk2(b[2], b[3]);
                *(u32x4*)(YS + (size_t)r * 1024 + col0 + bj * 128) = w; } }
    }
};

__device__ __forceinline__ int crow(int r, int hi) { return (r & 3) + 8 * (r >> 2) + 4 * hi; }
template <int DQK, bool FOX>
__device__ __forceinline__ void attn_unit(int wave_, LAS unsigned char* L, const bf16_t* Qb, int ldq, const bf16_t* Kb, int ldk, const bf16_t* Vtb, const float* cum, bf16_t* Ob, int ldo, int qb) {
    constexpr int KP = DQK + 8, KBYTES = 64 * KP * 2, VBYTES = 64 * 136, BUF = KBYTES + VBYTES + 256, NS = DQK / 16, KCH = DQK / 8;
    const int tid = wave_ * 64 + lane_id_opaque();
    const int lane = tid & 63, w = __builtin_amdgcn_readfirstlane(tid >> 6), r32 = lane & 31, hi = lane >> 5;
    const int R0 = 256 * qb + 32 * w, q = R0 + r32, NT = 4 * qb + 4, jmax = 4 * qb + (w >> 1);
    bf16x8 qf[NS];
#pragma unroll
    for (int s = 0; s < NS; ++s) qf[s] = *(const bf16x8*)(Qb + (size_t)q * ldq + 16 * s + 8 * hi);
    const float cq = FOX ? cum[q] : 0.f;
    f32x16 o0 = {}, o1 = {}; float mrun = -1e30f, lrun = 0.f;
    const int kr0 = tid / KCH, kc0 = tid % KCH, kr1 = (tid + 512) / KCH, kc1 = (tid + 512) % KCH; const bool has1 = (tid + 512) < 64 * KCH;
    const int ve = tid >> 3, vc = tid & 7;
    u32x4 kreg0, kreg1 = {}, vreg; float ckreg = 0.f;
#define ATT_LOAD(j) do { kreg0 = *(const u32x4*)(Kb + (size_t)(64 * (j) + kr0) * ldk + kc0 * 8); if (has1) kreg1 = *(const u32x4*)(Kb + (size_t)(64 * (j) + kr1) * ldk + kc1 * 8); \
        vreg = *(const u32x4*)(Vtb + (size_t)ve * T + 64 * (j) + vc * 8); if (FOX && tid < 64) ckreg = cum[64 * (j) + tid]; } while (0)
#define ATT_WRITE(bo) do { *(LAS u32x4*)(L + (bo) + kr0 * (KP * 2) + kc0 * 16) = kreg0; if (has1) *(LAS u32x4*)(L + (bo) + kr1 * (KP * 2) + kc1 * 16) = kreg1; \
        *(LAS u32x2*)(L + (bo) + KBYTES + ve * 136 + vc * 16) = (u32x2){vreg.x, vreg.y}; *(LAS u32x2*)(L + (bo) + KBYTES + ve * 136 + vc * 16 + 8) = (u32x2){vreg.z, vreg.w}; \
        if (FOX && tid < 64) *(LAS float*)(L + (bo) + KBYTES + VBYTES + tid * 4) = ckreg; } while (0)
    ATT_LOAD(0); ATT_WRITE(0); __syncthreads();
    for (int j = 0; j < NT; ++j) {
        const int bo = (j & 1) * BUF, bn = ((j + 1) & 1) * BUF;
        if (j + 1 < NT) ATT_LOAD(j + 1);
        if (j <= jmax) {
            f32x16 p0 = {}, p1 = {};
#pragma unroll
            for (int s = 0; s < NS; ++s) { const bf16x8 k0 = *(const LAS bf16x8*)(L + bo + r32 * (KP * 2) + (16 * s + 8 * hi) * 2), k1 = *(const LAS bf16x8*)(L + bo + (32 + r32) * (KP * 2) + (16 * s + 8 * hi) * 2);
                p0 = __builtin_amdgcn_mfma_f32_32x32x16_bf16(k0, qf[s], p0, 0, 0, 0); p1 = __builtin_amdgcn_mfma_f32_32x32x16_bf16(k1, qf[s], p1, 0, 0, 0); }
            if (FOX) {
#pragma unroll
                for (int g = 0; g < 4; ++g) { const f32x4 c0 = *(const LAS f32x4*)(L + bo + KBYTES + VBYTES + (8 * g + 4 * hi) * 4), c1 = *(const LAS f32x4*)(L + bo + KBYTES + VBYTES + (32 + 8 * g + 4 * hi) * 4);
#pragma unroll
                    for (int e = 0; e < 4; ++e) { p0[4 * g + e] += cq - c0[e]; p1[4 * g + e] += cq - c1[e]; } }
                if (j == jmax) {
#pragma unroll
                    for (int r = 0; r < 16; ++r) { const int kg = 64 * j + crow(r, hi); if (kg > q) p0[r] = -1e30f; if (kg + 32 > q) p1[r] = -1e30f; } }
            }
            float mx = fmaxf(p0[0], p1[0]);
#pragma unroll
            for (int r = 1; r < 16; ++r) mx = fmaxf(mx, fmaxf(p0[r], p1[r]));
            mx = fmaxf(mx, __shfl_xor(mx, 32));
            const float mnew = fmaxf(mrun, mx), alpha = __builtin_amdgcn_exp2f(mrun - mnew); mrun = mnew;
            float ls = 0.f;
#pragma unroll
            for (int r = 0; r < 16; ++r) { p0[r] = __builtin_amdgcn_exp2f(p0[r] - mnew); p1[r] = __builtin_amdgcn_exp2f(p1[r] - mnew); ls += p0[r] + p1[r]; }
            lrun = lrun * alpha + ls;
#pragma unroll
            for (int r = 0; r < 16; ++r) { o0[r] *= alpha; o1[r] *= alpha; }
            u32x4 pw[4];
#pragma unroll
            for (int ks = 0; ks < 4; ++ks) { const int b = 8 * (ks & 1);
                if (ks < 2) pw[ks] = (u32x4){pk2(p0[b], p0[b + 1]), pk2(p0[b + 2], p0[b + 3]), pk2(p0[b + 4], p0[b + 5]), pk2(p0[b + 6], p0[b + 7])};
                else        pw[ks] = (u32x4){pk2(p1[b], p1[b + 1]), pk2(p1[b + 2], p1[b + 3]), pk2(p1[b + 4], p1[b + 5]), pk2(p1[b + 6], p1[b + 7])}; }
#pragma unroll
            for (int ks = 0; ks < 4; ++ks) {
                const LAS unsigned char* vb = L + bo + KBYTES + r32 * 136 + 32 * ks + 8 * hi;
                const u32x2 a0 = *(const LAS u32x2*)(vb), a1 = *(const LAS u32x2*)(vb + 16), b0 = *(const LAS u32x2*)(vb + 32 * 136), b1 = *(const LAS u32x2*)(vb + 32 * 136 + 16);
                const bf16x8 va = __builtin_bit_cast(bf16x8, (u32x4){a0.x, a0.y, a1.x, a1.y}), vbb = __builtin_bit_cast(bf16x8, (u32x4){b0.x, b0.y, b1.x, b1.y}), pf = __builtin_bit_cast(bf16x8, pw[ks]);
                o0 = __builtin_amdgcn_mfma_f32_32x32x16_bf16(va, pf, o0, 0, 0, 0); o1 = __builtin_amdgcn_mfma_f32_32x32x16_bf16(vbb, pf, o1, 0, 0, 0); }
        }
        if (j + 1 < NT) ATT_WRITE(bn);
        __syncthreads();
    }
#undef ATT_LOAD
#undef ATT_WRITE
    const float inv = 1.0f / (lrun + __shfl_xor(lrun, 32));
    bf16_t* op = Ob + (size_t)q * ldo + 4 * hi;
#pragma unroll
    for (int g = 0; g < 4; ++g) { u32x2 w0, w1; w0.x = pk2(o0[4 * g] * inv, o0[4 * g + 1] * inv); w0.y = pk2(o0[4 * g + 2] * inv, o0[4 * g + 3] * inv);
        w1.x = pk2(o1[4 * g] * inv, o1[4 * g + 1] * inv); w1.y = pk2(o1[4 * g + 2] * inv, o1[4 * g + 3] * inv);
        *(u32x2*)(op + 8 * g) = w0; *(u32x2*)(op + 32 + 8 * g) = w1; }
}

constexpr int RT_KZP = 144;
constexpr int RT_QP = 528;
constexpr int RT_OFF_KZ = 0, RT_OFF_Q = 256 * RT_KZP, RT_OFF_K = RT_OFF_Q + 64 * RT_QP, RT_OFF_P = RT_OFF_K + 64 * RT_QP, RT_OFF_SS = RT_OFF_P + 64 * RT_KZP, RT_LDS = RT_OFF_SS + 64 * 8 * 4;
static_assert(RT_LDS <= 131072, "retention LDS");

__device__ __forceinline__ void ret_local(int wave_, LAS unsigned char* L, const bf16_t* KZT, const bf16_t* VT, f32x4* Lout, int u) {
    const int tid = wave_ * 64 + lane_id_opaque();
    const int lane = tid & 63, w = __builtin_amdgcn_readfirstlane(tid >> 6), l15 = lane & 15, g = lane >> 4;
    const int h = u >> 6, seg = (u >> 2) & 15, eb = u & 3, E0 = eb * 128 + w * 16;
    const float gc = __builtin_exp2f(64.0f * log2_gamma(h));
    f32x4 st[16];
#pragma unroll
    for (int i = 0; i < 16; ++i) st[i] = (f32x4){0.f, 0.f, 0.f, 0.f};
    u32x4 kz[4];
    const bf16_t* kzb = KZT + (size_t)(h * 256 + seg * SEGC) * 256 * 64;
#define R1_LOAD(ci) do { _Pragma("unroll") for (int i = 0; i < 4; ++i) kz[i] = *(const u32x4*)(kzb + (size_t)(ci) * 16384 + (size_t)(tid + 512 * i) * 8); } while (0)
#define R1_WRITE() do { _Pragma("unroll") for (int i = 0; i < 4; ++i) { const int id = tid + 512 * i; *(LAS u32x4*)(L + RT_OFF_KZ + (id >> 3) * RT_KZP + (id & 7) * 16) = kz[i]; } } while (0)
    R1_LOAD(0);
    for (int ci = 0; ci < SEGC; ++ci) {
        R1_WRITE(); __syncthreads();
        if (ci + 1 < SEGC) R1_LOAD(ci + 1);
        const bf16_t* vp = VT + ((size_t)(h * 256 + seg * SEGC + ci) * 512 + E0 + l15) * 64 + 8 * g;
        const bf16x8 vf0 = *(const bf16x8*)vp, vf1 = *(const bf16x8*)(vp + 32);
        if (ci > 0) {
#pragma unroll
            for (int i = 0; i < 16; ++i) st[i] *= gc; }
#pragma unroll
        for (int dt = 0; dt < 16; ++dt) { const LAS unsigned char* ap = L + RT_OFF_KZ + (16 * dt + l15) * RT_KZP + 16 * g;
            st[dt] = __builtin_amdgcn_mfma_f32_16x16x32_bf16(*(const LAS bf16x8*)ap, vf0, st[dt], 0, 0, 0);
            st[dt] = __builtin_amdgcn_mfma_f32_16x16x32_bf16(*(const LAS bf16x8*)(ap + 64), vf1, st[dt], 0, 0, 0); }
        __syncthreads();
    }
#undef R1_LOAD
#undef R1_WRITE
    f32x4* lo = Lout + ((size_t)(u * 8 + w) * 16) * 64 + lane;
#pragma unroll
    for (int dt = 0; dt < 16; ++dt) lo[dt * 64] = st[dt];
}

__device__ __forceinline__ void ret_scan(int wave_, LAS unsigned char* L, const bf16_t* QX, const bf16_t* KN, const bf16_t* KZT, const bf16_t* VT, const f32x4* Lin, bf16_t* O  , float* PO  , int u) {
    const int tid = wave_ * 64 + lane_id_opaque();
    const int lane = tid & 63, w = __builtin_amdgcn_readfirstlane(tid >> 6), l15 = lane & 15, g = lane >> 4;
    const int h = u >> 6, seg = (u >> 2) & 15, eb = u & 3, E0 = eb * 128 + w * 16;
    const float l2g = log2_gamma(h), gc = __builtin_exp2f(64.0f * l2g);
    f32x4 st[16];
#pragma unroll
    for (int i = 0; i < 16; ++i) st[i] = (f32x4){0.f, 0.f, 0.f, 0.f};
    for (int j = 0; j < seg; ++j) { const float wj = __builtin_exp2f((float)(64 * SEGC * (seg - 1 - j)) * l2g); const int uj = (u & ~(15 << 2)) | (j << 2);
        const f32x4* li = Lin + ((size_t)(uj * 8 + w) * 16) * 64 + lane;
#pragma unroll
        for (int dt = 0; dt < 16; ++dt) st[dt] += li[dt * 64] * wj; }
    u32x4 kz[4], qx[4], kn[4];
    const bf16_t* kzb = KZT + (size_t)(h * 256 + seg * SEGC) * 256 * 64;
    const bf16_t* qb = QX + (size_t)(seg * SEGC * 64) * 1024 + h * 256; const bf16_t* kb = KN + (size_t)(seg * SEGC * 64) * 1024 + h * 256;
#define R2_LOADKZ(ci) do { _Pragma("unroll") for (int i = 0; i < 4; ++i) { const int id = tid + 512 * i; kz[i] = *(const u32x4*)(kzb + (size_t)(ci) * 16384 + (size_t)id * 8); } } while (0)
#define R2_LOADQK(ci) do { _Pragma("unroll") for (int i = 0; i < 4; ++i) { const int id = tid + 512 * i; \
        qx[i] = *(const u32x4*)(qb + (size_t)((ci) * 64 + (id >> 5)) * 1024 + (id & 31) * 8); kn[i] = *(const u32x4*)(kb + (size_t)((ci) * 64 + (id >> 5)) * 1024 + (id & 31) * 8); } } while (0)
#define R2_WRITE() do { _Pragma("unroll") for (int i = 0; i < 4; ++i) { const int id = tid + 512 * i; *(LAS u32x4*)(L + RT_OFF_KZ + (id >> 3) * RT_KZP + (id & 7) * 16) = kz[i]; \
        *(LAS u32x4*)(L + RT_OFF_Q + (id >> 5) * RT_QP + (id & 31) * 16) = qx[i]; *(LAS u32x4*)(L + RT_OFF_K + (id >> 5) * RT_QP + (id & 31) * 16) = kn[i]; } } while (0)
    R2_LOADKZ(0); R2_LOADQK(0);
    const int tr = w >> 1;
    for (int ci = 0; ci < SEGC; ++ci) {
        R2_WRITE(); __syncthreads();
        if (ci + 1 < SEGC) R2_LOADKZ(ci + 1);
        const int chunk = seg * SEGC + ci;
        const bf16_t* vp = VT + ((size_t)(h * 256 + chunk) * 512 + E0 + l15) * 64 + 8 * g;
        const bf16x8 vf0 = *(const bf16x8*)vp, vf1 = *(const bf16x8*)(vp + 32);
#pragma unroll
        for (int t2 = 0; t2 < 2; ++t2) { const int tc = 2 * (w & 1) + t2; f32x4 pa = {0.f, 0.f, 0.f, 0.f};
            if (tc <= tr) {
#pragma unroll
                for (int ks = 0; ks < 8; ++ks) pa = __builtin_amdgcn_mfma_f32_16x16x32_bf16(*(const LAS bf16x8*)(L + RT_OFF_Q + (16 * tr + l15) * RT_QP + 64 * ks + 16 * g),
                                                                                           *(const LAS bf16x8*)(L + RT_OFF_K + (16 * tc + l15) * RT_QP + 64 * ks + 16 * g), pa, 0, 0, 0);
                const int cp = 16 * tc + l15; const float dk = __builtin_exp2f(-(float)(cp + 1) * l2g);
#pragma unroll
                for (int r = 0; r < 4; ++r) { const int c = 16 * tr + 4 * g + r; pa[r] = (c >= cp) ? pa[r] * dk : 0.f; } }
#pragma unroll
            for (int r = 0; r < 4; ++r) *(LAS bf16_t*)(L + RT_OFF_P + (16 * tr + 4 * g + r) * RT_KZP + (16 * tc + l15) * 2) = (bf16_t)f2bf(pa[r]); }
        __syncthreads();
        bf16x8 sb[8];
#pragma unroll
        for (int ks = 0; ks < 8; ++ks) sb[ks] = __builtin_bit_cast(bf16x8, (u32x4){pk2(st[2 * ks][0], st[2 * ks][1]), pk2(st[2 * ks][2], st[2 * ks][3]), pk2(st[2 * ks + 1][0], st[2 * ks + 1][1]), pk2(st[2 * ks + 1][2], st[2 * ks + 1][3])});
#pragma unroll
        for (int mt = 0; mt < 4; ++mt) { f32x4 oa = {0.f, 0.f, 0.f, 0.f};
#pragma unroll
            for (int ks = 0; ks < 8; ++ks) oa = __builtin_amdgcn_mfma_f32_16x16x32_bf16(*(const LAS bf16x8*)(L + RT_OFF_Q + (16 * mt + l15) * RT_QP + 64 * ks + 16 * g), sb[ks], oa, 0, 0, 0);
            oa = __builtin_amdgcn_mfma_f32_16x16x32_bf16(*(const LAS bf16x8*)(L + RT_OFF_P + (16 * mt + l15) * RT_KZP + 16 * g), vf0, oa, 0, 0, 0);
            oa = __builtin_amdgcn_mfma_f32_16x16x32_bf16(*(const LAS bf16x8*)(L + RT_OFF_P + (16 * mt + l15) * RT_KZP + 64 + 16 * g), vf1, oa, 0, 0, 0);
#pragma unroll
            for (int r = 0; r < 4; ++r) { const int c = 16 * mt + 4 * g + r; O[(size_t)(chunk * 64 + c) * 2048 + h * 512 + E0 + l15] = (bf16_t)f2bf(oa[r]);
                float ss = oa[r] * oa[r]; ss += __shfl_xor(ss, 1); ss += __shfl_xor(ss, 2); ss += __shfl_xor(ss, 4); ss += __shfl_xor(ss, 8);
                if (l15 == 0) *(LAS float*)(L + RT_OFF_SS + (c * 8 + w) * 4) = ss; } }
        if (ci + 1 < SEGC) R2_LOADQK(ci + 1);
#pragma unroll
        for (int i = 0; i < 16; ++i) st[i] *= gc;
#pragma unroll
        for (int dt = 0; dt < 16; ++dt) { const LAS unsigned char* ap = L + RT_OFF_KZ + (16 * dt + l15) * RT_KZP + 16 * g;
            st[dt] = __builtin_amdgcn_mfma_f32_16x16x32_bf16(*(const LAS bf16x8*)ap, vf0, st[dt], 0, 0, 0);
            st[dt] = __builtin_amdgcn_mfma_f32_16x16x32_bf16(*(const LAS bf16x8*)(ap + 64), vf1, st[dt], 0, 0, 0); }
        __syncthreads();
        if (tid < 64) { const LAS float* sp = (const LAS float*)(L + RT_OFF_SS + tid * 32); float s = 0.f;
#pragma unroll
            for (int i = 0; i < 8; ++i) s += sp[i];
            PO[(size_t)(chunk * 64 + tid) * 16 + h * 4 + eb] = s; }
    }
#undef R2_LOADKZ
#undef R2_LOADQK
#undef R2_WRITE
}

struct Ctx { int wave, vcu, G, gw, ngw; LAS unsigned char* lds; };
#define CTX_LANE const int lane_ = lane_id_opaque(), tid_ = C.wave * 64 + lane_

__device__ __forceinline__ void tr_item(const float* W, int ldw, int k0, int n0, int nvalid, const float* gain, bf16_t* dst, int ldd, LAS float* scr, int lane) {
#pragma unroll 8
    for (int i = 0; i < 32; ++i) { const int kk = 2 * i + (lane >> 5), nn = lane & 31; float v = (nn < nvalid) ? W[(size_t)(k0 + kk) * ldw + n0 + nn] : 0.f; if (gain) v *= gain[k0 + kk]; scr[kk * 33 + nn] = v; }
    asm volatile("s_waitcnt lgkmcnt(0)" ::: "memory");
    const int c = lane & 7;
#pragma unroll
    for (int j = 0; j < 4; ++j) { const int n = (lane >> 3) + 8 * j; const LAS float* s = scr + (8 * c) * 33 + n;
        u32x4 o; o.x = pk2(s[0], s[33]); o.y = pk2(s[2 * 33], s[3 * 33]); o.z = pk2(s[4 * 33], s[5 * 33]); o.w = pk2(s[6 * 33], s[7 * 33]);
        if (n < nvalid) *(u32x4*)(dst + (size_t)n * ldd + 8 * c) = o; }
    asm volatile("s_waitcnt lgkmcnt(0)" ::: "memory");
}
__device__ __forceinline__ void zero_rows(const Ctx& C, bf16_t* base, size_t pitch_el, int nrows, int col0, int ncol) {
    CTX_LANE;
    const int per = ncol / 8; const long n = (long)nrows * per;
    for (long i = (long)C.gw * 64 + lane_; i < n; i += (long)C.ngw * 64) { const long r = i / per; const int c = (int)(i % per); *(u32x4*)(base + (size_t)r * pitch_el + col0 + c * 8) = (u32x4){0u, 0u, 0u, 0u}; }
}
__device__ __forceinline__ void convert_moe(const Ctx& C, const Params&, int layer) {
    CTX_LANE;
    WS_OPAQUE;
    LAS float* scr = (LAS float*)(C.lds + C.wave * 16384);
    bf16_t* GU = WSP(bf16_t, OFF_WGU); bf16_t* DN = WSP(bf16_t, OFF_WDN); const float* gain = P.in[I_LN_FFN] + layer * 1024;
    for (int it = C.gw; it < 32 * 768; it += C.ngw) { const int e = it / 768, r = it % 768;
        if (r < 512) { const int up = r >> 8, rr = r & 255, kb = rr >> 4, nb = rr & 15, n0 = 32 * nb; const float* W = (up ? P.in[I_W_UP] : P.in[I_W_GATE]) + (size_t)(layer * 32 + e) * 1024 * 512;
            const int drow = 256 * (n0 >> 7) + (n0 & 127) + up * 128;
            tr_item(W, 512, 64 * kb, n0, 32, gain, GU + ((size_t)(e * 1024 + drow) * 1024 + 64 * kb), 1024, scr, lane_); }
        else { const int rr = r - 512, kb = rr >> 5, nb = rr & 31; const float* W = P.in[I_W_DOWN] + (size_t)(layer * 32 + e) * 512 * 1024;
            tr_item(W, 1024, 64 * kb, 32 * nb, 32, nullptr, DN + ((size_t)(e * 1024 + 32 * nb) * 512 + 64 * kb), 512, scr, lane_); } }
}
__device__ __forceinline__ void convert_mixer(const Ctx& C, const Params&) {
    CTX_LANE;
    WS_OPAQUE;
    LAS float* scr = (LAS float*)(C.lds + C.wave * 16384);
    bf16_t* WA1 = WSP(bf16_t, W_A1); bf16_t* WA1V = WSP(bf16_t, W_A1V); bf16_t* WA2 = WSP(bf16_t, W_A2); bf16_t* WA2V = WSP(bf16_t, W_A2V);
    bf16_t* WOE = WSP(bf16_t, W_OE); bf16_t* WB1 = WSP(bf16_t, W_B1); bf16_t* WOO = WSP(bf16_t, W_OO);
    constexpr int N1 = 16 * 62, N2 = 4 * 24, N3 = 2 * 32, N4 = 16 * 32, N5 = 16 * 192, N6 = 32 * 32, NT_ = N1 + N2 + N3 + N4 + N5 + N6;
    for (int it = C.gw; it < NT_; it += C.ngw) { int r = it;
        if (r < N1) { const int kb = r / 62, nb = r % 62, n0 = 32 * nb, k0 = 64 * kb; bf16_t* dst; int nv = 32;
            if (n0 < 416) dst = WA1 + (size_t)n0 * 1024; else if (n0 < 928) dst = WA1 + (size_t)(512 + n0 - 416) * 1024; else if (n0 < 1440) dst = WA1 + (size_t)(1024 + n0 - 928) * 1024;
            else if (n0 < 1952) dst = WA1V + (size_t)(n0 - 1440) * 1024; else { dst = WA1 + (size_t)416 * 1024; nv = 8; }
            tr_item(P.in[I_W_IN_E], 1960, k0, n0, nv, P.in[I_LN_MIX_E], dst + k0, 1024, scr, lane_); continue; } r -= N1;
        if (r < N2) { const int kb = r / 24, nb = r % 24, n0 = 32 * nb, hh = n0 / 96, off = n0 % 96;
            tr_item(P.in[I_W_UQ], 768, 64 * kb, n0, 32, P.in[I_LN_Q], WA2 + (size_t)(128 * hh + off) * 256 + 64 * kb, 256, scr, lane_); continue; } r -= N2;
        if (r < N3) { const int kb = r / 32, nb = r % 32, n0 = 32 * nb, hh = n0 / 128, off = n0 % 128;
            bf16_t* dst = off < 64 ? WA2 + (size_t)(1024 + 64 * hh + off) * 256 : WA2V + (size_t)(64 * hh + off - 64) * 256;
            tr_item(P.in[I_W_UKV], 1024, 64 * kb, n0, 32, P.in[I_LN_KV], dst + 64 * kb, 256, scr, lane_); continue; } r -= N3;
        if (r < N4) { const int kb = r / 32, nb = r % 32; tr_item(P.in[I_W_OUT_E], 1024, 64 * kb, 32 * nb, 32, nullptr, WOE + (size_t)(32 * nb) * 1024 + 64 * kb, 1024, scr, lane_); continue; } r -= N4;
        if (r < N5) { const int kb = r / 192, nb = r % 192; tr_item(P.in[I_W_IN_O], 6144, 64 * kb, 32 * nb, 32, P.in[I_LN_MIX_O], WB1 + (size_t)(32 * nb) * 1024 + 64 * kb, 1024, scr, lane_); continue; } r -= N5;
        { const int kb = r / 32, nb = r % 32; tr_item(P.in[I_W_OUT_O], 1024, 64 * kb, 32 * nb, 32, nullptr, WOO + (size_t)(32 * nb) * 2048 + 64 * kb, 2048, scr, lane_); } }
    zero_rows(C, WA1 + (size_t)424 * 1024, 1024, 88, 0, 1024);
    for (int hh = 0; hh < 8; ++hh) zero_rows(C, WA2 + (size_t)(128 * hh + 96) * 256, 256, 32, 0, 256);
    zero_rows(C, WA2 + (size_t)1024 * 256, 256, 512, 128, 128);
    zero_rows(C, WA2V, 256, 512, 128, 128);
}
__device__ __forceinline__ void make_rope(const Ctx& C, const Params&) {
    CTX_LANE;
    WS_OPAQUE;
    f32x2* rope = WSP(f32x2, OFF_ROPE);
    for (int i = C.gw * 64 + lane_; i < S * 128; i += C.ngw * 64) { const int pos = i >> 7, k = i & 127; const float inv = __builtin_exp2f(-(float)k * (13.287712379549449f / 128.0f));
        const float ang = (float)pos * inv; const double a = (double)ang; rope[i] = (f32x2){(float)cos(a), (float)sin(a)}; }
}
__device__ __forceinline__ void rows_to_bf16(const Ctx& C, const float* X, bf16_t* XB, float* RS) {
    CTX_LANE;
    for (int r = C.gw; r < T; r += C.ngw) { const f32x4* xr = (const f32x4*)(X + (size_t)r * D) + lane_; f32x4 v[4]; float s = 0.f;
#pragma unroll
        for (int j = 0; j < 4; ++j) { v[j] = xr[64 * j]; s += (v[j][0] * v[j][0] + v[j][1] * v[j][1]) + (v[j][2] * v[j][2] + v[j][3] * v[j][3]); }
        s = wave_sum(s); u32x2* o = (u32x2*)(XB + (size_t)r * D) + lane_;
#pragma unroll
        for (int j = 0; j < 4; ++j) o[64 * j] = (u32x2){pk2(v[j][0], v[j][1]), pk2(v[j][2], v[j][3])};
        if (lane_ == 0) RS[r] = rsqrt_f(s * (1.0f / D) + EPS); }
}
__device__ __forceinline__ void fox_cumsum(const Ctx& C, const float* LF, float* CUM, int bh) {
    CTX_LANE;
    LAS float* tot = (LAS float*)C.lds; const int b = bh >> 3, h = bh & 7; float v[32]; float run = 0.f;
#pragma unroll
    for (int i = 0; i < 32; ++i) { run += LF[((size_t)b * S + tid_ * 32 + i) * 8 + h]; v[i] = run; }
    tot[tid_] = run; __syncthreads();
    float off = 0.f; for (int t2 = 0; t2 < tid_; ++t2) off += tot[t2];
#pragma unroll
    for (int i = 0; i < 32; ++i) CUM[(size_t)bh * S + tid_ * 32 + i] = (off + v[i]) * LOG2E;
    __syncthreads();
}
__device__ __forceinline__ void moe_router(const Ctx& C, const Params&, int layer, int blk) {
    CTX_LANE;
    WS_OPAQUE;
    const float* XF = P.out; bf16_t* XB = WSP(bf16_t, OFF_XB); float* RS1 = WSP(float, SM_RS1);
    int* EID = WSP(int, SM_EID); float* GATE = WSP(float, SM_GATE); int* RANK = WSP(int, SM_RANK); int* CNT = WSP(int, SM_CNT);
    const float* wrg = P.in[I_W_RG] + (size_t)layer * 1024 * 4; const float* wre = P.in[I_W_RE] + (size_t)layer * 1024 * 32; const float* lnf = P.in[I_LN_FFN] + layer * 1024;
    LAS float* lg = (LAS float*)C.lds;
    LAS float* rsl = (LAS float*)(C.lds + 128 * 40 * 4);
    LAS int* eidl = (LAS int*)(C.lds + 128 * 40 * 4 + 512);
    float wv[5][16];
#pragma unroll
    for (int i = 0; i < 5; ++i) { const int o = C.wave + 8 * i; const int oc = o < 36 ? o : 35; const float* wp = oc < 4 ? wrg + oc : wre + (oc - 4); const int wst = oc < 4 ? 4 : 32; const float wz = o < 36 ? 1.f : 0.f;
#pragma unroll
        for (int j = 0; j < 4; ++j)
#pragma unroll
            for (int e = 0; e < 4; ++e) { const int k = 256 * j + 4 * lane_ + e; wv[i][4 * j + e] = lnf[k] * wp[(size_t)k * wst] * wz; } }
    for (int tt = 0; tt < 128; ++tt) { const int t = blk * 128 + tt; const f32x4* xr = (const f32x4*)(XF + (size_t)t * D) + lane_; f32x4 v[4];
#pragma unroll
        for (int j = 0; j < 4; ++j) v[j] = xr[64 * j];
        if ((tt & 7) == C.wave) { float s = 0.f;
#pragma unroll
            for (int j = 0; j < 4; ++j) s += (v[j][0] * v[j][0] + v[j][1] * v[j][1]) + (v[j][2] * v[j][2] + v[j][3] * v[j][3]);
            s = wave_sum(s); const float rs = rsqrt_f(s * (1.0f / D) + EPS); u32x2* o = (u32x2*)(XB + (size_t)t * D) + lane_;
#pragma unroll
            for (int j = 0; j < 4; ++j) o[64 * j] = (u32x2){pk2(v[j][0], v[j][1]), pk2(v[j][2], v[j][3])};
            if (lane_ == 0) { RS1[t] = rs; rsl[tt] = rs; } }
#pragma unroll
        for (int i = 0; i < 5; ++i) { float d = 0.f;
#pragma unroll
            for (int j = 0; j < 4; ++j) d += (v[j][0] * wv[i][4 * j] + v[j][1] * wv[i][4 * j + 1]) + (v[j][2] * wv[i][4 * j + 2] + v[j][3] * wv[i][4 * j + 3]);
            d = wave_sum(d); if (lane_ == 0 && C.wave + 8 * i < 36) lg[tt * 40 + C.wave + 8 * i] = d; } }
    __syncthreads();
    if (tid_ < 128) { const int tt = tid_, t = blk * 128 + tt; const float rs = rsl[tt]; const float* brg = P.in[I_B_RG] + layer * 4; const float* bre = P.in[I_B_RE] + layer * 32;
        float gl[4]; int gs = 0;
#pragma unroll
        for (int o = 0; o < 4; ++o) { gl[o] = lg[tt * 40 + o] * rs + brg[o]; if (gl[o] > gl[gs]) gs = o; }
        float gsum = 0.f;
#pragma unroll
        for (int o = 0; o < 4; ++o) gsum += __expf(gl[o] - gl[gs]);
        const float pg = 1.0f / gsum;
        float el[8]; int j1 = 0;
#pragma unroll
        for (int j = 0; j < 8; ++j) { el[j] = lg[tt * 40 + 4 + 8 * gs + j] * rs + bre[8 * gs + j]; if (el[j] > el[j1]) j1 = j; }
        int j2 = (j1 == 0) ? 1 : 0;
#pragma unroll
        for (int j = 0; j < 8; ++j) if (j != j1 && el[j] > el[j2]) j2 = j;
        const float e2 = __expf(el[j2] - el[j1]), den = 1.0f / (1.0f + e2);
        const int ea = 8 * gs + j1, eb = 8 * gs + j2;
        EID[t * 2] = ea; EID[t * 2 + 1] = eb; GATE[t * 2] = pg * den; GATE[t * 2 + 1] = pg * e2 * den; eidl[2 * tt] = ea; eidl[2 * tt + 1] = eb; }
    __syncthreads();
    if (tid_ < 256) { const int me = eidl[tid_]; int rk = 0; for (int a = 0; a < tid_; ++a) rk += (eidl[a] == me) ? 1 : 0; RANK[blk * 256 + tid_] = rk; }
    if (tid_ < 32) { int c = 0; for (int a = 0; a < 256; ++a) c += (eidl[a] == tid_) ? 1 : 0; CNT[blk * 32 + tid_] = c; }
    __syncthreads();
}
__device__ __forceinline__ void moe_scatter(const Ctx& C, const Params&, int blk) {
    CTX_LANE;
    WS_OPAQUE;
    const int* CNT = WSP(int, SM_CNT); const int* EID = WSP(int, SM_EID); const float* GATE = WSP(float, SM_GATE); const int* RANK = WSP(int, SM_RANK); const float* RS1 = WSP(float, SM_RS1);
    int* TSLOT = WSP(int, SM_TSLOT); int* STOK = WSP(int, SM_STOK); float* SW = WSP(float, SM_SW); float* SR = WSP(float, SM_SR); int* TILEE = WSP(int, SM_TILEE);
    const bf16_t* XB = WSP(bf16_t, OFF_XB); bf16_t* XS = WSP(bf16_t, A_XS);
    LAS int* part = (LAS int*)C.lds;
    LAS int* tot = part + 1024;
    LAS int* slotl = tot + 128;
    { const int e = tid_ & 31, pt = tid_ >> 5; int s = 0, pre = 0;
        for (int b = pt * 16; b < pt * 16 + 16; ++b) { const int c = ld_i(CNT + b * 32 + e); s += c; if (b < blk) pre += c; }
        part[pt * 32 + e] = s; part[512 + pt * 32 + e] = pre; }
    __syncthreads();
    if (tid_ < 32) { int s = 0, pre = 0; for (int pt = 0; pt < 16; ++pt) { s += part[pt * 32 + tid_]; pre += part[512 + pt * 32 + tid_]; } tot[tid_] = s; tot[32 + tid_] = pre; }
    __syncthreads();
    if (tid_ == 0) { int ps = 0; for (int e = 0; e < 32; ++e) { tot[64 + e] = ps; ps += (tot[e] + 255) & ~255; } tot[96] = ps; }
    __syncthreads();
    if (tid_ < 256) { const int a = blk * 256 + tid_, t = a >> 1, e = EID[a]; const int slot = tot[64 + e] + tot[32 + e] + RANK[a];
        slotl[tid_] = slot; TSLOT[a] = slot; STOK[slot] = t; SW[slot] = GATE[a]; SR[slot] = RS1[t]; }
    __syncthreads();
    for (int i = C.wave; i < 256; i += 8) { const int slot = slotl[i], t = (blk * 256 + i) >> 1;
        const u32x4* s = (const u32x4*)(XB + (size_t)t * D) + lane_; u32x4* d = (u32x4*)(XS + (size_t)slot * D) + lane_; d[0] = s[0]; d[64] = s[64]; }
    if (blk < 32) { const int e = blk, beg = tot[64 + e] + tot[e], end = tot[64 + e] + ((tot[e] + 255) & ~255);
        for (int sl = beg + C.wave; sl < end; sl += 8) { u32x4* d = (u32x4*)(XS + (size_t)sl * D) + lane_; d[0] = (u32x4){0u, 0u, 0u, 0u}; d[64] = (u32x4){0u, 0u, 0u, 0u}; if (lane_ == 0) { STOK[sl] = -1; SW[sl] = 0.f; SR[sl] = 0.f; } } }
    if (blk == 0 && tid_ < 32) { const int e = tid_, t0 = tot[64 + e] >> 8, nt = ((tot[e] + 255) & ~255) >> 8; for (int i = 0; i < nt; ++i) TILEE[t0 + i] = e; if (e == 0) TILEE[300] = tot[96] >> 8; }
    __syncthreads();
}
template <int MODE> __device__ __forceinline__ void moe_combine(const Ctx& C, const Params&, float* RS, const float* gainf) {
    CTX_LANE;
    WS_OPAQUE;
    float* XF = P.out; bf16_t* XB = WSP(bf16_t, OFF_XB); const bf16_t* YS = WSP(bf16_t, A_XS); const int* TSLOT = WSP(int, SM_TSLOT);
    for (int t = C.gw; t < T; t += C.ngw) { const int sa = ld_i(TSLOT + 2 * t), sb = ld_i(TSLOT + 2 * t + 1); f32x4* xr = (f32x4*)(XF + (size_t)t * D) + lane_;
        const u32x2* ya = (const u32x2*)(YS + (size_t)sa * D) + lane_; const u32x2* yb = (const u32x2*)(YS + (size_t)sb * D) + lane_; f32x4 v[4]; float s = 0.f;
#pragma unroll
        for (int j = 0; j < 4; ++j) { const u32x2 a = ya[64 * j], b = yb[64 * j]; v[j] = xr[64 * j];
            v[j][0] += bflo(a.x) + bflo(b.x); v[j][1] += bfhi(a.x) + bfhi(b.x); v[j][2] += bflo(a.y) + bflo(b.y); v[j][3] += bfhi(a.y) + bfhi(b.y);
            s += (v[j][0] * v[j][0] + v[j][1] * v[j][1]) + (v[j][2] * v[j][2] + v[j][3] * v[j][3]); }
        s = wave_sum(s); const float rs = rsqrt_f(s * (1.0f / D) + EPS);
        if (MODE == 0) { u32x2* o = (u32x2*)(XB + (size_t)t * D) + lane_;
#pragma unroll
            for (int j = 0; j < 4; ++j) { xr[64 * j] = v[j]; o[64 * j] = (u32x2){pk2(v[j][0], v[j][1]), pk2(v[j][2], v[j][3])}; }
            if (lane_ == 0) RS[t] = rs; }
        else { const f32x4* gr = (const f32x4*)gainf + lane_;
#pragma unroll
            for (int j = 0; j < 4; ++j) xr[64 * j] = v[j] * rs * gr[64 * j]; } }
}

constexpr int LDS_BYTES = 147456;
constexpr int LDS_MISC = LDS_BYTES - 256;
constexpr int NPHASE = 23;

__global__ void __launch_bounds__(512, 2) fwd_kernel(Params Pkern) {
    extern __shared__ __attribute__((aligned(16))) unsigned char lds_raw[];
    LAS unsigned char* lds = (LAS unsigned char*)lds_raw;
    Ctx C; { const int t0_ = threadIdx.x; C.wave = __builtin_amdgcn_readfirstlane(t0_ >> 6); } C.G = gridDim.x;
    C.vcu = (C.G % 8 == 0) ? ((int)blockIdx.x % 8) * (C.G / 8) + (int)blockIdx.x / 8 : (int)blockIdx.x;
    C.gw = C.vcu * 8 + C.wave; C.ngw = C.G * 8; C.lds = lds;
    const int bx = blockIdx.x;
    { const int l0 = lane_id_opaque(); if (C.wave == 0) ((LAS unsigned*)(lds + LDS_MISC))[l0] = 0u; }
    __syncthreads();
    const unsigned xcc = xb_xcc_id();
    if (Pkern.use_bar) { const bool t0 = (C.wave == 0) && (lane_id_opaque() == 0); (void)xcd_barrier_post((unsigned*)(Pkern.ws + OFF_CTL) + 4096, (volatile LAS unsigned*)(lds + LDS_MISC), t0); }
    const int lo = Pkern.ph_lo, hi = Pkern.ph_hi;
    const Params& P = Pkern;
#ifndef PH_MASK
#define PH_MASK 0x7fffffu
#endif
#define IN(k) ((((unsigned)PH_MASK >> (k)) & 1u) && lo <= (k) && (k) < hi)
#define SEAM(k) do { if (IN(k) && IN((k) + 1)) { P_OPAQUE; XcdBarrier bar; bar.bar = (unsigned*)(P.ws + OFF_CTL) + 4096; bar.x = xcc; bar.st = (volatile LAS unsigned*)(lds + LDS_MISC); \
        const bool t0 = (C.wave == 0) && (lane_id_opaque() == 0); xcd_barrier(bar, t0); } } while (0)

    if (IN(0)) { WS_OPAQUE; convert_mixer(C, P); convert_moe(C, P, 0); make_rope(C, P); rows_to_bf16(C, P.in[I_X], WSP(bf16_t, OFF_XB), WSP(float, SM_RS0)); __syncthreads(); }
    SEAM(0);
    if (IN(1)) {
        { WS_OPAQUE; DenseSched Sd; Sd.init(WSP(bf16_t, OFF_XB), 1024, WSP(bf16_t, W_A1), 1024, 128, 6, C.G, bx);
          EpiA1a E{WSP(float, SM_RS0), WSP(bf16_t, A_Z), WSP(float, SM_PQ), WSP(float, SM_PKV), WSP(bf16_t, A_KA), WSP(float, SM_LF), P.in[I_B_F], WSP(bf16_t, A_QF), WSP(bf16_t, A_KF), WSP(f32x2, OFF_ROPE)};
          pg8::gemm_phase(C.wave, lds, pg8::Dims{1024, 1024, 1024}, Sd, E); }
        { WS_OPAQUE; DenseSched Sd; Sd.init(WSP(bf16_t, W_A1V), 1024, WSP(bf16_t, OFF_XB), 1024, 2, 128, C.G, bx);
          EpiVT<0> E{WSP(float, SM_RS0), WSP(bf16_t, A_VTF), (size_t)T};
          pg8::gemm_phase(C.wave, lds, pg8::Dims{1024, 1024, 1024}, Sd, E); }
    }
    SEAM(1);
    if (IN(2)) {
        if (C.vcu < 16) { WS_OPAQUE; fox_cumsum(C, WSP(float, SM_LF), WSP(float, SM_CUM), C.vcu); }
        { WS_OPAQUE; DenseSched Sd; Sd.init(WSP(bf16_t, A_Z), 512, WSP(bf16_t, W_A2), 256, 128, 4, C.G, bx);
          EpiA2q E{WSP(float, SM_PQ), WSP(bf16_t, A_QA), WSP(f32x2, OFF_ROPE)};
          pg8::gemm_phase(C.wave, lds, pg8::Dims{512, 256, 256}, Sd, E); }
        { WS_OPAQUE; DenseSched Sd; Sd.init(WSP(bf16_t, A_Z) + 256, 512, WSP(bf16_t, W_A2) + (size_t)1024 * 256, 256, 128, 2, C.G, bx);
          EpiA2k E{WSP(float, SM_PKV), WSP(bf16_t, A_KA)};
          pg8::gemm_phase(C.wave, lds, pg8::Dims{512, 256, 256}, Sd, E); }
        { WS_OPAQUE; DenseSched Sd; Sd.init(WSP(bf16_t, W_A2V), 256, WSP(bf16_t, A_Z) + 256, 512, 2, 128, C.G, bx);
          EpiVT<1> E{WSP(float, SM_PKV), WSP(bf16_t, A_VTA), (size_t)T};
          pg8::gemm_phase(C.wave, lds, pg8::Dims{256, 512, 256}, Sd, E); }
    }
    SEAM(2);
    if (IN(3)) {
        const int bh = C.vcu >> 4, s4 = C.vcu & 15, b = bh >> 3, h = bh & 7;
        { WS_OPAQUE; bf16_t* AO = WSP(bf16_t, OFF_XB);
          for (int i = 0; i < 4; ++i) { const int qb = (i == 0) ? s4 : (i == 1) ? 31 - s4 : (i == 2) ? 32 + s4 : 63 - s4;
            attn_unit<96, false>(C.wave, lds, WSP(bf16_t, A_QA) + (size_t)b * S * 768 + h * 96, 768, WSP(bf16_t, A_KA) + (size_t)b * S * 768 + h * 96, 768,
                                 WSP(bf16_t, A_VTA) + (size_t)(h * 64) * T + (size_t)b * S, nullptr, AO + (size_t)b * S * 1024 + h * 64, 1024, qb); } }
        { WS_OPAQUE; bf16_t* AO = WSP(bf16_t, OFF_XB);
          for (int i = 0; i < 4; ++i) { const int qb = (i == 0) ? s4 : (i == 1) ? 31 - s4 : (i == 2) ? 32 + s4 : 63 - s4;
            attn_unit<64, true>(C.wave, lds, WSP(bf16_t, A_QF) + (size_t)b * S * 512 + h * 64, 512, WSP(bf16_t, A_KF) + (size_t)b * S * 512 + h * 64, 512,
                                WSP(bf16_t, A_VTF) + (size_t)(h * 64) * T + (size_t)b * S, WSP(float, SM_CUM) + (size_t)bh * S, AO + (size_t)b * S * 1024 + 512 + h * 64, 1024, qb); } }
    }
    SEAM(3);
    if (IN(4)) { WS_OPAQUE; DenseSched Sd; Sd.init(WSP(bf16_t, OFF_XB), 1024, WSP(bf16_t, W_OE), 1024, 128, 4, C.G, bx); EpiRes E{P.in[I_X], P.out};
        pg8::gemm_phase(C.wave, lds, pg8::Dims{1024, 1024, 1024}, Sd, E); }
    SEAM(4);

#define MOE_PHASES(layer, pb) do { \
        if (IN(pb)) moe_router(C, P, layer, bx); \
        SEAM(pb); \
        if (IN((pb) + 1)) moe_scatter(C, P, bx); \
        SEAM((pb) + 1); \
        if (IN((pb) + 2)) { WS_OPAQUE; MoeSched Sm; Sm.init(WSP(bf16_t, A_XS), 1024, WSP(bf16_t, OFF_WGU), 1024, 1024, WSP(int, SM_TILEE), C.G, bx); EpiM3 E{WSP(float, SM_SR), WSP(bf16_t, A_HID)}; \
            pg8::gemm_phase(C.wave, lds, pg8::Dims{1024, 1024, 1024}, Sm, E); } \
        SEAM((pb) + 2); \
        if (IN((pb) + 3)) { WS_OPAQUE; MoeSched Sm; Sm.init(WSP(bf16_t, A_HID), 512, WSP(bf16_t, OFF_WDN), 512, 1024, WSP(int, SM_TILEE), C.G, bx); EpiM4 E{WSP(float, SM_SW), WSP(bf16_t, A_XS)}; \
            pg8::gemm_phase(C.wave, lds, pg8::Dims{512, 512, 512}, Sm, E); } \
        SEAM((pb) + 3); } while (0)
#define RET_PHASES(bb, p0) do { \
        if (IN(p0)) { \
            { WS_OPAQUE; DenseSched Sd; Sd.init(WSP(bf16_t, OFF_XB) + (size_t)(bb) * S * 1024, 1024, WSP(bf16_t, W_B1), 1024, 64, 4, C.G, bx); EpiB1q E{WSP(float, SM_RS2) + (bb) * S, WSP(bf16_t, A_QX), WSP(f32x2, OFF_ROPE)}; \
              pg8::gemm_phase(C.wave, lds, pg8::Dims{1024, 1024, 1024}, Sd, E); } \
            { WS_OPAQUE; DenseSched Sd; Sd.init(WSP(bf16_t, W_B1) + (size_t)1024 * 1024, 1024, WSP(bf16_t, OFF_XB) + (size_t)(bb) * S * 1024, 1024, 4, 64, C.G, bx); EpiB1k E{WSP(float, SM_RS2) + (bb) * S, WSP(bf16_t, A_KN), WSP(bf16_t, A_KZT), WSP(f32x2, OFF_ROPE)}; \
              pg8::gemm_phase(C.wave, lds, pg8::Dims{1024, 1024, 1024}, Sd, E); } \
            { WS_OPAQUE; DenseSched Sd; Sd.init(WSP(bf16_t, W_B1) + (size_t)2048 * 1024, 1024, WSP(bf16_t, OFF_XB) + (size_t)(bb) * S * 1024, 1024, 8, 64, C.G, bx); EpiB1v E{WSP(float, SM_RS2) + (bb) * S, WSP(bf16_t, A_VT)}; \
              pg8::gemm_phase(C.wave, lds, pg8::Dims{1024, 1024, 1024}, Sd, E); } \
        } \
        SEAM(p0); \
        if (IN((p0) + 1)) { WS_OPAQUE; ret_local(C.wave, lds, WSP(bf16_t, A_KZT), WSP(bf16_t, A_VT), WSP(f32x4, A_L), C.vcu); } \
        SEAM((p0) + 1); \
        if (IN((p0) + 2)) { WS_OPAQUE; ret_scan(C.wave, lds, WSP(bf16_t, A_QX), WSP(bf16_t, A_KN), WSP(bf16_t, A_KZT), WSP(bf16_t, A_VT), WSP(f32x4, A_L), \
                                 WSP(bf16_t, A_O) + (size_t)(bb) * S * 2048, WSP(float, SM_PO) + (size_t)(bb) * S * 16, C.vcu); } \
        SEAM((p0) + 2); } while (0)

    MOE_PHASES(0, 5);
    if (IN(9)) { WS_OPAQUE; moe_combine<0>(C, P, WSP(float, SM_RS2), nullptr); convert_moe(C, P, 1); __syncthreads(); }
    SEAM(9);
    RET_PHASES(0, 10);
    RET_PHASES(1, 13);
    if (IN(16)) { WS_OPAQUE; DenseSched Sd; Sd.init(WSP(bf16_t, OFF_XB), 1024, WSP(bf16_t, W_B1) + (size_t)4096 * 1024, 1024, 128, 8, C.G, bx); EpiG E{WSP(float, SM_RS2), WSP(float, SM_PO), WSP(bf16_t, A_O)};
        pg8::gemm_phase(C.wave, lds, pg8::Dims{1024, 1024, 1024}, Sd, E); }
    SEAM(16);
    if (IN(17)) { WS_OPAQUE; DenseSched Sd; Sd.init(WSP(bf16_t, A_O), 2048, WSP(bf16_t, W_OO), 2048, 128, 4, C.G, bx); EpiRes E{P.out, P.out};
        pg8::gemm_phase(C.wave, lds, pg8::Dims{2048, 2048, 2048}, Sd, E); }
    SEAM(17);
    MOE_PHASES(1, 18);
#undef MOE_PHASES
#undef RET_PHASES
    if (IN(22)) { P_OPAQUE; moe_combine<1>(C, P, nullptr, P.in[I_LN_F]); }
#undef IN
#undef SEAM
}

extern "C" void kernel_launch(void* const* d_in, const int* in_sizes, int n_in, void* d_out, int out_size, void* d_ws, size_t ws_size, hipStream_t stream) {
    static int ready = 0;
    if (ready == 0) {
        if (n_in != 21 || out_size != T * D || ws_size < WS_NEED) { fprintf(stderr, "kernel_launch: unexpected shapes (n_in %d, out %d, ws %zu < %zu)\n", n_in, out_size, ws_size, (size_t)WS_NEED); ready = -1; return; }
        if (hipFuncSetAttribute((const void*)fwd_kernel, hipFuncAttributeMaxDynamicSharedMemorySize, LDS_BYTES) != hipSuccess) { fprintf(stderr, "kernel_launch: hipFuncSetAttribute failed\n"); ready = -1; return; }
        int per_cu = 0; (void)hipOccupancyMaxActiveBlocksPerMultiprocessor(&per_cu, (const void*)fwd_kernel, 512, LDS_BYTES); (void)hipGetLastError();
        if (per_cu < 1) fprintf(stderr, "kernel_launch: occupancy query reports %d blocks per CU\n", per_cu);
        ready = 1;
    }
    if (ready < 0) return;
    (void)hipMemsetAsync((char*)d_ws + OFF_CTL, 0, CTL_BYTES, stream);
    Params p{};
    for (int i = 0; i < 21; ++i) p.in[i] = (const float*)d_in[i];
    p.out = (float*)d_out; p.ws = (unsigned char*)d_ws; p.pad = 0;
#if N_LAUNCH_MODE == 1
    for (int ph = 0; ph < NPHASE; ++ph) { p.ph_lo = ph; p.ph_hi = ph + 1; p.use_bar = 0; hipLaunchKernelGGL(fwd_kernel, dim3(256), dim3(512), LDS_BYTES, stream, p); }
#else
    p.ph_lo = 0; p.ph_hi = NPHASE; p.use_bar = 1;
    hipLaunchKernelGGL(fwd_kernel, dim3(256), dim3(512), LDS_BYTES, stream, p);
#endif
}
```

```cpp
#include <hip/hip_runtime.h>
#include <cstdio>
#include <cstdint>

#ifndef N_LAUNCH_MODE
#define N_LAUNCH_MODE 0
#endif

#define LAS __attribute__((address_space(3)))
#define GAS __attribute__((address_space(1)))
typedef unsigned short bf16_t;
typedef short bf16x8 __attribute__((ext_vector_type(8)));
typedef float f32x2 __attribute__((ext_vector_type(2)));
typedef float f32x4 __attribute__((ext_vector_type(4)));
typedef float f32x16 __attribute__((ext_vector_type(16)));
typedef unsigned u32x2 __attribute__((ext_vector_type(2)));
typedef unsigned u32x4 __attribute__((ext_vector_type(4)));

constexpr int T = 32768, S = 16384, D = 1024;
constexpr float EPS = 1e-6f;
constexpr float LOG2E = 1.4426950408889634f;
constexpr int CAP = 65536 + 32 * 256;
constexpr int NSEG = 16, SEGC = 16;

constexpr size_t MiB = 1u << 20;
constexpr size_t OFF_CTL = 0, CTL_BYTES = 1 * MiB;
constexpr size_t OFF_SMALL = 1 * MiB;
constexpr size_t SM_RS0 = OFF_SMALL, SM_RS1 = SM_RS0 + T * 4, SM_RS2 = SM_RS1 + T * 4, SM_PQ = SM_RS2 + T * 4, SM_PKV = SM_PQ + (size_t)T * 16,
                 SM_LF = SM_PKV + (size_t)T * 16, SM_CUM = SM_LF + (size_t)T * 32, SM_EID = SM_CUM + (size_t)T * 32  ,
                 SM_GATE = SM_EID + (size_t)T * 8, SM_RANK = SM_GATE + (size_t)T * 8, SM_TSLOT = SM_RANK + (size_t)T * 8, SM_CNT = SM_TSLOT + (size_t)T * 8,
                 SM_STOK = SM_CNT + 256 * 32 * 4, SM_SW = SM_STOK + (size_t)CAP * 4, SM_SR = SM_SW + (size_t)CAP * 4, SM_TILEE = SM_SR + (size_t)CAP * 4,
                 SM_PO = SM_TILEE + 4096, SM_KNRM = SM_PO + (size_t)T * 64, SM_END = SM_KNRM + 16 * 256 * 4;
static_assert(SM_END <= 11 * MiB, "small region");
constexpr size_t OFF_ROPE = 11 * MiB;
constexpr size_t OFF_WMIX = 27 * MiB;
constexpr size_t W_A1 = OFF_WMIX, W_A1V = W_A1 + 3 * MiB, W_A2 = W_A1V + 1 * MiB, W_A2V = W_A2 + 768 * 1024, W_OE = W_A2V + 256 * 1024,
                 W_B1 = W_OE + 2 * MiB, W_OO = W_B1 + 12 * MiB, W_MIXEND = W_OO + 4 * MiB;
static_assert(W_MIXEND <= 51 * MiB, "mixer weights");
constexpr size_t OFF_WGU = 51 * MiB, OFF_WDN = OFF_WGU + 64 * MiB;
constexpr size_t OFF_XB = 147 * MiB;
constexpr size_t OFF_ACT = 211 * MiB;
constexpr size_t WS_NEED = OFF_ACT + 320 * MiB;
constexpr size_t A_Z = OFF_ACT, A_QF = A_Z + 32 * MiB, A_KF = A_QF + 32 * MiB, A_VTF = A_KF + 32 * MiB, A_QA = A_VTF + 32 * MiB, A_KA = A_QA + 48 * MiB, A_VTA = A_KA + 48 * MiB;
constexpr size_t A_XS = OFF_ACT, A_HID = OFF_ACT + 144 * MiB;
constexpr size_t A_QX = OFF_ACT, A_KN = A_QX + 32 * MiB, A_KZT = A_KN + 32 * MiB, A_VT = A_KZT + 32 * MiB, A_L = A_VT + 64 * MiB, A_O = A_L + 32 * MiB;
static_assert(A_O + 128 * MiB <= WS_NEED && A_HID + 72 * MiB <= WS_NEED && A_VTA + 32 * MiB <= WS_NEED, "act map");

__device__ __forceinline__ unsigned f2bf(float f) { unsigned u = __builtin_bit_cast(unsigned, f); return (u + 0x7fffu + ((u >> 16) & 1u)) >> 16; }
__device__ __forceinline__ unsigned pk2(float lo, float hi) { unsigned r; asm volatile("v_cvt_pk_bf16_f32 %0, %1, %2" : "=v"(r) : "v"(lo), "v"(hi)); return r; }
__device__ __forceinline__ float bf2f(unsigned short b) { return __builtin_bit_cast(float, ((unsigned)b) << 16); }
__device__ __forceinline__ float bflo(unsigned w) { return __builtin_bit_cast(float, w << 16); }
__device__ __forceinline__ float bfhi(unsigned w) { return __builtin_bit_cast(float, w & 0xffff0000u); }
__device__ __forceinline__ float wave_sum(float v) {
#pragma unroll
    for (int o = 1; o < 64; o <<= 1) v += __shfl_xor(v, o);
    return v;
}
__device__ __forceinline__ int lane_id_opaque() { unsigned z = 0u; asm volatile("" : "+s"(z)); int l = (int)__builtin_amdgcn_mbcnt_hi(~0u, __builtin_amdgcn_mbcnt_lo(~0u, z)); asm volatile("" : "+v"(l)); return l; }
__device__ __forceinline__ int ld_i(const int* p) { return __hip_atomic_load(p, __ATOMIC_RELAXED, __HIP_MEMORY_SCOPE_AGENT); }
__device__ __forceinline__ float rsqrt_f(float x) { return 1.0f / sqrtf(x); }

#define XB_TMO      128
#define XB_XCNT(j)  (256  + 64 * (j))
#define XB_XSUB(j)  (1280 + 64 * (j))
#define XB_XGEN(j)  (2304 + 64 * (j))
#define XB_TOP      3328
#define XB_TOPGEN   3392
#define XCD_BAR_WORDS 3456
#define XB_SPIN_CAP (1u << 18)
__device__ __forceinline__ unsigned xb_ld(unsigned* p)              { return __hip_atomic_load(p, __ATOMIC_RELAXED, __HIP_MEMORY_SCOPE_AGENT); }
__device__ __forceinline__ unsigned xb_add(unsigned* p, unsigned v) { return __hip_atomic_fetch_add(p, v, __ATOMIC_RELAXED, __HIP_MEMORY_SCOPE_AGENT); }
__device__ __forceinline__ unsigned xb_xcc_id() { return (unsigned)__builtin_amdgcn_s_getreg((3 << 11) | 20) & 0xFu; }
#define XB_SPIN(cond, bar) do { unsigned _sp = 0; while (cond) { __builtin_amdgcn_s_sleep(1); \
    if ((++_sp & 255u) == 0u) { if (xb_ld(&(bar)[XB_TMO])) break; if (_sp > XB_SPIN_CAP) { atomicAdd(&(bar)[XB_TMO], 1u); break; } } } } while (0)
struct XcdBarrier { unsigned* bar; unsigned x; volatile LAS unsigned* st; };
__device__ __forceinline__ XcdBarrier xcd_barrier_post(unsigned* bar, volatile LAS unsigned* st, bool t0) {
    XcdBarrier b; b.bar = bar; b.x = xb_xcc_id(); b.st = st;
    if (t0) (void)xb_add(&bar[XB_XCNT(b.x)], 1u);
    return b;
}
__device__ __forceinline__ void xcd_barrier_complete(unsigned* bar, unsigned x, unsigned& nloc, unsigned& nx) {
    const unsigned G = gridDim.x * gridDim.y * gridDim.z;
    unsigned sum, cnt, mine, sp = 0u;
    for (;;) {
        sum = 0u; cnt = 0u; mine = 0u;
#pragma unroll
        for (unsigned j = 0; j < 16; ++j) { const unsigned c = xb_ld(&bar[XB_XCNT(j)]); sum += c; cnt += (c > 0u) ? 1u : 0u; mine = (j == x) ? c : mine; }
        if (sum == G) break;
        __builtin_amdgcn_s_sleep(1);
        if ((++sp & 255u) == 0u) { if (xb_ld(&bar[XB_TMO])) break; if (sp > XB_SPIN_CAP) { atomicAdd(&bar[XB_TMO], 1u); break; } }
    }
    nloc = mine > 0u ? mine : 1u; nx = cnt > 0u ? cnt : 1u;
}
__device__ __forceinline__ void xcd_barrier(const XcdBarrier& b, bool t0) {
    asm volatile("s_waitcnt vmcnt(0)" ::: "memory");
    __syncthreads();
    if (t0) {
        unsigned* bar = b.bar;
        __builtin_amdgcn_s_waitcnt(0);
        unsigned nloc = b.st[0], nx = b.st[1];
        if (nloc == 0u) { xcd_barrier_complete(bar, b.x, nloc, nx); b.st[0] = nloc; b.st[1] = nx; }
        const unsigned old = xb_add(&bar[XB_XSUB(b.x)], 1u);
        const unsigned gen = old / nloc;
        if (old + 1u == (gen + 1u) * nloc) {
            __builtin_amdgcn_fence(__ATOMIC_RELEASE, "agent");
            asm volatile("s_waitcnt vmcnt(0)" ::: "memory");
            const unsigned og = xb_add(&bar[XB_TOP], 1u);
            const unsigned tg = og / nx;
            if (og + 1u == (tg + 1u) * nx) xb_add(&bar[XB_TOPGEN], 1u);
            else XB_SPIN(xb_ld(&bar[XB_TOPGEN]) == tg, bar);
            __builtin_amdgcn_fence(__ATOMIC_ACQUIRE, "agent");
            xb_add(&bar[XB_XGEN(b.x)], 1u);
            asm volatile("s_waitcnt vmcnt(0)" ::: "memory");
        } else {
            XB_SPIN(xb_ld(&bar[XB_XGEN(b.x)]) == gen, bar);
            __builtin_amdgcn_fence(__ATOMIC_ACQUIRE, "agent");
            asm volatile("s_waitcnt vmcnt(0)" ::: "memory");
        }
    }
    __syncthreads();
}

namespace pg8 {
constexpr int BM = 256, BK = 64, HALF = 128, HTB = HALF * BK * 2, STAGE_BYTES = 8 * HTB, NXCD = 8, WGM = 8;
__device__ __forceinline__ int lds_byte(int r, int c) { const int st = (r >> 4) * 2 + (c >> 5), rr = r & 15, cc = c & 31, ob = rr * 64 + cc * 2; return st * 1024 + (ob ^ (((ob >> 9) & 1) << 5)); }
__device__ __forceinline__ void stage_rc(int b, int& R, int& C) { const int st = b / 1024, sb = b % 1024, swz = sb ^ (((sb >> 9) & 1) << 5); R = (st >> 1) * 16 + swz / 64; C = (st & 1) * 32 + (swz % 64) / 2; }
__device__ __forceinline__ int perm32(int rho) { const int n = rho >> 4, i = rho & 15; return 8 * (i >> 2) + 4 * n + (i & 3); }
struct Unit { int pm, pn, aux; };
struct Dims { int lda, ldb, K; };
struct DenseOrder {
    int nM, nN, nwg, G, c;
    __device__ __forceinline__ void init(int nM_, int nN_, int G_, int c_) { nM = nM_; nN = nN_; nwg = nM * nN; G = G_; c = c_; }
    __device__ __forceinline__ bool tile(int i, Unit& u) const {
        const long L = (long)i * G + c; if (L >= nwg) return false;
        int wgid = (int)L; { const int q = nwg / NXCD, r = nwg % NXCD, xcd = wgid % NXCD, off = wgid / NXCD; wgid = (xcd < r ? xcd * (q + 1) : r * (q + 1) + (xcd - r) * q) + off; }
        const int nig = WGM * nN, gid = wgid / nig, fm = gid * WGM, gsz = (nM - fm) < WGM ? (nM - fm) : WGM;
        u.pm = fm + ((wgid % nig) % gsz); u.pn = (wgid % nig) / gsz; u.aux = 0; return true;
    }
};

template <class Epi, class Sched>
__device__ __forceinline__ void gemm_phase(int wave_, LAS unsigned char* lds, const Dims g, const Sched& S, const Epi& E) {
    const int tid = wave_ * 64 + lane_id_opaque();
    const int wid = __builtin_amdgcn_readfirstlane(tid >> 6), lane = tid & 63, wr = wid >> 2, wc = wid & 3, fr = lane & 15, fq = lane >> 4;
    const int K = g.K, nt = K / BK;
    unsigned voffA[2], voffB[2];
#pragma unroll
    for (int i = 0; i < 2; ++i) { int R, C; stage_rc(tid * 16 + i * 8192, R, C); const int Rb = Epi::PERM ? ((R & ~31) + perm32(R & 31)) : R;
        voffA[i] = (unsigned)(R * g.lda + C) * 2u; voffB[i] = (unsigned)(Rb * g.ldb + C) * 2u; }
    const size_t kstep = (size_t)(BK * 2);
    const size_t hstepA = (size_t)HALF * g.lda * 2, hstepB = (size_t)HALF * g.ldb * 2;
    const unsigned ldsw = (unsigned)wid * 1024u;
    const int aoff = lds_byte(wr * 64 + fr, fq * 8), boff = lds_byte(wc * 32 + fr, fq * 8);
#define PG8_SA(b, h) (((b) * 2 + (h)) * HTB)
#define PG8_SB(b, h) ((4 + (b) * 2 + (h)) * HTB)
#define PG8_STAGE(bufoff, gbase, voff) do { _Pragma("unroll") for (int _i = 0; _i < 2; ++_i) \
        __builtin_amdgcn_global_load_lds((const unsigned*)((const char*)(gbase) + (voff)[_i]), (LAS unsigned*)(lds + (bufoff) + ldsw + _i * 8192), 16, 0, 0); } while (0)
#define PG8_LDA(dst, b, h) do { _Pragma("unroll") for (int m = 0; m < 4; ++m) _Pragma("unroll") for (int k = 0; k < 2; ++k) dst[m][k] = *(const LAS bf16x8*)(lds + PG8_SA(b, h) + aoff + m * 2048 + k * 1024); } while (0)
#define PG8_LDB(dst, b, h) do { _Pragma("unroll") for (int n = 0; n < 2; ++n) _Pragma("unroll") for (int k = 0; k < 2; ++k) dst[n][k] = *(const LAS bf16x8*)(lds + PG8_SB(b, h) + boff + n * 2048 + k * 1024); } while (0)
#define PG8_MMA(ai, bj, At, Bt) do { __builtin_amdgcn_s_setprio(1); _Pragma("unroll") for (int m = 0; m < 4; ++m) _Pragma("unroll") for (int n = 0; n < 2; ++n) _Pragma("unroll") for (int k = 0; k < 2; ++k) \
        acc[ai][bj][m][n] = __builtin_amdgcn_mfma_f32_16x16x32_bf16(Bt[n][k], At[m][k], acc[ai][bj][m][n], 0, 0, 0); __builtin_amdgcn_s_setprio(0); } while (0)
#define PG8_WAIT_V(n) asm volatile("s_waitcnt vmcnt(" #n ")" ::: "memory")
#define PG8_WAIT_L(n) asm volatile("s_waitcnt lgkmcnt(" #n ")" ::: "memory")
#define PG8_BAR __builtin_amdgcn_s_barrier()
#define PG8_SCHED __builtin_amdgcn_sched_barrier(0)
    Unit cur, nxt; int ui = 0;
    if (!S.next(0, cur)) return;
    f32x4 acc[2][2][4][2];
#pragma unroll
    for (int a = 0; a < 2; ++a)
#pragma unroll
        for (int b = 0; b < 2; ++b)
#pragma unroll
            for (int m = 0; m < 4; ++m)
#pragma unroll
                for (int n = 0; n < 2; ++n) acc[a][b][m][n] = (f32x4){0.f, 0.f, 0.f, 0.f};
    bf16x8 At[4][2], B0[2][2], B1[2][2];
    const char* cA; const char* cB; S.ptrs(cur, cA, cB);
    PG8_STAGE(PG8_SB(0, 0), cB, voffB); PG8_STAGE(PG8_SA(0, 0), cA, voffA); PG8_STAGE(PG8_SB(0, 1), cB + hstepB, voffB); PG8_STAGE(PG8_SA(0, 1), cA + hstepA, voffA);
    if (wr == 1) PG8_BAR;
    PG8_WAIT_V(4); PG8_BAR;
    PG8_STAGE(PG8_SB(1, 0), cB + kstep, voffB); PG8_STAGE(PG8_SA(1, 0), cA + kstep, voffA); PG8_STAGE(PG8_SB(1, 1), cB + hstepB + kstep, voffB);
    PG8_WAIT_V(6); PG8_BAR;
    for (;;) {
        const bool has_next = S.next(ui + 1, nxt);
        const char* nA = cA; const char* nB = cB; if (has_next) S.ptrs(nxt, nA, nB);
        for (int t = 0; t < nt; t += 2) {
            const bool last = (t == nt - 2);
            const char* a1 = cA + (size_t)(t + 1) * kstep;
            const char* a2 = last ? nA : cA + (size_t)(t + 2) * kstep; const char* b2 = last ? nB : cB + (size_t)(t + 2) * kstep;
            const char* a3 = a2 + kstep; const char* b3 = b2 + kstep;
            PG8_LDB(B0, 0, 0); PG8_SCHED; PG8_LDA(At, 0, 0); PG8_STAGE(PG8_SA(1, 1), a1 + hstepA, voffA);
            PG8_WAIT_L(8); PG8_BAR; PG8_WAIT_L(0); PG8_MMA(0, 0, At, B0); PG8_BAR; PG8_SCHED;
            PG8_LDB(B1, 0, 1); PG8_STAGE(PG8_SB(0, 0), b2, voffB);
            PG8_BAR; PG8_WAIT_L(0); PG8_MMA(0, 1, At, B1); PG8_BAR;
            PG8_LDA(At, 0, 1); PG8_STAGE(PG8_SA(0, 0), a2, voffA);
            PG8_BAR; PG8_WAIT_L(0); PG8_MMA(1, 0, At, B0); PG8_BAR; PG8_SCHED;
            PG8_STAGE(PG8_SB(0, 1), b2 + hstepB, voffB);
            PG8_WAIT_V(6); PG8_BAR; PG8_MMA(1, 1, At, B1); PG8_BAR;
            PG8_LDB(B0, 1, 0); PG8_SCHED; PG8_LDA(At, 1, 0); PG8_STAGE(PG8_SA(0, 1), a2 + hstepA, voffA);
            PG8_WAIT_L(8); PG8_BAR; PG8_WAIT_L(0); PG8_MMA(0, 0, At, B0); PG8_BAR; PG8_SCHED;
            PG8_LDB(B1, 1, 1); PG8_STAGE(PG8_SB(1, 0), b3, voffB);
            PG8_BAR; PG8_WAIT_L(0); PG8_MMA(0, 1, At, B1); PG8_BAR;
            PG8_LDA(At, 1, 1); PG8_STAGE(PG8_SA(1, 0), a3, voffA);
            PG8_BAR; PG8_WAIT_L(0); PG8_MMA(1, 0, At, B0); PG8_BAR; PG8_SCHED;
            PG8_STAGE(PG8_SB(1, 1), b3 + hstepB, voffB);
            PG8_WAIT_V(6); PG8_BAR; PG8_MMA(1, 1, At, B1); PG8_BAR;
        }
        { int fr2 = fr, fq2 = fq; asm volatile("" : "+v"(fr2), "+v"(fq2)); E(acc, cur, wr, wc, fr2, fq2); }
        if (!has_next) break;
#pragma unroll
        for (int a = 0; a < 2; ++a)
#pragma unroll
            for (int b = 0; b < 2; ++b)
#pragma unroll
                for (int m = 0; m < 4; ++m)
#pragma unroll
                    for (int n = 0; n < 2; ++n) acc[a][b][m][n] = (f32x4){0.f, 0.f, 0.f, 0.f};
        cur = nxt; cA = nA; cB = nB; ++ui;
    }
    PG8_WAIT_V(0);
    if (wr == 0) PG8_BAR;
    PG8_BAR;
#undef PG8_SA
#undef PG8_SB
#undef PG8_STAGE
#undef PG8_LDA
#undef PG8_LDB
#undef PG8_MMA
#undef PG8_WAIT_V
#undef PG8_WAIT_L
#undef PG8_BAR
#undef PG8_SCHED
}
}
using pg8::Unit;

struct Params {
    const float* in[21];
    float* out;
    unsigned char* ws;
    int ph_lo, ph_hi;
    int use_bar, pad;
};
enum { I_X = 0, I_LN_MIX_E, I_W_IN_E, I_LN_Q, I_W_UQ, I_LN_KV, I_W_UKV, I_B_F, I_W_OUT_E, I_LN_MIX_O, I_W_IN_O, I_W_OUT_O, I_LN_FFN, I_W_RG, I_B_RG, I_W_RE, I_B_RE, I_W_GATE, I_W_UP, I_W_DOWN, I_LN_F };

#define WSP(T_, off) ((T_*)(ws_ + (off)))
typedef const Params __attribute__((address_space(4)))* KParams;
#define P_OPAQUE KParams Pk_ = (KParams)__builtin_amdgcn_kernarg_segment_ptr(); asm volatile("" : "+s"(Pk_)); const Params& P = *(const Params*)Pk_
#define WS_OPAQUE P_OPAQUE; unsigned char* ws_ = P.ws

__device__ __forceinline__ float log2_gamma(int h) { return __builtin_log2f(1.0f - __builtin_exp2f(-5.0f - (float)h)); }

struct DenseSched {
    pg8::DenseOrder O; const char* A; const char* B; size_t astep, bstep;
    __device__ __forceinline__ void init(const void* A_, int lda, const void* B_, int ldb, int nM, int nN, int G, int c) {
        O.init(nM, nN, G, c); A = (const char*)A_; B = (const char*)B_; astep = (size_t)256 * lda * 2; bstep = (size_t)256 * ldb * 2; }
    __device__ __forceinline__ bool next(int i, Unit& u) const { return O.tile(i, u); }
    __device__ __forceinline__ void ptrs(const Unit& u, const char*& a, const char*& b) const { a = A + (size_t)u.pm * astep; b = B + (size_t)u.pn * bstep; }
};
struct MoeSched {
    const char* A; const char* B; const int* tilee; size_t astep, estep, bstep; int ntile, G, c;
    __device__ __forceinline__ void init(const void* A_, int lda, const void* B_, int ldb, size_t expert_rows, const int* tilee_, int G_, int c_) {
        A = (const char*)A_; B = (const char*)B_; tilee = tilee_; astep = (size_t)256 * lda * 2; bstep = (size_t)256 * ldb * 2; estep = expert_rows * ldb * 2; G = G_; c = c_;
        ntile = __builtin_amdgcn_readfirstlane(ld_i(tilee_ + 300)); }
    __device__ __forceinline__ bool next(int i, Unit& u) const { const int L = i * G + c; if (L >= ntile * 4) return false; u.pm = L >> 2; u.pn = L & 3; u.aux = __builtin_amdgcn_readfirstlane(ld_i(tilee + (L >> 2))); return true; }
    __device__ __forceinline__ void ptrs(const Unit& u, const char*& a, const char*& b) const { a = A + (size_t)u.pm * astep; b = B + (size_t)u.aux * estep + (size_t)u.pn * bstep; }
};

typedef const f32x4 (&AccRef)[2][2][4][2];
#define EPI_LOOP_AI_M for (int ai = 0; ai < 2; ++ai) _Pragma("unroll") for (int m = 0; m < 4; ++m)
#define EPI_LOOP_BJ_N for (int bj = 0; bj < 2; ++bj) _Pragma("unroll") for (int n = 0; n < 2; ++n)

struct EpiA1a {
    static constexpr bool PERM = false;
    const float* rs0; bf16_t* Z; float* PQ; float* PKV; bf16_t* KA; float* LF; const float* bf; bf16_t* QF; bf16_t* KF; const f32x2* rope;
    __device__ __forceinline__ void operator()(AccRef acc, const Unit& u, int wr, int wc, int fr, int fq) const {
        const int row0 = u.pm * 256 + wr * 64 + fr;
        if (u.pn <= 1) {
            const int zc = u.pn * 256 + wc * 32 + 4 * fq;
#pragma unroll
            EPI_LOOP_AI_M { const int r = row0 + ai * 128 + m * 16; const float rs = rs0[r]; float ss = 0.f; f32x4 v[2][2];
#pragma unroll
                EPI_LOOP_BJ_N { v[bj][n] = acc[ai][bj][m][n] * rs; u32x2 w; w.x = pk2(v[bj][n][0], v[bj][n][1]); w.y = pk2(v[bj][n][2], v[bj][n][3]);
                    *(u32x2*)(Z + (size_t)r * 512 + zc + bj * 128 + n * 16) = w;
                    if (u.pn == 0 || bj == 0) ss += (v[bj][n][0] * v[bj][n][0] + v[bj][n][1] * v[bj][n][1]) + (v[bj][n][2] * v[bj][n][2] + v[bj][n][3] * v[bj][n][3]); }
                ss += __shfl_xor(ss, 16); ss += __shfl_xor(ss, 32);
                if (fq == 0) { if (u.pn == 0) PQ[(size_t)r * 4 + wc] = ss; else PKV[(size_t)r * 4 + wc] = ss; }
                if (u.pn == 1 && wc == 0) {
                    const int pos = r & (S - 1); const f32x4 x1 = v[1][0], x2 = v[1][1]; f32x4 o1, o2;
#pragma unroll
                    for (int j = 0; j < 4; ++j) { const f32x2 cs = rope[(size_t)pos * 128 + 8 * (4 * fq + j)]; o1[j] = x1[j] * cs.x - x2[j] * cs.y; o2[j] = x1[j] * cs.y + x2[j] * cs.x; }
                    u32x2 w1, w2; w1.x = pk2(o1[0], o1[1]); w1.y = pk2(o1[2], o1[3]); w2.x = pk2(o2[0], o2[1]); w2.y = pk2(o2[2], o2[3]);
#pragma unroll
                    for (int hh = 0; hh < 8; ++hh) { bf16_t* kp = KA + (size_t)r * 768 + hh * 96 + 64 + 4 * fq; *(u32x2*)kp = w1; *(u32x2*)(kp + 16) = w2; }
                }
                if (u.pn == 1 && wc == 1 && fq < 2) {
                    const f32x4 f = v[1][0]; f32x4 o;
#pragma unroll
                    for (int j = 0; j < 4; ++j) { const float x = f[j] + bf[4 * fq + j]; o[j] = fminf(x, 0.f) - log1pf(__expf(-fabsf(x))); }
                    *(f32x4*)(LF + (size_t)r * 8 + 4 * fq) = o;
                }
            }
        } else {
            const bool isq = u.pn < 4; bf16_t* dst = isq ? QF : KF; const int cc = (isq ? (u.pn - 2) : (u.pn - 4)) * 256 + wc * 32 + 4 * fq; const float sc = isq ? (0.125f * LOG2E) : 1.0f;
#pragma unroll
            EPI_LOOP_AI_M { const int r = row0 + ai * 128 + m * 16; const float rs = rs0[r] * sc;
#pragma unroll
                EPI_LOOP_BJ_N { const f32x4 v = acc[ai][bj][m][n] * rs; u32x2 w; w.x = pk2(v[0], v[1]); w.y = pk2(v[2], v[3]); *(u32x2*)(dst + (size_t)r * 512 + cc + bj * 128 + n * 16) = w; } }
        }
    }
};
template <int MODE> struct EpiVT {
    static constexpr bool PERM = true;
    const float* rs; bf16_t* OUT; size_t ldo;
    __device__ __forceinline__ float cs(int t) const { if (MODE == 0) return rs[t]; const f32x4 p = *(const f32x4*)(rs + (size_t)t * 4); return rsqrt_f(((p[0] + p[1]) + (p[2] + p[3])) * (1.0f / 128.0f) + EPS); }
    __device__ __forceinline__ void operator()(AccRef acc, const Unit& u, int wr, int wc, int fr, int fq) const {
        const int f0 = u.pm * 256 + wr * 64 + fr, t0 = u.pn * 256 + wc * 32 + 8 * fq;
#pragma unroll
        for (int bj = 0; bj < 2; ++bj) { float c[8];
#pragma unroll
            for (int j = 0; j < 8; ++j) c[j] = cs(t0 + bj * 128 + j);
#pragma unroll
            EPI_LOOP_AI_M { const f32x4 a = acc[ai][bj][m][0], b = acc[ai][bj][m][1]; u32x4 w;
                w.x = pk2(a[0] * c[0], a[1] * c[1]); w.y = pk2(a[2] * c[2], a[3] * c[3]); w.z = pk2(b[0] * c[4], b[1] * c[5]); w.w = pk2(b[2] * c[6], b[3] * c[7]);
                *(u32x4*)(OUT + (size_t)(f0 + ai * 128 + m * 16) * ldo + t0 + bj * 128) = w; }
            asm volatile("" ::: "memory"); }
    }
};
struct EpiA2q {
    static constexpr bool PERM = false;
    const float* PQ; bf16_t* QA; const f32x2* rope;
    __device__ __forceinline__ void operator()(AccRef acc, const Unit& u, int wr, int wc, int fr, int fq) const {
        if (wc == 3) return;
        const int row0 = u.pm * 256 + wr * 64 + fr; const float SCA = 0.10206207261596577f * LOG2E;
#pragma unroll
        EPI_LOOP_AI_M { const int r = row0 + ai * 128 + m * 16; const f32x4 p = *(const f32x4*)(PQ + (size_t)r * 4);
            const float rs = rsqrt_f(((p[0] + p[1]) + (p[2] + p[3])) * (1.0f / 256.0f) + EPS) * SCA; const int pos = r & (S - 1);
#pragma unroll
            for (int bj = 0; bj < 2; ++bj) { const int hh = 2 * u.pn + bj; bf16_t* qp = QA + (size_t)r * 768 + hh * 96 + wc * 32 + 4 * fq; f32x4 x1 = acc[ai][bj][m][0] * rs, x2 = acc[ai][bj][m][1] * rs;
                if (wc == 2) {
#pragma unroll
                    for (int j = 0; j < 4; ++j) { const f32x2 cs = rope[(size_t)pos * 128 + 8 * (4 * fq + j)]; const float a = x1[j], b = x2[j]; x1[j] = a * cs.x - b * cs.y; x2[j] = a * cs.y + b * cs.x; } }
                *(u32x2*)qp = (u32x2){pk2(x1[0], x1[1]), pk2(x1[2], x1[3])}; *(u32x2*)(qp + 16) = (u32x2){pk2(x2[0], x2[1]), pk2(x2[2], x2[3])};
                asm volatile("" ::: "memory"); } }
    }
};
struct EpiA2k {
    static constexpr bool PERM = false;
    const float* PKV; bf16_t* KA;
    __device__ __forceinline__ void operator()(AccRef acc, const Unit& u, int wr, int wc, int fr, int fq) const {
        const int row0 = u.pm * 256 + wr * 64 + fr;
#pragma unroll
        EPI_LOOP_AI_M { const int r = row0 + ai * 128 + m * 16; const f32x4 p = *(const f32x4*)(PKV + (size_t)r * 4);
            const float rs = rsqrt_f(((p[0] + p[1]) + (p[2] + p[3])) * (1.0f / 128.0f) + EPS);
#pragma unroll
            EPI_LOOP_BJ_N { const int hh = 4 * u.pn + 2 * bj + (wc >> 1), dd = 32 * (wc & 1) + 16 * n + 4 * fq; const f32x4 v = acc[ai][bj][m][n] * rs;
                *(u32x2*)(KA + (size_t)r * 768 + hh * 96 + dd) = (u32x2){pk2(v[0], v[1]), pk2(v[2], v[3])}; }
            asm volatile("" ::: "memory"); }
    }
};
struct EpiRes {
    static constexpr bool PERM = false;
    const float* base; float* outp;
    __device__ __forceinline__ void operator()(AccRef acc, const Unit& u, int wr, int wc, int fr, int fq) const {
        const int row0 = u.pm * 256 + wr * 64 + fr, col0 = u.pn * 256 + wc * 32 + 4 * fq;
#pragma unroll
        EPI_LOOP_AI_M { const size_t off = (size_t)(row0 + ai * 128 + m * 16) * D + col0;
#pragma unroll
            EPI_LOOP_BJ_N { const f32x4 b = *(const f32x4*)(base + off + bj * 128 + n * 16); *(f32x4*)(outp + off + bj * 128 + n * 16) = b + acc[ai][bj][m][n]; } }
    }
};
struct EpiB1q {
    static constexpr bool PERM = false;
    const float* rs2; bf16_t* QX; const f32x2* rope;
    __device__ __forceinline__ void operator()(AccRef acc, const Unit& u, int wr, int wc, int fr, int fq) const {
        const int row0 = u.pm * 256 + wr * 64 + fr; const float l2g = log2_gamma(u.pn);
#pragma unroll
        EPI_LOOP_AI_M { const int pos = row0 + ai * 128 + m * 16; const float rs = rs2[pos] * __builtin_exp2f((float)((pos & 63) + 1) * l2g);
#pragma unroll
            for (int n = 0; n < 2; ++n) { const int i0 = wc * 32 + 16 * n + 4 * fq; const f32x4 x1 = acc[ai][0][m][n] * rs, x2 = acc[ai][1][m][n] * rs; f32x4 o1, o2;
                const f32x4 ca = *(const f32x4*)(rope + (size_t)pos * 128 + i0), cb = *(const f32x4*)(rope + (size_t)pos * 128 + i0 + 2);
                const float cc[4] = {ca[0], ca[2], cb[0], cb[2]}, sn[4] = {ca[1], ca[3], cb[1], cb[3]};
#pragma unroll
                for (int j = 0; j < 4; ++j) { o1[j] = x1[j] * cc[j] - x2[j] * sn[j]; o2[j] = x1[j] * sn[j] + x2[j] * cc[j]; }
                u32x2 w1, w2; w1.x = pk2(o1[0], o1[1]); w1.y = pk2(o1[2], o1[3]); w2.x = pk2(o2[0], o2[1]); w2.y = pk2(o2[2], o2[3]);
                bf16_t* qp = QX + (size_t)pos * 1024 + u.pn * 256 + i0; *(u32x2*)qp = w1; *(u32x2*)(qp + 128) = w2; }
            asm volatile("" ::: "memory"); }
    }
};
__device__ __forceinline__ int rho_of_d(int d) { const int lo = d & 31; return (d & ~31) | (((lo >> 2) & 1) << 4) | ((lo >> 3) << 2) | (lo & 3); }
struct EpiB1k {
    static constexpr bool PERM = true;
    const float* rs2; bf16_t* KN; bf16_t* KZT; const f32x2* rope;
    __device__ __forceinline__ void operator()(AccRef acc, const Unit& u, int wr, int wc, int fr, int fq) const {
        const int h = u.pm, t0 = u.pn * 256 + wc * 32 + 8 * fq; const float l2g = log2_gamma(h);
#pragma unroll
        for (int bj = 0; bj < 2; ++bj)
#pragma unroll
            for (int n = 0; n < 2; ++n) { const int tb = t0 + bj * 128 + 4 * n; float rs[4], zt[4];
#pragma unroll
                for (int j = 0; j < 4; ++j) { rs[j] = rs2[tb + j] * 0.0625f; zt[j] = __builtin_exp2f((float)(63 - ((tb + j) & 63)) * l2g); }
                const int chunk = tb >> 6, c0 = tb & 63;
#pragma unroll
                for (int m = 0; m < 4; ++m) { const int d = wr * 64 + m * 16 + fr; float k1[4], k2[4];
#pragma unroll
                    for (int j = 0; j < 4; ++j) { const f32x2 cs = rope[(size_t)(tb + j) * 128 + d]; const float x1 = acc[0][bj][m][n][j] * rs[j], x2 = acc[1][bj][m][n][j] * rs[j];
                        k1[j] = x1 * cs.x - x2 * cs.y; k2[j] = x1 * cs.y + x2 * cs.x;
                        KN[(size_t)(tb + j) * 1024 + h * 256 + d] = (bf16_t)f2bf(k1[j]); KN[(size_t)(tb + j) * 1024 + h * 256 + 128 + d] = (bf16_t)f2bf(k2[j]); }
                    const int rho = rho_of_d(d); u32x2 w1, w2;
                    w1.x = pk2(k1[0] * zt[0], k1[1] * zt[1]); w1.y = pk2(k1[2] * zt[2], k1[3] * zt[3]); w2.x = pk2(k2[0] * zt[0], k2[1] * zt[1]); w2.y = pk2(k2[2] * zt[2], k2[3] * zt[3]);
                    bf16_t* zp = KZT + (((size_t)(h * 256 + chunk) * 256 + rho) * 64 + c0); *(u32x2*)zp = w1; *(u32x2*)(zp + 128 * 64) = w2;
                    asm volatile("" ::: "memory"); } }
    }
};
struct EpiB1v {
    static constexpr bool PERM = true;
    const float* rs2; bf16_t* VT;
    __device__ __forceinline__ void operator()(AccRef acc, const Unit& u, int wr, int wc, int fr, int fq) const {
        const int h = u.pm >> 1, e0 = (u.pm & 1) * 256 + wr * 64 + fr, t0 = u.pn * 256 + wc * 32 + 8 * fq;
#pragma unroll
        for (int bj = 0; bj < 2; ++bj) { const int tb = t0 + bj * 128; float c[8];
#pragma unroll
            for (int j = 0; j < 8; ++j) c[j] = rs2[tb + j];
            const int chunk = tb >> 6, c0 = tb & 63;
#pragma unroll
            EPI_LOOP_AI_M { const f32x4 a = acc[ai][bj][m][0], b = acc[ai][bj][m][1]; u32x4 w;
                w.x = pk2(a[0] * c[0], a[1] * c[1]); w.y = pk2(a[2] * c[2], a[3] * c[3]); w.z = pk2(b[0] * c[4], b[1] * c[5]); w.w = pk2(b[2] * c[6], b[3] * c[7]);
                *(u32x4*)(VT + (((size_t)(h * 256 + chunk) * 512 + e0 + ai * 128 + m * 16) * 64 + c0)) = w; } }
    }
};
struct EpiG {
    static constexpr bool PERM = true;
    const float* rs2; const float* PO; bf16_t* O;
    __device__ __forceinline__ void operator()(AccRef acc, const Unit& u, int wr, int wc, int fr, int fq) const {
        const int row0 = u.pm * 256 + wr * 64 + fr, col0 = u.pn * 256 + wc * 32 + 8 * fq, head = u.pn >> 1;
#pragma unroll
        EPI_LOOP_AI_M { const int r = row0 + ai * 128 + m * 16; const f32x4 p = *(const f32x4*)(PO + (size_t)r * 16 + head * 4);
            const float ro = rsqrt_f(((p[0] + p[1]) + (p[2] + p[3])) * (1.0f / 512.0f) + EPS), rs = rs2[r];
#pragma unroll
            for (int bj = 0; bj < 2; ++bj) { bf16_t* op = O + (size_t)r * 2048 + col0 + bj * 128; const u32x4 ov = *(const u32x4*)op; float o[8] = {bflo(ov.x), bfhi(ov.x), bflo(ov.y), bfhi(ov.y), bflo(ov.z), bfhi(ov.z), bflo(ov.w), bfhi(ov.w)}; float a[8];
#pragma unroll
                for (int j = 0; j < 8; ++j) { const float g = acc[ai][bj][m][j >> 2][j & 3] * rs; a[j] = o[j] * ro * g / (1.0f + __expf(-g)); }
                u32x4 w; w.x = pk2(a[0], a[1]); w.y = pk2(a[2], a[3]); w.z = pk2(a[4], a[5]); w.w = pk2(a[6], a[7]); *(u32x4*)op = w; }
            asm volatile("" ::: "memory"); }
    }
};
struct EpiM3 {
    static constexpr bool PERM = true;
    const float* SR; bf16_t* HID;
    __device__ __forceinline__ void operator()(AccRef acc, const Unit& u, int wr, int wc, int fr, int fq) const {
        const int row0 = u.pm * 256 + wr * 64 + fr, col0 = u.pn * 128 + wc * 32 + 8 * fq;
#pragma unroll
        EPI_LOOP_AI_M { const int r = row0 + ai * 128 + m * 16; const float rs = SR[r]; float hh[8];
#pragma unroll
            for (int j = 0; j < 8; ++j) { const float g = acc[ai][0][m][j >> 2][j & 3] * rs, up = acc[ai][1][m][j >> 2][j & 3] * rs; hh[j] = g / (1.0f + __expf(-g)) * up; }
            u32x4 w; w.x = pk2(hh[0], hh[1]); w.y = pk2(hh[2], hh[3]); w.z = pk2(hh[4], hh[5]); w.w = pk2(hh[6], hh[7]); *(u32x4*)(HID + (size_t)r * 512 + col0) = w; }
    }
};
struct EpiM4 {
    static constexpr bool PERM = true;
    const float* SW; bf16_t* YS;
    __device__ __forceinline__ void operator()(AccRef acc, const Unit& u, int wr, int wc, int fr, int fq) const {
        const int row0 = u.pm * 256 + wr * 64 + fr, col0 = u.pn * 256 + wc * 32 + 8 * fq;
#pragma unroll
        EPI_LOOP_AI_M { const int r = row0 + ai * 128 + m * 16; const float sw = SW[r];
#pragma unroll
            for (int bj = 0; bj < 2; ++bj) { const f32x4 a = acc[ai][bj][m][0] * sw, b = acc[ai][bj][m][1] * sw; u32x4 w; w.x = pk2(a[0], a[1]); w.y = pk2(a[2], a[3]); w.z = pk2(b[0], b[1]); w.w = pk2(b[2], b[3]);
                *(u32x4*)(YS + (size_t)r * 1024 + col0 + bj * 128) = w; } }
    }
};

__device__ __forceinline__ int crow(int r, int hi) { return (r & 3) + 8 * (r >> 2) + 4 * hi; }
template <int DQK, bool FOX>
__device__ __forceinline__ void attn_unit(int wave_, LAS unsigned char* L, const bf16_t* Qb, int ldq, const bf16_t* Kb, int ldk, const bf16_t* Vtb, const float* cum, const float* knrm, bf16_t* Ob, int ldo, int qb) {
    constexpr int KP = DQK + 8, KBYTES = 64 * KP * 2, VBYTES = 64 * 136, BUF = KBYTES + VBYTES + 256, NS = DQK / 16, KCH = DQK / 8;
    constexpr int XOFF = 2 * BUF;
    constexpr float THR = 8.0f;
    const int tid = wave_ * 64 + lane_id_opaque();
    const int lane = tid & 63, w = wave_, r32 = lane & 31, hi = lane >> 5;
    const int R0 = 256 * qb + 32 * w, q = R0 + r32, NT = 4 * qb + 4, jmax = 4 * qb + (w >> 1);
    bf16x8 qf[NS];
#pragma unroll
    for (int s = 0; s < NS; ++s) qf[s] = *(const bf16x8*)(Qb + (size_t)q * ldq + 16 * s + 8 * hi);
    const float cq = FOX ? cum[q] : 0.f;
    int j0 = 0;
    if (FOX) {
        float n2 = 0.f;
#pragma unroll
        for (int s = 0; s < NS; ++s)
#pragma unroll
            for (int e = 0; e < 8; ++e) { const float x = bf2f((unsigned short)qf[s][e]); n2 += x * x; }
        n2 += __shfl_xor(n2, 32);
#pragma unroll
        for (int o = 1; o < 32; o <<= 1) n2 = fmaxf(n2, __shfl_xor(n2, o));
        LAS float* xs = (LAS float*)(L + XOFF); LAS int* xj = (LAS int*)(L + XOFF + 32);
        if (lane == 0) xs[w] = n2;
        if (tid == 0) xj[0] = NT - 1;
        __syncthreads();
        float qn = xs[0];
#pragma unroll
        for (int i = 1; i < 8; ++i) qn = fmaxf(qn, xs[i]);
        qn = sqrtf(qn) * 1.01f;
        if (tid < NT) { const float bound = qn * knrm[tid] * 1.01f + cum[256 * qb] - cum[64 * tid + 63]; if (bound >= -160.0f) atomicMin((int*)xj, tid); }
        __syncthreads();
        j0 = xj[0];
    }
    f32x16 o0 = {}, o1 = {}; float mhat = 0.f, lrun = 0.f;
    const int kr0 = tid / KCH, kc0 = tid % KCH, kr1 = (tid + 512) / KCH, kc1 = (tid + 512) % KCH; const bool has1 = (tid + 512) < 64 * KCH;
    const int ve = tid >> 3, vc = tid & 7;
    u32x4 kreg0, kreg1 = {}, vreg; float ckreg = 0.f;
#define ATT_LOAD(j) do { kreg0 = *(const u32x4*)(Kb + (size_t)(64 * (j) + kr0) * ldk + kc0 * 8); if (has1) kreg1 = *(const u32x4*)(Kb + (size_t)(64 * (j) + kr1) * ldk + kc1 * 8); \
        vreg = *(const u32x4*)(Vtb + (size_t)ve * T + 64 * (j) + vc * 8); if (FOX && tid < 64) ckreg = cum[64 * (j) + tid]; } while (0)
#define ATT_WRITE(bo) do { *(LAS u32x4*)(L + (bo) + kr0 * (KP * 2) + kc0 * 16) = kreg0; if (has1) *(LAS u32x4*)(L + (bo) + kr1 * (KP * 2) + kc1 * 16) = kreg1; \
        *(LAS u32x2*)(L + (bo) + KBYTES + ve * 136 + vc * 16) = (u32x2){vreg.x, vreg.y}; *(LAS u32x2*)(L + (bo) + KBYTES + ve * 136 + vc * 16 + 8) = (u32x2){vreg.z, vreg.w}; \
        if (FOX && tid < 64) *(LAS float*)(L + (bo) + KBYTES + VBYTES + tid * 4) = ckreg; } while (0)
    ATT_LOAD(j0); ATT_WRITE((j0 & 1) * BUF); __syncthreads();
    for (int j = j0; j < NT; ++j) {
        const int bo = (j & 1) * BUF, bn = ((j + 1) & 1) * BUF;
        if (j + 1 < NT) ATT_LOAD(j + 1);
        if (j <= jmax) {
            f32x16 p0, p1;
            if (FOX) { const float cqm = cq - mhat;
#pragma unroll
                for (int g = 0; g < 4; ++g) { const f32x4 c0 = *(const LAS f32x4*)(L + bo + KBYTES + VBYTES + (8 * g + 4 * hi) * 4), c1 = *(const LAS f32x4*)(L + bo + KBYTES + VBYTES + (32 + 8 * g + 4 * hi) * 4);
#pragma unroll
                    for (int e = 0; e < 4; ++e) { p0[4 * g + e] = cqm - c0[e]; p1[4 * g + e] = cqm - c1[e]; } }
            } else {
#pragma unroll
                for (int r = 0; r < 16; ++r) { p0[r] = -mhat; p1[r] = -mhat; } }
#pragma unroll
            for (int s = 0; s < NS; ++s) { const bf16x8 k0 = *(const LAS bf16x8*)(L + bo + r32 * (KP * 2) + (16 * s + 8 * hi) * 2), k1 = *(const LAS bf16x8*)(L + bo + (32 + r32) * (KP * 2) + (16 * s + 8 * hi) * 2);
                p0 = __builtin_amdgcn_mfma_f32_32x32x16_bf16(k0, qf[s], p0, 0, 0, 0); p1 = __builtin_amdgcn_mfma_f32_32x32x16_bf16(k1, qf[s], p1, 0, 0, 0); }
            if (FOX && j == jmax) {
#pragma unroll
                for (int r = 0; r < 16; ++r) { const int kg = 64 * j + crow(r, hi); if (kg > q) p0[r] = -1e30f; if (kg + 32 > q) p1[r] = -1e30f; } }
            float mx = fmaxf(fmaxf(p0[0], p1[0]), fmaxf(p0[1], p1[1]));
#pragma unroll
            for (int r = 2; r < 16; r += 2) mx = fmaxf(mx, fmaxf(fmaxf(p0[r], p1[r]), fmaxf(p0[r + 1], p1[r + 1])));
            mx = fmaxf(mx, __shfl_xor(mx, 32));
            if (__any(mx > THR)) { const float dl = fmaxf(mx, 0.f), f = __builtin_amdgcn_exp2f(-dl); mhat += dl; lrun *= f;
#pragma unroll
                for (int r = 0; r < 16; ++r) { p0[r] -= dl; p1[r] -= dl; o0[r] *= f; o1[r] *= f; } }
            float ls0 = 0.f, ls1 = 0.f;
#pragma unroll
            for (int r = 0; r < 16; ++r) { p0[r] = __builtin_amdgcn_exp2f(p0[r]); p1[r] = __builtin_amdgcn_exp2f(p1[r]); ls0 += p0[r]; ls1 += p1[r]; }
            lrun += ls0 + ls1;
            u32x4 pw[4];
#pragma unroll
            for (int ks = 0; ks < 4; ++ks) { const int b = 8 * (ks & 1);
                if (ks < 2) pw[ks] = (u32x4){pk2(p0[b], p0[b + 1]), pk2(p0[b + 2], p0[b + 3]), pk2(p0[b + 4], p0[b + 5]), pk2(p0[b + 6], p0[b + 7])};
                else        pw[ks] = (u32x4){pk2(p1[b], p1[b + 1]), pk2(p1[b + 2], p1[b + 3]), pk2(p1[b + 4], p1[b + 5]), pk2(p1[b + 6], p1[b + 7])}; }
#pragma unroll
            for (int ks = 0; ks < 4; ++ks) {
                const LAS unsigned char* vb = L + bo + KBYTES + r32 * 136 + 32 * ks + 8 * hi;
                const u32x2 a0 = *(const LAS u32x2*)(vb), a1 = *(const LAS u32x2*)(vb + 16), b0 = *(const LAS u32x2*)(vb + 32 * 136), b1 = *(const LAS u32x2*)(vb + 32 * 136 + 16);
                const bf16x8 va = __builtin_bit_cast(bf16x8, (u32x4){a0.x, a0.y, a1.x, a1.y}), vbb = __builtin_bit_cast(bf16x8, (u32x4){b0.x, b0.y, b1.x, b1.y}), pf = __builtin_bit_cast(bf16x8, pw[ks]);
                o0 = __builtin_amdgcn_mfma_f32_32x32x16_bf16(va, pf, o0, 0, 0, 0); o1 = __builtin_amdgcn_mfma_f32_32x32x16_bf16(vbb, pf, o1, 0, 0, 0); }
        }
        if (j + 1 < NT) ATT_WRITE(bn);
        __syncthreads();
    }
#undef ATT_LOAD
#undef ATT_WRITE
    const float inv = 1.0f / (lrun + __shfl_xor(lrun, 32));
    bf16_t* op = Ob + (size_t)q * ldo + 4 * hi;
#pragma unroll
    for (int g = 0; g < 4; ++g) { u32x2 w0, w1; w0.x = pk2(o0[4 * g] * inv, o0[4 * g + 1] * inv); w0.y = pk2(o0[4 * g + 2] * inv, o0[4 * g + 3] * inv);
        w1.x = pk2(o1[4 * g] * inv, o1[4 * g + 1] * inv); w1.y = pk2(o1[4 * g + 2] * inv, o1[4 * g + 3] * inv);
        *(u32x2*)(op + 8 * g) = w0; *(u32x2*)(op + 32 + 8 * g) = w1; }
}
__device__ __forceinline__ void fox_knorm(int gw, int ngw, int lane, const bf16_t* KF, float* KNRM) {
    for (int it = gw; it < 16 * 256; it += ngw) { const int bh = it >> 8, j = it & 255, b = bh >> 3, h = bh & 7;
        const u32x4* kp = (const u32x4*)(KF + ((size_t)b * S + 64 * j + lane) * 512 + h * 64); float n2 = 0.f;
#pragma unroll
        for (int c = 0; c < 8; ++c) { const u32x4 v = kp[c]; const unsigned ww[4] = {v.x, v.y, v.z, v.w};
#pragma unroll
            for (int e = 0; e < 4; ++e) { const float a = bflo(ww[e]), bb = bfhi(ww[e]); n2 += a * a + bb * bb; } }
#pragma unroll
        for (int o = 1; o < 64; o <<= 1) n2 = fmaxf(n2, __shfl_xor(n2, o));
        if (lane == 0) KNRM[it] = sqrtf(n2); }
}

constexpr int RT_KZP = 144;
constexpr int RT_QP = 528;
constexpr int RT_OFF_KZ = 0, RT_OFF_Q = 256 * RT_KZP, RT_OFF_K = RT_OFF_Q + 64 * RT_QP, RT_OFF_P = RT_OFF_K + 64 * RT_QP, RT_OFF_SS = RT_OFF_P + 64 * RT_KZP, RT_LDS = RT_OFF_SS + 64 * 8 * 4;
static_assert(RT_LDS <= 131072, "retention LDS");

__device__ __forceinline__ void ret_local(int wave_, LAS unsigned char* L, const bf16_t* KZT, const bf16_t* VT, f32x4* Lout, int u) {
    const int tid = wave_ * 64 + lane_id_opaque();
    const int lane = tid & 63, w = __builtin_amdgcn_readfirstlane(tid >> 6), l15 = lane & 15, g = lane >> 4;
    const int h = u >> 6, seg = (u >> 2) & 15, eb = u & 3, E0 = eb * 128 + w * 16;
    const float gc = __builtin_exp2f(64.0f * log2_gamma(h));
    f32x4 st[16];
#pragma unroll
    for (int i = 0; i < 16; ++i) st[i] = (f32x4){0.f, 0.f, 0.f, 0.f};
    u32x4 kz[4];
    const bf16_t* kzb = KZT + (size_t)(h * 256 + seg * SEGC) * 256 * 64;
#define R1_LOAD(ci) do { _Pragma("unroll") for (int i = 0; i < 4; ++i) kz[i] = *(const u32x4*)(kzb + (size_t)(ci) * 16384 + (size_t)(tid + 512 * i) * 8); } while (0)
#define R1_WRITE() do { _Pragma("unroll") for (int i = 0; i < 4; ++i) { const int id = tid + 512 * i; *(LAS u32x4*)(L + RT_OFF_KZ + (id >> 3) * RT_KZP + (id & 7) * 16) = kz[i]; } } while (0)
    R1_LOAD(0);
    for (int ci = 0; ci < SEGC; ++ci) {
        R1_WRITE(); __syncthreads();
        if (ci + 1 < SEGC) R1_LOAD(ci + 1);
        const bf16_t* vp = VT + ((size_t)(h * 256 + seg * SEGC + ci) * 512 + E0 + l15) * 64 + 8 * g;
        const bf16x8 vf0 = *(const bf16x8*)vp, vf1 = *(const bf16x8*)(vp + 32);
        if (ci > 0) {
#pragma unroll
            for (int i = 0; i < 16; ++i) st[i] *= gc; }
#pragma unroll
        for (int dt = 0; dt < 16; ++dt) { const LAS unsigned char* ap = L + RT_OFF_KZ + (16 * dt + l15) * RT_KZP + 16 * g;
            st[dt] = __builtin_amdgcn_mfma_f32_16x16x32_bf16(*(const LAS bf16x8*)ap, vf0, st[dt], 0, 0, 0);
            st[dt] = __builtin_amdgcn_mfma_f32_16x16x32_bf16(*(const LAS bf16x8*)(ap + 64), vf1, st[dt], 0, 0, 0); }
        __syncthreads();
    }
#undef R1_LOAD
#undef R1_WRITE
    f32x4* lo = Lout + ((size_t)(u * 8 + w) * 16) * 64 + lane;
#pragma unroll
    for (int dt = 0; dt < 16; ++dt) lo[dt * 64] = st[dt];
}

__device__ __forceinline__ void ret_scan(int wave_, LAS unsigned char* L, const bf16_t* QX, const bf16_t* KN, const bf16_t* KZT, const bf16_t* VT, const f32x4* Lin, bf16_t* O  , float* PO  , int u) {
    const int tid = wave_ * 64 + lane_id_opaque();
    const int lane = tid & 63, w = __builtin_amdgcn_readfirstlane(tid >> 6), l15 = lane & 15, g = lane >> 4;
    const int h = u >> 6, seg = (u >> 2) & 15, eb = u & 3, E0 = eb * 128 + w * 16;
    const float l2g = log2_gamma(h), gc = __builtin_exp2f(64.0f * l2g);
    f32x4 st[16];
#pragma unroll
    for (int i = 0; i < 16; ++i) st[i] = (f32x4){0.f, 0.f, 0.f, 0.f};
    for (int j = 0; j < seg; ++j) { const float wj = __builtin_exp2f((float)(64 * SEGC * (seg - 1 - j)) * l2g); const int uj = (u & ~(15 << 2)) | (j << 2);
        const f32x4* li = Lin + ((size_t)(uj * 8 + w) * 16) * 64 + lane;
#pragma unroll
        for (int dt = 0; dt < 16; ++dt) st[dt] += li[dt * 64] * wj; }
    u32x4 kz[4], qx[4], kn[4];
    const bf16_t* kzb = KZT + (size_t)(h * 256 + seg * SEGC) * 256 * 64;
    const bf16_t* qb = QX + (size_t)(seg * SEGC * 64) * 1024 + h * 256; const bf16_t* kb = KN + (size_t)(seg * SEGC * 64) * 1024 + h * 256;
#define R2_LOADKZ(ci) do { _Pragma("unroll") for (int i = 0; i < 4; ++i) { const int id = tid + 512 * i; kz[i] = *(const u32x4*)(kzb + (size_t)(ci) * 16384 + (size_t)id * 8); } } while (0)
#define R2_LOADQK(ci) do { _Pragma("unroll") for (int i = 0; i < 4; ++i) { const int id = tid + 512 * i; \
        qx[i] = *(const u32x4*)(qb + (size_t)((ci) * 64 + (id >> 5)) * 1024 + (id & 31) * 8); kn[i] = *(const u32x4*)(kb + (size_t)((ci) * 64 + (id >> 5)) * 1024 + (id & 31) * 8); } } while (0)
#define R2_WRITE() do { _Pragma("unroll") for (int i = 0; i < 4; ++i) { const int id = tid + 512 * i; *(LAS u32x4*)(L + RT_OFF_KZ + (id >> 3) * RT_KZP + (id & 7) * 16) = kz[i]; \
        *(LAS u32x4*)(L + RT_OFF_Q + (id >> 5) * RT_QP + (id & 31) * 16) = qx[i]; *(LAS u32x4*)(L + RT_OFF_K + (id >> 5) * RT_QP + (id & 31) * 16) = kn[i]; } } while (0)
    R2_LOADKZ(0); R2_LOADQK(0);
    const int tr = w >> 1;
    for (int ci = 0; ci < SEGC; ++ci) {
        R2_WRITE(); __syncthreads();
        if (ci + 1 < SEGC) R2_LOADKZ(ci + 1);
        const int chunk = seg * SEGC + ci;
        const bf16_t* vp = VT + ((size_t)(h * 256 + chunk) * 512 + E0 + l15) * 64 + 8 * g;
        const bf16x8 vf0 = *(const bf16x8*)vp, vf1 = *(const bf16x8*)(vp + 32);
#pragma unroll
        for (int t2 = 0; t2 < 2; ++t2) { const int tc = 2 * (w & 1) + t2; f32x4 pa = {0.f, 0.f, 0.f, 0.f};
            if (tc <= tr) {
#pragma unroll
                for (int ks = 0; ks < 8; ++ks) pa = __builtin_amdgcn_mfma_f32_16x16x32_bf16(*(const LAS bf16x8*)(L + RT_OFF_Q + (16 * tr + l15) * RT_QP + 64 * ks + 16 * g),
                                                                                           *(const LAS bf16x8*)(L + RT_OFF_K + (16 * tc + l15) * RT_QP + 64 * ks + 16 * g), pa, 0, 0, 0);
                const int cp = 16 * tc + l15; const float dk = __builtin_exp2f(-(float)(cp + 1) * l2g);
#pragma unroll
                for (int r = 0; r < 4; ++r) { const int c = 16 * tr + 4 * g + r; pa[r] = (c >= cp) ? pa[r] * dk : 0.f; } }
#pragma unroll
            for (int r = 0; r < 4; ++r) *(LAS bf16_t*)(L + RT_OFF_P + (16 * tr + 4 * g + r) * RT_KZP + (16 * tc + l15) * 2) = (bf16_t)f2bf(pa[r]); }
        __syncthreads();
        bf16x8 sb[8];
#pragma unroll
        for (int ks = 0; ks < 8; ++ks) sb[ks] = __builtin_bit_cast(bf16x8, (u32x4){pk2(st[2 * ks][0], st[2 * ks][1]), pk2(st[2 * ks][2], st[2 * ks][3]), pk2(st[2 * ks + 1][0], st[2 * ks + 1][1]), pk2(st[2 * ks + 1][2], st[2 * ks + 1][3])});
#pragma unroll
        for (int mt = 0; mt < 4; ++mt) { f32x4 oa = {0.f, 0.f, 0.f, 0.f};
#pragma unroll
            for (int ks = 0; ks < 8; ++ks) oa = __builtin_amdgcn_mfma_f32_16x16x32_bf16(*(const LAS bf16x8*)(L + RT_OFF_Q + (16 * mt + l15) * RT_QP + 64 * ks + 16 * g), sb[ks], oa, 0, 0, 0);
            oa = __builtin_amdgcn_mfma_f32_16x16x32_bf16(*(const LAS bf16x8*)(L + RT_OFF_P + (16 * mt + l15) * RT_KZP + 16 * g), vf0, oa, 0, 0, 0);
            oa = __builtin_amdgcn_mfma_f32_16x16x32_bf16(*(const LAS bf16x8*)(L + RT_OFF_P + (16 * mt + l15) * RT_KZP + 64 + 16 * g), vf1, oa, 0, 0, 0);
#pragma unroll
            for (int r = 0; r < 4; ++r) { const int c = 16 * mt + 4 * g + r; O[(size_t)(chunk * 64 + c) * 2048 + h * 512 + E0 + l15] = (bf16_t)f2bf(oa[r]);
                float ss = oa[r] * oa[r]; ss += __shfl_xor(ss, 1); ss += __shfl_xor(ss, 2); ss += __shfl_xor(ss, 4); ss += __shfl_xor(ss, 8);
                if (l15 == 0) *(LAS float*)(L + RT_OFF_SS + (c * 8 + w) * 4) = ss; } }
        if (ci + 1 < SEGC) R2_LOADQK(ci + 1);
#pragma unroll
        for (int i = 0; i < 16; ++i) st[i] *= gc;
#pragma unroll
        for (int dt = 0; dt < 16; ++dt) { const LAS unsigned char* ap = L + RT_OFF_KZ + (16 * dt + l15) * RT_KZP + 16 * g;
            st[dt] = __builtin_amdgcn_mfma_f32_16x16x32_bf16(*(const LAS bf16x8*)ap, vf0, st[dt], 0, 0, 0);
            st[dt] = __builtin_amdgcn_mfma_f32_16x16x32_bf16(*(const LAS bf16x8*)(ap + 64), vf1, st[dt], 0, 0, 0); }
        __syncthreads();
        if (tid < 64) { const LAS float* sp = (const LAS float*)(L + RT_OFF_SS + tid * 32); float s = 0.f;
#pragma unroll
            for (int i = 0; i < 8; ++i) s += sp[i];
            PO[(size_t)(chunk * 64 + tid) * 16 + h * 4 + eb] = s; }
    }
#undef R2_LOADKZ
#undef R2_LOADQK
#undef R2_WRITE
}

struct Ctx { int wave, vcu, G, gw, ngw; LAS unsigned char* lds; };
#define CTX_LANE const int lane_ = lane_id_opaque(), tid_ = C.wave * 64 + lane_

__device__ __forceinline__ void tr_item(const float* W, int ldw, int k0, int n0, int nvalid, const float* gain, bf16_t* dst, int ldd, LAS float* scr, int lane) {
#pragma unroll 8
    for (int i = 0; i < 32; ++i) { const int kk = 2 * i + (lane >> 5), nn = lane & 31; float v = (nn < nvalid) ? W[(size_t)(k0 + kk) * ldw + n0 + nn] : 0.f; if (gain) v *= gain[k0 + kk]; scr[kk * 33 + nn] = v; }
    asm volatile("s_waitcnt lgkmcnt(0)" ::: "memory");
    const int c = lane & 7;
#pragma unroll
    for (int j = 0; j < 4; ++j) { const int n = (lane >> 3) + 8 * j; const LAS float* s = scr + (8 * c) * 33 + n;
        u32x4 o; o.x = pk2(s[0], s[33]); o.y = pk2(s[2 * 33], s[3 * 33]); o.z = pk2(s[4 * 33], s[5 * 33]); o.w = pk2(s[6 * 33], s[7 * 33]);
        if (n < nvalid) *(u32x4*)(dst + (size_t)n * ldd + 8 * c) = o; }
    asm volatile("s_waitcnt lgkmcnt(0)" ::: "memory");
}
__device__ __forceinline__ void zero_rows(const Ctx& C, bf16_t* base, size_t pitch_el, int nrows, int col0, int ncol) {
    CTX_LANE;
    const int per = ncol / 8; const long n = (long)nrows * per;
    for (long i = (long)C.gw * 64 + lane_; i < n; i += (long)C.ngw * 64) { const long r = i / per; const int c = (int)(i % per); *(u32x4*)(base + (size_t)r * pitch_el + col0 + c * 8) = (u32x4){0u, 0u, 0u, 0u}; }
}
__device__ __forceinline__ void convert_moe(const Ctx& C, const Params&, int layer) {
    CTX_LANE;
    WS_OPAQUE;
    LAS float* scr = (LAS float*)(C.lds + C.wave * 16384);
    bf16_t* GU = WSP(bf16_t, OFF_WGU); bf16_t* DN = WSP(bf16_t, OFF_WDN); const float* gain = P.in[I_LN_FFN] + layer * 1024;
    for (int it = C.gw; it < 32 * 768; it += C.ngw) { const int e = it / 768, r = it % 768;
        if (r < 512) { const int up = r >> 8, rr = r & 255, kb = rr >> 4, nb = rr & 15, n0 = 32 * nb; const float* W = (up ? P.in[I_W_UP] : P.in[I_W_GATE]) + (size_t)(layer * 32 + e) * 1024 * 512;
            const int drow = 256 * (n0 >> 7) + (n0 & 127) + up * 128;
            tr_item(W, 512, 64 * kb, n0, 32, gain, GU + ((size_t)(e * 1024 + drow) * 1024 + 64 * kb), 1024, scr, lane_); }
        else { const int rr = r - 512, kb = rr >> 5, nb = rr & 31; const float* W = P.in[I_W_DOWN] + (size_t)(layer * 32 + e) * 512 * 1024;
            tr_item(W, 1024, 64 * kb, 32 * nb, 32, nullptr, DN + ((size_t)(e * 1024 + 32 * nb) * 512 + 64 * kb), 512, scr, lane_); } }
}
__device__ __forceinline__ void convert_mixer(const Ctx& C, const Params&) {
    CTX_LANE;
    WS_OPAQUE;
    LAS float* scr = (LAS float*)(C.lds + C.wave * 16384);
    bf16_t* WA1 = WSP(bf16_t, W_A1); bf16_t* WA1V = WSP(bf16_t, W_A1V); bf16_t* WA2 = WSP(bf16_t, W_A2); bf16_t* WA2V = WSP(bf16_t, W_A2V);
    bf16_t* WOE = WSP(bf16_t, W_OE); bf16_t* WB1 = WSP(bf16_t, W_B1); bf16_t* WOO = WSP(bf16_t, W_OO);
    constexpr int N1 = 16 * 62, N2 = 4 * 24, N3 = 2 * 32, N4 = 16 * 32, N5 = 16 * 192, N6 = 32 * 32, NT_ = N1 + N2 + N3 + N4 + N5 + N6;
    for (int it = C.gw; it < NT_; it += C.ngw) { int r = it;
        if (r < N1) { const int kb = r / 62, nb = r % 62, n0 = 32 * nb, k0 = 64 * kb; bf16_t* dst; int nv = 32;
            if (n0 < 416) dst = WA1 + (size_t)n0 * 1024; else if (n0 < 928) dst = WA1 + (size_t)(512 + n0 - 416) * 1024; else if (n0 < 1440) dst = WA1 + (size_t)(1024 + n0 - 928) * 1024;
            else if (n0 < 1952) dst = WA1V + (size_t)(n0 - 1440) * 1024; else { dst = WA1 + (size_t)416 * 1024; nv = 8; }
            tr_item(P.in[I_W_IN_E], 1960, k0, n0, nv, P.in[I_LN_MIX_E], dst + k0, 1024, scr, lane_); continue; } r -= N1;
        if (r < N2) { const int kb = r / 24, nb = r % 24, n0 = 32 * nb, hh = n0 / 96, off = n0 % 96;
            tr_item(P.in[I_W_UQ], 768, 64 * kb, n0, 32, P.in[I_LN_Q], WA2 + (size_t)(128 * hh + off) * 256 + 64 * kb, 256, scr, lane_); continue; } r -= N2;
        if (r < N3) { const int kb = r / 32, nb = r % 32, n0 = 32 * nb, hh = n0 / 128, off = n0 % 128;
            bf16_t* dst = off < 64 ? WA2 + (size_t)(1024 + 64 * hh + off) * 256 : WA2V + (size_t)(64 * hh + off - 64) * 256;
            tr_item(P.in[I_W_UKV], 1024, 64 * kb, n0, 32, P.in[I_LN_KV], dst + 64 * kb, 256, scr, lane_); continue; } r -= N3;
        if (r < N4) { const int kb = r / 32, nb = r % 32; tr_item(P.in[I_W_OUT_E], 1024, 64 * kb, 32 * nb, 32, nullptr, WOE + (size_t)(32 * nb) * 1024 + 64 * kb, 1024, scr, lane_); continue; } r -= N4;
        if (r < N5) { const int kb = r / 192, nb = r % 192; tr_item(P.in[I_W_IN_O], 6144, 64 * kb, 32 * nb, 32, P.in[I_LN_MIX_O], WB1 + (size_t)(32 * nb) * 1024 + 64 * kb, 1024, scr, lane_); continue; } r -= N5;
        { const int kb = r / 32, nb = r % 32; tr_item(P.in[I_W_OUT_O], 1024, 64 * kb, 32 * nb, 32, nullptr, WOO + (size_t)(32 * nb) * 2048 + 64 * kb, 2048, scr, lane_); } }
    zero_rows(C, WA1 + (size_t)424 * 1024, 1024, 88, 0, 1024);
    for (int hh = 0; hh < 8; ++hh) zero_rows(C, WA2 + (size_t)(128 * hh + 96) * 256, 256, 32, 0, 256);
    zero_rows(C, WA2 + (size_t)1024 * 256, 256, 512, 128, 128);
    zero_rows(C, WA2V, 256, 512, 128, 128);
}
__device__ __forceinline__ void make_rope(const Ctx& C, const Params&) {
    CTX_LANE;
    WS_OPAQUE;
    f32x2* rope = WSP(f32x2, OFF_ROPE);
    for (int i = C.gw * 64 + lane_; i < S * 128; i += C.ngw * 64) { const int pos = i >> 7, k = i & 127; const float inv = __builtin_exp2f(-(float)k * (13.287712379549449f / 128.0f));
        const float ang = (float)pos * inv; const double a = (double)ang; rope[i] = (f32x2){(float)cos(a), (float)sin(a)}; }
}
__device__ __forceinline__ void rows_to_bf16(const Ctx& C, const float* X, bf16_t* XB, float* RS) {
    CTX_LANE;
    for (int r = C.gw; r < T; r += C.ngw) { const f32x4* xr = (const f32x4*)(X + (size_t)r * D) + lane_; f32x4 v[4]; float s = 0.f;
#pragma unroll
        for (int j = 0; j < 4; ++j) { v[j] = xr[64 * j]; s += (v[j][0] * v[j][0] + v[j][1] * v[j][1]) + (v[j][2] * v[j][2] + v[j][3] * v[j][3]); }
        s = wave_sum(s); u32x2* o = (u32x2*)(XB + (size_t)r * D) + lane_;
#pragma unroll
        for (int j = 0; j < 4; ++j) o[64 * j] = (u32x2){pk2(v[j][0], v[j][1]), pk2(v[j][2], v[j][3])};
        if (lane_ == 0) RS[r] = rsqrt_f(s * (1.0f / D) + EPS); }
}
__device__ __forceinline__ void fox_cumsum(const Ctx& C, const float* LF, float* CUM, int bh) {
    CTX_LANE;
    LAS float* tot = (LAS float*)C.lds; const int b = bh >> 3, h = bh & 7; float v[32]; float run = 0.f;
#pragma unroll
    for (int i = 0; i < 32; ++i) { run += LF[((size_t)b * S + tid_ * 32 + i) * 8 + h]; v[i] = run; }
    tot[tid_] = run; __syncthreads();
    float off = 0.f; for (int t2 = 0; t2 < tid_; ++t2) off += tot[t2];
#pragma unroll
    for (int i = 0; i < 32; ++i) CUM[(size_t)bh * S + tid_ * 32 + i] = (off + v[i]) * LOG2E;
    __syncthreads();
}
__device__ __forceinline__ void moe_router(const Ctx& C, const Params&, int layer, int blk) {
    CTX_LANE;
    WS_OPAQUE;
    const float* XF = P.out; bf16_t* XB = WSP(bf16_t, OFF_XB); float* RS1 = WSP(float, SM_RS1);
    int* EID = WSP(int, SM_EID); float* GATE = WSP(float, SM_GATE); int* RANK = WSP(int, SM_RANK); int* CNT = WSP(int, SM_CNT);
    const float* wrg = P.in[I_W_RG] + (size_t)layer * 1024 * 4; const float* wre = P.in[I_W_RE] + (size_t)layer * 1024 * 32; const float* lnf = P.in[I_LN_FFN] + layer * 1024;
    LAS float* lg = (LAS float*)C.lds;
    LAS float* rsl = (LAS float*)(C.lds + 128 * 40 * 4);
    LAS int* eidl = (LAS int*)(C.lds + 128 * 40 * 4 + 512);
    float wv[5][16];
#pragma unroll
    for (int i = 0; i < 5; ++i) { const int o = C.wave + 8 * i; const int oc = o < 36 ? o : 35; const float* wp = oc < 4 ? wrg + oc : wre + (oc - 4); const int wst = oc < 4 ? 4 : 32; const float wz = o < 36 ? 1.f : 0.f;
#pragma unroll
        for (int j = 0; j < 4; ++j)
#pragma unroll
            for (int e = 0; e < 4; ++e) { const int k = 256 * j + 4 * lane_ + e; wv[i][4 * j + e] = lnf[k] * wp[(size_t)k * wst] * wz; } }
    for (int tt0 = 0; tt0 < 128; tt0 += 4) { f32x4 v[4][4];
#pragma unroll
        for (int q = 0; q < 4; ++q) { const f32x4* xr = (const f32x4*)(XF + (size_t)(blk * 128 + tt0 + q) * D) + lane_;
#pragma unroll
            for (int j = 0; j < 4; ++j) v[q][j] = xr[64 * j]; }
#pragma unroll
        for (int q = 0; q < 4; ++q) { const int tt = tt0 + q, t = blk * 128 + tt;
            if ((tt & 7) == C.wave) { float s = 0.f;
#pragma unroll
                for (int j = 0; j < 4; ++j) s += (v[q][j][0] * v[q][j][0] + v[q][j][1] * v[q][j][1]) + (v[q][j][2] * v[q][j][2] + v[q][j][3] * v[q][j][3]);
                s = wave_sum(s); const float rs = rsqrt_f(s * (1.0f / D) + EPS); u32x2* o = (u32x2*)(XB + (size_t)t * D) + lane_;
#pragma unroll
                for (int j = 0; j < 4; ++j) o[64 * j] = (u32x2){pk2(v[q][j][0], v[q][j][1]), pk2(v[q][j][2], v[q][j][3])};
                if (lane_ == 0) { RS1[t] = rs; rsl[tt] = rs; } }
            float d[5];
#pragma unroll
            for (int i = 0; i < 5; ++i) { d[i] = 0.f;
#pragma unroll
                for (int j = 0; j < 4; ++j) d[i] += (v[q][j][0] * wv[i][4 * j] + v[q][j][1] * wv[i][4 * j + 1]) + (v[q][j][2] * wv[i][4 * j + 2] + v[q][j][3] * wv[i][4 * j + 3]); }
#pragma unroll
            for (int o2 = 1; o2 < 64; o2 <<= 1) {
#pragma unroll
                for (int i = 0; i < 5; ++i) d[i] += __shfl_xor(d[i], o2); }
            if (lane_ == 0) {
#pragma unroll
                for (int i = 0; i < 5; ++i) if (C.wave + 8 * i < 36) lg[tt * 40 + C.wave + 8 * i] = d[i]; } } }
    __syncthreads();
    if (tid_ < 128) { const int tt = tid_, t = blk * 128 + tt; const float rs = rsl[tt]; const float* brg = P.in[I_B_RG] + layer * 4; const float* bre = P.in[I_B_RE] + layer * 32;
        float gl[4]; int gs = 0;
#pragma unroll
        for (int o = 0; o < 4; ++o) { gl[o] = lg[tt * 40 + o] * rs + brg[o]; if (gl[o] > gl[gs]) gs = o; }
        float gsum = 0.f;
#pragma unroll
        for (int o = 0; o < 4; ++o) gsum += __expf(gl[o] - gl[gs]);
        const float pg = 1.0f / gsum;
        float el[8]; int j1 = 0;
#pragma unroll
        for (int j = 0; j < 8; ++j) { el[j] = lg[tt * 40 + 4 + 8 * gs + j] * rs + bre[8 * gs + j]; if (el[j] > el[j1]) j1 = j; }
        int j2 = (j1 == 0) ? 1 : 0;
#pragma unroll
        for (int j = 0; j < 8; ++j) if (j != j1 && el[j] > el[j2]) j2 = j;
        const float e2 = __expf(el[j2] - el[j1]), den = 1.0f / (1.0f + e2);
        const int ea = 8 * gs + j1, eb = 8 * gs + j2;
        EID[t * 2] = ea; EID[t * 2 + 1] = eb; GATE[t * 2] = pg * den; GATE[t * 2 + 1] = pg * e2 * den; eidl[2 * tt] = ea; eidl[2 * tt + 1] = eb; }
    __syncthreads();
    if (tid_ < 256) { const int me = eidl[tid_]; int rk = 0; for (int a = 0; a < tid_; ++a) rk += (eidl[a] == me) ? 1 : 0; RANK[blk * 256 + tid_] = rk; }
    if (tid_ < 32) { int c = 0; for (int a = 0; a < 256; ++a) c += (eidl[a] == tid_) ? 1 : 0; CNT[blk * 32 + tid_] = c; }
    __syncthreads();
}
__device__ __forceinline__ void moe_scatter(const Ctx& C, const Params&, int blk) {
    CTX_LANE;
    WS_OPAQUE;
    const int* CNT = WSP(int, SM_CNT); const int* EID = WSP(int, SM_EID); const float* GATE = WSP(float, SM_GATE); const int* RANK = WSP(int, SM_RANK); const float* RS1 = WSP(float, SM_RS1);
    int* TSLOT = WSP(int, SM_TSLOT); int* STOK = WSP(int, SM_STOK); float* SW = WSP(float, SM_SW); float* SR = WSP(float, SM_SR); int* TILEE = WSP(int, SM_TILEE);
    const bf16_t* XB = WSP(bf16_t, OFF_XB); bf16_t* XS = WSP(bf16_t, A_XS);
    LAS int* part = (LAS int*)C.lds;
    LAS int* tot = part + 1024;
    LAS int* slotl = tot + 128;
    { const int e = tid_ & 31, pt = tid_ >> 5; int s = 0, pre = 0;
        for (int b = pt * 16; b < pt * 16 + 16; ++b) { const int c = ld_i(CNT + b * 32 + e); s += c; if (b < blk) pre += c; }
        part[pt * 32 + e] = s; part[512 + pt * 32 + e] = pre; }
    __syncthreads();
    if (tid_ < 32) { int s = 0, pre = 0; for (int pt = 0; pt < 16; ++pt) { s += part[pt * 32 + tid_]; pre += part[512 + pt * 32 + tid_]; } tot[tid_] = s; tot[32 + tid_] = pre; }
    __syncthreads();
    if (tid_ == 0) { int ps = 0; for (int e = 0; e < 32; ++e) { tot[64 + e] = ps; ps += (tot[e] + 255) & ~255; } tot[96] = ps; }
    __syncthreads();
    if (tid_ < 256) { const int a = blk * 256 + tid_, t = a >> 1, e = EID[a]; const int slot = tot[64 + e] + tot[32 + e] + RANK[a];
        slotl[tid_] = slot; TSLOT[a] = slot; STOK[slot] = t; SW[slot] = GATE[a]; SR[slot] = RS1[t]; }
    __syncthreads();
    for (int i = C.wave; i < 256; i += 8) { const int slot = slotl[i], t = (blk * 256 + i) >> 1;
        const u32x4* s = (const u32x4*)(XB + (size_t)t * D) + lane_; u32x4* d = (u32x4*)(XS + (size_t)slot * D) + lane_; d[0] = s[0]; d[64] = s[64]; }
    if (blk < 32) { const int e = blk, beg = tot[64 + e] + tot[e], end = tot[64 + e] + ((tot[e] + 255) & ~255);
        for (int sl = beg + C.wave; sl < end; sl += 8) { u32x4* d = (u32x4*)(XS + (size_t)sl * D) + lane_; d[0] = (u32x4){0u, 0u, 0u, 0u}; d[64] = (u32x4){0u, 0u, 0u, 0u}; if (lane_ == 0) { STOK[sl] = -1; SW[sl] = 0.f; SR[sl] = 0.f; } } }
    if (blk == 0 && tid_ < 32) { const int e = tid_, t0 = tot[64 + e] >> 8, nt = ((tot[e] + 255) & ~255) >> 8; for (int i = 0; i < nt; ++i) TILEE[t0 + i] = e; if (e == 0) TILEE[300] = tot[96] >> 8; }
    __syncthreads();
}
template <int MODE> __device__ __forceinline__ void moe_combine(const Ctx& C, const Params&, float* RS, const float* gainf) {
    CTX_LANE;
    WS_OPAQUE;
    float* XF = P.out; bf16_t* XB = WSP(bf16_t, OFF_XB); const bf16_t* YS = WSP(bf16_t, A_XS); const int* TSLOT = WSP(int, SM_TSLOT);
    for (int t = C.gw; t < T; t += C.ngw) { const int sa = ld_i(TSLOT + 2 * t), sb = ld_i(TSLOT + 2 * t + 1); f32x4* xr = (f32x4*)(XF + (size_t)t * D) + lane_;
        const u32x2* ya = (const u32x2*)(YS + (size_t)sa * D) + lane_; const u32x2* yb = (const u32x2*)(YS + (size_t)sb * D) + lane_; f32x4 v[4]; float s = 0.f;
#pragma unroll
        for (int j = 0; j < 4; ++j) { const u32x2 a = ya[64 * j], b = yb[64 * j]; v[j] = xr[64 * j];
            v[j][0] += bflo(a.x) + bflo(b.x); v[j][1] += bfhi(a.x) + bfhi(b.x); v[j][2] += bflo(a.y) + bflo(b.y); v[j][3] += bfhi(a.y) + bfhi(b.y);
            s += (v[j][0] * v[j][0] + v[j][1] * v[j][1]) + (v[j][2] * v[j][2] + v[j][3] * v[j][3]); }
        s = wave_sum(s); const float rs = rsqrt_f(s * (1.0f / D) + EPS);
        if (MODE == 0) { u32x2* o = (u32x2*)(XB + (size_t)t * D) + lane_;
#pragma unroll
            for (int j = 0; j < 4; ++j) { xr[64 * j] = v[j]; o[64 * j] = (u32x2){pk2(v[j][0], v[j][1]), pk2(v[j][2], v[j][3])}; }
            if (lane_ == 0) RS[t] = rs; }
        else { const f32x4* gr = (const f32x4*)gainf + lane_;
#pragma unroll
            for (int j = 0; j < 4; ++j) xr[64 * j] = v[j] * rs * gr[64 * j]; } }
}

constexpr int LDS_BYTES = 147456;
constexpr int LDS_MISC = LDS_BYTES - 256;
constexpr int NPHASE = 23;

__global__ void __launch_bounds__(512, 2) fwd_kernel(Params Pkern) {
    extern __shared__ __attribute__((aligned(16))) unsigned char lds_raw[];
    LAS unsigned char* lds = (LAS unsigned char*)lds_raw;
    Ctx C; { const int t0_ = threadIdx.x; C.wave = __builtin_amdgcn_readfirstlane(t0_ >> 6); } C.G = gridDim.x;
    C.vcu = (C.G % 8 == 0) ? ((int)blockIdx.x % 8) * (C.G / 8) + (int)blockIdx.x / 8 : (int)blockIdx.x;
    C.gw = C.vcu * 8 + C.wave; C.ngw = C.G * 8; C.lds = lds;
    const int bx = blockIdx.x;
    { const int l0 = lane_id_opaque(); if (C.wave == 0) ((LAS unsigned*)(lds + LDS_MISC))[l0] = 0u; }
    __syncthreads();
    const unsigned xcc = xb_xcc_id();
    if (Pkern.use_bar) { const bool t0 = (C.wave == 0) && (lane_id_opaque() == 0); (void)xcd_barrier_post((unsigned*)(Pkern.ws + OFF_CTL) + 4096, (volatile LAS unsigned*)(lds + LDS_MISC), t0); }
    const int lo = Pkern.ph_lo, hi = Pkern.ph_hi;
    const Params& P = Pkern;
#ifndef PH_MASK
#define PH_MASK 0x7fffffu
#endif
#define IN(k) ((((unsigned)PH_MASK >> (k)) & 1u) && lo <= (k) && (k) < hi)
#ifndef PROBE_MASK
#define PROBE_MASK 0u
#endif
#define REP(k) for (int rep_ = 0; rep_ < ((((unsigned)PROBE_MASK >> (k)) & 1u) ? 2 : 1); ++rep_)
#define SEAM(k) do { if (IN(k) && IN((k) + 1)) { P_OPAQUE; XcdBarrier bar; bar.bar = (unsigned*)(P.ws + OFF_CTL) + 4096; bar.x = xcc; bar.st = (volatile LAS unsigned*)(lds + LDS_MISC); \
        const bool t0 = (C.wave == 0) && (lane_id_opaque() == 0); xcd_barrier(bar, t0); } } while (0)

    if (IN(0)) REP(0) { WS_OPAQUE; convert_mixer(C, P); convert_moe(C, P, 0); make_rope(C, P); rows_to_bf16(C, P.in[I_X], WSP(bf16_t, OFF_XB), WSP(float, SM_RS0)); __syncthreads(); }
    SEAM(0);
    if (IN(1)) REP(1) {
        { WS_OPAQUE; DenseSched Sd; Sd.init(WSP(bf16_t, OFF_XB), 1024, WSP(bf16_t, W_A1), 1024, 128, 6, C.G, bx);
          EpiA1a E{WSP(float, SM_RS0), WSP(bf16_t, A_Z), WSP(float, SM_PQ), WSP(float, SM_PKV), WSP(bf16_t, A_KA), WSP(float, SM_LF), P.in[I_B_F], WSP(bf16_t, A_QF), WSP(bf16_t, A_KF), WSP(f32x2, OFF_ROPE)};
          pg8::gemm_phase(C.wave, lds, pg8::Dims{1024, 1024, 1024}, Sd, E); }
        { WS_OPAQUE; DenseSched Sd; Sd.init(WSP(bf16_t, W_A1V), 1024, WSP(bf16_t, OFF_XB), 1024, 2, 128, C.G, bx);
          EpiVT<0> E{WSP(float, SM_RS0), WSP(bf16_t, A_VTF), (size_t)T};
          pg8::gemm_phase(C.wave, lds, pg8::Dims{1024, 1024, 1024}, Sd, E); }
    }
    SEAM(1);
    if (IN(2)) REP(2) {
        if (C.vcu < 16) { WS_OPAQUE; fox_cumsum(C, WSP(float, SM_LF), WSP(float, SM_CUM), C.vcu); }
        { WS_OPAQUE; fox_knorm(C.gw, C.ngw, lane_id_opaque(), WSP(bf16_t, A_KF), WSP(float, SM_KNRM)); }
        { WS_OPAQUE; DenseSched Sd; Sd.init(WSP(bf16_t, A_Z), 512, WSP(bf16_t, W_A2), 256, 128, 4, C.G, bx);
          EpiA2q E{WSP(float, SM_PQ), WSP(bf16_t, A_QA), WSP(f32x2, OFF_ROPE)};
          pg8::gemm_phase(C.wave, lds, pg8::Dims{512, 256, 256}, Sd, E); }
        { WS_OPAQUE; DenseSched Sd; Sd.init(WSP(bf16_t, A_Z) + 256, 512, WSP(bf16_t, W_A2) + (size_t)1024 * 256, 256, 128, 2, C.G, bx);
          EpiA2k E{WSP(float, SM_PKV), WSP(bf16_t, A_KA)};
          pg8::gemm_phase(C.wave, lds, pg8::Dims{512, 256, 256}, Sd, E); }
        { WS_OPAQUE; DenseSched Sd; Sd.init(WSP(bf16_t, W_A2V), 256, WSP(bf16_t, A_Z) + 256, 512, 2, 128, C.G, bx);
          EpiVT<1> E{WSP(float, SM_PKV), WSP(bf16_t, A_VTA), (size_t)T};
          pg8::gemm_phase(C.wave, lds, pg8::Dims{256, 512, 256}, Sd, E); }
    }
    SEAM(2);
    if (IN(3)) REP(3) {
        const int bh = C.vcu >> 4, s4 = C.vcu & 15, b = bh >> 3, h = bh & 7;
        { WS_OPAQUE; bf16_t* AO = WSP(bf16_t, OFF_XB);
          for (int i = 0; i < 4; ++i) { const int qb = (i == 0) ? s4 : (i == 1) ? 31 - s4 : (i == 2) ? 32 + s4 : 63 - s4;
            attn_unit<96, false>(C.wave, lds, WSP(bf16_t, A_QA) + (size_t)b * S * 768 + h * 96, 768, WSP(bf16_t, A_KA) + (size_t)b * S * 768 + h * 96, 768,
                                 WSP(bf16_t, A_VTA) + (size_t)(h * 64) * T + (size_t)b * S, nullptr, nullptr, AO + (size_t)b * S * 1024 + h * 64, 1024, qb); } }
        { WS_OPAQUE; bf16_t* AO = WSP(bf16_t, OFF_XB);
          for (int i = 0; i < 4; ++i) { const int qb = (i == 0) ? s4 : (i == 1) ? 31 - s4 : (i == 2) ? 32 + s4 : 63 - s4;
            attn_unit<64, true>(C.wave, lds, WSP(bf16_t, A_QF) + (size_t)b * S * 512 + h * 64, 512, WSP(bf16_t, A_KF) + (size_t)b * S * 512 + h * 64, 512,
                                WSP(bf16_t, A_VTF) + (size_t)(h * 64) * T + (size_t)b * S, WSP(float, SM_CUM) + (size_t)bh * S, WSP(float, SM_KNRM) + bh * 256, AO + (size_t)b * S * 1024 + 512 + h * 64, 1024, qb); } }
    }
    SEAM(3);
    if (IN(4)) REP(4) { WS_OPAQUE; DenseSched Sd; Sd.init(WSP(bf16_t, OFF_XB), 1024, WSP(bf16_t, W_OE), 1024, 128, 4, C.G, bx); EpiRes E{P.in[I_X], P.out};
        pg8::gemm_phase(C.wave, lds, pg8::Dims{1024, 1024, 1024}, Sd, E); }
    SEAM(4);

#define MOE_PHASES(layer, pb) do { \
        if (IN(pb)) REP(pb) moe_router(C, P, layer, bx); \
        SEAM(pb); \
        if (IN((pb) + 1)) REP((pb) + 1) moe_scatter(C, P, bx); \
        SEAM((pb) + 1); \
        if (IN((pb) + 2)) REP((pb) + 2) { WS_OPAQUE; MoeSched Sm; Sm.init(WSP(bf16_t, A_XS), 1024, WSP(bf16_t, OFF_WGU), 1024, 1024, WSP(int, SM_TILEE), C.G, bx); EpiM3 E{WSP(float, SM_SR), WSP(bf16_t, A_HID)}; \
            pg8::gemm_phase(C.wave, lds, pg8::Dims{1024, 1024, 1024}, Sm, E); } \
        SEAM((pb) + 2); \
        if (IN((pb) + 3)) REP((pb) + 3) { WS_OPAQUE; MoeSched Sm; Sm.init(WSP(bf16_t, A_HID), 512, WSP(bf16_t, OFF_WDN), 512, 1024, WSP(int, SM_TILEE), C.G, bx); EpiM4 E{WSP(float, SM_SW), WSP(bf16_t, A_XS)}; \
            pg8::gemm_phase(C.wave, lds, pg8::Dims{512, 512, 512}, Sm, E); } \
        SEAM((pb) + 3); } while (0)
#define RET_PHASES(bb, p0) do { \
        if (IN(p0)) REP(p0) { \
            { WS_OPAQUE; DenseSched Sd; Sd.init(WSP(bf16_t, OFF_XB) + (size_t)(bb) * S * 1024, 1024, WSP(bf16_t, W_B1), 1024, 64, 4, C.G, bx); EpiB1q E{WSP(float, SM_RS2) + (bb) * S, WSP(bf16_t, A_QX), WSP(f32x2, OFF_ROPE)}; \
              pg8::gemm_phase(C.wave, lds, pg8::Dims{1024, 1024, 1024}, Sd, E); } \
            { WS_OPAQUE; DenseSched Sd; Sd.init(WSP(bf16_t, W_B1) + (size_t)1024 * 1024, 1024, WSP(bf16_t, OFF_XB) + (size_t)(bb) * S * 1024, 1024, 4, 64, C.G, bx); EpiB1k E{WSP(float, SM_RS2) + (bb) * S, WSP(bf16_t, A_KN), WSP(bf16_t, A_KZT), WSP(f32x2, OFF_ROPE)}; \
              pg8::gemm_phase(C.wave, lds, pg8::Dims{1024, 1024, 1024}, Sd, E); } \
            { WS_OPAQUE; DenseSched Sd; Sd.init(WSP(bf16_t, W_B1) + (size_t)2048 * 1024, 1024, WSP(bf16_t, OFF_XB) + (size_t)(bb) * S * 1024, 1024, 8, 64, C.G, bx); EpiB1v E{WSP(float, SM_RS2) + (bb) * S, WSP(bf16_t, A_VT)}; \
              pg8::gemm_phase(C.wave, lds, pg8::Dims{1024, 1024, 1024}, Sd, E); } \
        } \
        SEAM(p0); \
        if (IN((p0) + 1)) REP((p0) + 1) { WS_OPAQUE; ret_local(C.wave, lds, WSP(bf16_t, A_KZT), WSP(bf16_t, A_VT), WSP(f32x4, A_L), C.vcu); } \
        SEAM((p0) + 1); \
        if (IN((p0) + 2)) REP((p0) + 2) { WS_OPAQUE; ret_scan(C.wave, lds, WSP(bf16_t, A_QX), WSP(bf16_t, A_KN), WSP(bf16_t, A_KZT), WSP(bf16_t, A_VT), WSP(f32x4, A_L), \
                                 WSP(bf16_t, A_O) + (size_t)(bb) * S * 2048, WSP(float, SM_PO) + (size_t)(bb) * S * 16, C.vcu); } \
        SEAM((p0) + 2); } while (0)

    MOE_PHASES(0, 5);
    if (IN(9)) { WS_OPAQUE; moe_combine<0>(C, P, WSP(float, SM_RS2), nullptr); convert_moe(C, P, 1); __syncthreads(); }
    SEAM(9);
    RET_PHASES(0, 10);
    RET_PHASES(1, 13);
    if (IN(16)) { WS_OPAQUE; DenseSched Sd; Sd.init(WSP(bf16_t, OFF_XB), 1024, WSP(bf16_t, W_B1) + (size_t)4096 * 1024, 1024, 128, 8, C.G, bx); EpiG E{WSP(float, SM_RS2), WSP(float, SM_PO), WSP(bf16_t, A_O)};
        pg8::gemm_phase(C.wave, lds, pg8::Dims{1024, 1024, 1024}, Sd, E); }
    SEAM(16);
    if (IN(17)) { WS_OPAQUE; DenseSched Sd; Sd.init(WSP(bf16_t, A_O), 2048, WSP(bf16_t, W_OO), 2048, 128, 4, C.G, bx); EpiRes E{P.out, P.out};
        pg8::gemm_phase(C.wave, lds, pg8::Dims{2048, 2048, 2048}, Sd, E); }
    SEAM(17);
    MOE_PHASES(1, 18);
#undef MOE_PHASES
#undef RET_PHASES
    if (IN(22)) { P_OPAQUE; moe_combine<1>(C, P, nullptr, P.in[I_LN_F]); }
#undef IN
#undef SEAM
}

extern "C" void kernel_launch(void* const* d_in, const int* in_sizes, int n_in, void* d_out, int out_size, void* d_ws, size_t ws_size, hipStream_t stream) {
    static int ready = 0;
    if (ready == 0) {
        if (n_in != 21 || out_size != T * D || ws_size < WS_NEED) { fprintf(stderr, "kernel_launch: unexpected shapes (n_in %d, out %d, ws %zu < %zu)\n", n_in, out_size, ws_size, (size_t)WS_NEED); ready = -1; return; }
        if (hipFuncSetAttribute((const void*)fwd_kernel, hipFuncAttributeMaxDynamicSharedMemorySize, LDS_BYTES) != hipSuccess) { fprintf(stderr, "kernel_launch: hipFuncSetAttribute failed\n"); ready = -1; return; }
        int per_cu = 0; (void)hipOccupancyMaxActiveBlocksPerMultiprocessor(&per_cu, (const void*)fwd_kernel, 512, LDS_BYTES); (void)hipGetLastError();
        if (per_cu < 1) fprintf(stderr, "kernel_launch: occupancy query reports %d blocks per CU\n", per_cu);
        ready = 1;
    }
    if (ready < 0) return;
    (void)hipMemsetAsync((char*)d_ws + OFF_CTL, 0, CTL_BYTES, stream);
    Params p{};
    for (int i = 0; i < 21; ++i) p.in[i] = (const float*)d_in[i];
    p.out = (float*)d_out; p.ws = (unsigned char*)d_ws; p.pad = 0;
#if N_LAUNCH_MODE == 1
    for (int ph = 0; ph < NPHASE; ++ph) { p.ph_lo = ph; p.ph_hi = ph + 1; p.use_bar = 0; hipLaunchKernelGGL(fwd_kernel, dim3(256), dim3(512), LDS_BYTES, stream, p); }
#else
    p.ph_lo = 0; p.ph_hi = NPHASE; p.use_bar = 1;
    hipLaunchKernelGGL(fwd_kernel, dim3(256), dim3(512), LDS_BYTES, stream, p);
#endif
}
```

```cpp
#include <hip/hip_runtime.h>
#include <cstdio>
#include <cstdint>

#ifndef N_LAUNCH_MODE
#define N_LAUNCH_MODE 0
#endif

#define LAS __attribute__((address_space(3)))
#define GAS __attribute__((address_space(1)))
typedef unsigned short bf16_t;
typedef short bf16x8 __attribute__((ext_vector_type(8)));
typedef float f32x2 __attribute__((ext_vector_type(2)));
typedef float f32x4 __attribute__((ext_vector_type(4)));
typedef float f32x16 __attribute__((ext_vector_type(16)));
typedef unsigned u32x2 __attribute__((ext_vector_type(2)));
typedef unsigned u32x4 __attribute__((ext_vector_type(4)));

constexpr int T = 32768, S = 16384, D = 1024;
constexpr float EPS = 1e-6f;
constexpr float LOG2E = 1.4426950408889634f;
constexpr int CAP = 65536 + 32 * 256;
constexpr int NSEG = 16, SEGC = 16;

constexpr size_t MiB = 1u << 20;
constexpr size_t OFF_CTL = 0, CTL_BYTES = 1 * MiB;
constexpr size_t OFF_SMALL = 1 * MiB;
constexpr size_t SM_RS0 = OFF_SMALL, SM_RS1 = SM_RS0 + T * 4, SM_RS2 = SM_RS1 + T * 4, SM_PQ = SM_RS2 + T * 4, SM_PKV = SM_PQ + (size_t)T * 16,
                 SM_LF = SM_PKV + (size_t)T * 16, SM_CUM = SM_LF + (size_t)T * 32, SM_EID = SM_CUM + (size_t)T * 32  ,
                 SM_GATE = SM_EID + (size_t)T * 8, SM_RANK = SM_GATE + (size_t)T * 8, SM_TSLOT = SM_RANK + (size_t)T * 8, SM_CNT = SM_TSLOT + (size_t)T * 8,
                 SM_STOK = SM_CNT + 256 * 32 * 4, SM_SW = SM_STOK + (size_t)CAP * 4, SM_SR = SM_SW + (size_t)CAP * 4, SM_TILEE = SM_SR + (size_t)CAP * 4,
                 SM_PO = SM_TILEE + 4096, SM_KNRM = SM_PO + (size_t)T * 64, SM_END = SM_KNRM + 16 * 256 * 4;
static_assert(SM_END <= 11 * MiB, "small region");
constexpr size_t OFF_ROPE = 11 * MiB;
constexpr size_t OFF_WMIX = 27 * MiB;
constexpr size_t W_A1 = OFF_WMIX, W_A1V = W_A1 + 3 * MiB, W_A2 = W_A1V + 1 * MiB, W_A2V = W_A2 + 768 * 1024, W_OE = W_A2V + 256 * 1024,
                 W_B1 = W_OE + 2 * MiB, W_OO = W_B1 + 12 * MiB, W_MIXEND = W_OO + 4 * MiB;
static_assert(W_MIXEND <= 51 * MiB, "mixer weights");
constexpr size_t OFF_WGU = 51 * MiB, OFF_WDN = OFF_WGU + 64 * MiB;
constexpr size_t OFF_XB = 147 * MiB;
constexpr size_t OFF_ACT = 211 * MiB;
constexpr size_t WS_NEED = OFF_ACT + 320 * MiB;
constexpr size_t A_Z = OFF_ACT, A_QF = A_Z + 32 * MiB, A_KF = A_QF + 32 * MiB, A_VTF = A_KF + 32 * MiB, A_QA = A_VTF + 32 * MiB, A_KA = A_QA + 48 * MiB, A_VTA = A_KA + 48 * MiB;
constexpr size_t A_XS = OFF_ACT, A_HID = OFF_ACT + 144 * MiB;
constexpr size_t A_QX = OFF_ACT, A_KN = A_QX + 32 * MiB, A_KZT = A_KN + 32 * MiB, A_VT = A_KZT + 32 * MiB, A_L = A_VT + 64 * MiB, A_O = A_L + 32 * MiB;
static_assert(A_O + 128 * MiB <= WS_NEED && A_HID + 72 * MiB <= WS_NEED && A_VTA + 32 * MiB <= WS_NEED, "act map");

__device__ __forceinline__ unsigned f2bf(float f) { unsigned u = __builtin_bit_cast(unsigned, f); return (u + 0x7fffu + ((u >> 16) & 1u)) >> 16; }
__device__ __forceinline__ unsigned pk2(float lo, float hi) { unsigned r; asm volatile("v_cvt_pk_bf16_f32 %0, %1, %2" : "=v"(r) : "v"(lo), "v"(hi)); return r; }
__device__ __forceinline__ float bf2f(unsigned short b) { return __builtin_bit_cast(float, ((unsigned)b) << 16); }
__device__ __forceinline__ float bflo(unsigned w) { return __builtin_bit_cast(float, w << 16); }
__device__ __forceinline__ float bfhi(unsigned w) { return __builtin_bit_cast(float, w & 0xffff0000u); }
__device__ __forceinline__ float wave_sum(float v) {
#pragma unroll
    for (int o = 1; o < 64; o <<= 1) v += __shfl_xor(v, o);
    return v;
}
__device__ __forceinline__ int lane_id_opaque() { unsigned z = 0u; asm volatile("" : "+s"(z)); int l = (int)__builtin_amdgcn_mbcnt_hi(~0u, __builtin_amdgcn_mbcnt_lo(~0u, z)); asm volatile("" : "+v"(l)); return l; }
__device__ __forceinline__ int ld_i(const int* p) { return __hip_atomic_load(p, __ATOMIC_RELAXED, __HIP_MEMORY_SCOPE_AGENT); }
__device__ __forceinline__ float rsqrt_f(float x) { return 1.0f / sqrtf(x); }

#define XB_TMO      128
#define XB_XCNT(j)  (256  + 64 * (j))
#define XB_XSUB(j)  (1280 + 64 * (j))
#define XB_XGEN(j)  (2304 + 64 * (j))
#define XB_TOP      3328
#define XB_TOPGEN   3392
#define XCD_BAR_WORDS 3456
#define XB_SPIN_CAP (1u << 18)
__device__ __forceinline__ unsigned xb_ld(unsigned* p)              { return __hip_atomic_load(p, __ATOMIC_RELAXED, __HIP_MEMORY_SCOPE_AGENT); }
__device__ __forceinline__ unsigned xb_add(unsigned* p, unsigned v) { return __hip_atomic_fetch_add(p, v, __ATOMIC_RELAXED, __HIP_MEMORY_SCOPE_AGENT); }
__device__ __forceinline__ unsigned xb_xcc_id() { return (unsigned)__builtin_amdgcn_s_getreg((3 << 11) | 20) & 0xFu; }
#define XB_SPIN(cond, bar) do { unsigned _sp = 0; while (cond) { __builtin_amdgcn_s_sleep(1); \
    if ((++_sp & 255u) == 0u) { if (xb_ld(&(bar)[XB_TMO])) break; if (_sp > XB_SPIN_CAP) { atomicAdd(&(bar)[XB_TMO], 1u); break; } } } } while (0)
struct XcdBarrier { unsigned* bar; unsigned x; volatile LAS unsigned* st; };
__device__ __forceinline__ XcdBarrier xcd_barrier_post(unsigned* bar, volatile LAS unsigned* st, bool t0) {
    XcdBarrier b; b.bar = bar; b.x = xb_xcc_id(); b.st = st;
    if (t0) (void)xb_add(&bar[XB_XCNT(b.x)], 1u);
    return b;
}
__device__ __forceinline__ void xcd_barrier_complete(unsigned* bar, unsigned x, unsigned& nloc, unsigned& nx) {
    const unsigned G = gridDim.x * gridDim.y * gridDim.z;
    unsigned sum, cnt, mine, sp = 0u;
    for (;;) {
        sum = 0u; cnt = 0u; mine = 0u;
#pragma unroll
        for (unsigned j = 0; j < 16; ++j) { const unsigned c = xb_ld(&bar[XB_XCNT(j)]); sum += c; cnt += (c > 0u) ? 1u : 0u; mine = (j == x) ? c : mine; }
        if (sum == G) break;
        __builtin_amdgcn_s_sleep(1);
        if ((++sp & 255u) == 0u) { if (xb_ld(&bar[XB_TMO])) break; if (sp > XB_SPIN_CAP) { atomicAdd(&bar[XB_TMO], 1u); break; } }
    }
    nloc = mine > 0u ? mine : 1u; nx = cnt > 0u ? cnt : 1u;
}
__device__ __forceinline__ void xcd_barrier(const XcdBarrier& b, bool t0) {
    asm volatile("s_waitcnt vmcnt(0)" ::: "memory");
    __syncthreads();
    if (t0) {
        unsigned* bar = b.bar;
        __builtin_amdgcn_s_waitcnt(0);
        unsigned nloc = b.st[0], nx = b.st[1];
        if (nloc == 0u) { xcd_barrier_complete(bar, b.x, nloc, nx); b.st[0] = nloc; b.st[1] = nx; }
        const unsigned old = xb_add(&bar[XB_XSUB(b.x)], 1u);
        const unsigned gen = old / nloc;
        if (old + 1u == (gen + 1u) * nloc) {
            __builtin_amdgcn_fence(__ATOMIC_RELEASE, "agent");
            asm volatile("s_waitcnt vmcnt(0)" ::: "memory");
            const unsigned og = xb_add(&bar[XB_TOP], 1u);
            const unsigned tg = og / nx;
            if (og + 1u == (tg + 1u) * nx) xb_add(&bar[XB_TOPGEN], 1u);
            else XB_SPIN(xb_ld(&bar[XB_TOPGEN]) == tg, bar);
            __builtin_amdgcn_fence(__ATOMIC_ACQUIRE, "agent");
            xb_add(&bar[XB_XGEN(b.x)], 1u);
            asm volatile("s_waitcnt vmcnt(0)" ::: "memory");
        } else {
            XB_SPIN(xb_ld(&bar[XB_XGEN(b.x)]) == gen, bar);
            __builtin_amdgcn_fence(__ATOMIC_ACQUIRE, "agent");
            asm volatile("s_waitcnt vmcnt(0)" ::: "memory");
        }
    }
    __syncthreads();
}

namespace pg8 {
constexpr int BM = 256, BK = 64, HALF = 128, HTB = HALF * BK * 2, STAGE_BYTES = 8 * HTB, NXCD = 8, WGM = 8;
__device__ __forceinline__ int lds_byte(int r, int c) { const int st = (r >> 4) * 2 + (c >> 5), rr = r & 15, cc = c & 31, ob = rr * 64 + cc * 2; return st * 1024 + (ob ^ (((ob >> 9) & 1) << 5)); }
__device__ __forceinline__ void stage_rc(int b, int& R, int& C) { const int st = b / 1024, sb = b % 1024, swz = sb ^ (((sb >> 9) & 1) << 5); R = (st >> 1) * 16 + swz / 64; C = (st & 1) * 32 + (swz % 64) / 2; }
__device__ __forceinline__ int perm32(int rho) { const int n = rho >> 4, i = rho & 15; return 8 * (i >> 2) + 4 * n + (i & 3); }
struct Unit { int pm, pn, aux; };
struct Dims { int lda, ldb, K; };
struct DenseOrder {
    int nM, nN, nwg, G, c;
    __device__ __forceinline__ void init(int nM_, int nN_, int G_, int c_) { nM = nM_; nN = nN_; nwg = nM * nN; G = G_; c = c_; }
    __device__ __forceinline__ bool tile(int i, Unit& u) const {
        const long L = (long)i * G + c; if (L >= nwg) return false;
        int wgid = (int)L; { const int q = nwg / NXCD, r = nwg % NXCD, xcd = wgid % NXCD, off = wgid / NXCD; wgid = (xcd < r ? xcd * (q + 1) : r * (q + 1) + (xcd - r) * q) + off; }
        const int nig = WGM * nN, gid = wgid / nig, fm = gid * WGM, gsz = (nM - fm) < WGM ? (nM - fm) : WGM;
        u.pm = fm + ((wgid % nig) % gsz); u.pn = (wgid % nig) / gsz; u.aux = 0; return true;
    }
};

template <class Epi, class Sched>
__device__ __forceinline__ void gemm_phase(int wave_, LAS unsigned char* lds, const Dims g, const Sched& S, const Epi& E) {
    const int tid = wave_ * 64 + lane_id_opaque();
    const int wid = __builtin_amdgcn_readfirstlane(tid >> 6), lane = tid & 63, wr = wid >> 2, wc = wid & 3, fr = lane & 15, fq = lane >> 4;
    const int K = g.K, nt = K / BK;
    unsigned voffA[2], voffB[2];
#pragma unroll
    for (int i = 0; i < 2; ++i) { int R, C; stage_rc(tid * 16 + i * 8192, R, C); const int Rb = Epi::PERM ? ((R & ~31) + perm32(R & 31)) : R;
        voffA[i] = (unsigned)(R * g.lda + C) * 2u; voffB[i] = (unsigned)(Rb * g.ldb + C) * 2u; }
    const size_t kstep = (size_t)(BK * 2);
    const size_t hstepA = (size_t)HALF * g.lda * 2, hstepB = (size_t)HALF * g.ldb * 2;
    const unsigned ldsw = (unsigned)wid * 1024u;
    const int aoff = lds_byte(wr * 64 + fr, fq * 8), boff = lds_byte(wc * 32 + fr, fq * 8);
#define PG8_SA(b, h) (((b) * 2 + (h)) * HTB)
#define PG8_SB(b, h) ((4 + (b) * 2 + (h)) * HTB)
#define PG8_STAGE(bufoff, gbase, voff) do { _Pragma("unroll") for (int _i = 0; _i < 2; ++_i) \
        __builtin_amdgcn_global_load_lds((const unsigned*)((const char*)(gbase) + (voff)[_i]), (LAS unsigned*)(lds + (bufoff) + ldsw + _i * 8192), 16, 0, 0); } while (0)
#define PG8_LDA(dst, b, h) do { _Pragma("unroll") for (int m = 0; m < 4; ++m) _Pragma("unroll") for (int k = 0; k < 2; ++k) dst[m][k] = *(const LAS bf16x8*)(lds + PG8_SA(b, h) + aoff + m * 2048 + k * 1024); } while (0)
#define PG8_LDB(dst, b, h) do { _Pragma("unroll") for (int n = 0; n < 2; ++n) _Pragma("unroll") for (int k = 0; k < 2; ++k) dst[n][k] = *(const LAS bf16x8*)(lds + PG8_SB(b, h) + boff + n * 2048 + k * 1024); } while (0)
#define PG8_MMA(ai, bj, At, Bt) do { __builtin_amdgcn_s_setprio(1); _Pragma("unroll") for (int m = 0; m < 4; ++m) _Pragma("unroll") for (int n = 0; n < 2; ++n) _Pragma("unroll") for (int k = 0; k < 2; ++k) \
        acc[ai][bj][m][n] = __builtin_amdgcn_mfma_f32_16x16x32_bf16(Bt[n][k], At[m][k], acc[ai][bj][m][n], 0, 0, 0); __builtin_amdgcn_s_setprio(0); } while (0)
#define PG8_WAIT_V(n) asm volatile("s_waitcnt vmcnt(" #n ")" ::: "memory")
#define PG8_WAIT_L(n) asm volatile("s_waitcnt lgkmcnt(" #n ")" ::: "memory")
#define PG8_BAR __builtin_amdgcn_s_barrier()
#define PG8_SCHED __builtin_amdgcn_sched_barrier(0)
    Unit cur, nxt; int ui = 0;
    if (!S.next(0, cur)) return;
    f32x4 acc[2][2][4][2];
#pragma unroll
    for (int a = 0; a < 2; ++a)
#pragma unroll
        for (int b = 0; b < 2; ++b)
#pragma unroll
            for (int m = 0; m < 4; ++m)
#pragma unroll
                for (int n = 0; n < 2; ++n) acc[a][b][m][n] = (f32x4){0.f, 0.f, 0.f, 0.f};
    bf16x8 At[4][2], B0[2][2], B1[2][2];
    const char* cA; const char* cB; S.ptrs(cur, cA, cB);
    PG8_STAGE(PG8_SB(0, 0), cB, voffB); PG8_STAGE(PG8_SA(0, 0), cA, voffA); PG8_STAGE(PG8_SB(0, 1), cB + hstepB, voffB); PG8_STAGE(PG8_SA(0, 1), cA + hstepA, voffA);
    if (wr == 1) PG8_BAR;
    PG8_WAIT_V(4); PG8_BAR;
    PG8_STAGE(PG8_SB(1, 0), cB + kstep, voffB); PG8_STAGE(PG8_SA(1, 0), cA + kstep, voffA); PG8_STAGE(PG8_SB(1, 1), cB + hstepB + kstep, voffB);
    PG8_WAIT_V(6); PG8_BAR;
    for (;;) {
        const bool has_next = S.next(ui + 1, nxt);
        const char* nA = cA; const char* nB = cB; if (has_next) S.ptrs(nxt, nA, nB);
        for (int t = 0; t < nt; t += 2) {
            const bool last = (t == nt - 2);
            const char* a1 = cA + (size_t)(t + 1) * kstep;
            const char* a2 = last ? nA : cA + (size_t)(t + 2) * kstep; const char* b2 = last ? nB : cB + (size_t)(t + 2) * kstep;
            const char* a3 = a2 + kstep; const char* b3 = b2 + kstep;
            PG8_LDB(B0, 0, 0); PG8_SCHED; PG8_LDA(At, 0, 0); PG8_STAGE(PG8_SA(1, 1), a1 + hstepA, voffA);
            PG8_WAIT_L(8); PG8_BAR; PG8_WAIT_L(0); PG8_MMA(0, 0, At, B0); PG8_BAR; PG8_SCHED;
            PG8_LDB(B1, 0, 1); PG8_STAGE(PG8_SB(0, 0), b2, voffB);
            PG8_BAR; PG8_WAIT_L(0); PG8_MMA(0, 1, At, B1); PG8_BAR;
            PG8_LDA(At, 0, 1); PG8_STAGE(PG8_SA(0, 0), a2, voffA);
            PG8_BAR; PG8_WAIT_L(0); PG8_MMA(1, 0, At, B0); PG8_BAR; PG8_SCHED;
            PG8_STAGE(PG8_SB(0, 1), b2 + hstepB, voffB);
            PG8_WAIT_V(6); PG8_BAR; PG8_MMA(1, 1, At, B1); PG8_BAR;
            PG8_LDB(B0, 1, 0); PG8_SCHED; PG8_LDA(At, 1, 0); PG8_STAGE(PG8_SA(0, 1), a2 + hstepA, voffA);
            PG8_WAIT_L(8); PG8_BAR; PG8_WAIT_L(0); PG8_MMA(0, 0, At, B0); PG8_BAR; PG8_SCHED;
            PG8_LDB(B1, 1, 1); PG8_STAGE(PG8_SB(1, 0), b3, voffB);
            PG8_BAR; PG8_WAIT_L(0); PG8_MMA(0, 1, At, B1); PG8_BAR;
            PG8_LDA(At, 1, 1); PG8_STAGE(PG8_SA(1, 0), a3, voffA);
            PG8_BAR; PG8_WAIT_L(0); PG8_MMA(1, 0, At, B0); PG8_BAR; PG8_SCHED;
            PG8_STAGE(PG8_SB(1, 1), b3 + hstepB, voffB);
            PG8_WAIT_V(6); PG8_BAR; PG8_MMA(1, 1, At, B1); PG8_BAR;
        }
        { int fr2 = fr, fq2 = fq; asm volatile("" : "+v"(fr2), "+v"(fq2)); E(acc, cur, wr, wc, fr2, fq2); }
        if (!has_next) break;
#pragma unroll
        for (int a = 0; a < 2; ++a)
#pragma unroll
            for (int b = 0; b < 2; ++b)
#pragma unroll
                for (int m = 0; m < 4; ++m)
#pragma unroll
                    for (int n = 0; n < 2; ++n) acc[a][b][m][n] = (f32x4){0.f, 0.f, 0.f, 0.f};
        cur = nxt; cA = nA; cB = nB; ++ui;
    }
    PG8_WAIT_V(0);
    if (wr == 0) PG8_BAR;
    PG8_BAR;
#undef PG8_SA
#undef PG8_SB
#undef PG8_STAGE
#undef PG8_LDA
#undef PG8_LDB
#undef PG8_MMA
#undef PG8_WAIT_V
#undef PG8_WAIT_L
#undef PG8_BAR
#undef PG8_SCHED
}
}
using pg8::Unit;

struct Params {
    const float* in[21];
    float* out;
    unsigned char* ws;
    int ph_lo, ph_hi;
    int use_bar, pad;
};
enum { I_X = 0, I_LN_MIX_E, I_W_IN_E, I_LN_Q, I_W_UQ, I_LN_KV, I_W_UKV, I_B_F, I_W_OUT_E, I_LN_MIX_O, I_W_IN_O, I_W_OUT_O, I_LN_FFN, I_W_RG, I_B_RG, I_W_RE, I_B_RE, I_W_GATE, I_W_UP, I_W_DOWN, I_LN_F };

#define WSP(T_, off) ((T_*)(ws_ + (off)))
typedef const Params __attribute__((address_space(4)))* KParams;
#define P_OPAQUE KParams Pk_ = (KParams)__builtin_amdgcn_kernarg_segment_ptr(); asm volatile("" : "+s"(Pk_)); const Params& P = *(const Params*)Pk_
#define WS_OPAQUE P_OPAQUE; unsigned char* ws_ = P.ws

__device__ __forceinline__ float log2_gamma(int h) { return __builtin_log2f(1.0f - __builtin_exp2f(-5.0f - (float)h)); }

struct DenseSched {
    pg8::DenseOrder O; const char* A; const char* B; size_t astep, bstep;
    __device__ __forceinline__ void init(const void* A_, int lda, const void* B_, int ldb, int nM, int nN, int G, int c) {
        O.init(nM, nN, G, c); A = (const char*)A_; B = (const char*)B_; astep = (size_t)256 * lda * 2; bstep = (size_t)256 * ldb * 2; }
    __device__ __forceinline__ bool next(int i, Unit& u) const { return O.tile(i, u); }
    __device__ __forceinline__ void ptrs(const Unit& u, const char*& a, const char*& b) const { a = A + (size_t)u.pm * astep; b = B + (size_t)u.pn * bstep; }
};
struct MoeSched {
    const char* A; const char* B; const int* tilee; size_t astep, estep, bstep; int ntile, G, c;
    __device__ __forceinline__ void init(const void* A_, int lda, const void* B_, int ldb, size_t expert_rows, const int* tilee_, int G_, int c_) {
        A = (const char*)A_; B = (const char*)B_; tilee = tilee_; astep = (size_t)256 * lda * 2; bstep = (size_t)256 * ldb * 2; estep = expert_rows * ldb * 2; G = G_; c = c_;
        ntile = __builtin_amdgcn_readfirstlane(ld_i(tilee_ + 300)); }
    __device__ __forceinline__ bool next(int i, Unit& u) const { const int L = i * G + c; if (L >= ntile * 4) return false; u.pm = L >> 2; u.pn = L & 3; u.aux = __builtin_amdgcn_readfirstlane(ld_i(tilee + (L >> 2))); return true; }
    __device__ __forceinline__ void ptrs(const Unit& u, const char*& a, const char*& b) const { a = A + (size_t)u.pm * astep; b = B + (size_t)u.aux * estep + (size_t)u.pn * bstep; }
};

typedef const f32x4 (&AccRef)[2][2][4][2];
#define EPI_LOOP_AI_M for (int ai = 0; ai < 2; ++ai) _Pragma("unroll") for (int m = 0; m < 4; ++m)
#define EPI_LOOP_BJ_N for (int bj = 0; bj < 2; ++bj) _Pragma("unroll") for (int n = 0; n < 2; ++n)

struct EpiA1a {
    static constexpr bool PERM = false;
    const float* rs0; bf16_t* Z; float* PQ; float* PKV; bf16_t* KA; float* LF; const float* bf; bf16_t* QF; bf16_t* KF; const f32x2* rope;
    __device__ __forceinline__ void operator()(AccRef acc, const Unit& u, int wr, int wc, int fr, int fq) const {
        const int row0 = u.pm * 256 + wr * 64 + fr;
        if (u.pn <= 1) {
            const int zc = u.pn * 256 + wc * 32 + 4 * fq;
#pragma unroll
            EPI_LOOP_AI_M { const int r = row0 + ai * 128 + m * 16; const float rs = rs0[r]; float ss = 0.f; f32x4 v[2][2];
#pragma unroll
                EPI_LOOP_BJ_N { v[bj][n] = acc[ai][bj][m][n] * rs; u32x2 w; w.x = pk2(v[bj][n][0], v[bj][n][1]); w.y = pk2(v[bj][n][2], v[bj][n][3]);
                    *(u32x2*)(Z + (size_t)r * 512 + zc + bj * 128 + n * 16) = w;
                    if (u.pn == 0 || bj == 0) ss += (v[bj][n][0] * v[bj][n][0] + v[bj][n][1] * v[bj][n][1]) + (v[bj][n][2] * v[bj][n][2] + v[bj][n][3] * v[bj][n][3]); }
                ss += __shfl_xor(ss, 16); ss += __shfl_xor(ss, 32);
                if (fq == 0) { if (u.pn == 0) PQ[(size_t)r * 4 + wc] = ss; else PKV[(size_t)r * 4 + wc] = ss; }
                if (u.pn == 1 && wc == 0) {
                    const int pos = r & (S - 1); const f32x4 x1 = v[1][0], x2 = v[1][1]; f32x4 o1, o2;
#pragma unroll
                    for (int j = 0; j < 4; ++j) { const f32x2 cs = rope[(size_t)pos * 128 + 8 * (4 * fq + j)]; o1[j] = x1[j] * cs.x - x2[j] * cs.y; o2[j] = x1[j] * cs.y + x2[j] * cs.x; }
                    u32x2 w1, w2; w1.x = pk2(o1[0], o1[1]); w1.y = pk2(o1[2], o1[3]); w2.x = pk2(o2[0], o2[1]); w2.y = pk2(o2[2], o2[3]);
#pragma unroll
                    for (int hh = 0; hh < 8; ++hh) { bf16_t* kp = KA + (size_t)r * 768 + hh * 96 + 64 + 4 * fq; *(u32x2*)kp = w1; *(u32x2*)(kp + 16) = w2; }
                }
                if (u.pn == 1 && wc == 1 && fq < 2) {
                    const f32x4 f = v[1][0]; f32x4 o;
#pragma unroll
                    for (int j = 0; j < 4; ++j) { const float x = f[j] + bf[4 * fq + j]; o[j] = fminf(x, 0.f) - log1pf(__expf(-fabsf(x))); }
                    *(f32x4*)(LF + (size_t)r * 8 + 4 * fq) = o;
                }
            }
        } else {
            const bool isq = u.pn < 4; bf16_t* dst = isq ? QF : KF; const int cc = (isq ? (u.pn - 2) : (u.pn - 4)) * 256 + wc * 32 + 4 * fq; const float sc = isq ? (0.125f * LOG2E) : 1.0f;
#pragma unroll
            EPI_LOOP_AI_M { const int r = row0 + ai * 128 + m * 16; const float rs = rs0[r] * sc;
#pragma unroll
                EPI_LOOP_BJ_N { const f32x4 v = acc[ai][bj][m][n] * rs; u32x2 w; w.x = pk2(v[0], v[1]); w.y = pk2(v[2], v[3]); *(u32x2*)(dst + (size_t)r * 512 + cc + bj * 128 + n * 16) = w; } }
        }
    }
};
template <int MODE> struct EpiVT {
    static constexpr bool PERM = true;
    const float* rs; bf16_t* OUT; size_t ldo;
    __device__ __forceinline__ float cs(int t) const { if (MODE == 0) return rs[t]; const f32x4 p = *(const f32x4*)(rs + (size_t)t * 4); return rsqrt_f(((p[0] + p[1]) + (p[2] + p[3])) * (1.0f / 128.0f) + EPS); }
    __device__ __forceinline__ void operator()(AccRef acc, const Unit& u, int wr, int wc, int fr, int fq) const {
        const int f0 = u.pm * 256 + wr * 64 + fr, t0 = u.pn * 256 + wc * 32 + 8 * fq;
#pragma unroll
        for (int bj = 0; bj < 2; ++bj) { float c[8];
#pragma unroll
            for (int j = 0; j < 8; ++j) c[j] = cs(t0 + bj * 128 + j);
#pragma unroll
            EPI_LOOP_AI_M { const f32x4 a = acc[ai][bj][m][0], b = acc[ai][bj][m][1]; u32x4 w;
                w.x = pk2(a[0] * c[0], a[1] * c[1]); w.y = pk2(a[2] * c[2], a[3] * c[3]); w.z = pk2(b[0] * c[4], b[1] * c[5]); w.w = pk2(b[2] * c[6], b[3] * c[7]);
                const int f_ = f0 + ai * 128 + m * 16, t_ = t0 + bj * 128;
                *(u32x4*)(OUT + (((size_t)(f_ >> 6) * (T / 64) + (t_ >> 6)) * 64 + (f_ & 63)) * 64 + (t_ & 63)) = w; }
            asm volatile("" ::: "memory"); }
    }
};
struct EpiA2q {
    static constexpr bool PERM = false;
    const float* PQ; bf16_t* QA; const f32x2* rope;
    __device__ __forceinline__ void operator()(AccRef acc, const Unit& u, int wr, int wc, int fr, int fq) const {
        if (wc == 3) return;
        const int row0 = u.pm * 256 + wr * 64 + fr; const float SCA = 0.10206207261596577f * LOG2E;
#pragma unroll
        EPI_LOOP_AI_M { const int r = row0 + ai * 128 + m * 16; const f32x4 p = *(const f32x4*)(PQ + (size_t)r * 4);
            const float rs = rsqrt_f(((p[0] + p[1]) + (p[2] + p[3])) * (1.0f / 256.0f) + EPS) * SCA; const int pos = r & (S - 1);
#pragma unroll
            for (int bj = 0; bj < 2; ++bj) { const int hh = 2 * u.pn + bj; bf16_t* qp = QA + (size_t)r * 768 + hh * 96 + wc * 32 + 4 * fq; f32x4 x1 = acc[ai][bj][m][0] * rs, x2 = acc[ai][bj][m][1] * rs;
                if (wc == 2) {
#pragma unroll
                    for (int j = 0; j < 4; ++j) { const f32x2 cs = rope[(size_t)pos * 128 + 8 * (4 * fq + j)]; const float a = x1[j], b = x2[j]; x1[j] = a * cs.x - b * cs.y; x2[j] = a * cs.y + b * cs.x; } }
                *(u32x2*)qp = (u32x2){pk2(x1[0], x1[1]), pk2(x1[2], x1[3])}; *(u32x2*)(qp + 16) = (u32x2){pk2(x2[0], x2[1]), pk2(x2[2], x2[3])};
                asm volatile("" ::: "memory"); } }
    }
};
struct EpiA2k {
    static constexpr bool PERM = false;
    const float* PKV; bf16_t* KA;
    __device__ __forceinline__ void operator()(AccRef acc, const Unit& u, int wr, int wc, int fr, int fq) const {
        const int row0 = u.pm * 256 + wr * 64 + fr;
#pragma unroll
        EPI_LOOP_AI_M { const int r = row0 + ai * 128 + m * 16; const f32x4 p = *(const f32x4*)(PKV + (size_t)r * 4);
            const float rs = rsqrt_f(((p[0] + p[1]) + (p[2] + p[3])) * (1.0f / 128.0f) + EPS);
#pragma unroll
            EPI_LOOP_BJ_N { const int hh = 4 * u.pn + 2 * bj + (wc >> 1), dd = 32 * (wc & 1) + 16 * n + 4 * fq; const f32x4 v = acc[ai][bj][m][n] * rs;
                *(u32x2*)(KA + (size_t)r * 768 + hh * 96 + dd) = (u32x2){pk2(v[0], v[1]), pk2(v[2], v[3])}; }
            asm volatile("" ::: "memory"); }
    }
};
struct EpiRes {
    static constexpr bool PERM = false;
    const float* base; float* outp;
    __device__ __forceinline__ void operator()(AccRef acc, const Unit& u, int wr, int wc, int fr, int fq) const {
        const int row0 = u.pm * 256 + wr * 64 + fr, col0 = u.pn * 256 + wc * 32 + 4 * fq;
#pragma unroll
        EPI_LOOP_AI_M { const size_t off = (size_t)(row0 + ai * 128 + m * 16) * D + col0;
#pragma unroll
            EPI_LOOP_BJ_N { const f32x4 b = *(const f32x4*)(base + off + bj * 128 + n * 16); *(f32x4*)(outp + off + bj * 128 + n * 16) = b + acc[ai][bj][m][n]; } }
    }
};
struct EpiB1q {
    static constexpr bool PERM = false;
    const float* rs2; bf16_t* QX; const f32x2* rope;
    __device__ __forceinline__ void operator()(AccRef acc, const Unit& u, int wr, int wc, int fr, int fq) const {
        const int row0 = u.pm * 256 + wr * 64 + fr; const float l2g = log2_gamma(u.pn);
#pragma unroll
        EPI_LOOP_AI_M { const int pos = row0 + ai * 128 + m * 16; const float rs = rs2[pos] * __builtin_exp2f((float)((pos & 63) + 1) * l2g);
#pragma unroll
            for (int n = 0; n < 2; ++n) { const int i0 = wc * 32 + 16 * n + 4 * fq; const f32x4 x1 = acc[ai][0][m][n] * rs, x2 = acc[ai][1][m][n] * rs; f32x4 o1, o2;
                const f32x4 ca = *(const f32x4*)(rope + (size_t)pos * 128 + i0), cb = *(const f32x4*)(rope + (size_t)pos * 128 + i0 + 2);
                const float cc[4] = {ca[0], ca[2], cb[0], cb[2]}, sn[4] = {ca[1], ca[3], cb[1], cb[3]};
#pragma unroll
                for (int j = 0; j < 4; ++j) { o1[j] = x1[j] * cc[j] - x2[j] * sn[j]; o2[j] = x1[j] * sn[j] + x2[j] * cc[j]; }
                u32x2 w1, w2; w1.x = pk2(o1[0], o1[1]); w1.y = pk2(o1[2], o1[3]); w2.x = pk2(o2[0], o2[1]); w2.y = pk2(o2[2], o2[3]);
                bf16_t* qp = QX + (size_t)pos * 1024 + u.pn * 256 + i0; *(u32x2*)qp = w1; *(u32x2*)(qp + 128) = w2; }
            asm volatile("" ::: "memory"); }
    }
};
__device__ __forceinline__ int rho_of_d(int d) { const int lo = d & 31; return (d & ~31) | (((lo >> 2) & 1) << 4) | ((lo >> 3) << 2) | (lo & 3); }
struct EpiB1k {
    static constexpr bool PERM = true;
    const float* rs2; bf16_t* KN; bf16_t* KZT; const f32x2* rope;
    __device__ __forceinline__ void operator()(AccRef acc, const Unit& u, int wr, int wc, int fr, int fq) const {
        const int h = u.pm, t0 = u.pn * 256 + wc * 32 + 8 * fq; const float l2g = log2_gamma(h);
#pragma unroll
        for (int bj = 0; bj < 2; ++bj)
#pragma unroll
            for (int n = 0; n < 2; ++n) { const int tb = t0 + bj * 128 + 4 * n; float rs[4], zt[4];
#pragma unroll
                for (int j = 0; j < 4; ++j) { rs[j] = rs2[tb + j] * 0.0625f; zt[j] = __builtin_exp2f((float)(63 - ((tb + j) & 63)) * l2g); }
                const int chunk = tb >> 6, c0 = tb & 63;
#pragma unroll
                for (int m = 0; m < 4; ++m) { const int d = wr * 64 + m * 16 + fr; float k1[4], k2[4];
#pragma unroll
                    for (int j = 0; j < 4; ++j) { const f32x2 cs = rope[(size_t)(tb + j) * 128 + d]; const float x1 = acc[0][bj][m][n][j] * rs[j], x2 = acc[1][bj][m][n][j] * rs[j];
                        k1[j] = x1 * cs.x - x2 * cs.y; k2[j] = x1 * cs.y + x2 * cs.x;
                        KN[(size_t)(tb + j) * 1024 + h * 256 + d] = (bf16_t)f2bf(k1[j]); KN[(size_t)(tb + j) * 1024 + h * 256 + 128 + d] = (bf16_t)f2bf(k2[j]); }
                    const int rho = rho_of_d(d); u32x2 w1, w2;
                    w1.x = pk2(k1[0] * zt[0], k1[1] * zt[1]); w1.y = pk2(k1[2] * zt[2], k1[3] * zt[3]); w2.x = pk2(k2[0] * zt[0], k2[1] * zt[1]); w2.y = pk2(k2[2] * zt[2], k2[3] * zt[3]);
                    bf16_t* zp = KZT + (((size_t)(h * 256 + chunk) * 256 + rho) * 64 + c0); *(u32x2*)zp = w1; *(u32x2*)(zp + 128 * 64) = w2;
                    asm volatile("" ::: "memory"); } }
    }
};
struct EpiB1v {
    static constexpr bool PERM = true;
    const float* rs2; bf16_t* VT;
    __device__ __forceinline__ void operator()(AccRef acc, const Unit& u, int wr, int wc, int fr, int fq) const {
        const int h = u.pm >> 1, e0 = (u.pm & 1) * 256 + wr * 64 + fr, t0 = u.pn * 256 + wc * 32 + 8 * fq;
#pragma unroll
        for (int bj = 0; bj < 2; ++bj) { const int tb = t0 + bj * 128; float c[8];
#pragma unroll
            for (int j = 0; j < 8; ++j) c[j] = rs2[tb + j];
            const int chunk = tb >> 6, c0 = tb & 63;
#pragma unroll
            EPI_LOOP_AI_M { const f32x4 a = acc[ai][bj][m][0], b = acc[ai][bj][m][1]; u32x4 w;
                w.x = pk2(a[0] * c[0], a[1] * c[1]); w.y = pk2(a[2] * c[2], a[3] * c[3]); w.z = pk2(b[0] * c[4], b[1] * c[5]); w.w = pk2(b[2] * c[6], b[3] * c[7]);
                *(u32x4*)(VT + (((size_t)(h * 256 + chunk) * 512 + e0 + ai * 128 + m * 16) * 64 + c0)) = w; } }
    }
};
struct EpiG {
    static constexpr bool PERM = true;
    const float* rs2; const float* PO; bf16_t* O;
    __device__ __forceinline__ void operator()(AccRef acc, const Unit& u, int wr, int wc, int fr, int fq) const {
        const int row0 = u.pm * 256 + wr * 64 + fr, col0 = u.pn * 256 + wc * 32 + 8 * fq, head = u.pn >> 1;
#pragma unroll
        EPI_LOOP_AI_M { const int r = row0 + ai * 128 + m * 16; const f32x4 p = *(const f32x4*)(PO + (size_t)r * 16 + head * 4);
            const float ro = rsqrt_f(((p[0] + p[1]) + (p[2] + p[3])) * (1.0f / 512.0f) + EPS), rs = rs2[r];
#pragma unroll
            for (int bj = 0; bj < 2; ++bj) { bf16_t* op = O + (size_t)r * 2048 + col0 + bj * 128; const u32x4 ov = *(const u32x4*)op; float o[8] = {bflo(ov.x), bfhi(ov.x), bflo(ov.y), bfhi(ov.y), bflo(ov.z), bfhi(ov.z), bflo(ov.w), bfhi(ov.w)}; float a[8];
#pragma unroll
                for (int j = 0; j < 8; ++j) { const float g = acc[ai][bj][m][j >> 2][j & 3] * rs; a[j] = o[j] * ro * g / (1.0f + __expf(-g)); }
                u32x4 w; w.x = pk2(a[0], a[1]); w.y = pk2(a[2], a[3]); w.z = pk2(a[4], a[5]); w.w = pk2(a[6], a[7]); *(u32x4*)op = w; }
            asm volatile("" ::: "memory"); }
    }
};
struct EpiM3 {
    static constexpr bool PERM = true;
    const float* SR; bf16_t* HID;
    __device__ __forceinline__ void operator()(AccRef acc, const Unit& u, int wr, int wc, int fr, int fq) const {
        const int row0 = u.pm * 256 + wr * 64 + fr, col0 = u.pn * 128 + wc * 32 + 8 * fq;
#pragma unroll
        EPI_LOOP_AI_M { const int r = row0 + ai * 128 + m * 16; const float rs = SR[r]; float hh[8];
#pragma unroll
            for (int j = 0; j < 8; ++j) { const float g = acc[ai][0][m][j >> 2][j & 3] * rs, up = acc[ai][1][m][j >> 2][j & 3] * rs; hh[j] = g / (1.0f + __expf(-g)) * up; }
            u32x4 w; w.x = pk2(hh[0], hh[1]); w.y = pk2(hh[2], hh[3]); w.z = pk2(hh[4], hh[5]); w.w = pk2(hh[6], hh[7]); *(u32x4*)(HID + (size_t)r * 512 + col0) = w; }
    }
};
struct EpiM4 {
    static constexpr bool PERM = true;
    const float* SW; bf16_t* YS;
    __device__ __forceinline__ void operator()(AccRef acc, const Unit& u, int wr, int wc, int fr, int fq) const {
        const int row0 = u.pm * 256 + wr * 64 + fr, col0 = u.pn * 256 + wc * 32 + 8 * fq;
#pragma unroll
        EPI_LOOP_AI_M { const int r = row0 + ai * 128 + m * 16; const float sw = SW[r];
#pragma unroll
            for (int bj = 0; bj < 2; ++bj) { const f32x4 a = acc[ai][bj][m][0] * sw, b = acc[ai][bj][m][1] * sw; u32x4 w; w.x = pk2(a[0], a[1]); w.y = pk2(a[2], a[3]); w.z = pk2(b[0], b[1]); w.w = pk2(b[2], b[3]);
                *(u32x4*)(YS + (size_t)r * 1024 + col0 + bj * 128) = w; } }
    }
};

__device__ __forceinline__ int crow(int r, int hi) { return (r & 3) + 8 * (r >> 2) + 4 * hi; }
template <int DQK, bool FOX>
__device__ __forceinline__ void attn_unit(int wave_, LAS unsigned char* L, const bf16_t* Qb, int ldq, const bf16_t* Kb, int ldk, const bf16_t* Vtb, const float* cum, const float* knrm, bf16_t* Ob, int ldo, int qb) {
    constexpr int KP = DQK + 8, KBYTES = 64 * KP * 2, VBYTES = 64 * 136, BUF = KBYTES + VBYTES + 256, NS = DQK / 16, KCH = DQK / 8;
    constexpr int XOFF = 2 * BUF;
    constexpr float THR = 8.0f;
    const int tid = wave_ * 64 + lane_id_opaque();
    const int lane = tid & 63, w = wave_, r32 = lane & 31, hi = lane >> 5;
    const int R0 = 256 * qb + 32 * w, q = R0 + r32, NT = 4 * qb + 4, jmax = 4 * qb + (w >> 1);
    bf16x8 qf[NS];
#pragma unroll
    for (int s = 0; s < NS; ++s) qf[s] = *(const bf16x8*)(Qb + (size_t)q * ldq + 16 * s + 8 * hi);
    const float cq = FOX ? cum[q] : 0.f;
    int j0 = 0;
    if (FOX) {
        float n2 = 0.f;
#pragma unroll
        for (int s = 0; s < NS; ++s)
#pragma unroll
            for (int e = 0; e < 8; ++e) { const float x = bf2f((unsigned short)qf[s][e]); n2 += x * x; }
        n2 += __shfl_xor(n2, 32);
#pragma unroll
        for (int o = 1; o < 32; o <<= 1) n2 = fmaxf(n2, __shfl_xor(n2, o));
        LAS float* xs = (LAS float*)(L + XOFF); LAS int* xj = (LAS int*)(L + XOFF + 32);
        if (lane == 0) xs[w] = n2;
        if (tid == 0) xj[0] = 4 * qb;
        __syncthreads();
        float qn = xs[0];
#pragma unroll
        for (int i = 1; i < 8; ++i) qn = fmaxf(qn, xs[i]);
        qn = sqrtf(qn) * 1.01f;
        if (tid < NT) { const float bound = qn * knrm[tid] * 1.01f + cum[256 * qb] - cum[64 * tid + 63]; if (bound >= -160.0f) atomicMin((int*)xj, tid); }
        __syncthreads();
        j0 = xj[0];
    }
    f32x16 o0 = {}, o1 = {}; float mhat = 0.f, lrun = 0.f;
    const int kr0 = tid / KCH, kc0 = tid % KCH, kr1 = (tid + 512) / KCH, kc1 = (tid + 512) % KCH; const bool has1 = (tid + 512) < 64 * KCH;
    const int ve = tid >> 3, vc = tid & 7;
    u32x4 kreg0A, kreg1A = {}, vregA, kreg0B, kreg1B = {}, vregB; float ckregA = 0.f, ckregB = 0.f;
    const int kr1c = has1 ? kr1 : kr0, kc1c = has1 ? kc1 : kc0; const int ckl = tid & 63;
#define ATT_LOADK(j, X) do { const int j_ = (j) < NT ? (j) : NT - 1; kreg0##X = *(const u32x4*)(Kb + (size_t)(64 * j_ + kr0) * ldk + kc0 * 8); if (DQK > 64) kreg1##X = *(const u32x4*)(Kb + (size_t)(64 * j_ + kr1c) * ldk + kc1c * 8); \
        if (FOX) ckreg##X = cum[64 * j_ + ckl]; } while (0)
#define ATT_LOADV(j, X) do { const int j_ = (j) < NT ? (j) : NT - 1; vreg##X = *(const u32x4*)(Vtb + (size_t)j_ * 4096 + ve * 64 + vc * 8); } while (0)
#define ATT_WRITEK(bo, X) do { *(LAS u32x4*)(L + (bo) + kr0 * (KP * 2) + kc0 * 16) = kreg0##X; if (DQK > 64) { if (has1) *(LAS u32x4*)(L + (bo) + kr1 * (KP * 2) + kc1 * 16) = kreg1##X; } \
        if (FOX && tid < 64) *(LAS float*)(L + (bo) + KBYTES + VBYTES + tid * 4) = ckreg##X; } while (0)
#define ATT_WRITEV(bo, X) do { *(LAS u32x2*)(L + (bo) + KBYTES + ve * 136 + vc * 16) = (u32x2){vreg##X.x, vreg##X.y}; *(LAS u32x2*)(L + (bo) + KBYTES + ve * 136 + vc * 16 + 8) = (u32x2){vreg##X.z, vreg##X.w}; } while (0)
    bf16x8 kf[2 * NS]; f32x4 ckv[8];
#define ATT_QK_ISSUE(bo) do { \
        _Pragma("unroll") for (int s = 0; s < NS; ++s) { kf[2 * s] = *(const LAS bf16x8*)(L + (bo) + r32 * (KP * 2) + (16 * s + 8 * hi) * 2); kf[2 * s + 1] = *(const LAS bf16x8*)(L + (bo) + (32 + r32) * (KP * 2) + (16 * s + 8 * hi) * 2); } \
        if (FOX) { _Pragma("unroll") for (int g = 0; g < 4; ++g) { ckv[g] = *(const LAS f32x4*)(L + (bo) + KBYTES + VBYTES + (8 * g + 4 * hi) * 4); ckv[4 + g] = *(const LAS f32x4*)(L + (bo) + KBYTES + VBYTES + (32 + 8 * g + 4 * hi) * 4); } } \
        __builtin_amdgcn_sched_barrier(0); } while (0)
#define ATT_QK_MMA(S0, S1) do { \
        asm volatile("s_waitcnt lgkmcnt(0)" ::: "memory"); __builtin_amdgcn_sched_barrier(0); \
        if (FOX) { const float cqm = cq - mhat; \
            _Pragma("unroll") for (int g = 0; g < 4; ++g) { _Pragma("unroll") for (int e = 0; e < 4; ++e) { S0[4 * g + e] = cqm - ckv[g][e]; S1[4 * g + e] = cqm - ckv[4 + g][e]; } } \
        } else { _Pragma("unroll") for (int r = 0; r < 16; ++r) { S0[r] = -mhat; S1[r] = -mhat; } } \
        _Pragma("unroll") for (int s = 0; s < NS; ++s) { S0 = __builtin_amdgcn_mfma_f32_32x32x16_bf16(kf[2 * s], qf[s], S0, 0, 0, 0); S1 = __builtin_amdgcn_mfma_f32_32x32x16_bf16(kf[2 * s + 1], qf[s], S1, 0, 0, 0); } } while (0)
#define ATT_QK(S0, S1, bo) do { ATT_QK_ISSUE(bo); ATT_QK_MMA(S0, S1); } while (0)
#define ATT_MASK(S0, S1, j) do { _Pragma("unroll") for (int r = 0; r < 16; ++r) { const int kg = 64 * (j) + crow(r, hi); if (kg > q) S0[r] = -1e30f; if (kg + 32 > q) S1[r] = -1e30f; } } while (0)
#define ATT_ROWMAX(S0, S1, out) do { float mx_ = fmaxf(fmaxf(S0[0], S1[0]), fmaxf(S0[1], S1[1])); \
        _Pragma("unroll") for (int r = 2; r < 16; r += 2) mx_ = fmaxf(mx_, fmaxf(fmaxf(S0[r], S1[r]), fmaxf(S0[r + 1], S1[r + 1]))); \
        out = fmaxf(mx_, __shfl_xor(mx_, 32)); } while (0)
#define ATT_SOFTMAX(S0, S1) do { float ls0 = 0.f, ls1 = 0.f; \
        _Pragma("unroll") for (int r = 0; r < 16; ++r) { S0[r] = __builtin_amdgcn_exp2f(S0[r]); S1[r] = __builtin_amdgcn_exp2f(S1[r]); ls0 += S0[r]; ls1 += S1[r]; } \
        lrun += ls0 + ls1; \
        _Pragma("unroll") for (int ks = 0; ks < 4; ++ks) { const int b_ = 8 * (ks & 1); \
            if (ks < 2) pw[ks] = (u32x4){pk2(S0[b_], S0[b_ + 1]), pk2(S0[b_ + 2], S0[b_ + 3]), pk2(S0[b_ + 4], S0[b_ + 5]), pk2(S0[b_ + 6], S0[b_ + 7])}; \
            else        pw[ks] = (u32x4){pk2(S1[b_], S1[b_ + 1]), pk2(S1[b_ + 2], S1[b_ + 3]), pk2(S1[b_ + 4], S1[b_ + 5]), pk2(S1[b_ + 6], S1[b_ + 7])}; } } while (0)
    u32x2 vfr[16];
#define ATT_PV_ISSUE(bo) do { _Pragma("unroll") for (int ks = 0; ks < 4; ++ks) { const LAS unsigned char* vb = L + (bo) + KBYTES + r32 * 136 + 32 * ks + 8 * hi; \
            vfr[4 * ks] = *(const LAS u32x2*)(vb); vfr[4 * ks + 1] = *(const LAS u32x2*)(vb + 16); vfr[4 * ks + 2] = *(const LAS u32x2*)(vb + 32 * 136); vfr[4 * ks + 3] = *(const LAS u32x2*)(vb + 32 * 136 + 16); } \
        __builtin_amdgcn_sched_barrier(0); } while (0)
#define ATT_PV_MMA() do { asm volatile("s_waitcnt lgkmcnt(0)" ::: "memory"); __builtin_amdgcn_sched_barrier(0); \
        _Pragma("unroll") for (int ks = 0; ks < 4; ++ks) { \
            const bf16x8 va = __builtin_bit_cast(bf16x8, (u32x4){vfr[4 * ks].x, vfr[4 * ks].y, vfr[4 * ks + 1].x, vfr[4 * ks + 1].y}), vbb = __builtin_bit_cast(bf16x8, (u32x4){vfr[4 * ks + 2].x, vfr[4 * ks + 2].y, vfr[4 * ks + 3].x, vfr[4 * ks + 3].y}), pf = __builtin_bit_cast(bf16x8, pw[ks]); \
            o0 = __builtin_amdgcn_mfma_f32_32x32x16_bf16(va, pf, o0, 0, 0, 0); o1 = __builtin_amdgcn_mfma_f32_32x32x16_bf16(vbb, pf, o1, 0, 0, 0); } } while (0)
    ATT_LOADK(j0, A); ATT_LOADV(j0, A); ATT_WRITEK((j0 & 1) * BUF, A); ATT_WRITEV((j0 & 1) * BUF, A);
    if (j0 + 1 < NT) { ATT_LOADK(j0 + 1, B); ATT_WRITEK(((j0 + 1) & 1) * BUF, B); }
    ATT_LOADK(j0 + 2, A);
    ATT_LOADV(j0 + 1, A);
    __syncthreads();
    f32x16 sc0, sc1; float rm = -1e30f; u32x4 pw[4];
    if (j0 <= jmax) { ATT_QK(sc0, sc1, (j0 & 1) * BUF); if (FOX && j0 == jmax) ATT_MASK(sc0, sc1, j0); ATT_ROWMAX(sc0, sc1, rm); }
    __syncthreads();
#define ATT_ITER(t, LW, LL) do { \
        const int bo = ((t) & 1) * BUF, bn = (((t) + 1) & 1) * BUF; \
        ATT_LOADK((t) + 3, LL); \
        ATT_LOADV((t) + 2, LL); \
        if ((t) <= jmax) { \
            if (__any(rm > THR)) { const float dl = fmaxf(rm, 0.f), f = __builtin_amdgcn_exp2f(-dl); mhat += dl; lrun *= f; \
                _Pragma("unroll") for (int r = 0; r < 16; ++r) { sc0[r] -= dl; sc1[r] -= dl; o0[r] *= f; o1[r] *= f; } } \
            if ((t) < jmax) { \
                f32x16 sn0, sn1; \
                ATT_QK_ISSUE(bn);                  \
                ATT_SOFTMAX(sc0, sc1);             \
                ATT_QK_MMA(sn0, sn1); \
                ATT_PV_ISSUE(bo);                  \
                ATT_PV_MMA(); \
                if (FOX && (t) + 1 == jmax) ATT_MASK(sn0, sn1, (t) + 1); \
                ATT_ROWMAX(sn0, sn1, rm); \
                sc0 = sn0; sc1 = sn1; \
            } else { ATT_PV_ISSUE(bo); ATT_SOFTMAX(sc0, sc1); ATT_PV_MMA(); } \
        } \
        if ((t) + 2 < NT) ATT_WRITEK(bo, LW); \
        if ((t) + 1 < NT) ATT_WRITEV(bn, LW); \
        __syncthreads(); } while (0)
    for (int t = j0; t < NT; t += 2) { ATT_ITER(t, A, B); if (t + 1 < NT) ATT_ITER(t + 1, B, A); }
#undef ATT_ITER
#undef ATT_LOADK
#undef ATT_LOADV
#undef ATT_WRITEK
#undef ATT_WRITEV
#undef ATT_QK
#undef ATT_MASK
#undef ATT_ROWMAX
#undef ATT_SOFTMAX
#undef ATT_PV_ISSUE
#undef ATT_PV_MMA
#undef ATT_QK_ISSUE
#undef ATT_QK_MMA
    const float inv = 1.0f / (lrun + __shfl_xor(lrun, 32));
    bf16_t* op = Ob + (size_t)q * ldo + 4 * hi;
#pragma unroll
    for (int g = 0; g < 4; ++g) { u32x2 w0, w1; w0.x = pk2(o0[4 * g] * inv, o0[4 * g + 1] * inv); w0.y = pk2(o0[4 * g + 2] * inv, o0[4 * g + 3] * inv);
        w1.x = pk2(o1[4 * g] * inv, o1[4 * g + 1] * inv); w1.y = pk2(o1[4 * g + 2] * inv, o1[4 * g + 3] * inv);
        *(u32x2*)(op + 8 * g) = w0; *(u32x2*)(op + 32 + 8 * g) = w1; }
}
__device__ __forceinline__ void fox_knorm(int gw, int ngw, int lane, const bf16_t* KF, float* KNRM) {
    for (int it = gw; it < 16 * 256; it += ngw) { const int bh = it >> 8, j = it & 255, b = bh >> 3, h = bh & 7;
        const u32x4* kp = (const u32x4*)(KF + ((size_t)b * S + 64 * j + lane) * 512 + h * 64); float n2 = 0.f;
#pragma unroll
        for (int c = 0; c < 8; ++c) { const u32x4 v = kp[c]; const unsigned ww[4] = {v.x, v.y, v.z, v.w};
#pragma unroll
            for (int e = 0; e < 4; ++e) { const float a = bflo(ww[e]), bb = bfhi(ww[e]); n2 += a * a + bb * bb; } }
#pragma unroll
        for (int o = 1; o < 64; o <<= 1) n2 = fmaxf(n2, __shfl_xor(n2, o));
        if (lane == 0) KNRM[it] = sqrtf(n2); }
}

constexpr int RT_KZP = 144;
constexpr int RT_QP = 528;
constexpr int RT_OFF_KZ = 0, RT_OFF_Q = 256 * RT_KZP, RT_OFF_K = RT_OFF_Q + 64 * RT_QP, RT_OFF_P = RT_OFF_K + 64 * RT_QP, RT_OFF_SS = RT_OFF_P + 64 * RT_KZP, RT_LDS = RT_OFF_SS + 64 * 8 * 4;
static_assert(RT_LDS <= 131072, "retention LDS");

__device__ __forceinline__ void ret_local(int wave_, LAS unsigned char* L, const bf16_t* KZT, const bf16_t* VT, f32x4* Lout, int u) {
    const int tid = wave_ * 64 + lane_id_opaque();
    const int lane = tid & 63, w = __builtin_amdgcn_readfirstlane(tid >> 6), l15 = lane & 15, g = lane >> 4;
    const int h = u >> 6, seg = (u >> 2) & 15, eb = u & 3, E0 = eb * 128 + w * 16;
    const float gc = __builtin_exp2f(64.0f * log2_gamma(h));
    f32x4 st[16];
#pragma unroll
    for (int i = 0; i < 16; ++i) st[i] = (f32x4){0.f, 0.f, 0.f, 0.f};
    u32x4 kz[4];
    const bf16_t* kzb = KZT + (size_t)(h * 256 + seg * SEGC) * 256 * 64;
#define R1_LOAD(ci) do { _Pragma("unroll") for (int i = 0; i < 4; ++i) kz[i] = *(const u32x4*)(kzb + (size_t)(ci) * 16384 + (size_t)(tid + 512 * i) * 8); } while (0)
#define R1_WRITE() do { _Pragma("unroll") for (int i = 0; i < 4; ++i) { const int id = tid + 512 * i; *(LAS u32x4*)(L + RT_OFF_KZ + (id >> 3) * RT_KZP + (id & 7) * 16) = kz[i]; } } while (0)
    R1_LOAD(0);
    for (int ci = 0; ci < SEGC; ++ci) {
        R1_WRITE(); __syncthreads();
        if (ci + 1 < SEGC) R1_LOAD(ci + 1);
        const bf16_t* vp = VT + ((size_t)(h * 256 + seg * SEGC + ci) * 512 + E0 + l15) * 64 + 8 * g;
        const bf16x8 vf0 = *(const bf16x8*)vp, vf1 = *(const bf16x8*)(vp + 32);
        if (ci > 0) {
#pragma unroll
            for (int i = 0; i < 16; ++i) st[i] *= gc; }
#pragma unroll
        for (int dt = 0; dt < 16; ++dt) { const LAS unsigned char* ap = L + RT_OFF_KZ + (16 * dt + l15) * RT_KZP + 16 * g;
            st[dt] = __builtin_amdgcn_mfma_f32_16x16x32_bf16(*(const LAS bf16x8*)ap, vf0, st[dt], 0, 0, 0);
            st[dt] = __builtin_amdgcn_mfma_f32_16x16x32_bf16(*(const LAS bf16x8*)(ap + 64), vf1, st[dt], 0, 0, 0); }
        __syncthreads();
    }
#undef R1_LOAD
#undef R1_WRITE
    f32x4* lo = Lout + ((size_t)(u * 8 + w) * 16) * 64 + lane;
#pragma unroll
    for (int dt = 0; dt < 16; ++dt) lo[dt * 64] = st[dt];
}

__device__ __forceinline__ void ret_scan(int wave_, LAS unsigned char* L, const bf16_t* QX, const bf16_t* KN, const bf16_t* KZT, const bf16_t* VT, const f32x4* Lin, bf16_t* O  , float* PO  , int u) {
    const int tid = wave_ * 64 + lane_id_opaque();
    const int lane = tid & 63, w = __builtin_amdgcn_readfirstlane(tid >> 6), l15 = lane & 15, g = lane >> 4;
    const int h = u >> 6, seg = (u >> 2) & 15, eb = u & 3, E0 = eb * 128 + w * 16;
    const float l2g = log2_gamma(h), gc = __builtin_exp2f(64.0f * l2g);
    f32x4 st[16];
#pragma unroll
    for (int i = 0; i < 16; ++i) st[i] = (f32x4){0.f, 0.f, 0.f, 0.f};
    for (int j = 0; j < seg; ++j) { const float wj = __builtin_exp2f((float)(64 * SEGC * (seg - 1 - j)) * l2g); const int uj = (u & ~(15 << 2)) | (j << 2);
        const f32x4* li = Lin + ((size_t)(uj * 8 + w) * 16) * 64 + lane;
#pragma unroll
        for (int dt = 0; dt < 16; ++dt) st[dt] += li[dt * 64] * wj; }
    u32x4 kz[4], qx[4], kn[4];
    const bf16_t* kzb = KZT + (size_t)(h * 256 + seg * SEGC) * 256 * 64;
    const bf16_t* qb = QX + (size_t)(seg * SEGC * 64) * 1024 + h * 256; const bf16_t* kb = KN + (size_t)(seg * SEGC * 64) * 1024 + h * 256;
#define R2_LOADKZ(ci) do { _Pragma("unroll") for (int i = 0; i < 4; ++i) { const int id = tid + 512 * i; kz[i] = *(const u32x4*)(kzb + (size_t)(ci) * 16384 + (size_t)id * 8); } } while (0)
#define R2_LOADQK(ci) do { _Pragma("unroll") for (int i = 0; i < 4; ++i) { const int id = tid + 512 * i; \
        qx[i] = *(const u32x4*)(qb + (size_t)((ci) * 64 + (id >> 5)) * 1024 + (id & 31) * 8); kn[i] = *(const u32x4*)(kb + (size_t)((ci) * 64 + (id >> 5)) * 1024 + (id & 31) * 8); } } while (0)
#define R2_WRITE() do { _Pragma("unroll") for (int i = 0; i < 4; ++i) { const int id = tid + 512 * i; *(LAS u32x4*)(L + RT_OFF_KZ + (id >> 3) * RT_KZP + (id & 7) * 16) = kz[i]; \
        *(LAS u32x4*)(L + RT_OFF_Q + (id >> 5) * RT_QP + (id & 31) * 16) = qx[i]; *(LAS u32x4*)(L + RT_OFF_K + (id >> 5) * RT_QP + (id & 31) * 16) = kn[i]; } } while (0)
    R2_LOADKZ(0); R2_LOADQK(0);
    const int tr = w >> 1;
    for (int ci = 0; ci < SEGC; ++ci) {
        R2_WRITE(); __syncthreads();
        if (ci + 1 < SEGC) R2_LOADKZ(ci + 1);
        const int chunk = seg * SEGC + ci;
        const bf16_t* vp = VT + ((size_t)(h * 256 + chunk) * 512 + E0 + l15) * 64 + 8 * g;
        const bf16x8 vf0 = *(const bf16x8*)vp, vf1 = *(const bf16x8*)(vp + 32);
#pragma unroll
        for (int t2 = 0; t2 < 2; ++t2) { const int tc = 2 * (w & 1) + t2; f32x4 pa = {0.f, 0.f, 0.f, 0.f};
            if (tc <= tr) {
#pragma unroll
                for (int ks = 0; ks < 8; ++ks) pa = __builtin_amdgcn_mfma_f32_16x16x32_bf16(*(const LAS bf16x8*)(L + RT_OFF_Q + (16 * tr + l15) * RT_QP + 64 * ks + 16 * g),
                                                                                           *(const LAS bf16x8*)(L + RT_OFF_K + (16 * tc + l15) * RT_QP + 64 * ks + 16 * g), pa, 0, 0, 0);
                const int cp = 16 * tc + l15; const float dk = __builtin_exp2f(-(float)(cp + 1) * l2g);
#pragma unroll
                for (int r = 0; r < 4; ++r) { const int c = 16 * tr + 4 * g + r; pa[r] = (c >= cp) ? pa[r] * dk : 0.f; } }
#pragma unroll
            for (int r = 0; r < 4; ++r) *(LAS bf16_t*)(L + RT_OFF_P + (16 * tr + 4 * g + r) * RT_KZP + (16 * tc + l15) * 2) = (bf16_t)f2bf(pa[r]); }
        __syncthreads();
        bf16x8 sb[8];
#pragma unroll
        for (int ks = 0; ks < 8; ++ks) sb[ks] = __builtin_bit_cast(bf16x8, (u32x4){pk2(st[2 * ks][0], st[2 * ks][1]), pk2(st[2 * ks][2], st[2 * ks][3]), pk2(st[2 * ks + 1][0], st[2 * ks + 1][1]), pk2(st[2 * ks + 1][2], st[2 * ks + 1][3])});
#pragma unroll
        for (int mt = 0; mt < 4; ++mt) { f32x4 oa = {0.f, 0.f, 0.f, 0.f};
#pragma unroll
            for (int ks = 0; ks < 8; ++ks) oa = __builtin_amdgcn_mfma_f32_16x16x32_bf16(*(const LAS bf16x8*)(L + RT_OFF_Q + (16 * mt + l15) * RT_QP + 64 * ks + 16 * g), sb[ks], oa, 0, 0, 0);
            oa = __builtin_amdgcn_mfma_f32_16x16x32_bf16(*(const LAS bf16x8*)(L + RT_OFF_P + (16 * mt + l15) * RT_KZP + 16 * g), vf0, oa, 0, 0, 0);
            oa = __builtin_amdgcn_mfma_f32_16x16x32_bf16(*(const LAS bf16x8*)(L + RT_OFF_P + (16 * mt + l15) * RT_KZP + 64 + 16 * g), vf1, oa, 0, 0, 0);
#pragma unroll
            for (int r = 0; r < 4; ++r) { const int c = 16 * mt + 4 * g + r; O[(size_t)(chunk * 64 + c) * 2048 + h * 512 + E0 + l15] = (bf16_t)f2bf(oa[r]);
                float ss = oa[r] * oa[r]; ss += __shfl_xor(ss, 1); ss += __shfl_xor(ss, 2); ss += __shfl_xor(ss, 4); ss += __shfl_xor(ss, 8);
                if (l15 == 0) *(LAS float*)(L + RT_OFF_SS + (c * 8 + w) * 4) = ss; } }
        if (ci + 1 < SEGC) R2_LOADQK(ci + 1);
#pragma unroll
        for (int i = 0; i < 16; ++i) st[i] *= gc;
#pragma unroll
        for (int dt = 0; dt < 16; ++dt) { const LAS unsigned char* ap = L + RT_OFF_KZ + (16 * dt + l15) * RT_KZP + 16 * g;
            st[dt] = __builtin_amdgcn_mfma_f32_16x16x32_bf16(*(const LAS bf16x8*)ap, vf0, st[dt], 0, 0, 0);
            st[dt] = __builtin_amdgcn_mfma_f32_16x16x32_bf16(*(const LAS bf16x8*)(ap + 64), vf1, st[dt], 0, 0, 0); }
        __syncthreads();
        if (tid < 64) { const LAS float* sp = (const LAS float*)(L + RT_OFF_SS + tid * 32); float s = 0.f;
#pragma unroll
            for (int i = 0; i < 8; ++i) s += sp[i];
            PO[(size_t)(chunk * 64 + tid) * 16 + h * 4 + eb] = s; }
    }
#undef R2_LOADKZ
#undef R2_LOADQK
#undef R2_WRITE
}

struct Ctx { int wave, vcu, G, gw, ngw; LAS unsigned char* lds; };
#define CTX_LANE const int lane_ = lane_id_opaque(), tid_ = C.wave * 64 + lane_

__device__ __forceinline__ void tr_item(const float* W, int ldw, int k0, int n0, int nvalid, const float* gain, bf16_t* dst, int ldd, LAS float* scr, int lane) {
#pragma unroll 8
    for (int i = 0; i < 32; ++i) { const int kk = 2 * i + (lane >> 5), nn = lane & 31; float v = (nn < nvalid) ? W[(size_t)(k0 + kk) * ldw + n0 + nn] : 0.f; if (gain) v *= gain[k0 + kk]; scr[kk * 33 + nn] = v; }
    asm volatile("s_waitcnt lgkmcnt(0)" ::: "memory");
    const int c = lane & 7;
#pragma unroll
    for (int j = 0; j < 4; ++j) { const int n = (lane >> 3) + 8 * j; const LAS float* s = scr + (8 * c) * 33 + n;
        u32x4 o; o.x = pk2(s[0], s[33]); o.y = pk2(s[2 * 33], s[3 * 33]); o.z = pk2(s[4 * 33], s[5 * 33]); o.w = pk2(s[6 * 33], s[7 * 33]);
        if (n < nvalid) *(u32x4*)(dst + (size_t)n * ldd + 8 * c) = o; }
    asm volatile("s_waitcnt lgkmcnt(0)" ::: "memory");
}
__device__ __forceinline__ void zero_rows(const Ctx& C, bf16_t* base, size_t pitch_el, int nrows, int col0, int ncol) {
    CTX_LANE;
    const int per = ncol / 8; const long n = (long)nrows * per;
    for (long i = (long)C.gw * 64 + lane_; i < n; i += (long)C.ngw * 64) { const long r = i / per; const int c = (int)(i % per); *(u32x4*)(base + (size_t)r * pitch_el + col0 + c * 8) = (u32x4){0u, 0u, 0u, 0u}; }
}
__device__ __forceinline__ void convert_moe(const Ctx& C, const Params&, int layer) {
    CTX_LANE;
    WS_OPAQUE;
    LAS float* scr = (LAS float*)(C.lds + C.wave * 16384);
    bf16_t* GU = WSP(bf16_t, OFF_WGU); bf16_t* DN = WSP(bf16_t, OFF_WDN); const float* gain = P.in[I_LN_FFN] + layer * 1024;
    for (int it = C.gw; it < 32 * 768; it += C.ngw) { const int e = it / 768, r = it % 768;
        if (r < 512) { const int up = r >> 8, rr = r & 255, kb = rr >> 4, nb = rr & 15, n0 = 32 * nb; const float* W = (up ? P.in[I_W_UP] : P.in[I_W_GATE]) + (size_t)(layer * 32 + e) * 1024 * 512;
            const int drow = 256 * (n0 >> 7) + (n0 & 127) + up * 128;
            tr_item(W, 512, 64 * kb, n0, 32, gain, GU + ((size_t)(e * 1024 + drow) * 1024 + 64 * kb), 1024, scr, lane_); }
        else { const int rr = r - 512, kb = rr >> 5, nb = rr & 31; const float* W = P.in[I_W_DOWN] + (size_t)(layer * 32 + e) * 512 * 1024;
            tr_item(W, 1024, 64 * kb, 32 * nb, 32, nullptr, DN + ((size_t)(e * 1024 + 32 * nb) * 512 + 64 * kb), 512, scr, lane_); } }
}
__device__ __forceinline__ void convert_mixer(const Ctx& C, const Params&) {
    CTX_LANE;
    WS_OPAQUE;
    LAS float* scr = (LAS float*)(C.lds + C.wave * 16384);
    bf16_t* WA1 = WSP(bf16_t, W_A1); bf16_t* WA1V = WSP(bf16_t, W_A1V); bf16_t* WA2 = WSP(bf16_t, W_A2); bf16_t* WA2V = WSP(bf16_t, W_A2V);
    bf16_t* WOE = WSP(bf16_t, W_OE); bf16_t* WB1 = WSP(bf16_t, W_B1); bf16_t* WOO = WSP(bf16_t, W_OO);
    constexpr int N1 = 16 * 62, N2 = 4 * 24, N3 = 2 * 32, N4 = 16 * 32, N5 = 16 * 192, N6 = 32 * 32, NT_ = N1 + N2 + N3 + N4 + N5 + N6;
    for (int it = C.gw; it < NT_; it += C.ngw) { int r = it;
        if (r < N1) { const int kb = r / 62, nb = r % 62, n0 = 32 * nb, k0 = 64 * kb; bf16_t* dst; int nv = 32;
            if (n0 < 416) dst = WA1 + (size_t)n0 * 1024; else if (n0 < 928) dst = WA1 + (size_t)(512 + n0 - 416) * 1024; else if (n0 < 1440) dst = WA1 + (size_t)(1024 + n0 - 928) * 1024;
            else if (n0 < 1952) dst = WA1V + (size_t)(n0 - 1440) * 1024; else { dst = WA1 + (size_t)416 * 1024; nv = 8; }
            tr_item(P.in[I_W_IN_E], 1960, k0, n0, nv, P.in[I_LN_MIX_E], dst + k0, 1024, scr, lane_); continue; } r -= N1;
        if (r < N2) { const int kb = r / 24, nb = r % 24, n0 = 32 * nb, hh = n0 / 96, off = n0 % 96;
            tr_item(P.in[I_W_UQ], 768, 64 * kb, n0, 32, P.in[I_LN_Q], WA2 + (size_t)(128 * hh + off) * 256 + 64 * kb, 256, scr, lane_); continue; } r -= N2;
        if (r < N3) { const int kb = r / 32, nb = r % 32, n0 = 32 * nb, hh = n0 / 128, off = n0 % 128;
            bf16_t* dst = off < 64 ? WA2 + (size_t)(1024 + 64 * hh + off) * 256 : WA2V + (size_t)(64 * hh + off - 64) * 256;
            tr_item(P.in[I_W_UKV], 1024, 64 * kb, n0, 32, P.in[I_LN_KV], dst + 64 * kb, 256, scr, lane_); continue; } r -= N3;
        if (r < N4) { const int kb = r / 32, nb = r % 32; tr_item(P.in[I_W_OUT_E], 1024, 64 * kb, 32 * nb, 32, nullptr, WOE + (size_t)(32 * nb) * 1024 + 64 * kb, 1024, scr, lane_); continue; } r -= N4;
        if (r < N5) { const int kb = r / 192, nb = r % 192; tr_item(P.in[I_W_IN_O], 6144, 64 * kb, 32 * nb, 32, P.in[I_LN_MIX_O], WB1 + (size_t)(32 * nb) * 1024 + 64 * kb, 1024, scr, lane_); continue; } r -= N5;
        { const int kb = r / 32, nb = r % 32; tr_item(P.in[I_W_OUT_O], 1024, 64 * kb, 32 * nb, 32, nullptr, WOO + (size_t)(32 * nb) * 2048 + 64 * kb, 2048, scr, lane_); } }
    zero_rows(C, WA1 + (size_t)424 * 1024, 1024, 88, 0, 1024);
    for (int hh = 0; hh < 8; ++hh) zero_rows(C, WA2 + (size_t)(128 * hh + 96) * 256, 256, 32, 0, 256);
    zero_rows(C, WA2 + (size_t)1024 * 256, 256, 512, 128, 128);
    zero_rows(C, WA2V, 256, 512, 128, 128);
}
__device__ __forceinline__ void make_rope(const Ctx& C, const Params&) {
    CTX_LANE;
    WS_OPAQUE;
    f32x2* rope = WSP(f32x2, OFF_ROPE);
    for (int i = C.gw * 64 + lane_; i < S * 128; i += C.ngw * 64) { const int pos = i >> 7, k = i & 127; const float inv = __builtin_exp2f(-(float)k * (13.287712379549449f / 128.0f));
        const float ang = (float)pos * inv; const double a = (double)ang; rope[i] = (f32x2){(float)cos(a), (float)sin(a)}; }
}
__device__ __forceinline__ void rows_to_bf16(const Ctx& C, const float* X, bf16_t* XB, float* RS) {
    CTX_LANE;
    for (int r = C.gw; r < T; r += C.ngw) { const f32x4* xr = (const f32x4*)(X + (size_t)r * D) + lane_; f32x4 v[4]; float s = 0.f;
#pragma unroll
        for (int j = 0; j < 4; ++j) { v[j] = xr[64 * j]; s += (v[j][0] * v[j][0] + v[j][1] * v[j][1]) + (v[j][2] * v[j][2] + v[j][3] * v[j][3]); }
        s = wave_sum(s); u32x2* o = (u32x2*)(XB + (size_t)r * D) + lane_;
#pragma unroll
        for (int j = 0; j < 4; ++j) o[64 * j] = (u32x2){pk2(v[j][0], v[j][1]), pk2(v[j][2], v[j][3])};
        if (lane_ == 0) RS[r] = rsqrt_f(s * (1.0f / D) + EPS); }
}
__device__ __forceinline__ void fox_cumsum(const Ctx& C, const float* LF, float* CUM, int bh) {
    CTX_LANE;
    LAS float* tot = (LAS float*)C.lds; const int b = bh >> 3, h = bh & 7; float v[32]; float run = 0.f;
#pragma unroll
    for (int i = 0; i < 32; ++i) { run += LF[((size_t)b * S + tid_ * 32 + i) * 8 + h]; v[i] = run; }
    tot[tid_] = run; __syncthreads();
    float off = 0.f; for (int t2 = 0; t2 < tid_; ++t2) off += tot[t2];
#pragma unroll
    for (int i = 0; i < 32; ++i) CUM[(size_t)bh * S + tid_ * 32 + i] = (off + v[i]) * LOG2E;
    __syncthreads();
}
__device__ __forceinline__ void moe_router(const Ctx& C, const Params&, int layer, int blk) {
    CTX_LANE;
    WS_OPAQUE;
    const float* XF = P.out; bf16_t* XB = WSP(bf16_t, OFF_XB); float* RS1 = WSP(float, SM_RS1);
    int* EID = WSP(int, SM_EID); float* GATE = WSP(float, SM_GATE); int* RANK = WSP(int, SM_RANK); int* CNT = WSP(int, SM_CNT);
    const float* wrg = P.in[I_W_RG] + (size_t)layer * 1024 * 4; const float* wre = P.in[I_W_RE] + (size_t)layer * 1024 * 32; const float* lnf = P.in[I_LN_FFN] + layer * 1024;
    LAS float* lg = (LAS float*)C.lds;
    LAS float* rsl = (LAS float*)(C.lds + 128 * 40 * 4);
    LAS int* eidl = (LAS int*)(C.lds + 128 * 40 * 4 + 512);
    LAS float* slab = (LAS float*)(C.lds + 32768);
    const int l15 = lane_ & 15, kg = lane_ >> 4, kbase = 128 * C.wave + 8 * kg;
    bf16x8 bh[3][4], bl[3][4];
#pragma unroll
    for (int nt = 0; nt < 3; ++nt) { const int col = 16 * nt + l15; const int cc = col < 36 ? col : 35; const float* wp = cc < 4 ? wrg + cc : wre + (cc - 4); const int wst = cc < 4 ? 4 : 32; const float wz = col < 36 ? 1.f : 0.f;
#pragma unroll
        for (int ks = 0; ks < 4; ++ks) { float wf[8]; unsigned hp[4], lp[4];
#pragma unroll
            for (int j = 0; j < 8; ++j) { const int k = kbase + 32 * ks + j; wf[j] = lnf[k] * wp[(size_t)k * wst] * wz; }
#pragma unroll
            for (int j = 0; j < 4; ++j) { hp[j] = pk2(wf[2 * j], wf[2 * j + 1]); lp[j] = pk2(wf[2 * j] - bflo(hp[j]), wf[2 * j + 1] - bfhi(hp[j])); }
            bh[nt][ks] = __builtin_bit_cast(bf16x8, (u32x4){hp[0], hp[1], hp[2], hp[3]}); bl[nt][ks] = __builtin_bit_cast(bf16x8, (u32x4){lp[0], lp[1], lp[2], lp[3]}); } }
    f32x4 xa[8], xb[8];
#define RT_LOADX(dst, mt) do { const float* xp = XF + (size_t)(blk * 128 + 16 * (mt) + l15) * D + kbase; _Pragma("unroll") for (int ks = 0; ks < 4; ++ks) { dst[2 * ks] = *(const f32x4*)(xp + 32 * ks); dst[2 * ks + 1] = *(const f32x4*)(xp + 32 * ks + 4); } } while (0)
#define RT_TILE(src, mt) do { f32x4 acc[3] = {{0.f, 0.f, 0.f, 0.f}, {0.f, 0.f, 0.f, 0.f}, {0.f, 0.f, 0.f, 0.f}}; float ss = 0.f; \
        _Pragma("unroll") for (int ks = 0; ks < 4; ++ks) { const f32x4 v0 = src[2 * ks], v1 = src[2 * ks + 1]; unsigned hp[4], lp[4]; \
            hp[0] = pk2(v0[0], v0[1]); hp[1] = pk2(v0[2], v0[3]); hp[2] = pk2(v1[0], v1[1]); hp[3] = pk2(v1[2], v1[3]); \
            lp[0] = pk2(v0[0] - bflo(hp[0]), v0[1] - bfhi(hp[0])); lp[1] = pk2(v0[2] - bflo(hp[1]), v0[3] - bfhi(hp[1])); lp[2] = pk2(v1[0] - bflo(hp[2]), v1[1] - bfhi(hp[2])); lp[3] = pk2(v1[2] - bflo(hp[3]), v1[3] - bfhi(hp[3])); \
            ss += (v0[0] * v0[0] + v0[1] * v0[1]) + (v0[2] * v0[2] + v0[3] * v0[3]) + (v1[0] * v1[0] + v1[1] * v1[1]) + (v1[2] * v1[2] + v1[3] * v1[3]); \
            const bf16x8 ah = __builtin_bit_cast(bf16x8, (u32x4){hp[0], hp[1], hp[2], hp[3]}), al = __builtin_bit_cast(bf16x8, (u32x4){lp[0], lp[1], lp[2], lp[3]}); \
            *(u32x4*)(XB + (size_t)(blk * 128 + 16 * (mt) + l15) * D + kbase + 32 * ks) = (u32x4){hp[0], hp[1], hp[2], hp[3]}; \
            _Pragma("unroll") for (int nt = 0; nt < 3; ++nt) { acc[nt] = __builtin_amdgcn_mfma_f32_16x16x32_bf16(ah, bh[nt][ks], acc[nt], 0, 0, 0); acc[nt] = __builtin_amdgcn_mfma_f32_16x16x32_bf16(ah, bl[nt][ks], acc[nt], 0, 0, 0); \
                acc[nt] = __builtin_amdgcn_mfma_f32_16x16x32_bf16(al, bh[nt][ks], acc[nt], 0, 0, 0); } } \
        ss += __shfl_xor(ss, 16); ss += __shfl_xor(ss, 32); \
        LAS float* sl = slab + (size_t)(C.wave * 64 + 16 * ((mt) & 3)) * 40; \
        _Pragma("unroll") for (int nt = 0; nt < 3; ++nt) { const int col = 16 * nt + l15; if (col < 36) { _Pragma("unroll") for (int r = 0; r < 4; ++r) sl[(4 * kg + r) * 40 + col] = acc[nt][r]; } } \
        if (kg == 0) sl[l15 * 40 + 36] = ss; } while (0)
    RT_LOADX(xa, 0);
    for (int half = 0; half < 2; ++half) {
        RT_LOADX(xb, 4 * half + 1); RT_TILE(xa, 4 * half + 0);
        RT_LOADX(xa, 4 * half + 2); RT_TILE(xb, 4 * half + 1);
        RT_LOADX(xb, 4 * half + 3); RT_TILE(xa, 4 * half + 2);
        if (half == 0) RT_LOADX(xa, 4); RT_TILE(xb, 4 * half + 3);
        __syncthreads();
        for (int it = tid_; it < 64 * 37; it += 512) { const int tt = it / 37, c = it % 37; float sm = 0.f;
#pragma unroll
            for (int w8 = 0; w8 < 8; ++w8) sm += slab[(size_t)(w8 * 64 + tt) * 40 + c];
            lg[(half * 64 + tt) * 40 + c] = sm; }
        __syncthreads();
    }
#undef RT_LOADX
#undef RT_TILE
    if (tid_ < 128) { const float rs = rsqrt_f(lg[tid_ * 40 + 36] * (1.0f / D) + EPS); rsl[tid_] = rs; RS1[blk * 128 + tid_] = rs; }
    __syncthreads();
    if (tid_ < 128) { const int tt = tid_, t = blk * 128 + tt; const float rs = rsl[tt]; const float* brg = P.in[I_B_RG] + layer * 4; const float* bre = P.in[I_B_RE] + layer * 32;
        float gl[4]; int gs = 0;
#pragma unroll
        for (int o = 0; o < 4; ++o) { gl[o] = lg[tt * 40 + o] * rs + brg[o]; if (gl[o] > gl[gs]) gs = o; }
        float gsum = 0.f;
#pragma unroll
        for (int o = 0; o < 4; ++o) gsum += __expf(gl[o] - gl[gs]);
        const float pg = 1.0f / gsum;
        float el[8]; int j1 = 0;
#pragma unroll
        for (int j = 0; j < 8; ++j) { el[j] = lg[tt * 40 + 4 + 8 * gs + j] * rs + bre[8 * gs + j]; if (el[j] > el[j1]) j1 = j; }
        int j2 = (j1 == 0) ? 1 : 0;
#pragma unroll
        for (int j = 0; j < 8; ++j) if (j != j1 && el[j] > el[j2]) j2 = j;
        const float e2 = __expf(el[j2] - el[j1]), den = 1.0f / (1.0f + e2);
        const int ea = 8 * gs + j1, eb = 8 * gs + j2;
        EID[t * 2] = ea; EID[t * 2 + 1] = eb; GATE[t * 2] = pg * den; GATE[t * 2 + 1] = pg * e2 * den; eidl[2 * tt] = ea; eidl[2 * tt + 1] = eb; }
    __syncthreads();
    if (tid_ < 256) { const int me = eidl[tid_]; int rk = 0; for (int a = 0; a < tid_; ++a) rk += (eidl[a] == me) ? 1 : 0; RANK[blk * 256 + tid_] = rk; }
    if (tid_ < 32) { int c = 0; for (int a = 0; a < 256; ++a) c += (eidl[a] == tid_) ? 1 : 0; CNT[blk * 32 + tid_] = c; }
    __syncthreads();
}
__device__ __forceinline__ void moe_scatter(const Ctx& C, const Params&, int blk) {
    CTX_LANE;
    WS_OPAQUE;
    const int* CNT = WSP(int, SM_CNT); const int* EID = WSP(int, SM_EID); const float* GATE = WSP(float, SM_GATE); const int* RANK = WSP(int, SM_RANK); const float* RS1 = WSP(float, SM_RS1);
    int* TSLOT = WSP(int, SM_TSLOT); int* STOK = WSP(int, SM_STOK); float* SW = WSP(float, SM_SW); float* SR = WSP(float, SM_SR); int* TILEE = WSP(int, SM_TILEE);
    const bf16_t* XB = WSP(bf16_t, OFF_XB); bf16_t* XS = WSP(bf16_t, A_XS);
    LAS int* part = (LAS int*)C.lds;
    LAS int* tot = part + 1024;
    LAS int* slotl = tot + 128;
    { const int e = tid_ & 31, pt = tid_ >> 5; int s = 0, pre = 0;
        for (int b = pt * 16; b < pt * 16 + 16; ++b) { const int c = ld_i(CNT + b * 32 + e); s += c; if (b < blk) pre += c; }
        part[pt * 32 + e] = s; part[512 + pt * 32 + e] = pre; }
    __syncthreads();
    if (tid_ < 32) { int s = 0, pre = 0; for (int pt = 0; pt < 16; ++pt) { s += part[pt * 32 + tid_]; pre += part[512 + pt * 32 + tid_]; } tot[tid_] = s; tot[32 + tid_] = pre; }
    __syncthreads();
    if (tid_ == 0) { int ps = 0; for (int e = 0; e < 32; ++e) { tot[64 + e] = ps; ps += (tot[e] + 255) & ~255; } tot[96] = ps; }
    __syncthreads();
    if (tid_ < 256) { const int a = blk * 256 + tid_, t = a >> 1, e = EID[a]; const int slot = tot[64 + e] + tot[32 + e] + RANK[a];
        slotl[tid_] = slot; TSLOT[a] = slot; STOK[slot] = t; SW[slot] = GATE[a]; SR[slot] = RS1[t]; }
    __syncthreads();
    for (int i = C.wave; i < 256; i += 8) { const int slot = slotl[i], t = (blk * 256 + i) >> 1;
        const u32x4* s = (const u32x4*)(XB + (size_t)t * D) + lane_; u32x4* d = (u32x4*)(XS + (size_t)slot * D) + lane_; d[0] = s[0]; d[64] = s[64]; }
    if (blk < 32) { const int e = blk, beg = tot[64 + e] + tot[e], end = tot[64 + e] + ((tot[e] + 255) & ~255);
        for (int sl = beg + C.wave; sl < end; sl += 8) { u32x4* d = (u32x4*)(XS + (size_t)sl * D) + lane_; d[0] = (u32x4){0u, 0u, 0u, 0u}; d[64] = (u32x4){0u, 0u, 0u, 0u}; if (lane_ == 0) { STOK[sl] = -1; SW[sl] = 0.f; SR[sl] = 0.f; } } }
    if (blk == 0 && tid_ < 32) { const int e = tid_, t0 = tot[64 + e] >> 8, nt = ((tot[e] + 255) & ~255) >> 8; for (int i = 0; i < nt; ++i) TILEE[t0 + i] = e; if (e == 0) TILEE[300] = tot[96] >> 8; }
    __syncthreads();
}
template <int MODE> __device__ __forceinline__ void moe_combine(const Ctx& C, const Params&, float* RS, const float* gainf) {
    CTX_LANE;
    WS_OPAQUE;
    float* XF = P.out; bf16_t* XB = WSP(bf16_t, OFF_XB); const bf16_t* YS = WSP(bf16_t, A_XS); const int* TSLOT = WSP(int, SM_TSLOT);
    for (int t = C.gw; t < T; t += C.ngw) { const int sa = ld_i(TSLOT + 2 * t), sb = ld_i(TSLOT + 2 * t + 1); f32x4* xr = (f32x4*)(XF + (size_t)t * D) + lane_;
        const u32x2* ya = (const u32x2*)(YS + (size_t)sa * D) + lane_; const u32x2* yb = (const u32x2*)(YS + (size_t)sb * D) + lane_; f32x4 v[4]; float s = 0.f;
#pragma unroll
        for (int j = 0; j < 4; ++j) { const u32x2 a = ya[64 * j], b = yb[64 * j]; v[j] = xr[64 * j];
            v[j][0] += bflo(a.x) + bflo(b.x); v[j][1] += bfhi(a.x) + bfhi(b.x); v[j][2] += bflo(a.y) + bflo(b.y); v[j][3] += bfhi(a.y) + bfhi(b.y);
            s += (v[j][0] * v[j][0] + v[j][1] * v[j][1]) + (v[j][2] * v[j][2] + v[j][3] * v[j][3]); }
        s = wave_sum(s); const float rs = rsqrt_f(s * (1.0f / D) + EPS);
        if (MODE == 0) { u32x2* o = (u32x2*)(XB + (size_t)t * D) + lane_;
#pragma unroll
            for (int j = 0; j < 4; ++j) { xr[64 * j] = v[j]; o[64 * j] = (u32x2){pk2(v[j][0], v[j][1]), pk2(v[j][2], v[j][3])}; }
            if (lane_ == 0) RS[t] = rs; }
        else { const f32x4* gr = (const f32x4*)gainf + lane_;
#pragma unroll
            for (int j = 0; j < 4; ++j) xr[64 * j] = v[j] * rs * gr[64 * j]; } }
}

constexpr int LDS_BYTES = 147456;
constexpr int LDS_MISC = LDS_BYTES - 256;
constexpr int NPHASE = 23;

__global__ void __launch_bounds__(512, 2) fwd_kernel(Params Pkern) {
    extern __shared__ __attribute__((aligned(16))) unsigned char lds_raw[];
    LAS unsigned char* lds = (LAS unsigned char*)lds_raw;
    Ctx C; { const int t0_ = threadIdx.x; C.wave = __builtin_amdgcn_readfirstlane(t0_ >> 6); } C.G = gridDim.x;
    C.vcu = (C.G % 8 == 0) ? ((int)blockIdx.x % 8) * (C.G / 8) + (int)blockIdx.x / 8 : (int)blockIdx.x;
    C.gw = C.vcu * 8 + C.wave; C.ngw = C.G * 8; C.lds = lds;
    const int bx = blockIdx.x;
    { const int l0 = lane_id_opaque(); if (C.wave == 0) ((LAS unsigned*)(lds + LDS_MISC))[l0] = 0u; }
    __syncthreads();
    const unsigned xcc = xb_xcc_id();
    if (Pkern.use_bar) { const bool t0 = (C.wave == 0) && (lane_id_opaque() == 0); (void)xcd_barrier_post((unsigned*)(Pkern.ws + OFF_CTL) + 4096, (volatile LAS unsigned*)(lds + LDS_MISC), t0); }
    const int lo = Pkern.ph_lo, hi = Pkern.ph_hi;
    const Params& P = Pkern;
#ifndef PH_MASK
#define PH_MASK 0x7fffffu
#endif
#define IN(k) ((((unsigned)PH_MASK >> (k)) & 1u) && lo <= (k) && (k) < hi)
#ifndef PROBE_MASK
#define PROBE_MASK 0u
#endif
#define REP(k) for (int rep_ = 0; rep_ < ((((unsigned)PROBE_MASK >> (k)) & 1u) ? 2 : 1); ++rep_)
#define SEAM(k) do { if (IN(k) && IN((k) + 1)) { P_OPAQUE; XcdBarrier bar; bar.bar = (unsigned*)(P.ws + OFF_CTL) + 4096; bar.x = xcc; bar.st = (volatile LAS unsigned*)(lds + LDS_MISC); \
        const bool t0 = (C.wave == 0) && (lane_id_opaque() == 0); xcd_barrier(bar, t0); } } while (0)

    if (IN(0)) REP(0) { WS_OPAQUE; convert_mixer(C, P); convert_moe(C, P, 0); make_rope(C, P); rows_to_bf16(C, P.in[I_X], WSP(bf16_t, OFF_XB), WSP(float, SM_RS0)); __syncthreads(); }
    SEAM(0);
    if (IN(1)) REP(1) {
        { WS_OPAQUE; DenseSched Sd; Sd.init(WSP(bf16_t, OFF_XB), 1024, WSP(bf16_t, W_A1), 1024, 128, 6, C.G, bx);
          EpiA1a E{WSP(float, SM_RS0), WSP(bf16_t, A_Z), WSP(float, SM_PQ), WSP(float, SM_PKV), WSP(bf16_t, A_KA), WSP(float, SM_LF), P.in[I_B_F], WSP(bf16_t, A_QF), WSP(bf16_t, A_KF), WSP(f32x2, OFF_ROPE)};
          pg8::gemm_phase(C.wave, lds, pg8::Dims{1024, 1024, 1024}, Sd, E); }
        { WS_OPAQUE; DenseSched Sd; Sd.init(WSP(bf16_t, W_A1V), 1024, WSP(bf16_t, OFF_XB), 1024, 2, 128, C.G, bx);
          EpiVT<0> E{WSP(float, SM_RS0), WSP(bf16_t, A_VTF), (size_t)T};
          pg8::gemm_phase(C.wave, lds, pg8::Dims{1024, 1024, 1024}, Sd, E); }
    }
    SEAM(1);
    if (IN(2)) REP(2) {
        if (C.vcu < 16) { WS_OPAQUE; fox_cumsum(C, WSP(float, SM_LF), WSP(float, SM_CUM), C.vcu); }
        { WS_OPAQUE; fox_knorm(C.gw, C.ngw, lane_id_opaque(), WSP(bf16_t, A_KF), WSP(float, SM_KNRM)); }
        { WS_OPAQUE; DenseSched Sd; Sd.init(WSP(bf16_t, A_Z), 512, WSP(bf16_t, W_A2), 256, 128, 4, C.G, bx);
          EpiA2q E{WSP(float, SM_PQ), WSP(bf16_t, A_QA), WSP(f32x2, OFF_ROPE)};
          pg8::gemm_phase(C.wave, lds, pg8::Dims{512, 256, 256}, Sd, E); }
        { WS_OPAQUE; DenseSched Sd; Sd.init(WSP(bf16_t, A_Z) + 256, 512, WSP(bf16_t, W_A2) + (size_t)1024 * 256, 256, 128, 2, C.G, bx);
          EpiA2k E{WSP(float, SM_PKV), WSP(bf16_t, A_KA)};
          pg8::gemm_phase(C.wave, lds, pg8::Dims{512, 256, 256}, Sd, E); }
        { WS_OPAQUE; DenseSched Sd; Sd.init(WSP(bf16_t, W_A2V), 256, WSP(bf16_t, A_Z) + 256, 512, 2, 128, C.G, bx);
          EpiVT<1> E{WSP(float, SM_PKV), WSP(bf16_t, A_VTA), (size_t)T};
          pg8::gemm_phase(C.wave, lds, pg8::Dims{256, 512, 256}, Sd, E); }
    }
    SEAM(2);
    if (IN(3)) REP(3) {
        const int bh = C.vcu >> 4, s4 = C.vcu & 15, b = bh >> 3, h = bh & 7;
        REP(23) { WS_OPAQUE; bf16_t* AO = WSP(bf16_t, OFF_XB);
          for (int i = 0; i < 4; ++i) { const int qb = (i == 0) ? s4 : (i == 1) ? 31 - s4 : (i == 2) ? 32 + s4 : 63 - s4;
            attn_unit<96, false>(C.wave, lds, WSP(bf16_t, A_QA) + (size_t)b * S * 768 + h * 96, 768, WSP(bf16_t, A_KA) + (size_t)b * S * 768 + h * 96, 768,
                                 WSP(bf16_t, A_VTA) + ((size_t)h * (T / 64) + (size_t)b * (S / 64)) * 4096, nullptr, nullptr, AO + (size_t)b * S * 1024 + h * 64, 1024, qb); } }
        REP(24) { WS_OPAQUE; bf16_t* AO = WSP(bf16_t, OFF_XB);
          for (int i = 0; i < 4; ++i) { const int qb = (i == 0) ? s4 : (i == 1) ? 31 - s4 : (i == 2) ? 32 + s4 : 63 - s4;
            attn_unit<64, true>(C.wave, lds, WSP(bf16_t, A_QF) + (size_t)b * S * 512 + h * 64, 512, WSP(bf16_t, A_KF) + (size_t)b * S * 512 + h * 64, 512,
                                WSP(bf16_t, A_VTF) + ((size_t)h * (T / 64) + (size_t)b * (S / 64)) * 4096, WSP(float, SM_CUM) + (size_t)bh * S, WSP(float, SM_KNRM) + bh * 256, AO + (size_t)b * S * 1024 + 512 + h * 64, 1024, qb); } }
    }
    SEAM(3);
    if (IN(4)) REP(4) { WS_OPAQUE; DenseSched Sd; Sd.init(WSP(bf16_t, OFF_XB), 1024, WSP(bf16_t, W_OE), 1024, 128, 4, C.G, bx); EpiRes E{P.in[I_X], P.out};
        pg8::gemm_phase(C.wave, lds, pg8::Dims{1024, 1024, 1024}, Sd, E); }
    SEAM(4);

#define MOE_PHASES(layer, pb) do { \
        if (IN(pb)) REP(pb) moe_router(C, P, layer, bx); \
        SEAM(pb); \
        if (IN((pb) + 1)) REP((pb) + 1) moe_scatter(C, P, bx); \
        SEAM((pb) + 1); \
        if (IN((pb) + 2)) REP((pb) + 2) { WS_OPAQUE; MoeSched Sm; Sm.init(WSP(bf16_t, A_XS), 1024, WSP(bf16_t, OFF_WGU), 1024, 1024, WSP(int, SM_TILEE), C.G, bx); EpiM3 E{WSP(float, SM_SR), WSP(bf16_t, A_HID)}; \
            pg8::gemm_phase(C.wave, lds, pg8::Dims{1024, 1024, 1024}, Sm, E); } \
        SEAM((pb) + 2); \
        if (IN((pb) + 3)) REP((pb) + 3) { WS_OPAQUE; MoeSched Sm; Sm.init(WSP(bf16_t, A_HID), 512, WSP(bf16_t, OFF_WDN), 512, 1024, WSP(int, SM_TILEE), C.G, bx); EpiM4 E{WSP(float, SM_SW), WSP(bf16_t, A_XS)}; \
            pg8::gemm_phase(C.wave, lds, pg8::Dims{512, 512, 512}, Sm, E); } \
        SEAM((pb) + 3); } while (0)
#define RET_PHASES(bb, p0) do { \
        if (IN(p0)) REP(p0) { \
            { WS_OPAQUE; DenseSched Sd; Sd.init(WSP(bf16_t, OFF_XB) + (size_t)(bb) * S * 1024, 1024, WSP(bf16_t, W_B1), 1024, 64, 4, C.G, bx); EpiB1q E{WSP(float, SM_RS2) + (bb) * S, WSP(bf16_t, A_QX), WSP(f32x2, OFF_ROPE)}; \
              pg8::gemm_phase(C.wave, lds, pg8::Dims{1024, 1024, 1024}, Sd, E); } \
            { WS_OPAQUE; DenseSched Sd; Sd.init(WSP(bf16_t, W_B1) + (size_t)1024 * 1024, 1024, WSP(bf16_t, OFF_XB) + (size_t)(bb) * S * 1024, 1024, 4, 64, C.G, bx); EpiB1k E{WSP(float, SM_RS2) + (bb) * S, WSP(bf16_t, A_KN), WSP(bf16_t, A_KZT), WSP(f32x2, OFF_ROPE)}; \
              pg8::gemm_phase(C.wave, lds, pg8::Dims{1024, 1024, 1024}, Sd, E); } \
            { WS_OPAQUE; DenseSched Sd; Sd.init(WSP(bf16_t, W_B1) + (size_t)2048 * 1024, 1024, WSP(bf16_t, OFF_XB) + (size_t)(bb) * S * 1024, 1024, 8, 64, C.G, bx); EpiB1v E{WSP(float, SM_RS2) + (bb) * S, WSP(bf16_t, A_VT)}; \
              pg8::gemm_phase(C.wave, lds, pg8::Dims{1024, 1024, 1024}, Sd, E); } \
        } \
        SEAM(p0); \
        if (IN((p0) + 1)) REP((p0) + 1) { WS_OPAQUE; ret_local(C.wave, lds, WSP(bf16_t, A_KZT), WSP(bf16_t, A_VT), WSP(f32x4, A_L), C.vcu); } \
        SEAM((p0) + 1); \
        if (IN((p0) + 2)) REP((p0) + 2) { WS_OPAQUE; ret_scan(C.wave, lds, WSP(bf16_t, A_QX), WSP(bf16_t, A_KN), WSP(bf16_t, A_KZT), WSP(bf16_t, A_VT), WSP(f32x4, A_L), \
                                 WSP(bf16_t, A_O) + (size_t)(bb) * S * 2048, WSP(float, SM_PO) + (size_t)(bb) * S * 16, C.vcu); } \
        SEAM((p0) + 2); } while (0)

    MOE_PHASES(0, 5);
    if (IN(9)) { WS_OPAQUE; moe_combine<0>(C, P, WSP(float, SM_RS2), nullptr); convert_moe(C, P, 1); __syncthreads(); }
    SEAM(9);
    RET_PHASES(0, 10);
    RET_PHASES(1, 13);
    if (IN(16)) { WS_OPAQUE; DenseSched Sd; Sd.init(WSP(bf16_t, OFF_XB), 1024, WSP(bf16_t, W_B1) + (size_t)4096 * 1024, 1024, 128, 8, C.G, bx); EpiG E{WSP(float, SM_RS2), WSP(float, SM_PO), WSP(bf16_t, A_O)};
        pg8::gemm_phase(C.wave, lds, pg8::Dims{1024, 1024, 1024}, Sd, E); }
    SEAM(16);
    if (IN(17)) { WS_OPAQUE; DenseSched Sd; Sd.init(WSP(bf16_t, A_O), 2048, WSP(bf16_t, W_OO), 2048, 128, 4, C.G, bx); EpiRes E{P.out, P.out};
        pg8::gemm_phase(C.wave, lds, pg8::Dims{2048, 2048, 2048}, Sd, E); }
    SEAM(17);
    MOE_PHASES(1, 18);
#undef MOE_PHASES
#undef RET_PHASES
    if (IN(22)) { P_OPAQUE; moe_combine<1>(C, P, nullptr, P.in[I_LN_F]); }
#undef IN
#undef SEAM
}

extern "C" void kernel_launch(void* const* d_in, const int* in_sizes, int n_in, void* d_out, int out_size, void* d_ws, size_t ws_size, hipStream_t stream) {
    static int ready = 0;
    if (ready == 0) {
        if (n_in != 21 || out_size != T * D || ws_size < WS_NEED) { fprintf(stderr, "kernel_launch: unexpected shapes (n_in %d, out %d, ws %zu < %zu)\n", n_in, out_size, ws_size, (size_t)WS_NEED); ready = -1; return; }
        if (hipFuncSetAttribute((const void*)fwd_kernel, hipFuncAttributeMaxDynamicSharedMemorySize, LDS_BYTES) != hipSuccess) { fprintf(stderr, "kernel_launch: hipFuncSetAttribute failed\n"); ready = -1; return; }
        int per_cu = 0; (void)hipOccupancyMaxActiveBlocksPerMultiprocessor(&per_cu, (const void*)fwd_kernel, 512, LDS_BYTES); (void)hipGetLastError();
        if (per_cu < 1) fprintf(stderr, "kernel_launch: occupancy query reports %d blocks per CU\n", per_cu);
        ready = 1;
    }
    if (ready < 0) return;
    (void)hipMemsetAsync((char*)d_ws + OFF_CTL, 0, CTL_BYTES, stream);
    Params p{};
    for (int i = 0; i < 21; ++i) p.in[i] = (const float*)d_in[i];
    p.out = (float*)d_out; p.ws = (unsigned char*)d_ws; p.pad = 0;
#if N_LAUNCH_MODE == 1
    for (int ph = 0; ph < NPHASE; ++ph) { p.ph_lo = ph; p.ph_hi = ph + 1; p.use_bar = 0; hipLaunchKernelGGL(fwd_kernel, dim3(256), dim3(512), LDS_BYTES, stream, p); }
#else
    p.ph_lo = 0; p.ph_hi = NPHASE; p.use_bar = 1;
    hipLaunchKernelGGL(fwd_kernel, dim3(256), dim3(512), LDS_BYTES, stream, p);
#endif
}
```

```cpp
#include <hip/hip_runtime.h>
#include <cstdio>
#include <cstdint>

#ifndef N_LAUNCH_MODE
#define N_LAUNCH_MODE 0
#endif

#define LAS __attribute__((address_space(3)))
#define GAS __attribute__((address_space(1)))
typedef unsigned short bf16_t;
typedef short bf16x8 __attribute__((ext_vector_type(8)));
typedef float f32x2 __attribute__((ext_vector_type(2)));
typedef float f32x4 __attribute__((ext_vector_type(4)));
typedef float f32x16 __attribute__((ext_vector_type(16)));
typedef unsigned u32x2 __attribute__((ext_vector_type(2)));
typedef unsigned u32x4 __attribute__((ext_vector_type(4)));

constexpr int T = 32768, S = 16384, D = 1024;
constexpr float EPS = 1e-6f;
constexpr float LOG2E = 1.4426950408889634f;
constexpr int CAP = 65536 + 32 * 256;
constexpr int NSEG = 16, SEGC = 16;

constexpr size_t MiB = 1u << 20;
constexpr size_t OFF_CTL = 0, CTL_BYTES = 1 * MiB;
constexpr size_t OFF_SMALL = 1 * MiB;
constexpr size_t SM_RS0 = OFF_SMALL, SM_RS1 = SM_RS0 + T * 4, SM_RS2 = SM_RS1 + T * 4, SM_PQ = SM_RS2 + T * 4, SM_PKV = SM_PQ + (size_t)T * 16,
                 SM_LF = SM_PKV + (size_t)T * 16, SM_CUM = SM_LF + (size_t)T * 32, SM_EID = SM_CUM + (size_t)T * 32  ,
                 SM_GATE = SM_EID + (size_t)T * 8, SM_RANK = SM_GATE + (size_t)T * 8, SM_TSLOT = SM_RANK + (size_t)T * 8, SM_CNT = SM_TSLOT + (size_t)T * 8,
                 SM_STOK = SM_CNT + 256 * 32 * 4, SM_SW = SM_STOK + (size_t)CAP * 4, SM_SR = SM_SW + (size_t)CAP * 4, SM_TILEE = SM_SR + (size_t)CAP * 4,
                 SM_PO = SM_TILEE + 4096, SM_KNRM = SM_PO + (size_t)T * 64, SM_END = SM_KNRM + 16 * 256 * 4;
static_assert(SM_END <= 11 * MiB, "small region");
constexpr size_t OFF_ROPE = 11 * MiB;
constexpr size_t OFF_WMIX = 27 * MiB;
constexpr size_t W_A1 = OFF_WMIX, W_A1V = W_A1 + 3 * MiB, W_A2 = W_A1V + 1 * MiB, W_A2V = W_A2 + 768 * 1024, W_OE = W_A2V + 256 * 1024,
                 W_B1 = W_OE + 2 * MiB, W_OO = W_B1 + 12 * MiB, W_MIXEND = W_OO + 4 * MiB;
static_assert(W_MIXEND <= 51 * MiB, "mixer weights");
constexpr size_t OFF_WGU = 51 * MiB, OFF_WDN = OFF_WGU + 64 * MiB;
constexpr size_t OFF_XB = 147 * MiB;
constexpr size_t OFF_ACT = 211 * MiB;
constexpr size_t WS_NEED = OFF_ACT + 320 * MiB;
constexpr size_t A_Z = OFF_ACT, A_QF = A_Z + 32 * MiB, A_KF = A_QF + 32 * MiB, A_VTF = A_KF + 32 * MiB, A_QA = A_VTF + 32 * MiB, A_KA = A_QA + 48 * MiB, A_VTA = A_KA + 48 * MiB;
constexpr size_t A_XS = OFF_ACT, A_HID = OFF_ACT + 144 * MiB;
constexpr size_t A_QX = OFF_ACT, A_KN = A_QX + 32 * MiB, A_KZT = A_KN + 32 * MiB, A_VT = A_KZT + 32 * MiB, A_L = A_VT + 64 * MiB, A_O = A_L + 32 * MiB;
static_assert(A_O + 128 * MiB <= WS_NEED && A_HID + 72 * MiB <= WS_NEED && A_VTA + 32 * MiB <= WS_NEED, "act map");

__device__ __forceinline__ unsigned f2bf(float f) { unsigned u = __builtin_bit_cast(unsigned, f); return (u + 0x7fffu + ((u >> 16) & 1u)) >> 16; }
__device__ __forceinline__ unsigned pk2(float lo, float hi) { unsigned r; asm volatile("v_cvt_pk_bf16_f32 %0, %1, %2" : "=v"(r) : "v"(lo), "v"(hi)); return r; }
__device__ __forceinline__ float bf2f(unsigned short b) { return __builtin_bit_cast(float, ((unsigned)b) << 16); }
__device__ __forceinline__ float bflo(unsigned w) { return __builtin_bit_cast(float, w << 16); }
__device__ __forceinline__ float bfhi(unsigned w) { return __builtin_bit_cast(float, w & 0xffff0000u); }
__device__ __forceinline__ float wave_sum(float v) {
#pragma unroll
    for (int o = 1; o < 64; o <<= 1) v += __shfl_xor(v, o);
    return v;
}
__device__ __forceinline__ int lane_id_opaque() { unsigned z = 0u; asm volatile("" : "+s"(z)); int l = (int)__builtin_amdgcn_mbcnt_hi(~0u, __builtin_amdgcn_mbcnt_lo(~0u, z)); asm volatile("" : "+v"(l)); return l; }
__device__ __forceinline__ int ld_i(const int* p) { return __hip_atomic_load(p, __ATOMIC_RELAXED, __HIP_MEMORY_SCOPE_AGENT); }
__device__ __forceinline__ float rsqrt_f(float x) { return 1.0f / sqrtf(x); }

#define XB_TMO      128
#define XB_XCNT(j)  (256  + 64 * (j))
#define XB_XSUB(j)  (1280 + 64 * (j))
#define XB_XGEN(j)  (2304 + 64 * (j))
#define XB_TOP      3328
#define XB_TOPGEN   3392
#define XCD_BAR_WORDS 3456
#define XB_SPIN_CAP (1u << 18)
__device__ __forceinline__ unsigned xb_ld(unsigned* p)              { return __hip_atomic_load(p, __ATOMIC_RELAXED, __HIP_MEMORY_SCOPE_AGENT); }
__device__ __forceinline__ unsigned xb_add(unsigned* p, unsigned v) { return __hip_atomic_fetch_add(p, v, __ATOMIC_RELAXED, __HIP_MEMORY_SCOPE_AGENT); }
__device__ __forceinline__ unsigned xb_xcc_id() { return (unsigned)__builtin_amdgcn_s_getreg((3 << 11) | 20) & 0xFu; }
#define XB_SPIN(cond, bar) do { unsigned _sp = 0; while (cond) { __builtin_amdgcn_s_sleep(1); \
    if ((++_sp & 255u) == 0u) { if (xb_ld(&(bar)[XB_TMO])) break; if (_sp > XB_SPIN_CAP) { atomicAdd(&(bar)[XB_TMO], 1u); break; } } } } while (0)
struct XcdBarrier { unsigned* bar; unsigned x; volatile LAS unsigned* st; };
__device__ __forceinline__ XcdBarrier xcd_barrier_post(unsigned* bar, volatile LAS unsigned* st, bool t0) {
    XcdBarrier b; b.bar = bar; b.x = xb_xcc_id(); b.st = st;
    if (t0) (void)xb_add(&bar[XB_XCNT(b.x)], 1u);
    return b;
}
__device__ __forceinline__ void xcd_barrier_complete(unsigned* bar, unsigned x, unsigned& nloc, unsigned& nx) {
    const unsigned G = gridDim.x * gridDim.y * gridDim.z;
    unsigned sum, cnt, mine, sp = 0u;
    for (;;) {
        sum = 0u; cnt = 0u; mine = 0u;
#pragma unroll
        for (unsigned j = 0; j < 16; ++j) { const unsigned c = xb_ld(&bar[XB_XCNT(j)]); sum += c; cnt += (c > 0u) ? 1u : 0u; mine = (j == x) ? c : mine; }
        if (sum == G) break;
        __builtin_amdgcn_s_sleep(1);
        if ((++sp & 255u) == 0u) { if (xb_ld(&bar[XB_TMO])) break; if (sp > XB_SPIN_CAP) { atomicAdd(&bar[XB_TMO], 1u); break; } }
    }
    nloc = mine > 0u ? mine : 1u; nx = cnt > 0u ? cnt : 1u;
}
__device__ __forceinline__ void xcd_barrier(const XcdBarrier& b, bool t0) {
    asm volatile("s_waitcnt vmcnt(0)" ::: "memory");
    __syncthreads();
    if (t0) {
        unsigned* bar = b.bar;
        __builtin_amdgcn_s_waitcnt(0);
        unsigned nloc = b.st[0], nx = b.st[1];
        if (nloc == 0u) { xcd_barrier_complete(bar, b.x, nloc, nx); b.st[0] = nloc; b.st[1] = nx; }
        const unsigned old = xb_add(&bar[XB_XSUB(b.x)], 1u);
        const unsigned gen = old / nloc;
        if (old + 1u == (gen + 1u) * nloc) {
            __builtin_amdgcn_fence(__ATOMIC_RELEASE, "agent");
            asm volatile("s_waitcnt vmcnt(0)" ::: "memory");
            const unsigned og = xb_add(&bar[XB_TOP], 1u);
            const unsigned tg = og / nx;
            if (og + 1u == (tg + 1u) * nx) xb_add(&bar[XB_TOPGEN], 1u);
            else XB_SPIN(xb_ld(&bar[XB_TOPGEN]) == tg, bar);
            __builtin_amdgcn_fence(__ATOMIC_ACQUIRE, "agent");
            xb_add(&bar[XB_XGEN(b.x)], 1u);
            asm volatile("s_waitcnt vmcnt(0)" ::: "memory");
        } else {
            XB_SPIN(xb_ld(&bar[XB_XGEN(b.x)]) == gen, bar);
            __builtin_amdgcn_fence(__ATOMIC_ACQUIRE, "agent");
            asm volatile("s_waitcnt vmcnt(0)" ::: "memory");
        }
    }
    __syncthreads();
}

namespace pg8 {
constexpr int BM = 256, BK = 64, HALF = 128, HTB = HALF * BK * 2, STAGE_BYTES = 8 * HTB, NXCD = 8, WGM = 8;
__device__ __forceinline__ int lds_byte(int r, int c) { const int st = (r >> 4) * 2 + (c >> 5), rr = r & 15, cc = c & 31, ob = rr * 64 + cc * 2; return st * 1024 + (ob ^ (((ob >> 9) & 1) << 5)); }
__device__ __forceinline__ void stage_rc(int b, int& R, int& C) { const int st = b / 1024, sb = b % 1024, swz = sb ^ (((sb >> 9) & 1) << 5); R = (st >> 1) * 16 + swz / 64; C = (st & 1) * 32 + (swz % 64) / 2; }
__device__ __forceinline__ int perm32(int rho) { const int n = rho >> 4, i = rho & 15; return 8 * (i >> 2) + 4 * n + (i & 3); }
struct Unit { int pm, pn, aux; };
struct Dims { int lda, ldb, K; };
struct DenseOrder {
    int nM, nN, nwg, G, c;
    __device__ __forceinline__ void init(int nM_, int nN_, int G_, int c_) { nM = nM_; nN = nN_; nwg = nM * nN; G = G_; c = c_; }
    __device__ __forceinline__ bool tile(int i, Unit& u) const {
        const long L = (long)i * G + c; if (L >= nwg) return false;
        int wgid = (int)L; { const int q = nwg / NXCD, r = nwg % NXCD, xcd = wgid % NXCD, off = wgid / NXCD; wgid = (xcd < r ? xcd * (q + 1) : r * (q + 1) + (xcd - r) * q) + off; }
        const int nig = WGM * nN, gid = wgid / nig, fm = gid * WGM, gsz = (nM - fm) < WGM ? (nM - fm) : WGM;
        u.pm = fm + ((wgid % nig) % gsz); u.pn = (wgid % nig) / gsz; u.aux = 0; return true;
    }
};

template <class Epi, class Sched>
__device__ __forceinline__ void gemm_phase(int wave_, LAS unsigned char* lds, const Dims g, const Sched& S, const Epi& E) {
    const int tid = wave_ * 64 + lane_id_opaque();
    const int wid = __builtin_amdgcn_readfirstlane(tid >> 6), lane = tid & 63, wr = wid >> 2, wc = wid & 3, fr = lane & 15, fq = lane >> 4;
    const int K = g.K, nt = K / BK;
    unsigned voffA[2], voffB[2];
#pragma unroll
    for (int i = 0; i < 2; ++i) { int R, C; stage_rc(tid * 16 + i * 8192, R, C); const int Rb = Epi::PERM ? ((R & ~31) + perm32(R & 31)) : R;
        voffA[i] = (unsigned)(R * g.lda + C) * 2u; voffB[i] = (unsigned)(Rb * g.ldb + C) * 2u; }
    const size_t kstep = (size_t)(BK * 2);
    const size_t hstepA = (size_t)HALF * g.lda * 2, hstepB = (size_t)HALF * g.ldb * 2;
    const unsigned ldsw = (unsigned)wid * 1024u;
    const int aoff = lds_byte(wr * 64 + fr, fq * 8), boff = lds_byte(wc * 32 + fr, fq * 8);
#define PG8_SA(b, h) (((b) * 2 + (h)) * HTB)
#define PG8_SB(b, h) ((4 + (b) * 2 + (h)) * HTB)
#define PG8_STAGE(bufoff, gbase, voff) do { _Pragma("unroll") for (int _i = 0; _i < 2; ++_i) \
        __builtin_amdgcn_global_load_lds((const unsigned*)((const char*)(gbase) + (voff)[_i]), (LAS unsigned*)(lds + (bufoff) + ldsw + _i * 8192), 16, 0, 0); } while (0)
#define PG8_LDA(dst, b, h) do { _Pragma("unroll") for (int m = 0; m < 4; ++m) _Pragma("unroll") for (int k = 0; k < 2; ++k) dst[m][k] = *(const LAS bf16x8*)(lds + PG8_SA(b, h) + aoff + m * 2048 + k * 1024); } while (0)
#define PG8_LDB(dst, b, h) do { _Pragma("unroll") for (int n = 0; n < 2; ++n) _Pragma("unroll") for (int k = 0; k < 2; ++k) dst[n][k] = *(const LAS bf16x8*)(lds + PG8_SB(b, h) + boff + n * 2048 + k * 1024); } while (0)
#define PG8_MMA(ai, bj, At, Bt) do { __builtin_amdgcn_s_setprio(1); _Pragma("unroll") for (int m = 0; m < 4; ++m) _Pragma("unroll") for (int n = 0; n < 2; ++n) _Pragma("unroll") for (int k = 0; k < 2; ++k) \
        acc[ai][bj][m][n] = __builtin_amdgcn_mfma_f32_16x16x32_bf16(Bt[n][k], At[m][k], acc[ai][bj][m][n], 0, 0, 0); __builtin_amdgcn_s_setprio(0); } while (0)
#define PG8_WAIT_V(n) asm volatile("s_waitcnt vmcnt(" #n ")" ::: "memory")
#define PG8_WAIT_L(n) asm volatile("s_waitcnt lgkmcnt(" #n ")" ::: "memory")
#define PG8_BAR __builtin_amdgcn_s_barrier()
#define PG8_SCHED __builtin_amdgcn_sched_barrier(0)
    Unit cur, nxt; int ui = 0;
    if (!S.next(0, cur)) return;
    f32x4 acc[2][2][4][2];
#pragma unroll
    for (int a = 0; a < 2; ++a)
#pragma unroll
        for (int b = 0; b < 2; ++b)
#pragma unroll
            for (int m = 0; m < 4; ++m)
#pragma unroll
                for (int n = 0; n < 2; ++n) acc[a][b][m][n] = (f32x4){0.f, 0.f, 0.f, 0.f};
    bf16x8 At[4][2], B0[2][2], B1[2][2];
    const char* cA; const char* cB; S.ptrs(cur, cA, cB);
    PG8_STAGE(PG8_SB(0, 0), cB, voffB); PG8_STAGE(PG8_SA(0, 0), cA, voffA); PG8_STAGE(PG8_SB(0, 1), cB + hstepB, voffB); PG8_STAGE(PG8_SA(0, 1), cA + hstepA, voffA);
    if (wr == 1) PG8_BAR;
    PG8_WAIT_V(4); PG8_BAR;
    PG8_STAGE(PG8_SB(1, 0), cB + kstep, voffB); PG8_STAGE(PG8_SA(1, 0), cA + kstep, voffA); PG8_STAGE(PG8_SB(1, 1), cB + hstepB + kstep, voffB);
    PG8_WAIT_V(6); PG8_BAR;
    for (;;) {
        const bool has_next = S.next(ui + 1, nxt);
        const char* nA = cA; const char* nB = cB; if (has_next) S.ptrs(nxt, nA, nB);
        for (int t = 0; t < nt; t += 2) {
            const bool last = (t == nt - 2);
            const char* a1 = cA + (size_t)(t + 1) * kstep;
            const char* a2 = last ? nA : cA + (size_t)(t + 2) * kstep; const char* b2 = last ? nB : cB + (size_t)(t + 2) * kstep;
            const char* a3 = a2 + kstep; const char* b3 = b2 + kstep;
            PG8_LDB(B0, 0, 0); PG8_SCHED; PG8_LDA(At, 0, 0); PG8_STAGE(PG8_SA(1, 1), a1 + hstepA, voffA);
            PG8_WAIT_L(8); PG8_BAR; PG8_WAIT_L(0); PG8_MMA(0, 0, At, B0); PG8_BAR; PG8_SCHED;
            PG8_LDB(B1, 0, 1); PG8_STAGE(PG8_SB(0, 0), b2, voffB);
            PG8_BAR; PG8_WAIT_L(0); PG8_MMA(0, 1, At, B1); PG8_BAR;
            PG8_LDA(At, 0, 1); PG8_STAGE(PG8_SA(0, 0), a2, voffA);
            PG8_BAR; PG8_WAIT_L(0); PG8_MMA(1, 0, At, B0); PG8_BAR; PG8_SCHED;
            PG8_STAGE(PG8_SB(0, 1), b2 + hstepB, voffB);
            PG8_WAIT_V(6); PG8_BAR; PG8_MMA(1, 1, At, B1); PG8_BAR;
            PG8_LDB(B0, 1, 0); PG8_SCHED; PG8_LDA(At, 1, 0); PG8_STAGE(PG8_SA(0, 1), a2 + hstepA, voffA);
            PG8_WAIT_L(8); PG8_BAR; PG8_WAIT_L(0); PG8_MMA(0, 0, At, B0); PG8_BAR; PG8_SCHED;
            PG8_LDB(B1, 1, 1); PG8_STAGE(PG8_SB(1, 0), b3, voffB);
            PG8_BAR; PG8_WAIT_L(0); PG8_MMA(0, 1, At, B1); PG8_BAR;
            PG8_LDA(At, 1, 1); PG8_STAGE(PG8_SA(1, 0), a3, voffA);
            PG8_BAR; PG8_WAIT_L(0); PG8_MMA(1, 0, At, B0); PG8_BAR; PG8_SCHED;
            PG8_STAGE(PG8_SB(1, 1), b3 + hstepB, voffB);
            PG8_WAIT_V(6); PG8_BAR; PG8_MMA(1, 1, At, B1); PG8_BAR;
        }
        { int fr2 = fr, fq2 = fq; asm volatile("" : "+v"(fr2), "+v"(fq2)); E(acc, cur, wr, wc, fr2, fq2); }
        if (!has_next) break;
#pragma unroll
        for (int a = 0; a < 2; ++a)
#pragma unroll
            for (int b = 0; b < 2; ++b)
#pragma unroll
                for (int m = 0; m < 4; ++m)
#pragma unroll
                    for (int n = 0; n < 2; ++n) acc[a][b][m][n] = (f32x4){0.f, 0.f, 0.f, 0.f};
        cur = nxt; cA = nA; cB = nB; ++ui;
    }
    PG8_WAIT_V(0);
    if (wr == 0) PG8_BAR;
    PG8_BAR;
#undef PG8_SA
#undef PG8_SB
#undef PG8_STAGE
#undef PG8_LDA
#undef PG8_LDB
#undef PG8_MMA
#undef PG8_WAIT_V
#undef PG8_WAIT_L
#undef PG8_BAR
#undef PG8_SCHED
}
}
using pg8::Unit;

struct Params {
    const float* in[21];
    float* out;
    unsigned char* ws;
    int ph_lo, ph_hi;
    int use_bar, pad;
};
enum { I_X = 0, I_LN_MIX_E, I_W_IN_E, I_LN_Q, I_W_UQ, I_LN_KV, I_W_UKV, I_B_F, I_W_OUT_E, I_LN_MIX_O, I_W_IN_O, I_W_OUT_O, I_LN_FFN, I_W_RG, I_B_RG, I_W_RE, I_B_RE, I_W_GATE, I_W_UP, I_W_DOWN, I_LN_F };

#define WSP(T_, off) ((T_*)(ws_ + (off)))
typedef const Params __attribute__((address_space(4)))* KParams;
#define P_OPAQUE KParams Pk_ = (KParams)__builtin_amdgcn_kernarg_segment_ptr(); asm volatile("" : "+s"(Pk_)); const Params& P = *(const Params*)Pk_
#define WS_OPAQUE P_OPAQUE; unsigned char* ws_ = P.ws

__device__ __forceinline__ float log2_gamma(int h) { return __builtin_log2f(1.0f - __builtin_exp2f(-5.0f - (float)h)); }

struct DenseSched {
    pg8::DenseOrder O; const char* A; const char* B; size_t astep, bstep;
    __device__ __forceinline__ void init(const void* A_, int lda, const void* B_, int ldb, int nM, int nN, int G, int c) {
        O.init(nM, nN, G, c); A = (const char*)A_; B = (const char*)B_; astep = (size_t)256 * lda * 2; bstep = (size_t)256 * ldb * 2; }
    __device__ __forceinline__ bool next(int i, Unit& u) const { return O.tile(i, u); }
    __device__ __forceinline__ void ptrs(const Unit& u, const char*& a, const char*& b) const { a = A + (size_t)u.pm * astep; b = B + (size_t)u.pn * bstep; }
};
struct MoeSched {
    const char* A; const char* B; const int* tilee; size_t astep, estep, bstep; int ntile, G, c;
    __device__ __forceinline__ void init(const void* A_, int lda, const void* B_, int ldb, size_t expert_rows, const int* tilee_, int G_, int c_) {
        A = (const char*)A_; B = (const char*)B_; tilee = tilee_; astep = (size_t)256 * lda * 2; bstep = (size_t)256 * ldb * 2; estep = expert_rows * ldb * 2; G = G_; c = c_;
        ntile = __builtin_amdgcn_readfirstlane(ld_i(tilee_ + 300)); }
    __device__ __forceinline__ bool next(int i, Unit& u) const { const int L = i * G + c; if (L >= ntile * 4) return false; u.pm = L >> 2; u.pn = L & 3; u.aux = __builtin_amdgcn_readfirstlane(ld_i(tilee + (L >> 2))); return true; }
    __device__ __forceinline__ void ptrs(const Unit& u, const char*& a, const char*& b) const { a = A + (size_t)u.pm * astep; b = B + (size_t)u.aux * estep + (size_t)u.pn * bstep; }
};

typedef const f32x4 (&AccRef)[2][2][4][2];
#define EPI_LOOP_AI_M for (int ai = 0; ai < 2; ++ai) _Pragma("unroll") for (int m = 0; m < 4; ++m)
#define EPI_LOOP_BJ_N for (int bj = 0; bj < 2; ++bj) _Pragma("unroll") for (int n = 0; n < 2; ++n)

struct EpiA1a {
    static constexpr bool PERM = false;
    const float* rs0; bf16_t* Z; float* PQ; float* PKV; bf16_t* KA; float* LF; const float* bf; bf16_t* QF; bf16_t* KF; const f32x2* rope;
    __device__ __forceinline__ void operator()(AccRef acc, const Unit& u, int wr, int wc, int fr, int fq) const {
        const int row0 = u.pm * 256 + wr * 64 + fr; float rsv[2][4];
#pragma unroll
        EPI_LOOP_AI_M rsv[ai][m] = rs0[row0 + ai * 128 + m * 16];
        if (u.pn <= 1) {
            const int zc = u.pn * 256 + wc * 32 + 4 * fq;
#pragma unroll
            EPI_LOOP_AI_M { const int r = row0 + ai * 128 + m * 16; const float rs = rsv[ai][m]; float ss = 0.f; f32x4 v[2][2];
#pragma unroll
                EPI_LOOP_BJ_N { v[bj][n] = acc[ai][bj][m][n] * rs; u32x2 w; w.x = pk2(v[bj][n][0], v[bj][n][1]); w.y = pk2(v[bj][n][2], v[bj][n][3]);
                    *(u32x2*)(Z + (size_t)r * 512 + zc + bj * 128 + n * 16) = w;
                    if (u.pn == 0 || bj == 0) ss += (v[bj][n][0] * v[bj][n][0] + v[bj][n][1] * v[bj][n][1]) + (v[bj][n][2] * v[bj][n][2] + v[bj][n][3] * v[bj][n][3]); }
                ss += __shfl_xor(ss, 16); ss += __shfl_xor(ss, 32);
                if (fq == 0) { if (u.pn == 0) PQ[(size_t)r * 4 + wc] = ss; else PKV[(size_t)r * 4 + wc] = ss; }
                if (u.pn == 1 && wc == 0) {
                    const int pos = r & (S - 1); const f32x4 x1 = v[1][0], x2 = v[1][1]; f32x4 o1, o2;
#pragma unroll
                    for (int j = 0; j < 4; ++j) { const f32x2 cs = rope[(size_t)pos * 128 + 8 * (4 * fq + j)]; o1[j] = x1[j] * cs.x - x2[j] * cs.y; o2[j] = x1[j] * cs.y + x2[j] * cs.x; }
                    u32x2 w1, w2; w1.x = pk2(o1[0], o1[1]); w1.y = pk2(o1[2], o1[3]); w2.x = pk2(o2[0], o2[1]); w2.y = pk2(o2[2], o2[3]);
#pragma unroll
                    for (int hh = 0; hh < 8; ++hh) { bf16_t* kp = KA + (size_t)r * 768 + hh * 96 + 64 + 4 * fq; *(u32x2*)kp = w1; *(u32x2*)(kp + 16) = w2; }
                }
                if (u.pn == 1 && wc == 1 && fq < 2) {
                    const f32x4 f = v[1][0]; f32x4 o;
#pragma unroll
                    for (int j = 0; j < 4; ++j) { const float x = f[j] + bf[4 * fq + j]; o[j] = fminf(x, 0.f) - log1pf(__expf(-fabsf(x))); }
                    *(f32x4*)(LF + (size_t)r * 8 + 4 * fq) = o;
                }
            }
        } else {
            const bool isq = u.pn < 4; bf16_t* dst = isq ? QF : KF; const int cc = (isq ? (u.pn - 2) : (u.pn - 4)) * 256 + wc * 32 + 4 * fq; const float sc = isq ? (0.125f * LOG2E) : 1.0f;
#pragma unroll
            EPI_LOOP_AI_M { const int r = row0 + ai * 128 + m * 16; const float rs = rsv[ai][m] * sc;
#pragma unroll
                EPI_LOOP_BJ_N { const f32x4 v = acc[ai][bj][m][n] * rs; u32x2 w; w.x = pk2(v[0], v[1]); w.y = pk2(v[2], v[3]); *(u32x2*)(dst + (size_t)r * 512 + cc + bj * 128 + n * 16) = w; } }
        }
    }
};
template <int MODE> struct EpiVT {
    static constexpr bool PERM = true;
    const float* rs; bf16_t* OUT; size_t ldo;
    __device__ __forceinline__ float cs(int t) const { if (MODE == 0) return rs[t]; const f32x4 p = *(const f32x4*)(rs + (size_t)t * 4); return rsqrt_f(((p[0] + p[1]) + (p[2] + p[3])) * (1.0f / 128.0f) + EPS); }
    __device__ __forceinline__ void operator()(AccRef acc, const Unit& u, int wr, int wc, int fr, int fq) const {
        const int f0 = u.pm * 256 + wr * 64 + fr, t0 = u.pn * 256 + wc * 32 + 8 * fq;
#pragma unroll
        for (int bj = 0; bj < 2; ++bj) { float c[8];
#pragma unroll
            for (int j = 0; j < 8; ++j) c[j] = cs(t0 + bj * 128 + j);
#pragma unroll
            EPI_LOOP_AI_M { const f32x4 a = acc[ai][bj][m][0], b = acc[ai][bj][m][1]; u32x4 w;
                w.x = pk2(a[0] * c[0], a[1] * c[1]); w.y = pk2(a[2] * c[2], a[3] * c[3]); w.z = pk2(b[0] * c[4], b[1] * c[5]); w.w = pk2(b[2] * c[6], b[3] * c[7]);
                const int f_ = f0 + ai * 128 + m * 16, t_ = t0 + bj * 128;
                *(u32x4*)(OUT + (((size_t)(f_ >> 6) * (T / 64) + (t_ >> 6)) * 64 + (f_ & 63)) * 64 + (t_ & 63)) = w; } }
    }
};
struct EpiA2q {
    static constexpr bool PERM = false;
    const float* PQ; bf16_t* QA; const f32x2* rope;
    __device__ __forceinline__ void operator()(AccRef acc, const Unit& u, int wr, int wc, int fr, int fq) const {
        if (wc == 3) return;
        const int row0 = u.pm * 256 + wr * 64 + fr; const float SCA = 0.10206207261596577f * LOG2E;
        f32x4 pv[2][4];
#pragma unroll
        EPI_LOOP_AI_M pv[ai][m] = *(const f32x4*)(PQ + (size_t)(row0 + ai * 128 + m * 16) * 4);
#pragma unroll
        for (int ai = 0; ai < 2; ++ai) { f32x2 csv[4][4];
            if (wc == 2) {
#pragma unroll
                for (int m = 0; m < 4; ++m)
#pragma unroll
                    for (int j = 0; j < 4; ++j) csv[m][j] = rope[(size_t)((row0 + ai * 128 + m * 16) & (S - 1)) * 128 + 8 * (4 * fq + j)]; }
#pragma unroll
            for (int m = 0; m < 4; ++m) { const int r = row0 + ai * 128 + m * 16; const f32x4 p = pv[ai][m];
                const float rs = rsqrt_f(((p[0] + p[1]) + (p[2] + p[3])) * (1.0f / 256.0f) + EPS) * SCA;
#pragma unroll
                for (int bj = 0; bj < 2; ++bj) { const int hh = 2 * u.pn + bj; bf16_t* qp = QA + (size_t)r * 768 + hh * 96 + wc * 32 + 4 * fq; f32x4 x1 = acc[ai][bj][m][0] * rs, x2 = acc[ai][bj][m][1] * rs;
                    if (wc == 2) {
#pragma unroll
                        for (int j = 0; j < 4; ++j) { const f32x2 cs = csv[m][j]; const float a = x1[j], b = x2[j]; x1[j] = a * cs.x - b * cs.y; x2[j] = a * cs.y + b * cs.x; } }
                    *(u32x2*)qp = (u32x2){pk2(x1[0], x1[1]), pk2(x1[2], x1[3])}; *(u32x2*)(qp + 16) = (u32x2){pk2(x2[0], x2[1]), pk2(x2[2], x2[3])}; } } }
    }
};
struct EpiA2k {
    static constexpr bool PERM = false;
    const float* PKV; bf16_t* KA;
    __device__ __forceinline__ void operator()(AccRef acc, const Unit& u, int wr, int wc, int fr, int fq) const {
        const int row0 = u.pm * 256 + wr * 64 + fr; f32x4 pv[2][4];
#pragma unroll
        EPI_LOOP_AI_M pv[ai][m] = *(const f32x4*)(PKV + (size_t)(row0 + ai * 128 + m * 16) * 4);
#pragma unroll
        EPI_LOOP_AI_M { const int r = row0 + ai * 128 + m * 16; const f32x4 p = pv[ai][m];
            const float rs = rsqrt_f(((p[0] + p[1]) + (p[2] + p[3])) * (1.0f / 128.0f) + EPS);
#pragma unroll
            EPI_LOOP_BJ_N { const int hh = 4 * u.pn + 2 * bj + (wc >> 1), dd = 32 * (wc & 1) + 16 * n + 4 * fq; const f32x4 v = acc[ai][bj][m][n] * rs;
                *(u32x2*)(KA + (size_t)r * 768 + hh * 96 + dd) = (u32x2){pk2(v[0], v[1]), pk2(v[2], v[3])}; } }
    }
};
struct EpiRes {
    static constexpr bool PERM = false;
    const float* base; float* outp;
    __device__ __forceinline__ void operator()(AccRef acc, const Unit& u, int wr, int wc, int fr, int fq) const {
        const int row0 = u.pm * 256 + wr * 64 + fr, col0 = u.pn * 256 + wc * 32 + 4 * fq;
#pragma unroll
        for (int ai = 0; ai < 2; ++ai) { f32x4 b[4][2][2];
#pragma unroll
            for (int m = 0; m < 4; ++m)
#pragma unroll
                EPI_LOOP_BJ_N b[m][bj][n] = *(const f32x4*)(base + (size_t)(row0 + ai * 128 + m * 16) * D + col0 + bj * 128 + n * 16);
#pragma unroll
            for (int m = 0; m < 4; ++m)
#pragma unroll
                EPI_LOOP_BJ_N *(f32x4*)(outp + (size_t)(row0 + ai * 128 + m * 16) * D + col0 + bj * 128 + n * 16) = b[m][bj][n] + acc[ai][bj][m][n]; }
    }
};
struct EpiB1q {
    static constexpr bool PERM = false;
    const float* rs2; bf16_t* QX; const f32x2* rope;
    __device__ __forceinline__ void operator()(AccRef acc, const Unit& u, int wr, int wc, int fr, int fq) const {
        const int row0 = u.pm * 256 + wr * 64 + fr; const float l2g = log2_gamma(u.pn); float rsv[2][4];
#pragma unroll
        EPI_LOOP_AI_M rsv[ai][m] = rs2[row0 + ai * 128 + m * 16];
#pragma unroll
        for (int ai = 0; ai < 2; ++ai)
#pragma unroll
            for (int mp = 0; mp < 2; ++mp) { f32x4 ca[2][2], cb[2][2];
#pragma unroll
                for (int mm = 0; mm < 2; ++mm)
#pragma unroll
                    for (int n = 0; n < 2; ++n) { const int pos = row0 + ai * 128 + (2 * mp + mm) * 16, i0 = wc * 32 + 16 * n + 4 * fq; ca[mm][n] = *(const f32x4*)(rope + (size_t)pos * 128 + i0); cb[mm][n] = *(const f32x4*)(rope + (size_t)pos * 128 + i0 + 2); }
#pragma unroll
                for (int mm = 0; mm < 2; ++mm) { const int m = 2 * mp + mm, pos = row0 + ai * 128 + m * 16; const float rs = rsv[ai][m] * __builtin_exp2f((float)((pos & 63) + 1) * l2g);
#pragma unroll
                    for (int n = 0; n < 2; ++n) { const int i0 = wc * 32 + 16 * n + 4 * fq; const f32x4 x1 = acc[ai][0][m][n] * rs, x2 = acc[ai][1][m][n] * rs; f32x4 o1, o2;
                        const float cc[4] = {ca[mm][n][0], ca[mm][n][2], cb[mm][n][0], cb[mm][n][2]}, sn[4] = {ca[mm][n][1], ca[mm][n][3], cb[mm][n][1], cb[mm][n][3]};
#pragma unroll
                        for (int j = 0; j < 4; ++j) { o1[j] = x1[j] * cc[j] - x2[j] * sn[j]; o2[j] = x1[j] * sn[j] + x2[j] * cc[j]; }
                        bf16_t* qp = QX + (size_t)pos * 1024 + u.pn * 256 + i0; *(u32x2*)qp = (u32x2){pk2(o1[0], o1[1]), pk2(o1[2], o1[3])}; *(u32x2*)(qp + 128) = (u32x2){pk2(o2[0], o2[1]), pk2(o2[2], o2[3])}; } } }
    }
};
__device__ __forceinline__ int rho_of_d(int d) { const int lo = d & 31; return (d & ~31) | (((lo >> 2) & 1) << 4) | ((lo >> 3) << 2) | (lo & 3); }
struct EpiB1k {
    static constexpr bool PERM = true;
    const float* rs2; bf16_t* KN; bf16_t* KZT; const f32x2* rope; LAS unsigned char* scr;
    __device__ __forceinline__ void operator()(AccRef acc, const Unit& u, int wr, int wc, int fr, int fq) const {
        const int h = u.pm, t0 = u.pn * 256 + wc * 32 + 8 * fq; const float l2g = log2_gamma(h);
        LAS unsigned char* my = scr + (wr * 4 + wc) * 1024; const int lane = fq * 16 + fr;
#pragma unroll
        for (int bj = 0; bj < 2; ++bj) { const int tb = t0 + bj * 128; float rs[8], zt[8];
#pragma unroll
            for (int j = 0; j < 8; ++j) { rs[j] = rs2[tb + j] * 0.0625f; zt[j] = __builtin_exp2f((float)(63 - ((tb + j) & 63)) * l2g); }
            const int chunk = tb >> 6, c0 = tb & 63;
            f32x2 csv[4][8];
#pragma unroll
            for (int m = 0; m < 4; ++m)
#pragma unroll
                for (int j = 0; j < 8; ++j) csv[m][j] = rope[(size_t)(tb + j) * 128 + wr * 64 + m * 16 + fr];
#pragma unroll
            for (int m = 0; m < 4; ++m) { const int d = wr * 64 + m * 16 + fr; float k1[8], k2[8];
#pragma unroll
                for (int j = 0; j < 8; ++j) { const f32x2 cs = csv[m][j]; const float x1 = acc[0][bj][m][j >> 2][j & 3] * rs[j], x2 = acc[1][bj][m][j >> 2][j & 3] * rs[j];
                    k1[j] = x1 * cs.x - x2 * cs.y; k2[j] = x1 * cs.y + x2 * cs.x; }
                const int rho = rho_of_d(d); u32x4 w1, w2;
                w1.x = pk2(k1[0] * zt[0], k1[1] * zt[1]); w1.y = pk2(k1[2] * zt[2], k1[3] * zt[3]); w1.z = pk2(k1[4] * zt[4], k1[5] * zt[5]); w1.w = pk2(k1[6] * zt[6], k1[7] * zt[7]);
                w2.x = pk2(k2[0] * zt[0], k2[1] * zt[1]); w2.y = pk2(k2[2] * zt[2], k2[3] * zt[3]); w2.z = pk2(k2[4] * zt[4], k2[5] * zt[5]); w2.w = pk2(k2[6] * zt[6], k2[7] * zt[7]);
                bf16_t* zp = KZT + (((size_t)(h * 256 + chunk) * 256 + rho) * 64 + c0); *(u32x4*)zp = w1; *(u32x4*)(zp + 128 * 64) = w2;
#pragma unroll
                for (int half = 0; half < 2; ++half) { const float* kk = half ? k2 : k1;
#pragma unroll
                    for (int j = 0; j < 8; ++j) *(LAS bf16_t*)(my + (8 * fq + j) * 32 + fr * 2) = (bf16_t)f2bf(kk[j]);
                    asm volatile("s_waitcnt lgkmcnt(0)" ::: "memory");
                    const u32x4 v = *(const LAS u32x4*)(my + (lane >> 1) * 32 + (lane & 1) * 16);
                    const int tok = u.pn * 256 + wc * 32 + bj * 128 + (lane >> 1);
                    *(u32x4*)(KN + (size_t)tok * 1024 + h * 256 + half * 128 + wr * 64 + m * 16 + (lane & 1) * 8) = v;
                    asm volatile("s_waitcnt lgkmcnt(0)" ::: "memory"); } } }
    }
};
struct EpiB1v {
    static constexpr bool PERM = true;
    const float* rs2; bf16_t* VT;
    __device__ __forceinline__ void operator()(AccRef acc, const Unit& u, int wr, int wc, int fr, int fq) const {
        const int h = u.pm >> 1, e0 = (u.pm & 1) * 256 + wr * 64 + fr, t0 = u.pn * 256 + wc * 32 + 8 * fq;
#pragma unroll
        for (int bj = 0; bj < 2; ++bj) { const int tb = t0 + bj * 128; float c[8];
#pragma unroll
            for (int j = 0; j < 8; ++j) c[j] = rs2[tb + j];
            const int chunk = tb >> 6, c0 = tb & 63;
#pragma unroll
            EPI_LOOP_AI_M { const f32x4 a = acc[ai][bj][m][0], b = acc[ai][bj][m][1]; u32x4 w;
                w.x = pk2(a[0] * c[0], a[1] * c[1]); w.y = pk2(a[2] * c[2], a[3] * c[3]); w.z = pk2(b[0] * c[4], b[1] * c[5]); w.w = pk2(b[2] * c[6], b[3] * c[7]);
                *(u32x4*)(VT + (((size_t)(h * 256 + chunk) * 512 + e0 + ai * 128 + m * 16) * 64 + c0)) = w; } }
    }
};
struct EpiG {
    static constexpr bool PERM = true;
    const float* rs2; const float* PO; bf16_t* O;
    __device__ __forceinline__ void operator()(AccRef acc, const Unit& u, int wr, int wc, int fr, int fq) const {
        const int row0 = u.pm * 256 + wr * 64 + fr, col0 = u.pn * 256 + wc * 32 + 8 * fq, head = u.pn >> 1;
        f32x4 pv[2][4]; float rsv[2][4];
#pragma unroll
        EPI_LOOP_AI_M { const int r = row0 + ai * 128 + m * 16; pv[ai][m] = *(const f32x4*)(PO + (size_t)r * 16 + head * 4); rsv[ai][m] = rs2[r]; }
#pragma unroll
        for (int ai = 0; ai < 2; ++ai) { u32x4 ov[4][2];
#pragma unroll
            for (int m = 0; m < 4; ++m)
#pragma unroll
                for (int bj = 0; bj < 2; ++bj) ov[m][bj] = *(const u32x4*)(O + (size_t)(row0 + ai * 128 + m * 16) * 2048 + col0 + bj * 128);
#pragma unroll
            for (int m = 0; m < 4; ++m) { const f32x4 p = pv[ai][m]; const float ro = rsqrt_f(((p[0] + p[1]) + (p[2] + p[3])) * (1.0f / 512.0f) + EPS), rs = rsv[ai][m];
#pragma unroll
                for (int bj = 0; bj < 2; ++bj) { const u32x4 o4 = ov[m][bj]; const float o[8] = {bflo(o4.x), bfhi(o4.x), bflo(o4.y), bfhi(o4.y), bflo(o4.z), bfhi(o4.z), bflo(o4.w), bfhi(o4.w)}; float a[8];
#pragma unroll
                    for (int j = 0; j < 8; ++j) { const float g = acc[ai][bj][m][j >> 2][j & 3] * rs; a[j] = o[j] * ro * g / (1.0f + __expf(-g)); }
                    *(u32x4*)(O + (size_t)(row0 + ai * 128 + m * 16) * 2048 + col0 + bj * 128) = (u32x4){pk2(a[0], a[1]), pk2(a[2], a[3]), pk2(a[4], a[5]), pk2(a[6], a[7])}; } } }
    }
};
struct EpiM3 {
    static constexpr bool PERM = true;
    const float* SR; bf16_t* HID;
    __device__ __forceinline__ void operator()(AccRef acc, const Unit& u, int wr, int wc, int fr, int fq) const {
        const int row0 = u.pm * 256 + wr * 64 + fr, col0 = u.pn * 128 + wc * 32 + 8 * fq; float rsv[2][4];
#pragma unroll
        EPI_LOOP_AI_M rsv[ai][m] = SR[row0 + ai * 128 + m * 16];
#pragma unroll
        EPI_LOOP_AI_M { const int r = row0 + ai * 128 + m * 16; const float rs = rsv[ai][m]; float hh[8];
#pragma unroll
            for (int j = 0; j < 8; ++j) { const float g = acc[ai][0][m][j >> 2][j & 3] * rs, up = acc[ai][1][m][j >> 2][j & 3] * rs; hh[j] = g / (1.0f + __expf(-g)) * up; }
            u32x4 w; w.x = pk2(hh[0], hh[1]); w.y = pk2(hh[2], hh[3]); w.z = pk2(hh[4], hh[5]); w.w = pk2(hh[6], hh[7]); *(u32x4*)(HID + (size_t)r * 512 + col0) = w; }
    }
};
struct EpiM4 {
    static constexpr bool PERM = true;
    const float* SW; bf16_t* YS;
    __device__ __forceinline__ void operator()(AccRef acc, const Unit& u, int wr, int wc, int fr, int fq) const {
        const int row0 = u.pm * 256 + wr * 64 + fr, col0 = u.pn * 256 + wc * 32 + 8 * fq; float swv[2][4];
#pragma unroll
        EPI_LOOP_AI_M swv[ai][m] = SW[row0 + ai * 128 + m * 16];
#pragma unroll
        EPI_LOOP_AI_M { const int r = row0 + ai * 128 + m * 16; const float sw = swv[ai][m];
#pragma unroll
            for (int bj = 0; bj < 2; ++bj) { const f32x4 a = acc[ai][bj][m][0] * sw, b = acc[ai][bj][m][1] * sw; u32x4 w; w.x = pk2(a[0], a[1]); w.y = pk2(a[2], a[3]); w.z = pk2(b[0], b[1]); w.w = pk2(b[2], b[3]);
                *(u32x4*)(YS + (size_t)r * 1024 + col0 + bj * 128) = w; } }
    }
};

__device__ __forceinline__ int crow(int r, int hi) { return (r & 3) + 8 * (r >> 2) + 4 * hi; }
template <int DQK, bool FOX>
__device__ __forceinline__ void attn_unit(int wave_, LAS unsigned char* L, const bf16_t* Qb, int ldq, const bf16_t* Kb, int ldk, const bf16_t* Vtb, const float* cum, const float* knrm, bf16_t* Ob, int ldo, int qb) {
    constexpr int KP = DQK + 8, KBYTES = 64 * KP * 2, VBYTES = 64 * 136, BUF = KBYTES + VBYTES + 256, NS = DQK / 16, KCH = DQK / 8;
    constexpr int XOFF = 2 * BUF;
    constexpr float THR = 8.0f;
    const int tid = wave_ * 64 + lane_id_opaque();
    const int lane = tid & 63, w = wave_, r32 = lane & 31, hi = lane >> 5;
    const int R0 = 256 * qb + 32 * w, q = R0 + r32, NT = 4 * qb + 4, jmax = 4 * qb + (w >> 1);
    bf16x8 qf[NS];
#pragma unroll
    for (int s = 0; s < NS; ++s) qf[s] = *(const bf16x8*)(Qb + (size_t)q * ldq + 16 * s + 8 * hi);
    const float cq = FOX ? cum[q] : 0.f;
    int j0 = 0;
    if (FOX) {
        float n2 = 0.f;
#pragma unroll
        for (int s = 0; s < NS; ++s)
#pragma unroll
            for (int e = 0; e < 8; ++e) { const float x = bf2f((unsigned short)qf[s][e]); n2 += x * x; }
        n2 += __shfl_xor(n2, 32);
#pragma unroll
        for (int o = 1; o < 32; o <<= 1) n2 = fmaxf(n2, __shfl_xor(n2, o));
        LAS float* xs = (LAS float*)(L + XOFF); LAS int* xj = (LAS int*)(L + XOFF + 32);
        if (lane == 0) xs[w] = n2;
        if (tid == 0) xj[0] = 4 * qb;
        __syncthreads();
        float qn = xs[0];
#pragma unroll
        for (int i = 1; i < 8; ++i) qn = fmaxf(qn, xs[i]);
        qn = sqrtf(qn) * 1.01f;
        if (tid < NT) { const float bound = qn * knrm[tid] * 1.01f + cum[256 * qb] - cum[64 * tid + 63]; if (bound >= -160.0f) atomicMin((int*)xj, tid); }
        __syncthreads();
        j0 = xj[0];
    }
    f32x16 o0 = {}, o1 = {}; float mhat = 0.f, lrun = 0.f;
    const int kr0 = tid / KCH, kc0 = tid % KCH, kr1 = (tid + 512) / KCH, kc1 = (tid + 512) % KCH; const bool has1 = (tid + 512) < 64 * KCH;
    const int ve = tid >> 3, vc = tid & 7;
    u32x4 kreg0A, kreg1A = {}, vregA, kreg0B, kreg1B = {}, vregB; float ckregA = 0.f, ckregB = 0.f;
    const int kr1c = has1 ? kr1 : kr0, kc1c = has1 ? kc1 : kc0; const int ckl = tid & 63;
#define ATT_LOADK(j, X) do { const int j_ = (j) < NT ? (j) : NT - 1; kreg0##X = *(const u32x4*)(Kb + (size_t)(64 * j_ + kr0) * ldk + kc0 * 8); if (DQK > 64) kreg1##X = *(const u32x4*)(Kb + (size_t)(64 * j_ + kr1c) * ldk + kc1c * 8); \
        if (FOX) ckreg##X = cum[64 * j_ + ckl]; } while (0)
#define ATT_LOADV(j, X) do { const int j_ = (j) < NT ? (j) : NT - 1; vreg##X = *(const u32x4*)(Vtb + (size_t)j_ * 4096 + ve * 64 + vc * 8); } while (0)
#define ATT_WRITEK(bo, X) do { *(LAS u32x4*)(L + (bo) + kr0 * (KP * 2) + kc0 * 16) = kreg0##X; if (DQK > 64) { if (has1) *(LAS u32x4*)(L + (bo) + kr1 * (KP * 2) + kc1 * 16) = kreg1##X; } \
        if (FOX && tid < 64) *(LAS float*)(L + (bo) + KBYTES + VBYTES + tid * 4) = ckreg##X; } while (0)
#define ATT_WRITEV(bo, X) do { *(LAS u32x2*)(L + (bo) + KBYTES + ve * 136 + vc * 16) = (u32x2){vreg##X.x, vreg##X.y}; *(LAS u32x2*)(L + (bo) + KBYTES + ve * 136 + vc * 16 + 8) = (u32x2){vreg##X.z, vreg##X.w}; } while (0)
    bf16x8 kf[2 * NS]; f32x4 ckv[8];
#define ATT_QK_ISSUE(bo) do { \
        _Pragma("unroll") for (int s = 0; s < NS; ++s) { kf[2 * s] = *(const LAS bf16x8*)(L + (bo) + r32 * (KP * 2) + (16 * s + 8 * hi) * 2); kf[2 * s + 1] = *(const LAS bf16x8*)(L + (bo) + (32 + r32) * (KP * 2) + (16 * s + 8 * hi) * 2); } \
        if (FOX) { _Pragma("unroll") for (int g = 0; g < 4; ++g) { ckv[g] = *(const LAS f32x4*)(L + (bo) + KBYTES + VBYTES + (8 * g + 4 * hi) * 4); ckv[4 + g] = *(const LAS f32x4*)(L + (bo) + KBYTES + VBYTES + (32 + 8 * g + 4 * hi) * 4); } } \
        __builtin_amdgcn_sched_barrier(0); } while (0)
#define ATT_QK_MMA(S0, S1) do { \
        asm volatile("s_waitcnt lgkmcnt(0)" ::: "memory"); __builtin_amdgcn_sched_barrier(0); \
        if (FOX) { const float cqm = cq - mhat; \
            _Pragma("unroll") for (int g = 0; g < 4; ++g) { _Pragma("unroll") for (int e = 0; e < 4; ++e) { S0[4 * g + e] = cqm - ckv[g][e]; S1[4 * g + e] = cqm - ckv[4 + g][e]; } } \
        } else { _Pragma("unroll") for (int r = 0; r < 16; ++r) { S0[r] = -mhat; S1[r] = -mhat; } } \
        _Pragma("unroll") for (int s = 0; s < NS; ++s) { S0 = __builtin_amdgcn_mfma_f32_32x32x16_bf16(kf[2 * s], qf[s], S0, 0, 0, 0); S1 = __builtin_amdgcn_mfma_f32_32x32x16_bf16(kf[2 * s + 1], qf[s], S1, 0, 0, 0); } } while (0)
#define ATT_QK(S0, S1, bo) do { ATT_QK_ISSUE(bo); ATT_QK_MMA(S0, S1); } while (0)
#define ATT_MASK(S0, S1, j) do { _Pragma("unroll") for (int r = 0; r < 16; ++r) { const int kg = 64 * (j) + crow(r, hi); if (kg > q) S0[r] = -1e30f; if (kg + 32 > q) S1[r] = -1e30f; } } while (0)
#define ATT_ROWMAX(S0, S1, out) do { float mx_ = fmaxf(fmaxf(S0[0], S1[0]), fmaxf(S0[1], S1[1])); \
        _Pragma("unroll") for (int r = 2; r < 16; r += 2) mx_ = fmaxf(mx_, fmaxf(fmaxf(S0[r], S1[r]), fmaxf(S0[r + 1], S1[r + 1]))); \
        out = fmaxf(mx_, __shfl_xor(mx_, 32)); } while (0)
#define ATT_SOFTMAX(S0, S1) do { float ls0 = 0.f, ls1 = 0.f; \
        _Pragma("unroll") for (int r = 0; r < 16; ++r) { S0[r] = __builtin_amdgcn_exp2f(S0[r]); S1[r] = __builtin_amdgcn_exp2f(S1[r]); ls0 += S0[r]; ls1 += S1[r]; } \
        lrun += ls0 + ls1; \
        _Pragma("unroll") for (int ks = 0; ks < 4; ++ks) { const int b_ = 8 * (ks & 1); \
            if (ks < 2) pw[ks] = (u32x4){pk2(S0[b_], S0[b_ + 1]), pk2(S0[b_ + 2], S0[b_ + 3]), pk2(S0[b_ + 4], S0[b_ + 5]), pk2(S0[b_ + 6], S0[b_ + 7])}; \
            else        pw[ks] = (u32x4){pk2(S1[b_], S1[b_ + 1]), pk2(S1[b_ + 2], S1[b_ + 3]), pk2(S1[b_ + 4], S1[b_ + 5]), pk2(S1[b_ + 6], S1[b_ + 7])}; } } while (0)
    u32x2 vfr[16];
#define ATT_PV_ISSUE(bo) do { _Pragma("unroll") for (int ks = 0; ks < 4; ++ks) { const LAS unsigned char* vb = L + (bo) + KBYTES + r32 * 136 + 32 * ks + 8 * hi; \
            vfr[4 * ks] = *(const LAS u32x2*)(vb); vfr[4 * ks + 1] = *(const LAS u32x2*)(vb + 16); vfr[4 * ks + 2] = *(const LAS u32x2*)(vb + 32 * 136); vfr[4 * ks + 3] = *(const LAS u32x2*)(vb + 32 * 136 + 16); } \
        __builtin_amdgcn_sched_barrier(0); } while (0)
#define ATT_PV_MMA() do { asm volatile("s_waitcnt lgkmcnt(0)" ::: "memory"); __builtin_amdgcn_sched_barrier(0); \
        _Pragma("unroll") for (int ks = 0; ks < 4; ++ks) { \
            const bf16x8 va = __builtin_bit_cast(bf16x8, (u32x4){vfr[4 * ks].x, vfr[4 * ks].y, vfr[4 * ks + 1].x, vfr[4 * ks + 1].y}), vbb = __builtin_bit_cast(bf16x8, (u32x4){vfr[4 * ks + 2].x, vfr[4 * ks + 2].y, vfr[4 * ks + 3].x, vfr[4 * ks + 3].y}), pf = __builtin_bit_cast(bf16x8, pw[ks]); \
            o0 = __builtin_amdgcn_mfma_f32_32x32x16_bf16(va, pf, o0, 0, 0, 0); o1 = __builtin_amdgcn_mfma_f32_32x32x16_bf16(vbb, pf, o1, 0, 0, 0); } } while (0)
    ATT_LOADK(j0, A); ATT_LOADV(j0, A); ATT_WRITEK((j0 & 1) * BUF, A); ATT_WRITEV((j0 & 1) * BUF, A);
    if (j0 + 1 < NT) { ATT_LOADK(j0 + 1, B); ATT_WRITEK(((j0 + 1) & 1) * BUF, B); }
    ATT_LOADK(j0 + 2, A);
    ATT_LOADV(j0 + 1, A);
    __syncthreads();
    f32x16 sc0, sc1; float rm = -1e30f; u32x4 pw[4];
    if (j0 <= jmax) { ATT_QK(sc0, sc1, (j0 & 1) * BUF); if (FOX && j0 == jmax) ATT_MASK(sc0, sc1, j0); ATT_ROWMAX(sc0, sc1, rm); }
    __syncthreads();
#define ATT_ITER(t, LW, LL) do { \
        const int bo = ((t) & 1) * BUF, bn = (((t) + 1) & 1) * BUF; \
        ATT_LOADK((t) + 3, LL); \
        ATT_LOADV((t) + 2, LL); \
        if ((t) <= jmax) { \
            if (__any(rm > THR)) { const float dl = fmaxf(rm, 0.f), f = __builtin_amdgcn_exp2f(-dl); mhat += dl; lrun *= f; \
                _Pragma("unroll") for (int r = 0; r < 16; ++r) { sc0[r] -= dl; sc1[r] -= dl; o0[r] *= f; o1[r] *= f; } } \
            if ((t) < jmax) { \
                f32x16 sn0, sn1; \
                ATT_QK_ISSUE(bn);                  \
                ATT_SOFTMAX(sc0, sc1);             \
                ATT_QK_MMA(sn0, sn1); \
                ATT_PV_ISSUE(bo);                  \
                ATT_PV_MMA(); \
                if (FOX && (t) + 1 == jmax) ATT_MASK(sn0, sn1, (t) + 1); \
                ATT_ROWMAX(sn0, sn1, rm); \
                sc0 = sn0; sc1 = sn1; \
            } else { ATT_PV_ISSUE(bo); ATT_SOFTMAX(sc0, sc1); ATT_PV_MMA(); } \
        } \
        if ((t) + 2 < NT) ATT_WRITEK(bo, LW); \
        if ((t) + 1 < NT) ATT_WRITEV(bn, LW); \
        __syncthreads(); } while (0)
    for (int t = j0; t < NT; t += 2) { ATT_ITER(t, A, B); if (t + 1 < NT) ATT_ITER(t + 1, B, A); }
#undef ATT_ITER
#undef ATT_LOADK
#undef ATT_LOADV
#undef ATT_WRITEK
#undef ATT_WRITEV
#undef ATT_QK
#undef ATT_MASK
#undef ATT_ROWMAX
#undef ATT_SOFTMAX
#undef ATT_PV_ISSUE
#undef ATT_PV_MMA
#undef ATT_QK_ISSUE
#undef ATT_QK_MMA
    const float inv = 1.0f / (lrun + __shfl_xor(lrun, 32));
    bf16_t* op = Ob + (size_t)q * ldo + 4 * hi;
#pragma unroll
    for (int g = 0; g < 4; ++g) { u32x2 w0, w1; w0.x = pk2(o0[4 * g] * inv, o0[4 * g + 1] * inv); w0.y = pk2(o0[4 * g + 2] * inv, o0[4 * g + 3] * inv);
        w1.x = pk2(o1[4 * g] * inv, o1[4 * g + 1] * inv); w1.y = pk2(o1[4 * g + 2] * inv, o1[4 * g + 3] * inv);
        *(u32x2*)(op + 8 * g) = w0; *(u32x2*)(op + 32 + 8 * g) = w1; }
}
__device__ __forceinline__ void fox_knorm(int gw, int ngw, int lane, const bf16_t* KF, float* KNRM) {
    for (int it = gw; it < 16 * 256; it += ngw) { const int bh = it >> 8, j = it & 255, b = bh >> 3, h = bh & 7;
        const u32x4* kp = (const u32x4*)(KF + ((size_t)b * S + 64 * j + lane) * 512 + h * 64); float n2 = 0.f;
#pragma unroll
        for (int c = 0; c < 8; ++c) { const u32x4 v = kp[c]; const unsigned ww[4] = {v.x, v.y, v.z, v.w};
#pragma unroll
            for (int e = 0; e < 4; ++e) { const float a = bflo(ww[e]), bb = bfhi(ww[e]); n2 += a * a + bb * bb; } }
#pragma unroll
        for (int o = 1; o < 64; o <<= 1) n2 = fmaxf(n2, __shfl_xor(n2, o));
        if (lane == 0) KNRM[it] = sqrtf(n2); }
}

constexpr int RT_KZP = 144;
constexpr int RT_QP = 528;
constexpr int RT_OFF_KZ = 0, RT_OFF_Q = 256 * RT_KZP, RT_OFF_K = RT_OFF_Q + 64 * RT_QP, RT_OFF_P = RT_OFF_K + 64 * RT_QP, RT_OFF_SS = RT_OFF_P + 64 * RT_KZP, RT_OFF_OT = RT_OFF_SS + 64 * 8 * 4, RT_LDS = RT_OFF_OT + 64 * 272;
static_assert(RT_LDS <= 147456 - 256, "retention LDS");

__device__ __forceinline__ void ret_local(int wave_, LAS unsigned char* L, const bf16_t* KZT, const bf16_t* VT, f32x4* Lout, int u) {
    const int tid = wave_ * 64 + lane_id_opaque();
    const int lane = tid & 63, w = __builtin_amdgcn_readfirstlane(tid >> 6), l15 = lane & 15, g = lane >> 4;
    const int h = u >> 6, seg = (u >> 2) & 15, eb = u & 3, E0 = eb * 128 + w * 16;
    const float gc = __builtin_exp2f(64.0f * log2_gamma(h));
    f32x4 st[16];
#pragma unroll
    for (int i = 0; i < 16; ++i) st[i] = (f32x4){0.f, 0.f, 0.f, 0.f};
    u32x4 kz[4];
    const bf16_t* kzb = KZT + (size_t)(h * 256 + seg * SEGC) * 256 * 64;
#define R1_LOAD(ci) do { _Pragma("unroll") for (int i = 0; i < 4; ++i) kz[i] = *(const u32x4*)(kzb + (size_t)(ci) * 16384 + (size_t)(tid + 512 * i) * 8); } while (0)
#define R1_WRITE() do { _Pragma("unroll") for (int i = 0; i < 4; ++i) { const int id = tid + 512 * i; *(LAS u32x4*)(L + RT_OFF_KZ + (id >> 3) * RT_KZP + (id & 7) * 16) = kz[i]; } } while (0)
    R1_LOAD(0);
    for (int ci = 0; ci < SEGC; ++ci) {
        R1_WRITE(); __syncthreads();
        if (ci + 1 < SEGC) R1_LOAD(ci + 1);
        const bf16_t* vp = VT + ((size_t)(h * 256 + seg * SEGC + ci) * 512 + E0 + l15) * 64 + 8 * g;
        const bf16x8 vf0 = *(const bf16x8*)vp, vf1 = *(const bf16x8*)(vp + 32);
        if (ci > 0) {
#pragma unroll
            for (int i = 0; i < 16; ++i) st[i] *= gc; }
#pragma unroll
        for (int dt = 0; dt < 16; ++dt) { const LAS unsigned char* ap = L + RT_OFF_KZ + (16 * dt + l15) * RT_KZP + 16 * g;
            st[dt] = __builtin_amdgcn_mfma_f32_16x16x32_bf16(*(const LAS bf16x8*)ap, vf0, st[dt], 0, 0, 0);
            st[dt] = __builtin_amdgcn_mfma_f32_16x16x32_bf16(*(const LAS bf16x8*)(ap + 64), vf1, st[dt], 0, 0, 0); }
        __syncthreads();
    }
#undef R1_LOAD
#undef R1_WRITE
    f32x4* lo = Lout + ((size_t)(u * 8 + w) * 16) * 64 + lane;
#pragma unroll
    for (int dt = 0; dt < 16; ++dt) lo[dt * 64] = st[dt];
}

__device__ __forceinline__ void ret_scan(int wave_, LAS unsigned char* L, const bf16_t* QX, const bf16_t* KN, const bf16_t* KZT, const bf16_t* VT, const f32x4* Lin, bf16_t* O  , float* PO  , int u) {
    const int tid = wave_ * 64 + lane_id_opaque();
    const int lane = tid & 63, w = __builtin_amdgcn_readfirstlane(tid >> 6), l15 = lane & 15, g = lane >> 4;
    const int h = u >> 6, seg = (u >> 2) & 15, eb = u & 3, E0 = eb * 128 + w * 16;
    const float l2g = log2_gamma(h), gc = __builtin_exp2f(64.0f * l2g);
    f32x4 st[16];
#pragma unroll
    for (int i = 0; i < 16; ++i) st[i] = (f32x4){0.f, 0.f, 0.f, 0.f};
    for (int j = 0; j < seg; ++j) { const float wj = __builtin_exp2f((float)(64 * SEGC * (seg - 1 - j)) * l2g); const int uj = (u & ~(15 << 2)) | (j << 2);
        const f32x4* li = Lin + ((size_t)(uj * 8 + w) * 16) * 64 + lane;
#pragma unroll
        for (int dt = 0; dt < 16; ++dt) st[dt] += li[dt * 64] * wj; }
    u32x4 kz[4], qx[4], kn[4];
    const bf16_t* kzb = KZT + (size_t)(h * 256 + seg * SEGC) * 256 * 64;
    const bf16_t* qb = QX + (size_t)(seg * SEGC * 64) * 1024 + h * 256; const bf16_t* kb = KN + (size_t)(seg * SEGC * 64) * 1024 + h * 256;
#define R2_LOADKZ(ci) do { _Pragma("unroll") for (int i = 0; i < 4; ++i) { const int id = tid + 512 * i; kz[i] = *(const u32x4*)(kzb + (size_t)(ci) * 16384 + (size_t)id * 8); } } while (0)
#define R2_LOADQK(ci) do { _Pragma("unroll") for (int i = 0; i < 4; ++i) { const int id = tid + 512 * i; \
        qx[i] = *(const u32x4*)(qb + (size_t)((ci) * 64 + (id >> 5)) * 1024 + (id & 31) * 8); kn[i] = *(const u32x4*)(kb + (size_t)((ci) * 64 + (id >> 5)) * 1024 + (id & 31) * 8); } } while (0)
#define R2_WRITE() do { _Pragma("unroll") for (int i = 0; i < 4; ++i) { const int id = tid + 512 * i; *(LAS u32x4*)(L + RT_OFF_KZ + (id >> 3) * RT_KZP + (id & 7) * 16) = kz[i]; \
        *(LAS u32x4*)(L + RT_OFF_Q + (id >> 5) * RT_QP + (id & 31) * 16) = qx[i]; *(LAS u32x4*)(L + RT_OFF_K + (id >> 5) * RT_QP + (id & 31) * 16) = kn[i]; } } while (0)
    R2_LOADKZ(0); R2_LOADQK(0);
    const int tr = w >> 1;
    const bf16_t* vp0 = VT + ((size_t)(h * 256 + seg * SEGC) * 512 + E0 + l15) * 64 + 8 * g;
    bf16x8 vn0 = *(const bf16x8*)vp0, vn1 = *(const bf16x8*)(vp0 + 32);
    for (int ci = 0; ci < SEGC; ++ci) {
        R2_WRITE(); __syncthreads();
        const bf16x8 vf0 = vn0, vf1 = vn1;
        if (ci + 1 < SEGC) { R2_LOADKZ(ci + 1); R2_LOADQK(ci + 1); vn0 = *(const bf16x8*)(vp0 + (size_t)(ci + 1) * 32768); vn1 = *(const bf16x8*)(vp0 + (size_t)(ci + 1) * 32768 + 32); }
        const int chunk = seg * SEGC + ci;
#pragma unroll
        for (int t2 = 0; t2 < 2; ++t2) { const int tc = 2 * (w & 1) + t2; f32x4 pa = {0.f, 0.f, 0.f, 0.f};
            if (tc <= tr) {
#pragma unroll
                for (int ks = 0; ks < 8; ++ks) pa = __builtin_amdgcn_mfma_f32_16x16x32_bf16(*(const LAS bf16x8*)(L + RT_OFF_Q + (16 * tr + l15) * RT_QP + 64 * ks + 16 * g),
                                                                                           *(const LAS bf16x8*)(L + RT_OFF_K + (16 * tc + l15) * RT_QP + 64 * ks + 16 * g), pa, 0, 0, 0);
                const int cp = 16 * tc + l15; const float dk = __builtin_exp2f(-(float)(cp + 1) * l2g);
#pragma unroll
                for (int r = 0; r < 4; ++r) { const int c = 16 * tr + 4 * g + r; pa[r] = (c >= cp) ? pa[r] * dk : 0.f; } }
#pragma unroll
            for (int r = 0; r < 4; ++r) *(LAS bf16_t*)(L + RT_OFF_P + (16 * tr + 4 * g + r) * RT_KZP + (16 * tc + l15) * 2) = (bf16_t)f2bf(pa[r]); }
        __syncthreads();
        f32x4 oa[4];
#pragma unroll
        for (int mt = 0; mt < 4; ++mt) oa[mt] = (f32x4){0.f, 0.f, 0.f, 0.f};
#pragma unroll
        for (int ks = 0; ks < 8; ++ks) { const bf16x8 sbk = __builtin_bit_cast(bf16x8, (u32x4){pk2(st[2 * ks][0], st[2 * ks][1]), pk2(st[2 * ks][2], st[2 * ks][3]), pk2(st[2 * ks + 1][0], st[2 * ks + 1][1]), pk2(st[2 * ks + 1][2], st[2 * ks + 1][3])});
#pragma unroll
            for (int mt = 0; mt < 4; ++mt) oa[mt] = __builtin_amdgcn_mfma_f32_16x16x32_bf16(*(const LAS bf16x8*)(L + RT_OFF_Q + (16 * mt + l15) * RT_QP + 64 * ks + 16 * g), sbk, oa[mt], 0, 0, 0); }
#pragma unroll
        for (int mt = 0; mt < 4; ++mt) {
            oa[mt] = __builtin_amdgcn_mfma_f32_16x16x32_bf16(*(const LAS bf16x8*)(L + RT_OFF_P + (16 * mt + l15) * RT_KZP + 16 * g), vf0, oa[mt], 0, 0, 0);
            oa[mt] = __builtin_amdgcn_mfma_f32_16x16x32_bf16(*(const LAS bf16x8*)(L + RT_OFF_P + (16 * mt + l15) * RT_KZP + 64 + 16 * g), vf1, oa[mt], 0, 0, 0); }
#pragma unroll
        for (int i = 0; i < 16; ++i) st[i] *= gc;
#pragma unroll
        for (int dt = 0; dt < 16; ++dt) { const LAS unsigned char* ap = L + RT_OFF_KZ + (16 * dt + l15) * RT_KZP + 16 * g;
            st[dt] = __builtin_amdgcn_mfma_f32_16x16x32_bf16(*(const LAS bf16x8*)ap, vf0, st[dt], 0, 0, 0);
            st[dt] = __builtin_amdgcn_mfma_f32_16x16x32_bf16(*(const LAS bf16x8*)(ap + 64), vf1, st[dt], 0, 0, 0); }
#pragma unroll
        for (int mt = 0; mt < 4; ++mt) {
#pragma unroll
            for (int r = 0; r < 4; ++r) { const int c = 16 * mt + 4 * g + r; *(LAS bf16_t*)(L + RT_OFF_OT + c * 272 + (16 * w + l15) * 2) = (bf16_t)f2bf(oa[mt][r]);
                float ss = oa[mt][r] * oa[mt][r]; ss += __shfl_xor(ss, 1); ss += __shfl_xor(ss, 2); ss += __shfl_xor(ss, 4); ss += __shfl_xor(ss, 8);
                if (l15 == 0) *(LAS float*)(L + RT_OFF_SS + (c * 8 + w) * 4) = ss; } }
        __syncthreads();
        if (tid < 64) { const LAS float* sp = (const LAS float*)(L + RT_OFF_SS + tid * 32); float s = 0.f;
#pragma unroll
            for (int i = 0; i < 8; ++i) s += sp[i];
            PO[(size_t)(chunk * 64 + tid) * 16 + h * 4 + eb] = s; }
#pragma unroll
        for (int i = 0; i < 2; ++i) { const int id = tid + 512 * i, row = id >> 4, ch = id & 15;
            *(u32x4*)(O + (size_t)(chunk * 64 + row) * 2048 + h * 512 + eb * 128 + ch * 8) = *(const LAS u32x4*)(L + RT_OFF_OT + row * 272 + ch * 16); }
    }
#undef R2_LOADKZ
#undef R2_LOADQK
#undef R2_WRITE
}

struct Ctx { int wave, vcu, G, gw, ngw; LAS unsigned char* lds; };
#define CTX_LANE const int lane_ = lane_id_opaque(), tid_ = C.wave * 64 + lane_

__device__ __forceinline__ void tr_item(const float* W, int ldw, int k0, int n0, int nvalid, const float* gain, bf16_t* dst, int ldd, LAS float* scr, int lane) {
#pragma unroll 8
    for (int i = 0; i < 32; ++i) { const int kk = 2 * i + (lane >> 5), nn = lane & 31; float v = (nn < nvalid) ? W[(size_t)(k0 + kk) * ldw + n0 + nn] : 0.f; if (gain) v *= gain[k0 + kk]; scr[kk * 33 + nn] = v; }
    asm volatile("s_waitcnt lgkmcnt(0)" ::: "memory");
    const int c = lane & 7;
#pragma unroll
    for (int j = 0; j < 4; ++j) { const int n = (lane >> 3) + 8 * j; const LAS float* s = scr + (8 * c) * 33 + n;
        u32x4 o; o.x = pk2(s[0], s[33]); o.y = pk2(s[2 * 33], s[3 * 33]); o.z = pk2(s[4 * 33], s[5 * 33]); o.w = pk2(s[6 * 33], s[7 * 33]);
        if (n < nvalid) *(u32x4*)(dst + (size_t)n * ldd + 8 * c) = o; }
    asm volatile("s_waitcnt lgkmcnt(0)" ::: "memory");
}
__device__ __forceinline__ void zero_rows(const Ctx& C, bf16_t* base, size_t pitch_el, int nrows, int col0, int ncol) {
    CTX_LANE;
    const int per = ncol / 8; const long n = (long)nrows * per;
    for (long i = (long)C.gw * 64 + lane_; i < n; i += (long)C.ngw * 64) { const long r = i / per; const int c = (int)(i % per); *(u32x4*)(base + (size_t)r * pitch_el + col0 + c * 8) = (u32x4){0u, 0u, 0u, 0u}; }
}
__device__ __forceinline__ void convert_moe(const Ctx& C, const Params&, int layer) {
    CTX_LANE;
    WS_OPAQUE;
    LAS float* scr = (LAS float*)(C.lds + C.wave * 16384);
    bf16_t* GU = WSP(bf16_t, OFF_WGU); bf16_t* DN = WSP(bf16_t, OFF_WDN); const float* gain = P.in[I_LN_FFN] + layer * 1024;
    for (int it = C.gw; it < 32 * 768; it += C.ngw) { const int e = it / 768, r = it % 768;
        if (r < 512) { const int up = r >> 8, rr = r & 255, kb = rr >> 4, nb = rr & 15, n0 = 32 * nb; const float* W = (up ? P.in[I_W_UP] : P.in[I_W_GATE]) + (size_t)(layer * 32 + e) * 1024 * 512;
            const int drow = 256 * (n0 >> 7) + (n0 & 127) + up * 128;
            tr_item(W, 512, 64 * kb, n0, 32, gain, GU + ((size_t)(e * 1024 + drow) * 1024 + 64 * kb), 1024, scr, lane_); }
        else { const int rr = r - 512, kb = rr >> 5, nb = rr & 31; const float* W = P.in[I_W_DOWN] + (size_t)(layer * 32 + e) * 512 * 1024;
            tr_item(W, 1024, 64 * kb, 32 * nb, 32, nullptr, DN + ((size_t)(e * 1024 + 32 * nb) * 512 + 64 * kb), 512, scr, lane_); } }
}
__device__ __forceinline__ void convert_mixer(const Ctx& C, const Params&) {
    CTX_LANE;
    WS_OPAQUE;
    LAS float* scr = (LAS float*)(C.lds + C.wave * 16384);
    bf16_t* WA1 = WSP(bf16_t, W_A1); bf16_t* WA1V = WSP(bf16_t, W_A1V); bf16_t* WA2 = WSP(bf16_t, W_A2); bf16_t* WA2V = WSP(bf16_t, W_A2V);
    bf16_t* WOE = WSP(bf16_t, W_OE); bf16_t* WB1 = WSP(bf16_t, W_B1); bf16_t* WOO = WSP(bf16_t, W_OO);
    constexpr int N1 = 16 * 62, N2 = 4 * 24, N3 = 2 * 32, N4 = 16 * 32, N5 = 16 * 192, N6 = 32 * 32, NT_ = N1 + N2 + N3 + N4 + N5 + N6;
    for (int it = C.gw; it < NT_; it += C.ngw) { int r = it;
        if (r < N1) { const int kb = r / 62, nb = r % 62, n0 = 32 * nb, k0 = 64 * kb; bf16_t* dst; int nv = 32;
            if (n0 < 416) dst = WA1 + (size_t)n0 * 1024; else if (n0 < 928) dst = WA1 + (size_t)(512 + n0 - 416) * 1024; else if (n0 < 1440) dst = WA1 + (size_t)(1024 + n0 - 928) * 1024;
            else if (n0 < 1952) dst = WA1V + (size_t)(n0 - 1440) * 1024; else { dst = WA1 + (size_t)416 * 1024; nv = 8; }
            tr_item(P.in[I_W_IN_E], 1960, k0, n0, nv, P.in[I_LN_MIX_E], dst + k0, 1024, scr, lane_); continue; } r -= N1;
        if (r < N2) { const int kb = r / 24, nb = r % 24, n0 = 32 * nb, hh = n0 / 96, off = n0 % 96;
            tr_item(P.in[I_W_UQ], 768, 64 * kb, n0, 32, P.in[I_LN_Q], WA2 + (size_t)(128 * hh + off) * 256 + 64 * kb, 256, scr, lane_); continue; } r -= N2;
        if (r < N3) { const int kb = r / 32, nb = r % 32, n0 = 32 * nb, hh = n0 / 128, off = n0 % 128;
            bf16_t* dst = off < 64 ? WA2 + (size_t)(1024 + 64 * hh + off) * 256 : WA2V + (size_t)(64 * hh + off - 64) * 256;
            tr_item(P.in[I_W_UKV], 1024, 64 * kb, n0, 32, P.in[I_LN_KV], dst + 64 * kb, 256, scr, lane_); continue; } r -= N3;
        if (r < N4) { const int kb = r / 32, nb = r % 32; tr_item(P.in[I_W_OUT_E], 1024, 64 * kb, 32 * nb, 32, nullptr, WOE + (size_t)(32 * nb) * 1024 + 64 * kb, 1024, scr, lane_); continue; } r -= N4;
        if (r < N5) { const int kb = r / 192, nb = r % 192; tr_item(P.in[I_W_IN_O], 6144, 64 * kb, 32 * nb, 32, P.in[I_LN_MIX_O], WB1 + (size_t)(32 * nb) * 1024 + 64 * kb, 1024, scr, lane_); continue; } r -= N5;
        { const int kb = r / 32, nb = r % 32; tr_item(P.in[I_W_OUT_O], 1024, 64 * kb, 32 * nb, 32, nullptr, WOO + (size_t)(32 * nb) * 2048 + 64 * kb, 2048, scr, lane_); } }
    zero_rows(C, WA1 + (size_t)424 * 1024, 1024, 88, 0, 1024);
    for (int hh = 0; hh < 8; ++hh) zero_rows(C, WA2 + (size_t)(128 * hh + 96) * 256, 256, 32, 0, 256);
    zero_rows(C, WA2 + (size_t)1024 * 256, 256, 512, 128, 128);
    zero_rows(C, WA2V, 256, 512, 128, 128);
}
__device__ __forceinline__ void make_rope(const Ctx& C, const Params&) {
    CTX_LANE;
    WS_OPAQUE;
    f32x2* rope = WSP(f32x2, OFF_ROPE);
    for (int i = C.gw * 64 + lane_; i < S * 128; i += C.ngw * 64) { const int pos = i >> 7, k = i & 127; const float inv = __builtin_exp2f(-(float)k * (13.287712379549449f / 128.0f));
        const float ang = (float)pos * inv; const double a = (double)ang; rope[i] = (f32x2){(float)cos(a), (float)sin(a)}; }
}
__device__ __forceinline__ void rows_to_bf16(const Ctx& C, const float* X, bf16_t* XB, float* RS) {
    CTX_LANE;
    for (int r = C.gw; r < T; r += C.ngw) { const f32x4* xr = (const f32x4*)(X + (size_t)r * D) + lane_; f32x4 v[4]; float s = 0.f;
#pragma unroll
        for (int j = 0; j < 4; ++j) { v[j] = xr[64 * j]; s += (v[j][0] * v[j][0] + v[j][1] * v[j][1]) + (v[j][2] * v[j][2] + v[j][3] * v[j][3]); }
        s = wave_sum(s); u32x2* o = (u32x2*)(XB + (size_t)r * D) + lane_;
#pragma unroll
        for (int j = 0; j < 4; ++j) o[64 * j] = (u32x2){pk2(v[j][0], v[j][1]), pk2(v[j][2], v[j][3])};
        if (lane_ == 0) RS[r] = rsqrt_f(s * (1.0f / D) + EPS); }
}
__device__ __forceinline__ void fox_cumsum(const Ctx& C, const float* LF, float* CUM, int bh) {
    CTX_LANE;
    LAS float* tot = (LAS float*)C.lds; const int b = bh >> 3, h = bh & 7; float v[32]; float run = 0.f;
#pragma unroll
    for (int i = 0; i < 32; ++i) { run += LF[((size_t)b * S + tid_ * 32 + i) * 8 + h]; v[i] = run; }
    tot[tid_] = run; __syncthreads();
    float off = 0.f; for (int t2 = 0; t2 < tid_; ++t2) off += tot[t2];
#pragma unroll
    for (int i = 0; i < 32; ++i) CUM[(size_t)bh * S + tid_ * 32 + i] = (off + v[i]) * LOG2E;
    __syncthreads();
}
__device__ __forceinline__ void moe_router(const Ctx& C, const Params&, int layer, int blk) {
    CTX_LANE;
    WS_OPAQUE;
    const float* XF = P.out; bf16_t* XB = WSP(bf16_t, OFF_XB); float* RS1 = WSP(float, SM_RS1);
    int* EID = WSP(int, SM_EID); float* GATE = WSP(float, SM_GATE); int* RANK = WSP(int, SM_RANK); int* CNT = WSP(int, SM_CNT);
    const float* wrg = P.in[I_W_RG] + (size_t)layer * 1024 * 4; const float* wre = P.in[I_W_RE] + (size_t)layer * 1024 * 32; const float* lnf = P.in[I_LN_FFN] + layer * 1024;
    LAS float* lg = (LAS float*)C.lds;
    LAS float* rsl = (LAS float*)(C.lds + 128 * 40 * 4);
    LAS int* eidl = (LAS int*)(C.lds + 128 * 40 * 4 + 512);
    LAS float* slab = (LAS float*)(C.lds + 32768);
    const int l15 = lane_ & 15, kg = lane_ >> 4, kbase = 128 * C.wave + 8 * kg;
    bf16x8 bh[3][4], bl[3][4];
#pragma unroll
    for (int nt = 0; nt < 3; ++nt) { const int col = 16 * nt + l15; const int cc = col < 36 ? col : 35; const float* wp = cc < 4 ? wrg + cc : wre + (cc - 4); const int wst = cc < 4 ? 4 : 32; const float wz = col < 36 ? 1.f : 0.f;
#pragma unroll
        for (int ks = 0; ks < 4; ++ks) { float wf[8]; unsigned hp[4], lp[4];
#pragma unroll
            for (int j = 0; j < 8; ++j) { const int k = kbase + 32 * ks + j; wf[j] = lnf[k] * wp[(size_t)k * wst] * wz; }
#pragma unroll
            for (int j = 0; j < 4; ++j) { hp[j] = pk2(wf[2 * j], wf[2 * j + 1]); lp[j] = pk2(wf[2 * j] - bflo(hp[j]), wf[2 * j + 1] - bfhi(hp[j])); }
            bh[nt][ks] = __builtin_bit_cast(bf16x8, (u32x4){hp[0], hp[1], hp[2], hp[3]}); bl[nt][ks] = __builtin_bit_cast(bf16x8, (u32x4){lp[0], lp[1], lp[2], lp[3]}); } }
    f32x4 xa[8], xb[8];
#define RT_LOADX(dst, mt) do { const float* xp = XF + (size_t)(blk * 128 + 16 * (mt) + l15) * D + kbase; _Pragma("unroll") for (int ks = 0; ks < 4; ++ks) { dst[2 * ks] = *(const f32x4*)(xp + 32 * ks); dst[2 * ks + 1] = *(const f32x4*)(xp + 32 * ks + 4); } } while (0)
#define RT_TILE(src, mt) do { f32x4 acc[3] = {{0.f, 0.f, 0.f, 0.f}, {0.f, 0.f, 0.f, 0.f}, {0.f, 0.f, 0.f, 0.f}}; float ss = 0.f; \
        _Pragma("unroll") for (int ks = 0; ks < 4; ++ks) { const f32x4 v0 = src[2 * ks], v1 = src[2 * ks + 1]; unsigned hp[4], lp[4]; \
            hp[0] = pk2(v0[0], v0[1]); hp[1] = pk2(v0[2], v0[3]); hp[2] = pk2(v1[0], v1[1]); hp[3] = pk2(v1[2], v1[3]); \
            lp[0] = pk2(v0[0] - bflo(hp[0]), v0[1] - bfhi(hp[0])); lp[1] = pk2(v0[2] - bflo(hp[1]), v0[3] - bfhi(hp[1])); lp[2] = pk2(v1[0] - bflo(hp[2]), v1[1] - bfhi(hp[2])); lp[3] = pk2(v1[2] - bflo(hp[3]), v1[3] - bfhi(hp[3])); \
            ss += (v0[0] * v0[0] + v0[1] * v0[1]) + (v0[2] * v0[2] + v0[3] * v0[3]) + (v1[0] * v1[0] + v1[1] * v1[1]) + (v1[2] * v1[2] + v1[3] * v1[3]); \
            const bf16x8 ah = __builtin_bit_cast(bf16x8, (u32x4){hp[0], hp[1], hp[2], hp[3]}), al = __builtin_bit_cast(bf16x8, (u32x4){lp[0], lp[1], lp[2], lp[3]}); \
            *(u32x4*)(XB + (size_t)(blk * 128 + 16 * (mt) + l15) * D + kbase + 32 * ks) = (u32x4){hp[0], hp[1], hp[2], hp[3]}; \
            _Pragma("unroll") for (int nt = 0; nt < 3; ++nt) { acc[nt] = __builtin_amdgcn_mfma_f32_16x16x32_bf16(ah, bh[nt][ks], acc[nt], 0, 0, 0); acc[nt] = __builtin_amdgcn_mfma_f32_16x16x32_bf16(ah, bl[nt][ks], acc[nt], 0, 0, 0); \
                acc[nt] = __builtin_amdgcn_mfma_f32_16x16x32_bf16(al, bh[nt][ks], acc[nt], 0, 0, 0); } } \
        ss += __shfl_xor(ss, 16); ss += __shfl_xor(ss, 32); \
        LAS float* sl = slab + (size_t)(C.wave * 64 + 16 * ((mt) & 3)) * 40; \
        _Pragma("unroll") for (int nt = 0; nt < 3; ++nt) { const int col = 16 * nt + l15; if (col < 36) { _Pragma("unroll") for (int r = 0; r < 4; ++r) sl[(4 * kg + r) * 40 + col] = acc[nt][r]; } } \
        if (kg == 0) sl[l15 * 40 + 36] = ss; } while (0)
    RT_LOADX(xa, 0);
    for (int half = 0; half < 2; ++half) {
        RT_LOADX(xb, 4 * half + 1); RT_TILE(xa, 4 * half + 0);
        RT_LOADX(xa, 4 * half + 2); RT_TILE(xb, 4 * half + 1);
        RT_LOADX(xb, 4 * half + 3); RT_TILE(xa, 4 * half + 2);
        if (half == 0) RT_LOADX(xa, 4); RT_TILE(xb, 4 * half + 3);
        __syncthreads();
        for (int it = tid_; it < 64 * 37; it += 512) { const int tt = it / 37, c = it % 37; float sm = 0.f;
#pragma unroll
            for (int w8 = 0; w8 < 8; ++w8) sm += slab[(size_t)(w8 * 64 + tt) * 40 + c];
            lg[(half * 64 + tt) * 40 + c] = sm; }
        __syncthreads();
    }
#undef RT_LOADX
#undef RT_TILE
    if (tid_ < 128) { const float rs = rsqrt_f(lg[tid_ * 40 + 36] * (1.0f / D) + EPS); rsl[tid_] = rs; RS1[blk * 128 + tid_] = rs; }
    __syncthreads();
    if (tid_ < 128) { const int tt = tid_, t = blk * 128 + tt; const float rs = rsl[tt]; const float* brg = P.in[I_B_RG] + layer * 4; const float* bre = P.in[I_B_RE] + layer * 32;
        float gl[4]; int gs = 0;
#pragma unroll
        for (int o = 0; o < 4; ++o) { gl[o] = lg[tt * 40 + o] * rs + brg[o]; if (gl[o] > gl[gs]) gs = o; }
        float gsum = 0.f;
#pragma unroll
        for (int o = 0; o < 4; ++o) gsum += __expf(gl[o] - gl[gs]);
        const float pg = 1.0f / gsum;
        float el[8]; int j1 = 0;
#pragma unroll
        for (int j = 0; j < 8; ++j) { el[j] = lg[tt * 40 + 4 + 8 * gs + j] * rs + bre[8 * gs + j]; if (el[j] > el[j1]) j1 = j; }
        int j2 = (j1 == 0) ? 1 : 0;
#pragma unroll
        for (int j = 0; j < 8; ++j) if (j != j1 && el[j] > el[j2]) j2 = j;
        const float e2 = __expf(el[j2] - el[j1]), den = 1.0f / (1.0f + e2);
        const int ea = 8 * gs + j1, eb = 8 * gs + j2;
        EID[t * 2] = ea; EID[t * 2 + 1] = eb; GATE[t * 2] = pg * den; GATE[t * 2 + 1] = pg * e2 * den; eidl[2 * tt] = ea; eidl[2 * tt + 1] = eb; }
    __syncthreads();
    if (tid_ < 256) { const int me = eidl[tid_]; int rk = 0; for (int a = 0; a < tid_; ++a) rk += (eidl[a] == me) ? 1 : 0; RANK[blk * 256 + tid_] = rk; }
    if (tid_ < 32) { int c = 0; for (int a = 0; a < 256; ++a) c += (eidl[a] == tid_) ? 1 : 0; CNT[blk * 32 + tid_] = c; }
    __syncthreads();
}
__device__ __forceinline__ void moe_scatter(const Ctx& C, const Params&, int blk) {
    CTX_LANE;
    WS_OPAQUE;
    const int* CNT = WSP(int, SM_CNT); const int* EID = WSP(int, SM_EID); const float* GATE = WSP(float, SM_GATE); const int* RANK = WSP(int, SM_RANK); const float* RS1 = WSP(float, SM_RS1);
    int* TSLOT = WSP(int, SM_TSLOT); int* STOK = WSP(int, SM_STOK); float* SW = WSP(float, SM_SW); float* SR = WSP(float, SM_SR); int* TILEE = WSP(int, SM_TILEE);
    const bf16_t* XB = WSP(bf16_t, OFF_XB); bf16_t* XS = WSP(bf16_t, A_XS);
    LAS int* part = (LAS int*)C.lds;
    LAS int* tot = part + 1024;
    LAS int* slotl = tot + 128;
    { const int e = tid_ & 31, pt = tid_ >> 5; int s = 0, pre = 0;
        for (int b = pt * 16; b < pt * 16 + 16; ++b) { const int c = ld_i(CNT + b * 32 + e); s += c; if (b < blk) pre += c; }
        part[pt * 32 + e] = s; part[512 + pt * 32 + e] = pre; }
    __syncthreads();
    if (tid_ < 32) { int s = 0, pre = 0; for (int pt = 0; pt < 16; ++pt) { s += part[pt * 32 + tid_]; pre += part[512 + pt * 32 + tid_]; } tot[tid_] = s; tot[32 + tid_] = pre; }
    __syncthreads();
    if (tid_ == 0) { int ps = 0; for (int e = 0; e < 32; ++e) { tot[64 + e] = ps; ps += (tot[e] + 255) & ~255; } tot[96] = ps; }
    __syncthreads();
    if (tid_ < 256) { const int a = blk * 256 + tid_, t = a >> 1, e = EID[a]; const int slot = tot[64 + e] + tot[32 + e] + RANK[a];
        slotl[tid_] = slot; TSLOT[a] = slot; STOK[slot] = t; SW[slot] = GATE[a]; SR[slot] = RS1[t]; }
    __syncthreads();
    for (int i = C.wave; i < 256; i += 8) { const int slot = slotl[i], t = (blk * 256 + i) >> 1;
        const u32x4* s = (const u32x4*)(XB + (size_t)t * D) + lane_; u32x4* d = (u32x4*)(XS + (size_t)slot * D) + lane_; d[0] = s[0]; d[64] = s[64]; }
    if (blk < 32) { const int e = blk, beg = tot[64 + e] + tot[e], end = tot[64 + e] + ((tot[e] + 255) & ~255);
        for (int sl = beg + C.wave; sl < end; sl += 8) { u32x4* d = (u32x4*)(XS + (size_t)sl * D) + lane_; d[0] = (u32x4){0u, 0u, 0u, 0u}; d[64] = (u32x4){0u, 0u, 0u, 0u}; if (lane_ == 0) { STOK[sl] = -1; SW[sl] = 0.f; SR[sl] = 0.f; } } }
    if (blk == 0 && tid_ < 32) { const int e = tid_, t0 = tot[64 + e] >> 8, nt = ((tot[e] + 255) & ~255) >> 8; for (int i = 0; i < nt; ++i) TILEE[t0 + i] = e; if (e == 0) TILEE[300] = tot[96] >> 8; }
    __syncthreads();
}
template <int MODE> __device__ __forceinline__ void moe_combine(const Ctx& C, const Params&, float* RS, const float* gainf) {
    CTX_LANE;
    WS_OPAQUE;
    float* XF = P.out; bf16_t* XB = WSP(bf16_t, OFF_XB); const bf16_t* YS = WSP(bf16_t, A_XS); const int* TSLOT = WSP(int, SM_TSLOT);
    for (int t = C.gw; t < T; t += C.ngw) { const int sa = ld_i(TSLOT + 2 * t), sb = ld_i(TSLOT + 2 * t + 1); f32x4* xr = (f32x4*)(XF + (size_t)t * D) + lane_;
        const u32x2* ya = (const u32x2*)(YS + (size_t)sa * D) + lane_; const u32x2* yb = (const u32x2*)(YS + (size_t)sb * D) + lane_; f32x4 v[4]; float s = 0.f;
#pragma unroll
        for (int j = 0; j < 4; ++j) { const u32x2 a = ya[64 * j], b = yb[64 * j]; v[j] = xr[64 * j];
            v[j][0] += bflo(a.x) + bflo(b.x); v[j][1] += bfhi(a.x) + bfhi(b.x); v[j][2] += bflo(a.y) + bflo(b.y); v[j][3] += bfhi(a.y) + bfhi(b.y);
            s += (v[j][0] * v[j][0] + v[j][1] * v[j][1]) + (v[j][2] * v[j][2] + v[j][3] * v[j][3]); }
        s = wave_sum(s); const float rs = rsqrt_f(s * (1.0f / D) + EPS);
        if (MODE == 0) { u32x2* o = (u32x2*)(XB + (size_t)t * D) + lane_;
#pragma unroll
            for (int j = 0; j < 4; ++j) { xr[64 * j] = v[j]; o[64 * j] = (u32x2){pk2(v[j][0], v[j][1]), pk2(v[j][2], v[j][3])}; }
            if (lane_ == 0) RS[t] = rs; }
        else { const f32x4* gr = (const f32x4*)gainf + lane_;
#pragma unroll
            for (int j = 0; j < 4; ++j) xr[64 * j] = v[j] * rs * gr[64 * j]; } }
}

constexpr int LDS_BYTES = 147456;
constexpr int LDS_MISC = LDS_BYTES - 256;
constexpr int NPHASE = 23;

__global__ void __launch_bounds__(512, 2) fwd_kernel(Params Pkern) {
    extern __shared__ __attribute__((aligned(16))) unsigned char lds_raw[];
    LAS unsigned char* lds = (LAS unsigned char*)lds_raw;
    Ctx C; { const int t0_ = threadIdx.x; C.wave = __builtin_amdgcn_readfirstlane(t0_ >> 6); } C.G = gridDim.x;
    C.vcu = (C.G % 8 == 0) ? ((int)blockIdx.x % 8) * (C.G / 8) + (int)blockIdx.x / 8 : (int)blockIdx.x;
    C.gw = C.vcu * 8 + C.wave; C.ngw = C.G * 8; C.lds = lds;
    const int bx = blockIdx.x;
    { const int l0 = lane_id_opaque(); if (C.wave == 0) ((LAS unsigned*)(lds + LDS_MISC))[l0] = 0u; }
    __syncthreads();
    const unsigned xcc = xb_xcc_id();
    if (Pkern.use_bar) { const bool t0 = (C.wave == 0) && (lane_id_opaque() == 0); (void)xcd_barrier_post((unsigned*)(Pkern.ws + OFF_CTL) + 4096, (volatile LAS unsigned*)(lds + LDS_MISC), t0); }
    const int lo = Pkern.ph_lo, hi = Pkern.ph_hi;
    const Params& P = Pkern;
#ifndef PH_MASK
#define PH_MASK 0x7fffffu
#endif
#define IN(k) ((((unsigned)PH_MASK >> (k)) & 1u) && lo <= (k) && (k) < hi)
#ifndef PROBE_MASK
#define PROBE_MASK 0u
#endif
#ifdef PROBE_T
#define STAMP(i) do { if (bx == 0 && C.wave == 0 && lane_id_opaque() == 0) ((volatile LAS unsigned long long*)(lds + LDS_MISC + 64))[(i)] = __builtin_amdgcn_s_memrealtime(); } while (0)
#else
#define STAMP(i) do { } while (0)
#endif
#define REP(k) for (int rep_ = 0; rep_ < ((((unsigned)PROBE_MASK >> (k)) & 1u) ? 2 : 1); ++rep_)
#define SEAM(k) do { if (IN(k) && IN((k) + 1)) { P_OPAQUE; XcdBarrier bar; bar.bar = (unsigned*)(P.ws + OFF_CTL) + 4096; bar.x = xcc; bar.st = (volatile LAS unsigned*)(lds + LDS_MISC); \
        const bool t0 = (C.wave == 0) && (lane_id_opaque() == 0); xcd_barrier(bar, t0); } STAMP((k) + 1); } while (0)

    STAMP(0);
    if (IN(0)) REP(0) { WS_OPAQUE; convert_mixer(C, P); convert_moe(C, P, 0); make_rope(C, P); rows_to_bf16(C, P.in[I_X], WSP(bf16_t, OFF_XB), WSP(float, SM_RS0)); __syncthreads(); }
    SEAM(0);
    if (IN(1)) REP(1) {
        { WS_OPAQUE; DenseSched Sd; Sd.init(WSP(bf16_t, OFF_XB), 1024, WSP(bf16_t, W_A1), 1024, 128, 6, C.G, bx);
          EpiA1a E{WSP(float, SM_RS0), WSP(bf16_t, A_Z), WSP(float, SM_PQ), WSP(float, SM_PKV), WSP(bf16_t, A_KA), WSP(float, SM_LF), P.in[I_B_F], WSP(bf16_t, A_QF), WSP(bf16_t, A_KF), WSP(f32x2, OFF_ROPE)};
          pg8::gemm_phase(C.wave, lds, pg8::Dims{1024, 1024, 1024}, Sd, E); }
        { WS_OPAQUE; DenseSched Sd; Sd.init(WSP(bf16_t, W_A1V), 1024, WSP(bf16_t, OFF_XB), 1024, 2, 128, C.G, bx);
          EpiVT<0> E{WSP(float, SM_RS0), WSP(bf16_t, A_VTF), (size_t)T};
          pg8::gemm_phase(C.wave, lds, pg8::Dims{1024, 1024, 1024}, Sd, E); }
    }
    SEAM(1);
    if (IN(2)) REP(2) {
        if (C.vcu < 16) { WS_OPAQUE; fox_cumsum(C, WSP(float, SM_LF), WSP(float, SM_CUM), C.vcu); }
        { WS_OPAQUE; fox_knorm(C.gw, C.ngw, lane_id_opaque(), WSP(bf16_t, A_KF), WSP(float, SM_KNRM)); }
        { WS_OPAQUE; DenseSched Sd; Sd.init(WSP(bf16_t, A_Z), 512, WSP(bf16_t, W_A2), 256, 128, 4, C.G, bx);
          EpiA2q E{WSP(float, SM_PQ), WSP(bf16_t, A_QA), WSP(f32x2, OFF_ROPE)};
          pg8::gemm_phase(C.wave, lds, pg8::Dims{512, 256, 256}, Sd, E); }
        { WS_OPAQUE; DenseSched Sd; Sd.init(WSP(bf16_t, A_Z) + 256, 512, WSP(bf16_t, W_A2) + (size_t)1024 * 256, 256, 128, 2, C.G, bx);
          EpiA2k E{WSP(float, SM_PKV), WSP(bf16_t, A_KA)};
          pg8::gemm_phase(C.wave, lds, pg8::Dims{512, 256, 256}, Sd, E); }
        { WS_OPAQUE; DenseSched Sd; Sd.init(WSP(bf16_t, W_A2V), 256, WSP(bf16_t, A_Z) + 256, 512, 2, 128, C.G, bx);
          EpiVT<1> E{WSP(float, SM_PKV), WSP(bf16_t, A_VTA), (size_t)T};
          pg8::gemm_phase(C.wave, lds, pg8::Dims{256, 512, 256}, Sd, E); }
    }
    SEAM(2);
    if (IN(3)) REP(3) {
        const int bh = C.vcu >> 4, s4 = C.vcu & 15, b = bh >> 3, h = bh & 7;
        REP(23) { WS_OPAQUE; bf16_t* AO = WSP(bf16_t, OFF_XB);
          for (int i = 0; i < 4; ++i) { const int qb = (i == 0) ? s4 : (i == 1) ? 31 - s4 : (i == 2) ? 32 + s4 : 63 - s4;
            attn_unit<96, false>(C.wave, lds, WSP(bf16_t, A_QA) + (size_t)b * S * 768 + h * 96, 768, WSP(bf16_t, A_KA) + (size_t)b * S * 768 + h * 96, 768,
                                 WSP(bf16_t, A_VTA) + ((size_t)h * (T / 64) + (size_t)b * (S / 64)) * 4096, nullptr, nullptr, AO + (size_t)b * S * 1024 + h * 64, 1024, qb); } }
        REP(24) { WS_OPAQUE; bf16_t* AO = WSP(bf16_t, OFF_XB);
          for (int i = 0; i < 4; ++i) { const int qb = (i == 0) ? s4 : (i == 1) ? 31 - s4 : (i == 2) ? 32 + s4 : 63 - s4;
            attn_unit<64, true>(C.wave, lds, WSP(bf16_t, A_QF) + (size_t)b * S * 512 + h * 64, 512, WSP(bf16_t, A_KF) + (size_t)b * S * 512 + h * 64, 512,
                                WSP(bf16_t, A_VTF) + ((size_t)h * (T / 64) + (size_t)b * (S / 64)) * 4096, WSP(float, SM_CUM) + (size_t)bh * S, WSP(float, SM_KNRM) + bh * 256, AO + (size_t)b * S * 1024 + 512 + h * 64, 1024, qb); } }
    }
    SEAM(3);
    if (IN(4)) REP(4) { WS_OPAQUE; DenseSched Sd; Sd.init(WSP(bf16_t, OFF_XB), 1024, WSP(bf16_t, W_OE), 1024, 128, 4, C.G, bx); EpiRes E{P.in[I_X], P.out};
        pg8::gemm_phase(C.wave, lds, pg8::Dims{1024, 1024, 1024}, Sd, E); }
    SEAM(4);

#define MOE_PHASES(layer, pb) do { \
        if (IN(pb)) REP(pb) moe_router(C, P, layer, bx); \
        SEAM(pb); \
        if (IN((pb) + 1)) REP((pb) + 1) moe_scatter(C, P, bx); \
        SEAM((pb) + 1); \
        if (IN((pb) + 2)) REP((pb) + 2) { WS_OPAQUE; MoeSched Sm; Sm.init(WSP(bf16_t, A_XS), 1024, WSP(bf16_t, OFF_WGU), 1024, 1024, WSP(int, SM_TILEE), C.G, bx); EpiM3 E{WSP(float, SM_SR), WSP(bf16_t, A_HID)}; \
            pg8::gemm_phase(C.wave, lds, pg8::Dims{1024, 1024, 1024}, Sm, E); } \
        SEAM((pb) + 2); \
        if (IN((pb) + 3)) REP((pb) + 3) { WS_OPAQUE; MoeSched Sm; Sm.init(WSP(bf16_t, A_HID), 512, WSP(bf16_t, OFF_WDN), 512, 1024, WSP(int, SM_TILEE), C.G, bx); EpiM4 E{WSP(float, SM_SW), WSP(bf16_t, A_XS)}; \
            pg8::gemm_phase(C.wave, lds, pg8::Dims{512, 512, 512}, Sm, E); } \
        SEAM((pb) + 3); } while (0)
#define RET_PHASES(bb, p0) do { \
        if (IN(p0)) REP(p0) { \
            { WS_OPAQUE; DenseSched Sd; Sd.init(WSP(bf16_t, OFF_XB) + (size_t)(bb) * S * 1024, 1024, WSP(bf16_t, W_B1), 1024, 64, 4, C.G, bx); EpiB1q E{WSP(float, SM_RS2) + (bb) * S, WSP(bf16_t, A_QX), WSP(f32x2, OFF_ROPE)}; \
              pg8::gemm_phase(C.wave, lds, pg8::Dims{1024, 1024, 1024}, Sd, E); } \
            { WS_OPAQUE; DenseSched Sd; Sd.init(WSP(bf16_t, W_B1) + (size_t)1024 * 1024, 1024, WSP(bf16_t, OFF_XB) + (size_t)(bb) * S * 1024, 1024, 4, 64, C.G, bx); EpiB1k E{WSP(float, SM_RS2) + (bb) * S, WSP(bf16_t, A_KN), WSP(bf16_t, A_KZT), WSP(f32x2, OFF_ROPE), lds + 131072}; \
              pg8::gemm_phase(C.wave, lds, pg8::Dims{1024, 1024, 1024}, Sd, E); } \
            { WS_OPAQUE; DenseSched Sd; Sd.init(WSP(bf16_t, W_B1) + (size_t)2048 * 1024, 1024, WSP(bf16_t, OFF_XB) + (size_t)(bb) * S * 1024, 1024, 8, 64, C.G, bx); EpiB1v E{WSP(float, SM_RS2) + (bb) * S, WSP(bf16_t, A_VT)}; \
              pg8::gemm_phase(C.wave, lds, pg8::Dims{1024, 1024, 1024}, Sd, E); } \
        } \
        SEAM(p0); \
        if (IN((p0) + 1)) REP((p0) + 1) { WS_OPAQUE; ret_local(C.wave, lds, WSP(bf16_t, A_KZT), WSP(bf16_t, A_VT), WSP(f32x4, A_L), C.vcu); } \
        SEAM((p0) + 1); \
        if (IN((p0) + 2)) REP((p0) + 2) { WS_OPAQUE; ret_scan(C.wave, lds, WSP(bf16_t, A_QX), WSP(bf16_t, A_KN), WSP(bf16_t, A_KZT), WSP(bf16_t, A_VT), WSP(f32x4, A_L), \
                                 WSP(bf16_t, A_O) + (size_t)(bb) * S * 2048, WSP(float, SM_PO) + (size_t)(bb) * S * 16, C.vcu); } \
        SEAM((p0) + 2); } while (0)

    MOE_PHASES(0, 5);
    if (IN(9)) { WS_OPAQUE; moe_combine<0>(C, P, WSP(float, SM_RS2), nullptr); convert_moe(C, P, 1); __syncthreads(); }
    SEAM(9);
    RET_PHASES(0, 10);
    RET_PHASES(1, 13);
    if (IN(16)) { WS_OPAQUE; DenseSched Sd; Sd.init(WSP(bf16_t, OFF_XB), 1024, WSP(bf16_t, W_B1) + (size_t)4096 * 1024, 1024, 128, 8, C.G, bx); EpiG E{WSP(float, SM_RS2), WSP(float, SM_PO), WSP(bf16_t, A_O)};
        pg8::gemm_phase(C.wave, lds, pg8::Dims{1024, 1024, 1024}, Sd, E); }
    SEAM(16);
    if (IN(17)) { WS_OPAQUE; DenseSched Sd; Sd.init(WSP(bf16_t, A_O), 2048, WSP(bf16_t, W_OO), 2048, 128, 4, C.G, bx); EpiRes E{P.out, P.out};
        pg8::gemm_phase(C.wave, lds, pg8::Dims{2048, 2048, 2048}, Sd, E); }
    SEAM(17);
    MOE_PHASES(1, 18);
#undef MOE_PHASES
#undef RET_PHASES
    if (IN(22)) { P_OPAQUE; moe_combine<1>(C, P, nullptr, P.in[I_LN_F]); }
#ifdef PROBE_T
    __syncthreads();
    if (bx == 0 && C.wave == 0 && lane_id_opaque() == 0) { volatile LAS unsigned long long* st_ = (volatile LAS unsigned long long*)(lds + LDS_MISC + 64);
        const unsigned long long tend = __builtin_amdgcn_s_memrealtime(); const unsigned long long tb = (PROBE_T == 22) ? tend : st_[PROBE_T + 1]; const unsigned long long dt = tb - st_[PROBE_T];
        while (__builtin_amdgcn_s_memrealtime() - tend < 8ull * dt) __builtin_amdgcn_s_sleep(8); }
#endif
#undef IN
#undef SEAM
}

extern "C" void kernel_launch(void* const* d_in, const int* in_sizes, int n_in, void* d_out, int out_size, void* d_ws, size_t ws_size, hipStream_t stream) {
    static int ready = 0;
    if (ready == 0) {
        if (n_in != 21 || out_size != T * D || ws_size < WS_NEED) { fprintf(stderr, "kernel_launch: unexpected shapes (n_in %d, out %d, ws %zu < %zu)\n", n_in, out_size, ws_size, (size_t)WS_NEED); ready = -1; return; }
        if (hipFuncSetAttribute((const void*)fwd_kernel, hipFuncAttributeMaxDynamicSharedMemorySize, LDS_BYTES) != hipSuccess) { fprintf(stderr, "kernel_launch: hipFuncSetAttribute failed\n"); ready = -1; return; }
        int per_cu = 0; (void)hipOccupancyMaxActiveBlocksPerMultiprocessor(&per_cu, (const void*)fwd_kernel, 512, LDS_BYTES); (void)hipGetLastError();
        if (per_cu < 1) fprintf(stderr, "kernel_launch: occupancy query reports %d blocks per CU\n", per_cu);
        ready = 1;
    }
    if (ready < 0) return;
    (void)hipMemsetAsync((char*)d_ws + OFF_CTL, 0, CTL_BYTES, stream);
    Params p{};
    for (int i = 0; i < 21; ++i) p.in[i] = (const float*)d_in[i];
    p.out = (float*)d_out; p.ws = (unsigned char*)d_ws; p.pad = 0;
#if N_LAUNCH_MODE == 1
    for (int ph = 0; ph < NPHASE; ++ph) { p.ph_lo = ph; p.ph_hi = ph + 1; p.use_bar = 0; hipLaunchKernelGGL(fwd_kernel, dim3(256), dim3(512), LDS_BYTES, stream, p); }
#else
    p.ph_lo = 0; p.ph_hi = NPHASE; p.use_bar = 1;
    hipLaunchKernelGGL(fwd_kernel, dim3(256), dim3(512), LDS_BYTES, stream, p);
#endif
}
```

```cpp
#include <hip/hip_runtime.h>
#include <cstdio>
#include <cstdint>

#ifndef N_LAUNCH_MODE
#define N_LAUNCH_MODE 0
#endif

#define LAS __attribute__((address_space(3)))
#define GAS __attribute__((address_space(1)))
typedef unsigned short bf16_t;
typedef short bf16x8 __attribute__((ext_vector_type(8)));
typedef float f32x2 __attribute__((ext_vector_type(2)));
typedef float f32x4 __attribute__((ext_vector_type(4)));
typedef float f32x16 __attribute__((ext_vector_type(16)));
typedef unsigned u32x2 __attribute__((ext_vector_type(2)));
typedef unsigned u32x4 __attribute__((ext_vector_type(4)));

constexpr int T = 32768, S = 16384, D = 1024;
constexpr float EPS = 1e-6f;
constexpr float LOG2E = 1.4426950408889634f;
constexpr int CAP = 65536 + 32 * 256;
constexpr int NSEG = 16, SEGC = 16;

constexpr size_t MiB = 1u << 20;
constexpr size_t OFF_CTL = 0, CTL_BYTES = 1 * MiB;
constexpr size_t OFF_SMALL = 1 * MiB;
constexpr size_t SM_RS0 = OFF_SMALL, SM_RS1 = SM_RS0 + T * 4, SM_RS2 = SM_RS1 + T * 4, SM_PQ = SM_RS2 + T * 4, SM_PKV = SM_PQ + (size_t)T * 16,
                 SM_LF = SM_PKV + (size_t)T * 16, SM_CUM = SM_LF + (size_t)T * 32, SM_EID = SM_CUM + (size_t)T * 32  ,
                 SM_GATE = SM_EID + (size_t)T * 8, SM_RANK = SM_GATE + (size_t)T * 8, SM_TSLOT = SM_RANK + (size_t)T * 8, SM_CNT = SM_TSLOT + (size_t)T * 8,
                 SM_STOK = SM_CNT + 256 * 32 * 4, SM_SW = SM_STOK + (size_t)CAP * 4, SM_SR = SM_SW + (size_t)CAP * 4, SM_TILEE = SM_SR + (size_t)CAP * 4,
                 SM_PO = SM_TILEE + 4096, SM_KNRM = SM_PO + (size_t)T * 64, SM_END = SM_KNRM + 16 * 256 * 4;
static_assert(SM_END <= 11 * MiB, "small region");
constexpr size_t OFF_ROPE = 11 * MiB;
constexpr size_t OFF_WMIX = 27 * MiB;
constexpr size_t W_A1 = OFF_WMIX, W_A1V = W_A1 + 3 * MiB, W_A2 = W_A1V + 1 * MiB, W_A2V = W_A2 + 768 * 1024, W_OE = W_A2V + 256 * 1024,
                 W_B1 = W_OE + 2 * MiB, W_OO = W_B1 + 12 * MiB, W_MIXEND = W_OO + 4 * MiB;
static_assert(W_MIXEND <= 51 * MiB, "mixer weights");
constexpr size_t OFF_WGU = 51 * MiB, OFF_WDN = OFF_WGU + 64 * MiB;
constexpr size_t OFF_XB = 147 * MiB;
constexpr size_t OFF_ACT = 211 * MiB;
constexpr size_t WS_NEED = OFF_ACT + 320 * MiB;
constexpr size_t A_Z = OFF_ACT, A_QF = A_Z + 32 * MiB, A_KF = A_QF + 32 * MiB, A_VTF = A_KF + 32 * MiB, A_QA = A_VTF + 32 * MiB, A_KA = A_QA + 48 * MiB, A_VTA = A_KA + 48 * MiB;
constexpr size_t A_XS = OFF_ACT, A_HID = OFF_ACT + 144 * MiB;
constexpr size_t A_QX = OFF_ACT, A_KN = A_QX + 32 * MiB, A_KZT = A_KN + 32 * MiB, A_VT = A_KZT + 32 * MiB, A_L = A_VT + 64 * MiB, A_O = A_L + 32 * MiB;
static_assert(A_O + 128 * MiB <= WS_NEED && A_HID + 72 * MiB <= WS_NEED && A_VTA + 32 * MiB <= WS_NEED, "act map");

__device__ __forceinline__ unsigned f2bf(float f) { unsigned u = __builtin_bit_cast(unsigned, f); return (u + 0x7fffu + ((u >> 16) & 1u)) >> 16; }
__device__ __forceinline__ unsigned pk2(float lo, float hi) { unsigned r; asm volatile("v_cvt_pk_bf16_f32 %0, %1, %2" : "=v"(r) : "v"(lo), "v"(hi)); return r; }
__device__ __forceinline__ float bf2f(unsigned short b) { return __builtin_bit_cast(float, ((unsigned)b) << 16); }
__device__ __forceinline__ float bflo(unsigned w) { return __builtin_bit_cast(float, w << 16); }
__device__ __forceinline__ float bfhi(unsigned w) { return __builtin_bit_cast(float, w & 0xffff0000u); }
__device__ __forceinline__ float wave_sum(float v) {
#pragma unroll
    for (int o = 1; o < 64; o <<= 1) v += __shfl_xor(v, o);
    return v;
}
__device__ __forceinline__ int lane_id_opaque() { unsigned z = 0u; asm volatile("" : "+s"(z)); int l = (int)__builtin_amdgcn_mbcnt_hi(~0u, __builtin_amdgcn_mbcnt_lo(~0u, z)); asm volatile("" : "+v"(l)); return l; }
__device__ __forceinline__ int ld_i(const int* p) { return __hip_atomic_load(p, __ATOMIC_RELAXED, __HIP_MEMORY_SCOPE_AGENT); }
__device__ __forceinline__ float rsqrt_f(float x) { return 1.0f / sqrtf(x); }

#define XB_TMO      128
#define XB_XCNT(j)  (256  + 64 * (j))
#define XB_XSUB(j)  (1280 + 64 * (j))
#define XB_XGEN(j)  (2304 + 64 * (j))
#define XB_TOP      3328
#define XB_TOPGEN   3392
#define XCD_BAR_WORDS 3456
#define XB_SPIN_CAP (1u << 18)
__device__ __forceinline__ unsigned xb_ld(unsigned* p)              { return __hip_atomic_load(p, __ATOMIC_RELAXED, __HIP_MEMORY_SCOPE_AGENT); }
__device__ __forceinline__ unsigned xb_add(unsigned* p, unsigned v) { return __hip_atomic_fetch_add(p, v, __ATOMIC_RELAXED, __HIP_MEMORY_SCOPE_AGENT); }
__device__ __forceinline__ unsigned xb_xcc_id() { return (unsigned)__builtin_amdgcn_s_getreg((3 << 11) | 20) & 0xFu; }
#define XB_SPIN(cond, bar) do { unsigned _sp = 0; while (cond) { __builtin_amdgcn_s_sleep(1); \
    if ((++_sp & 255u) == 0u) { if (xb_ld(&(bar)[XB_TMO])) break; if (_sp > XB_SPIN_CAP) { atomicAdd(&(bar)[XB_TMO], 1u); break; } } } } while (0)
struct XcdBarrier { unsigned* bar; unsigned x; volatile LAS unsigned* st; };
__device__ __forceinline__ XcdBarrier xcd_barrier_post(unsigned* bar, volatile LAS unsigned* st, bool t0) {
    XcdBarrier b; b.bar = bar; b.x = xb_xcc_id(); b.st = st;
    if (t0) (void)xb_add(&bar[XB_XCNT(b.x)], 1u);
    return b;
}
__device__ __forceinline__ void xcd_barrier_complete(unsigned* bar, unsigned x, unsigned& nloc, unsigned& nx) {
    const unsigned G = gridDim.x * gridDim.y * gridDim.z;
    unsigned sum, cnt, mine, sp = 0u;
    for (;;) {
        sum = 0u; cnt = 0u; mine = 0u;
#pragma unroll
        for (unsigned j = 0; j < 16; ++j) { const unsigned c = xb_ld(&bar[XB_XCNT(j)]); sum += c; cnt += (c > 0u) ? 1u : 0u; mine = (j == x) ? c : mine; }
        if (sum == G) break;
        __builtin_amdgcn_s_sleep(1);
        if ((++sp & 255u) == 0u) { if (xb_ld(&bar[XB_TMO])) break; if (sp > XB_SPIN_CAP) { atomicAdd(&bar[XB_TMO], 1u); break; } }
    }
    nloc = mine > 0u ? mine : 1u; nx = cnt > 0u ? cnt : 1u;
}
__device__ __forceinline__ void xcd_barrier(const XcdBarrier& b, bool t0) {
    asm volatile("s_waitcnt vmcnt(0)" ::: "memory");
    __syncthreads();
    if (t0) {
        unsigned* bar = b.bar;
        __builtin_amdgcn_s_waitcnt(0);
        unsigned nloc = b.st[0], nx = b.st[1];
        if (nloc == 0u) { xcd_barrier_complete(bar, b.x, nloc, nx); b.st[0] = nloc; b.st[1] = nx; }
        const unsigned old = xb_add(&bar[XB_XSUB(b.x)], 1u);
        const unsigned gen = old / nloc;
        if (old + 1u == (gen + 1u) * nloc) {
            __builtin_amdgcn_fence(__ATOMIC_RELEASE, "agent");
            asm volatile("s_waitcnt vmcnt(0)" ::: "memory");
            const unsigned og = xb_add(&bar[XB_TOP], 1u);
            const unsigned tg = og / nx;
            if (og + 1u == (tg + 1u) * nx) xb_add(&bar[XB_TOPGEN], 1u);
            else XB_SPIN(xb_ld(&bar[XB_TOPGEN]) == tg, bar);
            __builtin_amdgcn_fence(__ATOMIC_ACQUIRE, "agent");
            xb_add(&bar[XB_XGEN(b.x)], 1u);
            asm volatile("s_waitcnt vmcnt(0)" ::: "memory");
        } else {
            XB_SPIN(xb_ld(&bar[XB_XGEN(b.x)]) == gen, bar);
            __builtin_amdgcn_fence(__ATOMIC_ACQUIRE, "agent");
            asm volatile("s_waitcnt vmcnt(0)" ::: "memory");
        }
    }
    __syncthreads();
}

namespace pg8 {
constexpr int BM = 256, BK = 64, HALF = 128, HTB = HALF * BK * 2, STAGE_BYTES = 8 * HTB, NXCD = 8, WGM = 8;
__device__ __forceinline__ int lds_byte(int r, int c) { const int st = (r >> 4) * 2 + (c >> 5), rr = r & 15, cc = c & 31, ob = rr * 64 + cc * 2; return st * 1024 + (ob ^ (((ob >> 9) & 1) << 5)); }
__device__ __forceinline__ void stage_rc(int b, int& R, int& C) { const int st = b / 1024, sb = b % 1024, swz = sb ^ (((sb >> 9) & 1) << 5); R = (st >> 1) * 16 + swz / 64; C = (st & 1) * 32 + (swz % 64) / 2; }
__device__ __forceinline__ int perm32(int rho) { const int n = rho >> 4, i = rho & 15; return 8 * (i >> 2) + 4 * n + (i & 3); }
struct Unit { int pm, pn, aux; };
struct Dims { int lda, ldb, K; };
struct DenseOrder {
    int nM, nN, nwg, G, c;
    __device__ __forceinline__ void init(int nM_, int nN_, int G_, int c_) { nM = nM_; nN = nN_; nwg = nM * nN; G = G_; c = c_; }
    __device__ __forceinline__ bool tile(int i, Unit& u) const {
        const long L = (long)i * G + c; if (L >= nwg) return false;
        int wgid = (int)L; { const int q = nwg / NXCD, r = nwg % NXCD, xcd = wgid % NXCD, off = wgid / NXCD; wgid = (xcd < r ? xcd * (q + 1) : r * (q + 1) + (xcd - r) * q) + off; }
        const int nig = WGM * nN, gid = wgid / nig, fm = gid * WGM, gsz = (nM - fm) < WGM ? (nM - fm) : WGM;
        u.pm = fm + ((wgid % nig) % gsz); u.pn = (wgid % nig) / gsz; u.aux = 0; return true;
    }
};

template <class Epi, class Sched>
__device__ __forceinline__ void gemm_phase(int wave_, LAS unsigned char* lds, const Dims g, const Sched& S, const Epi& E) {
    const int tid = wave_ * 64 + lane_id_opaque();
    const int wid = __builtin_amdgcn_readfirstlane(tid >> 6), lane = tid & 63, wr = wid >> 2, wc = wid & 3, fr = lane & 15, fq = lane >> 4;
    const int K = g.K, nt = K / BK;
    unsigned voffA[2], voffB[2];
#pragma unroll
    for (int i = 0; i < 2; ++i) { int R, C; stage_rc(tid * 16 + i * 8192, R, C); const int Rb = Epi::PERM ? ((R & ~31) + perm32(R & 31)) : R;
        voffA[i] = (unsigned)(R * g.lda + C) * 2u; voffB[i] = (unsigned)(Rb * g.ldb + C) * 2u; }
    const size_t kstep = (size_t)(BK * 2);
    const size_t hstepA = (size_t)HALF * g.lda * 2, hstepB = (size_t)HALF * g.ldb * 2;
    const unsigned ldsw = (unsigned)wid * 1024u;
    const int aoff = lds_byte(wr * 64 + fr, fq * 8), boff = lds_byte(wc * 32 + fr, fq * 8);
#define PG8_SA(b, h) (((b) * 2 + (h)) * HTB)
#define PG8_SB(b, h) ((4 + (b) * 2 + (h)) * HTB)
#define PG8_STAGE(bufoff, gbase, voff) do { _Pragma("unroll") for (int _i = 0; _i < 2; ++_i) \
        __builtin_amdgcn_global_load_lds((const unsigned*)((const char*)(gbase) + (voff)[_i]), (LAS unsigned*)(lds + (bufoff) + ldsw + _i * 8192), 16, 0, 0); } while (0)
#define PG8_LDA(dst, b, h) do { _Pragma("unroll") for (int m = 0; m < 4; ++m) _Pragma("unroll") for (int k = 0; k < 2; ++k) dst[m][k] = *(const LAS bf16x8*)(lds + PG8_SA(b, h) + aoff + m * 2048 + k * 1024); } while (0)
#define PG8_LDB(dst, b, h) do { _Pragma("unroll") for (int n = 0; n < 2; ++n) _Pragma("unroll") for (int k = 0; k < 2; ++k) dst[n][k] = *(const LAS bf16x8*)(lds + PG8_SB(b, h) + boff + n * 2048 + k * 1024); } while (0)
#define PG8_MMA(ai, bj, At, Bt) do { __builtin_amdgcn_s_setprio(1); _Pragma("unroll") for (int m = 0; m < 4; ++m) _Pragma("unroll") for (int n = 0; n < 2; ++n) _Pragma("unroll") for (int k = 0; k < 2; ++k) \
        acc[ai][bj][m][n] = __builtin_amdgcn_mfma_f32_16x16x32_bf16(Bt[n][k], At[m][k], acc[ai][bj][m][n], 0, 0, 0); __builtin_amdgcn_s_setprio(0); } while (0)
#define PG8_WAIT_V(n) asm volatile("s_waitcnt vmcnt(" #n ")" ::: "memory")
#define PG8_WAIT_L(n) asm volatile("s_waitcnt lgkmcnt(" #n ")" ::: "memory")
#define PG8_BAR __builtin_amdgcn_s_barrier()
#define PG8_SCHED __builtin_amdgcn_sched_barrier(0)
    Unit cur, nxt; int ui = 0;
    if (!S.next(0, cur)) return;
    f32x4 acc[2][2][4][2];
#pragma unroll
    for (int a = 0; a < 2; ++a)
#pragma unroll
        for (int b = 0; b < 2; ++b)
#pragma unroll
            for (int m = 0; m < 4; ++m)
#pragma unroll
                for (int n = 0; n < 2; ++n) acc[a][b][m][n] = (f32x4){0.f, 0.f, 0.f, 0.f};
    bf16x8 At[4][2], B0[2][2], B1[2][2];
    const char* cA; const char* cB; S.ptrs(cur, cA, cB);
    PG8_STAGE(PG8_SB(0, 0), cB, voffB); PG8_STAGE(PG8_SA(0, 0), cA, voffA); PG8_STAGE(PG8_SB(0, 1), cB + hstepB, voffB); PG8_STAGE(PG8_SA(0, 1), cA + hstepA, voffA);
    if (wr == 1) PG8_BAR;
    PG8_WAIT_V(4); PG8_BAR;
    PG8_STAGE(PG8_SB(1, 0), cB + kstep, voffB); PG8_STAGE(PG8_SA(1, 0), cA + kstep, voffA); PG8_STAGE(PG8_SB(1, 1), cB + hstepB + kstep, voffB);
    PG8_WAIT_V(6); PG8_BAR;
    for (;;) {
        const bool has_next = S.next(ui + 1, nxt);
        const char* nA = cA; const char* nB = cB; if (has_next) S.ptrs(nxt, nA, nB);
        for (int t = 0; t < nt; t += 2) {
            const bool last = (t == nt - 2);
            const char* a1 = cA + (size_t)(t + 1) * kstep;
            const char* a2 = last ? nA : cA + (size_t)(t + 2) * kstep; const char* b2 = last ? nB : cB + (size_t)(t + 2) * kstep;
            const char* a3 = a2 + kstep; const char* b3 = b2 + kstep;
            PG8_LDB(B0, 0, 0); PG8_SCHED; PG8_LDA(At, 0, 0); PG8_STAGE(PG8_SA(1, 1), a1 + hstepA, voffA);
            PG8_WAIT_L(8); PG8_BAR; PG8_WAIT_L(0); PG8_MMA(0, 0, At, B0); PG8_BAR; PG8_SCHED;
            PG8_LDB(B1, 0, 1); PG8_STAGE(PG8_SB(0, 0), b2, voffB);
            PG8_BAR; PG8_WAIT_L(0); PG8_MMA(0, 1, At, B1); PG8_BAR;
            PG8_LDA(At, 0, 1); PG8_STAGE(PG8_SA(0, 0), a2, voffA);
            PG8_BAR; PG8_WAIT_L(0); PG8_MMA(1, 0, At, B0); PG8_BAR; PG8_SCHED;
            PG8_STAGE(PG8_SB(0, 1), b2 + hstepB, voffB);
            PG8_WAIT_V(6); PG8_BAR; PG8_MMA(1, 1, At, B1); PG8_BAR;
            PG8_LDB(B0, 1, 0); PG8_SCHED; PG8_LDA(At, 1, 0); PG8_STAGE(PG8_SA(0, 1), a2 + hstepA, voffA);
            PG8_WAIT_L(8); PG8_BAR; PG8_WAIT_L(0); PG8_MMA(0, 0, At, B0); PG8_BAR; PG8_SCHED;
            PG8_LDB(B1, 1, 1); PG8_STAGE(PG8_SB(1, 0), b3, voffB);
            PG8_BAR; PG8_WAIT_L(0); PG8_MMA(0, 1, At, B1); PG8_BAR;
            PG8_LDA(At, 1, 1); PG8_STAGE(PG8_SA(1, 0), a3, voffA);
            PG8_BAR; PG8_WAIT_L(0); PG8_MMA(1, 0, At, B0); PG8_BAR; PG8_SCHED;
            PG8_STAGE(PG8_SB(1, 1), b3 + hstepB, voffB);
            PG8_WAIT_V(6); PG8_BAR; PG8_MMA(1, 1, At, B1); PG8_BAR;
        }
        { int fr2 = fr, fq2 = fq; asm volatile("" : "+v"(fr2), "+v"(fq2)); E(acc, cur, wr, wc, fr2, fq2); }
        if (!has_next) break;
#pragma unroll
        for (int a = 0; a < 2; ++a)
#pragma unroll
            for (int b = 0; b < 2; ++b)
#pragma unroll
                for (int m = 0; m < 4; ++m)
#pragma unroll
                    for (int n = 0; n < 2; ++n) acc[a][b][m][n] = (f32x4){0.f, 0.f, 0.f, 0.f};
        cur = nxt; cA = nA; cB = nB; ++ui;
    }
    PG8_WAIT_V(0);
    if (wr == 0) PG8_BAR;
    PG8_BAR;
#undef PG8_SA
#undef PG8_SB
#undef PG8_STAGE
#undef PG8_LDA
#undef PG8_LDB
#undef PG8_MMA
#undef PG8_WAIT_V
#undef PG8_WAIT_L
#undef PG8_BAR
#undef PG8_SCHED
}
}
using pg8::Unit;

struct Params {
    const float* in[21];
    float* out;
    unsigned char* ws;
    int ph_lo, ph_hi;
    int use_bar, pad;
};
enum { I_X = 0, I_LN_MIX_E, I_W_IN_E, I_LN_Q, I_W_UQ, I_LN_KV, I_W_UKV, I_B_F, I_W_OUT_E, I_LN_MIX_O, I_W_IN_O, I_W_OUT_O, I_LN_FFN, I_W_RG, I_B_RG, I_W_RE, I_B_RE, I_W_GATE, I_W_UP, I_W_DOWN, I_LN_F };

#define WSP(T_, off) ((T_*)(ws_ + (off)))
typedef const Params __attribute__((address_space(4)))* KParams;
#define P_OPAQUE KParams Pk_ = (KParams)__builtin_amdgcn_kernarg_segment_ptr(); asm volatile("" : "+s"(Pk_)); const Params& P = *(const Params*)Pk_
#define WS_OPAQUE P_OPAQUE; unsigned char* ws_ = P.ws

__device__ __forceinline__ float log2_gamma(int h) { return __builtin_log2f(1.0f - __builtin_exp2f(-5.0f - (float)h)); }

struct DenseSched {
    pg8::DenseOrder O; const char* A; const char* B; size_t astep, bstep;
    __device__ __forceinline__ void init(const void* A_, int lda, const void* B_, int ldb, int nM, int nN, int G, int c) {
        O.init(nM, nN, G, c); A = (const char*)A_; B = (const char*)B_; astep = (size_t)256 * lda * 2; bstep = (size_t)256 * ldb * 2; }
    __device__ __forceinline__ bool next(int i, Unit& u) const { return O.tile(i, u); }
    __device__ __forceinline__ void ptrs(const Unit& u, const char*& a, const char*& b) const { a = A + (size_t)u.pm * astep; b = B + (size_t)u.pn * bstep; }
};
struct MoeSched {
    const char* A; const char* B; const int* tilee; size_t astep, estep, bstep; int ntile, G, c;
    __device__ __forceinline__ void init(const void* A_, int lda, const void* B_, int ldb, size_t expert_rows, const int* tilee_, int G_, int c_) {
        A = (const char*)A_; B = (const char*)B_; tilee = tilee_; astep = (size_t)256 * lda * 2; bstep = (size_t)256 * ldb * 2; estep = expert_rows * ldb * 2; G = G_; c = c_;
        ntile = __builtin_amdgcn_readfirstlane(ld_i(tilee_ + 300)); }
    __device__ __forceinline__ bool next(int i, Unit& u) const { const int L = i * G + c; if (L >= ntile * 4) return false; u.pm = L >> 2; u.pn = L & 3; u.aux = __builtin_amdgcn_readfirstlane(ld_i(tilee + (L >> 2))); return true; }
    __device__ __forceinline__ void ptrs(const Unit& u, const char*& a, const char*& b) const { a = A + (size_t)u.pm * astep; b = B + (size_t)u.aux * estep + (size_t)u.pn * bstep; }
};

typedef const f32x4 (&AccRef)[2][2][4][2];
#define EPI_LOOP_AI_M for (int ai = 0; ai < 2; ++ai) _Pragma("unroll") for (int m = 0; m < 4; ++m)
#define EPI_LOOP_BJ_N for (int bj = 0; bj < 2; ++bj) _Pragma("unroll") for (int n = 0; n < 2; ++n)

struct EpiA1a {
    static constexpr bool PERM = false;
    const float* rs0; bf16_t* Z; float* PQ; float* PKV; bf16_t* KA; float* LF; const float* bf; bf16_t* QF; bf16_t* KF; const f32x2* rope;
    __device__ __forceinline__ void operator()(AccRef acc, const Unit& u, int wr, int wc, int fr, int fq) const {
        const int row0 = u.pm * 256 + wr * 64 + fr; float rsv[2][4];
#pragma unroll
        EPI_LOOP_AI_M rsv[ai][m] = rs0[row0 + ai * 128 + m * 16];
        if (u.pn <= 1) {
            const int zc = u.pn * 256 + wc * 32 + 4 * fq;
#pragma unroll
            EPI_LOOP_AI_M { const int r = row0 + ai * 128 + m * 16; const float rs = rsv[ai][m]; float ss = 0.f; f32x4 v[2][2];
#pragma unroll
                EPI_LOOP_BJ_N { v[bj][n] = acc[ai][bj][m][n] * rs; u32x2 w; w.x = pk2(v[bj][n][0], v[bj][n][1]); w.y = pk2(v[bj][n][2], v[bj][n][3]);
                    *(u32x2*)(Z + (size_t)r * 512 + zc + bj * 128 + n * 16) = w;
                    if (u.pn == 0 || bj == 0) ss += (v[bj][n][0] * v[bj][n][0] + v[bj][n][1] * v[bj][n][1]) + (v[bj][n][2] * v[bj][n][2] + v[bj][n][3] * v[bj][n][3]); }
                ss += __shfl_xor(ss, 16); ss += __shfl_xor(ss, 32);
                if (fq == 0) { if (u.pn == 0) PQ[(size_t)r * 4 + wc] = ss; else PKV[(size_t)r * 4 + wc] = ss; }
                if (u.pn == 1 && wc == 0) {
                    const int pos = r & (S - 1); const f32x4 x1 = v[1][0], x2 = v[1][1]; f32x4 o1, o2;
#pragma unroll
                    for (int j = 0; j < 4; ++j) { const f32x2 cs = rope[(size_t)pos * 128 + 8 * (4 * fq + j)]; o1[j] = x1[j] * cs.x - x2[j] * cs.y; o2[j] = x1[j] * cs.y + x2[j] * cs.x; }
                    u32x2 w1, w2; w1.x = pk2(o1[0], o1[1]); w1.y = pk2(o1[2], o1[3]); w2.x = pk2(o2[0], o2[1]); w2.y = pk2(o2[2], o2[3]);
#pragma unroll
                    for (int hh = 0; hh < 8; ++hh) { bf16_t* kp = KA + (size_t)r * 768 + hh * 96 + 64 + 4 * fq; *(u32x2*)kp = w1; *(u32x2*)(kp + 16) = w2; }
                }
                if (u.pn == 1 && wc == 1 && fq < 2) {
                    const f32x4 f = v[1][0]; f32x4 o;
#pragma unroll
                    for (int j = 0; j < 4; ++j) { const float x = f[j] + bf[4 * fq + j]; o[j] = fminf(x, 0.f) - log1pf(__expf(-fabsf(x))); }
                    *(f32x4*)(LF + (size_t)r * 8 + 4 * fq) = o;
                }
            }
        } else {
            const bool isq = u.pn < 4; bf16_t* dst = isq ? QF : KF; const int cc = (isq ? (u.pn - 2) : (u.pn - 4)) * 256 + wc * 32 + 4 * fq; const float sc = isq ? (0.125f * LOG2E) : 1.0f;
#pragma unroll
            EPI_LOOP_AI_M { const int r = row0 + ai * 128 + m * 16; const float rs = rsv[ai][m] * sc;
#pragma unroll
                EPI_LOOP_BJ_N { const f32x4 v = acc[ai][bj][m][n] * rs; u32x2 w; w.x = pk2(v[0], v[1]); w.y = pk2(v[2], v[3]); *(u32x2*)(dst + (size_t)r * 512 + cc + bj * 128 + n * 16) = w; } }
        }
    }
};
template <int MODE> struct EpiVT {
    static constexpr bool PERM = true;
    const float* rs; bf16_t* OUT; size_t ldo;
    __device__ __forceinline__ float cs(int t) const { if (MODE == 0) return rs[t]; const f32x4 p = *(const f32x4*)(rs + (size_t)t * 4); return rsqrt_f(((p[0] + p[1]) + (p[2] + p[3])) * (1.0f / 128.0f) + EPS); }
    __device__ __forceinline__ void operator()(AccRef acc, const Unit& u, int wr, int wc, int fr, int fq) const {
        const int f0 = u.pm * 256 + wr * 64 + fr, t0 = u.pn * 256 + wc * 32 + 8 * fq;
#pragma unroll
        for (int bj = 0; bj < 2; ++bj) { float c[8];
#pragma unroll
            for (int j = 0; j < 8; ++j) c[j] = cs(t0 + bj * 128 + j);
#pragma unroll
            EPI_LOOP_AI_M { const f32x4 a = acc[ai][bj][m][0], b = acc[ai][bj][m][1]; u32x4 w;
                w.x = pk2(a[0] * c[0], a[1] * c[1]); w.y = pk2(a[2] * c[2], a[3] * c[3]); w.z = pk2(b[0] * c[4], b[1] * c[5]); w.w = pk2(b[2] * c[6], b[3] * c[7]);
                const int f_ = f0 + ai * 128 + m * 16, t_ = t0 + bj * 128;
                *(u32x4*)(OUT + (((size_t)(f_ >> 6) * (T / 64) + (t_ >> 6)) * 64 + (f_ & 63)) * 64 + (t_ & 63)) = w; } }
    }
};
struct EpiA2q {
    static constexpr bool PERM = false;
    const float* PQ; bf16_t* QA; const f32x2* rope;
    __device__ __forceinline__ void operator()(AccRef acc, const Unit& u, int wr, int wc, int fr, int fq) const {
        if (wc == 3) return;
        const int row0 = u.pm * 256 + wr * 64 + fr; const float SCA = 0.10206207261596577f * LOG2E;
        f32x4 pv[2][4];
#pragma unroll
        EPI_LOOP_AI_M pv[ai][m] = *(const f32x4*)(PQ + (size_t)(row0 + ai * 128 + m * 16) * 4);
#pragma unroll
        for (int ai = 0; ai < 2; ++ai) { f32x2 csv[4][4];
            if (wc == 2) {
#pragma unroll
                for (int m = 0; m < 4; ++m)
#pragma unroll
                    for (int j = 0; j < 4; ++j) csv[m][j] = rope[(size_t)((row0 + ai * 128 + m * 16) & (S - 1)) * 128 + 8 * (4 * fq + j)]; }
#pragma unroll
            for (int m = 0; m < 4; ++m) { const int r = row0 + ai * 128 + m * 16; const f32x4 p = pv[ai][m];
                const float rs = rsqrt_f(((p[0] + p[1]) + (p[2] + p[3])) * (1.0f / 256.0f) + EPS) * SCA;
#pragma unroll
                for (int bj = 0; bj < 2; ++bj) { const int hh = 2 * u.pn + bj; bf16_t* qp = QA + (size_t)r * 768 + hh * 96 + wc * 32 + 4 * fq; f32x4 x1 = acc[ai][bj][m][0] * rs, x2 = acc[ai][bj][m][1] * rs;
                    if (wc == 2) {
#pragma unroll
                        for (int j = 0; j < 4; ++j) { const f32x2 cs = csv[m][j]; const float a = x1[j], b = x2[j]; x1[j] = a * cs.x - b * cs.y; x2[j] = a * cs.y + b * cs.x; } }
                    *(u32x2*)qp = (u32x2){pk2(x1[0], x1[1]), pk2(x1[2], x1[3])}; *(u32x2*)(qp + 16) = (u32x2){pk2(x2[0], x2[1]), pk2(x2[2], x2[3])}; } } }
    }
};
struct EpiA2k {
    static constexpr bool PERM = false;
    const float* PKV; bf16_t* KA;
    __device__ __forceinline__ void operator()(AccRef acc, const Unit& u, int wr, int wc, int fr, int fq) const {
        const int row0 = u.pm * 256 + wr * 64 + fr; f32x4 pv[2][4];
#pragma unroll
        EPI_LOOP_AI_M pv[ai][m] = *(const f32x4*)(PKV + (size_t)(row0 + ai * 128 + m * 16) * 4);
#pragma unroll
        EPI_LOOP_AI_M { const int r = row0 + ai * 128 + m * 16; const f32x4 p = pv[ai][m];
            const float rs = rsqrt_f(((p[0] + p[1]) + (p[2] + p[3])) * (1.0f / 128.0f) + EPS);
#pragma unroll
            EPI_LOOP_BJ_N { const int hh = 4 * u.pn + 2 * bj + (wc >> 1), dd = 32 * (wc & 1) + 16 * n + 4 * fq; const f32x4 v = acc[ai][bj][m][n] * rs;
                *(u32x2*)(KA + (size_t)r * 768 + hh * 96 + dd) = (u32x2){pk2(v[0], v[1]), pk2(v[2], v[3])}; } }
    }
};
struct EpiRes {
    static constexpr bool PERM = false;
    const float* base; float* outp;
    __device__ __forceinline__ void operator()(AccRef acc, const Unit& u, int wr, int wc, int fr, int fq) const {
        const int row0 = u.pm * 256 + wr * 64 + fr, col0 = u.pn * 256 + wc * 32 + 4 * fq;
#pragma unroll
        for (int ai = 0; ai < 2; ++ai) { f32x4 b[4][2][2];
#pragma unroll
            for (int m = 0; m < 4; ++m)
#pragma unroll
                EPI_LOOP_BJ_N b[m][bj][n] = *(const f32x4*)(base + (size_t)(row0 + ai * 128 + m * 16) * D + col0 + bj * 128 + n * 16);
#pragma unroll
            for (int m = 0; m < 4; ++m)
#pragma unroll
                EPI_LOOP_BJ_N *(f32x4*)(outp + (size_t)(row0 + ai * 128 + m * 16) * D + col0 + bj * 128 + n * 16) = b[m][bj][n] + acc[ai][bj][m][n]; }
    }
};
struct EpiB1q {
    static constexpr bool PERM = false;
    const float* rs2; bf16_t* QX; const f32x2* rope;
    __device__ __forceinline__ void operator()(AccRef acc, const Unit& u, int wr, int wc, int fr, int fq) const {
        const int row0 = u.pm * 256 + wr * 64 + fr; const float l2g = log2_gamma(u.pn); float rsv[2][4];
#pragma unroll
        EPI_LOOP_AI_M rsv[ai][m] = rs2[row0 + ai * 128 + m * 16];
#pragma unroll
        for (int ai = 0; ai < 2; ++ai)
#pragma unroll
            for (int mp = 0; mp < 2; ++mp) { f32x4 ca[2][2], cb[2][2];
#pragma unroll
                for (int mm = 0; mm < 2; ++mm)
#pragma unroll
                    for (int n = 0; n < 2; ++n) { const int pos = row0 + ai * 128 + (2 * mp + mm) * 16, i0 = wc * 32 + 16 * n + 4 * fq; ca[mm][n] = *(const f32x4*)(rope + (size_t)pos * 128 + i0); cb[mm][n] = *(const f32x4*)(rope + (size_t)pos * 128 + i0 + 2); }
#pragma unroll
                for (int mm = 0; mm < 2; ++mm) { const int m = 2 * mp + mm, pos = row0 + ai * 128 + m * 16; const float rs = rsv[ai][m] * __builtin_exp2f((float)((pos & 63) + 1) * l2g);
#pragma unroll
                    for (int n = 0; n < 2; ++n) { const int i0 = wc * 32 + 16 * n + 4 * fq; const f32x4 x1 = acc[ai][0][m][n] * rs, x2 = acc[ai][1][m][n] * rs; f32x4 o1, o2;
                        const float cc[4] = {ca[mm][n][0], ca[mm][n][2], cb[mm][n][0], cb[mm][n][2]}, sn[4] = {ca[mm][n][1], ca[mm][n][3], cb[mm][n][1], cb[mm][n][3]};
#pragma unroll
                        for (int j = 0; j < 4; ++j) { o1[j] = x1[j] * cc[j] - x2[j] * sn[j]; o2[j] = x1[j] * sn[j] + x2[j] * cc[j]; }
                        bf16_t* qp = QX + (size_t)pos * 1024 + u.pn * 256 + i0; *(u32x2*)qp = (u32x2){pk2(o1[0], o1[1]), pk2(o1[2], o1[3])}; *(u32x2*)(qp + 128) = (u32x2){pk2(o2[0], o2[1]), pk2(o2[2], o2[3])}; } } }
    }
};
__device__ __forceinline__ int rho_of_d(int d) { const int lo = d & 31; return (d & ~31) | (((lo >> 2) & 1) << 4) | ((lo >> 3) << 2) | (lo & 3); }
struct EpiB1k {
    static constexpr bool PERM = true;
    const float* rs2; bf16_t* KN; bf16_t* KZT; const f32x2* rope; LAS unsigned char* scr;
    __device__ __forceinline__ void operator()(AccRef acc, const Unit& u, int wr, int wc, int fr, int fq) const {
        const int h = u.pm, t0 = u.pn * 256 + wc * 32 + 8 * fq; const float l2g = log2_gamma(h);
        LAS unsigned char* my = scr + (wr * 4 + wc) * 1024; const int lane = fq * 16 + fr;
#pragma unroll
        for (int bj = 0; bj < 2; ++bj) { const int tb = t0 + bj * 128; float rs[8], zt[8];
#pragma unroll
            for (int j = 0; j < 8; ++j) { rs[j] = rs2[tb + j] * 0.0625f; zt[j] = __builtin_exp2f((float)(63 - ((tb + j) & 63)) * l2g); }
            const int chunk = tb >> 6, c0 = tb & 63;
            f32x2 csv[4][8];
#pragma unroll
            for (int m = 0; m < 4; ++m)
#pragma unroll
                for (int j = 0; j < 8; ++j) csv[m][j] = rope[(size_t)(tb + j) * 128 + wr * 64 + m * 16 + fr];
#pragma unroll
            for (int m = 0; m < 4; ++m) { const int d = wr * 64 + m * 16 + fr; float k1[8], k2[8];
#pragma unroll
                for (int j = 0; j < 8; ++j) { const f32x2 cs = csv[m][j]; const float x1 = acc[0][bj][m][j >> 2][j & 3] * rs[j], x2 = acc[1][bj][m][j >> 2][j & 3] * rs[j];
                    k1[j] = x1 * cs.x - x2 * cs.y; k2[j] = x1 * cs.y + x2 * cs.x; }
                const int rho = rho_of_d(d); u32x4 w1, w2;
                w1.x = pk2(k1[0] * zt[0], k1[1] * zt[1]); w1.y = pk2(k1[2] * zt[2], k1[3] * zt[3]); w1.z = pk2(k1[4] * zt[4], k1[5] * zt[5]); w1.w = pk2(k1[6] * zt[6], k1[7] * zt[7]);
                w2.x = pk2(k2[0] * zt[0], k2[1] * zt[1]); w2.y = pk2(k2[2] * zt[2], k2[3] * zt[3]); w2.z = pk2(k2[4] * zt[4], k2[5] * zt[5]); w2.w = pk2(k2[6] * zt[6], k2[7] * zt[7]);
                bf16_t* zp = KZT + (((size_t)(h * 256 + chunk) * 256 + rho) * 64 + c0); *(u32x4*)zp = w1; *(u32x4*)(zp + 128 * 64) = w2;
#pragma unroll
                for (int half = 0; half < 2; ++half) { const float* kk = half ? k2 : k1;
#pragma unroll
                    for (int j = 0; j < 8; ++j) *(LAS bf16_t*)(my + (8 * fq + j) * 32 + fr * 2) = (bf16_t)f2bf(kk[j]);
                    asm volatile("s_waitcnt lgkmcnt(0)" ::: "memory");
                    const u32x4 v = *(const LAS u32x4*)(my + (lane >> 1) * 32 + (lane & 1) * 16);
                    const int tok = u.pn * 256 + wc * 32 + bj * 128 + (lane >> 1);
                    *(u32x4*)(KN + (size_t)tok * 1024 + h * 256 + half * 128 + wr * 64 + m * 16 + (lane & 1) * 8) = v;
                    asm volatile("s_waitcnt lgkmcnt(0)" ::: "memory"); } } }
    }
};
struct EpiB1v {
    static constexpr bool PERM = true;
    const float* rs2; bf16_t* VT;
    __device__ __forceinline__ void operator()(AccRef acc, const Unit& u, int wr, int wc, int fr, int fq) const {
        const int h = u.pm >> 1, e0 = (u.pm & 1) * 256 + wr * 64 + fr, t0 = u.pn * 256 + wc * 32 + 8 * fq;
#pragma unroll
        for (int bj = 0; bj < 2; ++bj) { const int tb = t0 + bj * 128; float c[8];
#pragma unroll
            for (int j = 0; j < 8; ++j) c[j] = rs2[tb + j];
            const int chunk = tb >> 6, c0 = tb & 63;
#pragma unroll
            EPI_LOOP_AI_M { const f32x4 a = acc[ai][bj][m][0], b = acc[ai][bj][m][1]; u32x4 w;
                w.x = pk2(a[0] * c[0], a[1] * c[1]); w.y = pk2(a[2] * c[2], a[3] * c[3]); w.z = pk2(b[0] * c[4], b[1] * c[5]); w.w = pk2(b[2] * c[6], b[3] * c[7]);
                *(u32x4*)(VT + (((size_t)(h * 256 + chunk) * 512 + e0 + ai * 128 + m * 16) * 64 + c0)) = w; } }
    }
};
struct EpiG {
    static constexpr bool PERM = true;
    const float* rs2; const float* PO; bf16_t* O;
    __device__ __forceinline__ void operator()(AccRef acc, const Unit& u, int wr, int wc, int fr, int fq) const {
        const int row0 = u.pm * 256 + wr * 64 + fr, col0 = u.pn * 256 + wc * 32 + 8 * fq, head = u.pn >> 1;
        f32x4 pv[2][4]; float rsv[2][4];
#pragma unroll
        EPI_LOOP_AI_M { const int r = row0 + ai * 128 + m * 16; pv[ai][m] = *(const f32x4*)(PO + (size_t)r * 16 + head * 4); rsv[ai][m] = rs2[r]; }
#pragma unroll
        for (int ai = 0; ai < 2; ++ai) { u32x4 ov[4][2];
#pragma unroll
            for (int m = 0; m < 4; ++m)
#pragma unroll
                for (int bj = 0; bj < 2; ++bj) ov[m][bj] = *(const u32x4*)(O + (size_t)(row0 + ai * 128 + m * 16) * 2048 + col0 + bj * 128);
#pragma unroll
            for (int m = 0; m < 4; ++m) { const f32x4 p = pv[ai][m]; const float ro = rsqrt_f(((p[0] + p[1]) + (p[2] + p[3])) * (1.0f / 512.0f) + EPS), rs = rsv[ai][m];
#pragma unroll
                for (int bj = 0; bj < 2; ++bj) { const u32x4 o4 = ov[m][bj]; const float o[8] = {bflo(o4.x), bfhi(o4.x), bflo(o4.y), bfhi(o4.y), bflo(o4.z), bfhi(o4.z), bflo(o4.w), bfhi(o4.w)}; float a[8];
#pragma unroll
                    for (int j = 0; j < 8; ++j) { const float g = acc[ai][bj][m][j >> 2][j & 3] * rs; a[j] = o[j] * ro * g / (1.0f + __expf(-g)); }
                    *(u32x4*)(O + (size_t)(row0 + ai * 128 + m * 16) * 2048 + col0 + bj * 128) = (u32x4){pk2(a[0], a[1]), pk2(a[2], a[3]), pk2(a[4], a[5]), pk2(a[6], a[7])}; } } }
    }
};
struct EpiM3 {
    static constexpr bool PERM = true;
    const float* SR; bf16_t* HID;
    __device__ __forceinline__ void operator()(AccRef acc, const Unit& u, int wr, int wc, int fr, int fq) const {
        const int row0 = u.pm * 256 + wr * 64 + fr, col0 = u.pn * 128 + wc * 32 + 8 * fq; float rsv[2][4];
#pragma unroll
        EPI_LOOP_AI_M rsv[ai][m] = SR[row0 + ai * 128 + m * 16];
#pragma unroll
        EPI_LOOP_AI_M { const int r = row0 + ai * 128 + m * 16; const float rs = rsv[ai][m]; float hh[8];
#pragma unroll
            for (int j = 0; j < 8; ++j) { const float g = acc[ai][0][m][j >> 2][j & 3] * rs, up = acc[ai][1][m][j >> 2][j & 3] * rs; hh[j] = g / (1.0f + __expf(-g)) * up; }
            u32x4 w; w.x = pk2(hh[0], hh[1]); w.y = pk2(hh[2], hh[3]); w.z = pk2(hh[4], hh[5]); w.w = pk2(hh[6], hh[7]); *(u32x4*)(HID + (size_t)r * 512 + col0) = w; }
    }
};
struct EpiM4 {
    static constexpr bool PERM = true;
    const float* SW; bf16_t* YS;
    __device__ __forceinline__ void operator()(AccRef acc, const Unit& u, int wr, int wc, int fr, int fq) const {
        const int row0 = u.pm * 256 + wr * 64 + fr, col0 = u.pn * 256 + wc * 32 + 8 * fq; float swv[2][4];
#pragma unroll
        EPI_LOOP_AI_M swv[ai][m] = SW[row0 + ai * 128 + m * 16];
#pragma unroll
        EPI_LOOP_AI_M { const int r = row0 + ai * 128 + m * 16; const float sw = swv[ai][m];
#pragma unroll
            for (int bj = 0; bj < 2; ++bj) { const f32x4 a = acc[ai][bj][m][0] * sw, b = acc[ai][bj][m][1] * sw; u32x4 w; w.x = pk2(a[0], a[1]); w.y = pk2(a[2], a[3]); w.z = pk2(b[0], b[1]); w.w = pk2(b[2], b[3]);
                *(u32x4*)(YS + (size_t)r * 1024 + col0 + bj * 128) = w; } }
    }
};

__device__ __forceinline__ int crow(int r, int hi) { return (r & 3) + 8 * (r >> 2) + 4 * hi; }
template <int DQK, bool FOX>
__device__ __forceinline__ void attn_unit(int wave_, LAS unsigned char* L, const bf16_t* Qb, int ldq, const bf16_t* Kb, int ldk, const bf16_t* Vtb, const float* cum, const float* knrm, bf16_t* Ob, int ldo, int qb) {
    constexpr int KP = DQK + 8, KBYTES = 64 * KP * 2, VBYTES = 64 * 136, BUF = KBYTES + VBYTES + 256, NS = DQK / 16, KCH = DQK / 8;
    constexpr int XOFF = 3 * BUF;
    constexpr float THR = 8.0f;
    const int tid = wave_ * 64 + lane_id_opaque();
    const int lane = tid & 63, w = wave_, r32 = lane & 31, hi = lane >> 5;
    const int R0 = 256 * qb + 32 * w, q = R0 + r32, NT = 4 * qb + 4, jmax = 4 * qb + (w >> 1);
    bf16x8 qf[NS];
#pragma unroll
    for (int s = 0; s < NS; ++s) qf[s] = *(const bf16x8*)(Qb + (size_t)q * ldq + 16 * s + 8 * hi);
    const float cq = FOX ? cum[q] : 0.f;
    int j0 = 0;
    if (FOX) {
        float n2 = 0.f;
#pragma unroll
        for (int s = 0; s < NS; ++s)
#pragma unroll
            for (int e = 0; e < 8; ++e) { const float x = bf2f((unsigned short)qf[s][e]); n2 += x * x; }
        n2 += __shfl_xor(n2, 32);
#pragma unroll
        for (int o = 1; o < 32; o <<= 1) n2 = fmaxf(n2, __shfl_xor(n2, o));
        LAS float* xs = (LAS float*)(L + XOFF); LAS int* xj = (LAS int*)(L + XOFF + 32);
        if (lane == 0) xs[w] = n2;
        if (tid == 0) xj[0] = 4 * qb;
        __syncthreads();
        float qn = xs[0];
#pragma unroll
        for (int i = 1; i < 8; ++i) qn = fmaxf(qn, xs[i]);
        qn = sqrtf(qn) * 1.01f;
        if (tid < NT) { const float bound = qn * knrm[tid] * 1.01f + cum[256 * qb] - cum[64 * tid + 63]; if (bound >= -160.0f) atomicMin((int*)xj, tid); }
        __syncthreads();
        j0 = xj[0];
    }
    f32x16 o0 = {}, o1 = {}; float mhat = 0.f, lrun = 0.f;
    const int kr0 = tid / KCH, kc0 = tid % KCH, kr1 = (tid + 512) / KCH, kc1 = (tid + 512) % KCH; const bool has1 = (tid + 512) < 64 * KCH;
    const int ve = tid >> 3, vc = tid & 7;
    u32x4 kreg0A, kreg1A = {}, vregA, kreg0B, kreg1B = {}, vregB; float ckregA = 0.f, ckregB = 0.f;
    const int kr1c = has1 ? kr1 : kr0, kc1c = has1 ? kc1 : kc0; const int ckl = tid & 63;
#define ATT_SLOT(i) (((i) % 3) * BUF)
#define ATT_LOADK(j, X) do { const int j_ = (j) < NT ? (j) : NT - 1; kreg0##X = *(const u32x4*)(Kb + (size_t)(64 * j_ + kr0) * ldk + kc0 * 8); if (DQK > 64) kreg1##X = *(const u32x4*)(Kb + (size_t)(64 * j_ + kr1c) * ldk + kc1c * 8); \
        if (FOX) ckreg##X = cum[64 * j_ + ckl]; } while (0)
#define ATT_LOADV(j, X) do { const int j_ = (j) < NT ? (j) : NT - 1; vreg##X = *(const u32x4*)(Vtb + (size_t)j_ * 4096 + ve * 64 + vc * 8); } while (0)
#define ATT_WRITEK(bo, X) do { *(LAS u32x4*)(L + (bo) + kr0 * (KP * 2) + kc0 * 16) = kreg0##X; if (DQK > 64) { if (has1) *(LAS u32x4*)(L + (bo) + kr1 * (KP * 2) + kc1 * 16) = kreg1##X; } \
        if (FOX && tid < 64) *(LAS float*)(L + (bo) + KBYTES + VBYTES + tid * 4) = ckreg##X; } while (0)
#define ATT_WRITEV(bo, X) do { *(LAS u32x2*)(L + (bo) + KBYTES + ve * 136 + vc * 16) = (u32x2){vreg##X.x, vreg##X.y}; *(LAS u32x2*)(L + (bo) + KBYTES + ve * 136 + vc * 16 + 8) = (u32x2){vreg##X.z, vreg##X.w}; } while (0)
    bf16x8 kf[2 * NS]; f32x4 ckv[8]; u32x2 vfr[16]; f32x16 s0, s1; u32x4 pw[4]; float rm = 0.f;
#define ATT_QK_ISSUE(bo) do { \
        _Pragma("unroll") for (int s = 0; s < NS; ++s) { kf[2 * s] = *(const LAS bf16x8*)(L + (bo) + r32 * (KP * 2) + (16 * s + 8 * hi) * 2); kf[2 * s + 1] = *(const LAS bf16x8*)(L + (bo) + (32 + r32) * (KP * 2) + (16 * s + 8 * hi) * 2); } \
        if (FOX) { _Pragma("unroll") for (int g = 0; g < 4; ++g) { ckv[g] = *(const LAS f32x4*)(L + (bo) + KBYTES + VBYTES + (8 * g + 4 * hi) * 4); ckv[4 + g] = *(const LAS f32x4*)(L + (bo) + KBYTES + VBYTES + (32 + 8 * g + 4 * hi) * 4); } } } while (0)
#define ATT_QK_MMA(S0, S1) do { \
        if (FOX) { const float cqm = cq - mhat; \
            _Pragma("unroll") for (int g = 0; g < 4; ++g) { _Pragma("unroll") for (int e = 0; e < 4; ++e) { S0[4 * g + e] = cqm - ckv[g][e]; S1[4 * g + e] = cqm - ckv[4 + g][e]; } } \
        } else { _Pragma("unroll") for (int r = 0; r < 16; ++r) { S0[r] = -mhat; S1[r] = -mhat; } } \
        _Pragma("unroll") for (int s = 0; s < NS; ++s) { S0 = __builtin_amdgcn_mfma_f32_32x32x16_bf16(kf[2 * s], qf[s], S0, 0, 0, 0); S1 = __builtin_amdgcn_mfma_f32_32x32x16_bf16(kf[2 * s + 1], qf[s], S1, 0, 0, 0); } } while (0)
#define ATT_PV_ISSUE(bo) do { _Pragma("unroll") for (int ks = 0; ks < 4; ++ks) { const LAS unsigned char* vb = L + (bo) + KBYTES + r32 * 136 + 32 * ks + 8 * hi; \
            vfr[4 * ks] = *(const LAS u32x2*)(vb); vfr[4 * ks + 1] = *(const LAS u32x2*)(vb + 16); vfr[4 * ks + 2] = *(const LAS u32x2*)(vb + 32 * 136); vfr[4 * ks + 3] = *(const LAS u32x2*)(vb + 32 * 136 + 16); } } while (0)
#define ATT_PV_MMA() do { _Pragma("unroll") for (int ks = 0; ks < 4; ++ks) { \
            const bf16x8 va = __builtin_bit_cast(bf16x8, (u32x4){vfr[4 * ks].x, vfr[4 * ks].y, vfr[4 * ks + 1].x, vfr[4 * ks + 1].y}), vbb = __builtin_bit_cast(bf16x8, (u32x4){vfr[4 * ks + 2].x, vfr[4 * ks + 2].y, vfr[4 * ks + 3].x, vfr[4 * ks + 3].y}), pf = __builtin_bit_cast(bf16x8, pw[ks]); \
            o0 = __builtin_amdgcn_mfma_f32_32x32x16_bf16(va, pf, o0, 0, 0, 0); o1 = __builtin_amdgcn_mfma_f32_32x32x16_bf16(vbb, pf, o1, 0, 0, 0); } } while (0)
#define ATT_M(t) do { const int t_ = (t); const bool doPV = (t_ - 1 >= j0) && (t_ - 1 <= jmax), doQK = (t_ < NT) && (t_ <= jmax); \
        if (doPV) { ATT_PV_ISSUE(ATT_SLOT(t_ - 1)); __builtin_amdgcn_sched_barrier(0); asm volatile("s_waitcnt lgkmcnt(0)" ::: "memory"); __builtin_amdgcn_sched_barrier(0); ATT_PV_MMA(); } \
        if (doQK) { ATT_QK_ISSUE(ATT_SLOT(t_)); __builtin_amdgcn_sched_barrier(0); asm volatile("s_waitcnt lgkmcnt(0)" ::: "memory"); __builtin_amdgcn_sched_barrier(0); ATT_QK_MMA(s0, s1); } } while (0)
#define ATT_X(t, X) do { const int t_ = (t); \
        if (t_ <= jmax) { \
            if (FOX && t_ == jmax) { _Pragma("unroll") for (int r = 0; r < 16; ++r) { const int kg = 64 * t_ + crow(r, hi); if (kg > q) s0[r] = -1e30f; if (kg + 32 > q) s1[r] = -1e30f; } } \
            float mx_ = fmaxf(fmaxf(s0[0], s1[0]), fmaxf(s0[1], s1[1])); \
            _Pragma("unroll") for (int r = 2; r < 16; r += 2) mx_ = fmaxf(mx_, fmaxf(fmaxf(s0[r], s1[r]), fmaxf(s0[r + 1], s1[r + 1]))); \
            rm = fmaxf(mx_, __shfl_xor(mx_, 32)); \
            if (__any(rm > THR)) { const float dl = fmaxf(rm, 0.f), f = __builtin_amdgcn_exp2f(-dl); mhat += dl; lrun *= f; \
                _Pragma("unroll") for (int r = 0; r < 16; ++r) { s0[r] -= dl; s1[r] -= dl; o0[r] *= f; o1[r] *= f; } } \
            float ls0 = 0.f, ls1 = 0.f; \
            _Pragma("unroll") for (int r = 0; r < 16; ++r) { s0[r] = __builtin_amdgcn_exp2f(s0[r]); s1[r] = __builtin_amdgcn_exp2f(s1[r]); ls0 += s0[r]; ls1 += s1[r]; } \
            lrun += ls0 + ls1; \
            _Pragma("unroll") for (int ks = 0; ks < 4; ++ks) { const int b_ = 8 * (ks & 1); \
                if (ks < 2) pw[ks] = (u32x4){pk2(s0[b_], s0[b_ + 1]), pk2(s0[b_ + 2], s0[b_ + 3]), pk2(s0[b_ + 4], s0[b_ + 5]), pk2(s0[b_ + 6], s0[b_ + 7])}; \
                else        pw[ks] = (u32x4){pk2(s1[b_], s1[b_ + 1]), pk2(s1[b_ + 2], s1[b_ + 3]), pk2(s1[b_ + 4], s1[b_ + 5]), pk2(s1[b_ + 6], s1[b_ + 7])}; } } \
        if (t_ + 2 < NT) ATT_WRITEK(ATT_SLOT(t_ + 2), X); \
        if (t_ + 1 < NT) ATT_WRITEV(ATT_SLOT(t_ + 1), X); \
        ATT_LOADK(t_ + 4, X); ATT_LOADV(t_ + 3, X); } while (0)
    ATT_LOADK(j0, A); ATT_LOADV(j0, A); ATT_LOADK(j0 + 1, B);
    ATT_WRITEK(ATT_SLOT(j0), A); ATT_WRITEV(ATT_SLOT(j0), A); ATT_WRITEK(ATT_SLOT(j0 + 1), B);
    ATT_LOADK(j0 + 2, A); ATT_LOADV(j0 + 1, A); ATT_LOADK(j0 + 3, B); ATT_LOADV(j0 + 2, B);
    __syncthreads();
    const int grp = w >> 2;
    if (grp == 1) __syncthreads();
    for (int t = j0; t < NT; t += 2) {
        ATT_M(t); __syncthreads(); ATT_X(t, A); __syncthreads();
        if (t + 1 < NT) { ATT_M(t + 1); __syncthreads(); ATT_X(t + 1, B); __syncthreads(); }
    }
    ATT_M(NT);
    if (grp == 0) __syncthreads();
    __syncthreads();
#undef ATT_SLOT
#undef ATT_LOADK
#undef ATT_LOADV
#undef ATT_WRITEK
#undef ATT_WRITEV
#undef ATT_QK_ISSUE
#undef ATT_QK_MMA
#undef ATT_PV_ISSUE
#undef ATT_PV_MMA
#undef ATT_M
#undef ATT_X
    const float inv = 1.0f / (lrun + __shfl_xor(lrun, 32));
    bf16_t* op = Ob + (size_t)q * ldo + 4 * hi;
#pragma unroll
    for (int g = 0; g < 4; ++g) { u32x2 w0, w1; w0.x = pk2(o0[4 * g] * inv, o0[4 * g + 1] * inv); w0.y = pk2(o0[4 * g + 2] * inv, o0[4 * g + 3] * inv);
        w1.x = pk2(o1[4 * g] * inv, o1[4 * g + 1] * inv); w1.y = pk2(o1[4 * g + 2] * inv, o1[4 * g + 3] * inv);
        *(u32x2*)(op + 8 * g) = w0; *(u32x2*)(op + 32 + 8 * g) = w1; }
}
__device__ __forceinline__ void fox_knorm(int gw, int ngw, int lane, const bf16_t* KF, float* KNRM) {
    for (int it = gw; it < 16 * 256; it += ngw) { const int bh = it >> 8, j = it & 255, b = bh >> 3, h = bh & 7;
        const u32x4* kp = (const u32x4*)(KF + ((size_t)b * S + 64 * j + lane) * 512 + h * 64); float n2 = 0.f;
#pragma unroll
        for (int c = 0; c < 8; ++c) { const u32x4 v = kp[c]; const unsigned ww[4] = {v.x, v.y, v.z, v.w};
#pragma unroll
            for (int e = 0; e < 4; ++e) { const float a = bflo(ww[e]), bb = bfhi(ww[e]); n2 += a * a + bb * bb; } }
#pragma unroll
        for (int o = 1; o < 64; o <<= 1) n2 = fmaxf(n2, __shfl_xor(n2, o));
        if (lane == 0) KNRM[it] = sqrtf(n2); }
}

constexpr int RT_KZP = 144;
constexpr int RT_QP = 528;
constexpr int RT_OFF_KZ = 0, RT_OFF_Q = 256 * RT_KZP, RT_OFF_K = RT_OFF_Q + 64 * RT_QP, RT_OFF_P = RT_OFF_K + 64 * RT_QP, RT_OFF_SS = RT_OFF_P + 64 * RT_KZP, RT_OFF_OT = RT_OFF_SS + 64 * 8 * 4, RT_LDS = RT_OFF_OT + 64 * 272;
static_assert(RT_LDS <= 147456 - 256, "retention LDS");

__device__ __forceinline__ void ret_local(int wave_, LAS unsigned char* L, const bf16_t* KZT, const bf16_t* VT, f32x4* Lout, int u) {
    const int tid = wave_ * 64 + lane_id_opaque();
    const int lane = tid & 63, w = __builtin_amdgcn_readfirstlane(tid >> 6), l15 = lane & 15, g = lane >> 4;
    const int h = u >> 6, seg = (u >> 2) & 15, eb = u & 3, E0 = eb * 128 + w * 16;
    const float gc = __builtin_exp2f(64.0f * log2_gamma(h));
    f32x4 st[16];
#pragma unroll
    for (int i = 0; i < 16; ++i) st[i] = (f32x4){0.f, 0.f, 0.f, 0.f};
    u32x4 kz[4];
    const bf16_t* kzb = KZT + (size_t)(h * 256 + seg * SEGC) * 256 * 64;
#define R1_LOAD(ci) do { _Pragma("unroll") for (int i = 0; i < 4; ++i) kz[i] = *(const u32x4*)(kzb + (size_t)(ci) * 16384 + (size_t)(tid + 512 * i) * 8); } while (0)
#define R1_WRITE() do { _Pragma("unroll") for (int i = 0; i < 4; ++i) { const int id = tid + 512 * i; *(LAS u32x4*)(L + RT_OFF_KZ + (id >> 3) * RT_KZP + (id & 7) * 16) = kz[i]; } } while (0)
    R1_LOAD(0);
    for (int ci = 0; ci < SEGC; ++ci) {
        R1_WRITE(); __syncthreads();
        if (ci + 1 < SEGC) R1_LOAD(ci + 1);
        const bf16_t* vp = VT + ((size_t)(h * 256 + seg * SEGC + ci) * 512 + E0 + l15) * 64 + 8 * g;
        const bf16x8 vf0 = *(const bf16x8*)vp, vf1 = *(const bf16x8*)(vp + 32);
        if (ci > 0) {
#pragma unroll
            for (int i = 0; i < 16; ++i) st[i] *= gc; }
#pragma unroll
        for (int dt = 0; dt < 16; ++dt) { const LAS unsigned char* ap = L + RT_OFF_KZ + (16 * dt + l15) * RT_KZP + 16 * g;
            st[dt] = __builtin_amdgcn_mfma_f32_16x16x32_bf16(*(const LAS bf16x8*)ap, vf0, st[dt], 0, 0, 0);
            st[dt] = __builtin_amdgcn_mfma_f32_16x16x32_bf16(*(const LAS bf16x8*)(ap + 64), vf1, st[dt], 0, 0, 0); }
        __syncthreads();
    }
#undef R1_LOAD
#undef R1_WRITE
    f32x4* lo = Lout + ((size_t)(u * 8 + w) * 16) * 64 + lane;
#pragma unroll
    for (int dt = 0; dt < 16; ++dt) lo[dt * 64] = st[dt];
}

__device__ __forceinline__ void ret_scan(int wave_, LAS unsigned char* L, const bf16_t* QX, const bf16_t* KN, const bf16_t* KZT, const bf16_t* VT, const f32x4* Lin, bf16_t* O  , float* PO  , int u) {
    const int tid = wave_ * 64 + lane_id_opaque();
    const int lane = tid & 63, w = __builtin_amdgcn_readfirstlane(tid >> 6), l15 = lane & 15, g = lane >> 4;
    const int h = u >> 6, seg = (u >> 2) & 15, eb = u & 3, E0 = eb * 128 + w * 16;
    const float l2g = log2_gamma(h), gc = __builtin_exp2f(64.0f * l2g);
    f32x4 st[16];
#pragma unroll
    for (int i = 0; i < 16; ++i) st[i] = (f32x4){0.f, 0.f, 0.f, 0.f};
    for (int j = 0; j < seg; ++j) { const float wj = __builtin_exp2f((float)(64 * SEGC * (seg - 1 - j)) * l2g); const int uj = (u & ~(15 << 2)) | (j << 2);
        const f32x4* li = Lin + ((size_t)(uj * 8 + w) * 16) * 64 + lane;
#pragma unroll
        for (int dt = 0; dt < 16; ++dt) st[dt] += li[dt * 64] * wj; }
    u32x4 kz[4], qx[4], kn[4];
    const bf16_t* kzb = KZT + (size_t)(h * 256 + seg * SEGC) * 256 * 64;
    const bf16_t* qb = QX + (size_t)(seg * SEGC * 64) * 1024 + h * 256; const bf16_t* kb = KN + (size_t)(seg * SEGC * 64) * 1024 + h * 256;
#define R2_LOADKZ(ci) do { _Pragma("unroll") for (int i = 0; i < 4; ++i) { const int id = tid + 512 * i; kz[i] = *(const u32x4*)(kzb + (size_t)(ci) * 16384 + (size_t)id * 8); } } while (0)
#define R2_LOADQK(ci) do { _Pragma("unroll") for (int i = 0; i < 4; ++i) { const int id = tid + 512 * i; \
        qx[i] = *(const u32x4*)(qb + (size_t)((ci) * 64 + (id >> 5)) * 1024 + (id & 31) * 8); kn[i] = *(const u32x4*)(kb + (size_t)((ci) * 64 + (id >> 5)) * 1024 + (id & 31) * 8); } } while (0)
#define R2_WRITE() do { _Pragma("unroll") for (int i = 0; i < 4; ++i) { const int id = tid + 512 * i; *(LAS u32x4*)(L + RT_OFF_KZ + (id >> 3) * RT_KZP + (id & 7) * 16) = kz[i]; \
        *(LAS u32x4*)(L + RT_OFF_Q + (id >> 5) * RT_QP + (id & 31) * 16) = qx[i]; *(LAS u32x4*)(L + RT_OFF_K + (id >> 5) * RT_QP + (id & 31) * 16) = kn[i]; } } while (0)
    R2_LOADKZ(0); R2_LOADQK(0);
    const int tr = w >> 1;
    const bf16_t* vp0 = VT + ((size_t)(h * 256 + seg * SEGC) * 512 + E0 + l15) * 64 + 8 * g;
    bf16x8 vn0 = *(const bf16x8*)vp0, vn1 = *(const bf16x8*)(vp0 + 32);
    for (int ci = 0; ci < SEGC; ++ci) {
        R2_WRITE(); __syncthreads();
        const bf16x8 vf0 = vn0, vf1 = vn1;
        if (ci + 1 < SEGC) { R2_LOADKZ(ci + 1); R2_LOADQK(ci + 1); vn0 = *(const bf16x8*)(vp0 + (size_t)(ci + 1) * 32768); vn1 = *(const bf16x8*)(vp0 + (size_t)(ci + 1) * 32768 + 32); }
        const int chunk = seg * SEGC + ci;
#pragma unroll
        for (int t2 = 0; t2 < 2; ++t2) { const int tc = 2 * (w & 1) + t2; f32x4 pa = {0.f, 0.f, 0.f, 0.f};
            if (tc <= tr) {
#pragma unroll
                for (int ks = 0; ks < 8; ++ks) pa = __builtin_amdgcn_mfma_f32_16x16x32_bf16(*(const LAS bf16x8*)(L + RT_OFF_Q + (16 * tr + l15) * RT_QP + 64 * ks + 16 * g),
                                                                                           *(const LAS bf16x8*)(L + RT_OFF_K + (16 * tc + l15) * RT_QP + 64 * ks + 16 * g), pa, 0, 0, 0);
                const int cp = 16 * tc + l15; const float dk = __builtin_exp2f(-(float)(cp + 1) * l2g);
#pragma unroll
                for (int r = 0; r < 4; ++r) { const int c = 16 * tr + 4 * g + r; pa[r] = (c >= cp) ? pa[r] * dk : 0.f; } }
#pragma unroll
            for (int r = 0; r < 4; ++r) *(LAS bf16_t*)(L + RT_OFF_P + (16 * tr + 4 * g + r) * RT_KZP + (16 * tc + l15) * 2) = (bf16_t)f2bf(pa[r]); }
        __syncthreads();
        f32x4 oa[4];
#pragma unroll
        for (int mt = 0; mt < 4; ++mt) oa[mt] = (f32x4){0.f, 0.f, 0.f, 0.f};
#pragma unroll
        for (int ks = 0; ks < 8; ++ks) { const bf16x8 sbk = __builtin_bit_cast(bf16x8, (u32x4){pk2(st[2 * ks][0], st[2 * ks][1]), pk2(st[2 * ks][2], st[2 * ks][3]), pk2(st[2 * ks + 1][0], st[2 * ks + 1][1]), pk2(st[2 * ks + 1][2], st[2 * ks + 1][3])});
#pragma unroll
            for (int mt = 0; mt < 4; ++mt) oa[mt] = __builtin_amdgcn_mfma_f32_16x16x32_bf16(*(const LAS bf16x8*)(L + RT_OFF_Q + (16 * mt + l15) * RT_QP + 64 * ks + 16 * g), sbk, oa[mt], 0, 0, 0); }
#pragma unroll
        for (int mt = 0; mt < 4; ++mt) {
            oa[mt] = __builtin_amdgcn_mfma_f32_16x16x32_bf16(*(const LAS bf16x8*)(L + RT_OFF_P + (16 * mt + l15) * RT_KZP + 16 * g), vf0, oa[mt], 0, 0, 0);
            oa[mt] = __builtin_amdgcn_mfma_f32_16x16x32_bf16(*(const LAS bf16x8*)(L + RT_OFF_P + (16 * mt + l15) * RT_KZP + 64 + 16 * g), vf1, oa[mt], 0, 0, 0); }
#pragma unroll
        for (int i = 0; i < 16; ++i) st[i] *= gc;
#pragma unroll
        for (int dt = 0; dt < 16; ++dt) { const LAS unsigned char* ap = L + RT_OFF_KZ + (16 * dt + l15) * RT_KZP + 16 * g;
            st[dt] = __builtin_amdgcn_mfma_f32_16x16x32_bf16(*(const LAS bf16x8*)ap, vf0, st[dt], 0, 0, 0);
            st[dt] = __builtin_amdgcn_mfma_f32_16x16x32_bf16(*(const LAS bf16x8*)(ap + 64), vf1, st[dt], 0, 0, 0); }
#pragma unroll
        for (int mt = 0; mt < 4; ++mt) {
#pragma unroll
            for (int r = 0; r < 4; ++r) { const int c = 16 * mt + 4 * g + r; *(LAS bf16_t*)(L + RT_OFF_OT + c * 272 + (16 * w + l15) * 2) = (bf16_t)f2bf(oa[mt][r]);
                float ss = oa[mt][r] * oa[mt][r]; ss += __shfl_xor(ss, 1); ss += __shfl_xor(ss, 2); ss += __shfl_xor(ss, 4); ss += __shfl_xor(ss, 8);
                if (l15 == 0) *(LAS float*)(L + RT_OFF_SS + (c * 8 + w) * 4) = ss; } }
        __syncthreads();
        if (tid < 64) { const LAS float* sp = (const LAS float*)(L + RT_OFF_SS + tid * 32); float s = 0.f;
#pragma unroll
            for (int i = 0; i < 8; ++i) s += sp[i];
            PO[(size_t)(chunk * 64 + tid) * 16 + h * 4 + eb] = s; }
#pragma unroll
        for (int i = 0; i < 2; ++i) { const int id = tid + 512 * i, row = id >> 4, ch = id & 15;
            *(u32x4*)(O + (size_t)(chunk * 64 + row) * 2048 + h * 512 + eb * 128 + ch * 8) = *(const LAS u32x4*)(L + RT_OFF_OT + row * 272 + ch * 16); }
    }
#undef R2_LOADKZ
#undef R2_LOADQK
#undef R2_WRITE
}

struct Ctx { int wave, vcu, G, gw, ngw; LAS unsigned char* lds; };
#define CTX_LANE const int lane_ = lane_id_opaque(), tid_ = C.wave * 64 + lane_

__device__ __forceinline__ void tr_item(const float* W, int ldw, int k0, int n0, int nvalid, const float* gain, bf16_t* dst, int ldd, LAS float* scr, int lane) {
    float vv[32]; const int nn_ = lane & 31, kh_ = lane >> 5;
#pragma unroll
    for (int i = 0; i < 32; ++i) vv[i] = (nn_ < nvalid) ? W[(size_t)(k0 + 2 * i + kh_) * ldw + n0 + nn_] : 0.f;
    if (gain) {
#pragma unroll
        for (int i = 0; i < 32; ++i) vv[i] *= gain[k0 + 2 * i + kh_]; }
#pragma unroll
    for (int i = 0; i < 32; ++i) scr[(2 * i + kh_) * 33 + nn_] = vv[i];
    asm volatile("s_waitcnt lgkmcnt(0)" ::: "memory");
    const int c = lane & 7;
#pragma unroll
    for (int j = 0; j < 4; ++j) { const int n = (lane >> 3) + 8 * j; const LAS float* s = scr + (8 * c) * 33 + n;
        u32x4 o; o.x = pk2(s[0], s[33]); o.y = pk2(s[2 * 33], s[3 * 33]); o.z = pk2(s[4 * 33], s[5 * 33]); o.w = pk2(s[6 * 33], s[7 * 33]);
        if (n < nvalid) *(u32x4*)(dst + (size_t)n * ldd + 8 * c) = o; }
    asm volatile("s_waitcnt lgkmcnt(0)" ::: "memory");
}
__device__ __forceinline__ void zero_rows(const Ctx& C, bf16_t* base, size_t pitch_el, int nrows, int col0, int ncol) {
    CTX_LANE;
    const int per = ncol / 8; const long n = (long)nrows * per;
    for (long i = (long)C.gw * 64 + lane_; i < n; i += (long)C.ngw * 64) { const long r = i / per; const int c = (int)(i % per); *(u32x4*)(base + (size_t)r * pitch_el + col0 + c * 8) = (u32x4){0u, 0u, 0u, 0u}; }
}
__device__ __forceinline__ void convert_moe(const Ctx& C, const Params&, int layer) {
    CTX_LANE;
    WS_OPAQUE;
    LAS float* scr = (LAS float*)(C.lds + C.wave * 16384);
    bf16_t* GU = WSP(bf16_t, OFF_WGU); bf16_t* DN = WSP(bf16_t, OFF_WDN); const float* gain = P.in[I_LN_FFN] + layer * 1024;
    for (int it = C.gw; it < 32 * 768; it += C.ngw) { const int e = it / 768, r = it % 768;
        if (r < 512) { const int up = r >> 8, rr = r & 255, kb = rr >> 4, nb = rr & 15, n0 = 32 * nb; const float* W = (up ? P.in[I_W_UP] : P.in[I_W_GATE]) + (size_t)(layer * 32 + e) * 1024 * 512;
            const int drow = 256 * (n0 >> 7) + (n0 & 127) + up * 128;
            tr_item(W, 512, 64 * kb, n0, 32, gain, GU + ((size_t)(e * 1024 + drow) * 1024 + 64 * kb), 1024, scr, lane_); }
        else { const int rr = r - 512, kb = rr >> 5, nb = rr & 31; const float* W = P.in[I_W_DOWN] + (size_t)(layer * 32 + e) * 512 * 1024;
            tr_item(W, 1024, 64 * kb, 32 * nb, 32, nullptr, DN + ((size_t)(e * 1024 + 32 * nb) * 512 + 64 * kb), 512, scr, lane_); } }
}
__device__ __forceinline__ void convert_mixer(const Ctx& C, const Params&) {
    CTX_LANE;
    WS_OPAQUE;
    LAS float* scr = (LAS float*)(C.lds + C.wave * 16384);
    bf16_t* WA1 = WSP(bf16_t, W_A1); bf16_t* WA1V = WSP(bf16_t, W_A1V); bf16_t* WA2 = WSP(bf16_t, W_A2); bf16_t* WA2V = WSP(bf16_t, W_A2V);
    bf16_t* WOE = WSP(bf16_t, W_OE); bf16_t* WB1 = WSP(bf16_t, W_B1); bf16_t* WOO = WSP(bf16_t, W_OO);
    constexpr int N1 = 16 * 62, N2 = 4 * 24, N3 = 2 * 32, N4 = 16 * 32, N5 = 16 * 192, N6 = 32 * 32, NT_ = N1 + N2 + N3 + N4 + N5 + N6;
    for (int it = C.gw; it < NT_; it += C.ngw) { int r = it;
        if (r < N1) { const int kb = r / 62, nb = r % 62, n0 = 32 * nb, k0 = 64 * kb; bf16_t* dst; int nv = 32;
            if (n0 < 416) dst = WA1 + (size_t)n0 * 1024; else if (n0 < 928) dst = WA1 + (size_t)(512 + n0 - 416) * 1024; else if (n0 < 1440) dst = WA1 + (size_t)(1024 + n0 - 928) * 1024;
            else if (n0 < 1952) dst = WA1V + (size_t)(n0 - 1440) * 1024; else { dst = WA1 + (size_t)416 * 1024; nv = 8; }
            tr_item(P.in[I_W_IN_E], 1960, k0, n0, nv, P.in[I_LN_MIX_E], dst + k0, 1024, scr, lane_); continue; } r -= N1;
        if (r < N2) { const int kb = r / 24, nb = r % 24, n0 = 32 * nb, hh = n0 / 96, off = n0 % 96;
            tr_item(P.in[I_W_UQ], 768, 64 * kb, n0, 32, P.in[I_LN_Q], WA2 + (size_t)(128 * hh + off) * 256 + 64 * kb, 256, scr, lane_); continue; } r -= N2;
        if (r < N3) { const int kb = r / 32, nb = r % 32, n0 = 32 * nb, hh = n0 / 128, off = n0 % 128;
            bf16_t* dst = off < 64 ? WA2 + (size_t)(1024 + 64 * hh + off) * 256 : WA2V + (size_t)(64 * hh + off - 64) * 256;
            tr_item(P.in[I_W_UKV], 1024, 64 * kb, n0, 32, P.in[I_LN_KV], dst + 64 * kb, 256, scr, lane_); continue; } r -= N3;
        if (r < N4) { const int kb = r / 32, nb = r % 32; tr_item(P.in[I_W_OUT_E], 1024, 64 * kb, 32 * nb, 32, nullptr, WOE + (size_t)(32 * nb) * 1024 + 64 * kb, 1024, scr, lane_); continue; } r -= N4;
        if (r < N5) { const int kb = r / 192, nb = r % 192; tr_item(P.in[I_W_IN_O], 6144, 64 * kb, 32 * nb, 32, P.in[I_LN_MIX_O], WB1 + (size_t)(32 * nb) * 1024 + 64 * kb, 1024, scr, lane_); continue; } r -= N5;
        { const int kb = r / 32, nb = r % 32; tr_item(P.in[I_W_OUT_O], 1024, 64 * kb, 32 * nb, 32, nullptr, WOO + (size_t)(32 * nb) * 2048 + 64 * kb, 2048, scr, lane_); } }
    zero_rows(C, WA1 + (size_t)424 * 1024, 1024, 88, 0, 1024);
    for (int hh = 0; hh < 8; ++hh) zero_rows(C, WA2 + (size_t)(128 * hh + 96) * 256, 256, 32, 0, 256);
    zero_rows(C, WA2 + (size_t)1024 * 256, 256, 512, 128, 128);
    zero_rows(C, WA2V, 256, 512, 128, 128);
}
__device__ __forceinline__ void make_rope(const Ctx& C, const Params&) {
    CTX_LANE;
    WS_OPAQUE;
    f32x2* rope = WSP(f32x2, OFF_ROPE);
    for (int i = C.gw * 64 + lane_; i < S * 128; i += C.ngw * 64) { const int pos = i >> 7, k = i & 127; const float inv = __builtin_exp2f(-(float)k * (13.287712379549449f / 128.0f));
        const float ang = (float)pos * inv; const double a = (double)ang; rope[i] = (f32x2){(float)cos(a), (float)sin(a)}; }
}
__device__ __forceinline__ void rows_to_bf16(const Ctx& C, const float* X, bf16_t* XB, float* RS) {
    CTX_LANE;
    for (int r0 = C.gw; r0 < T; r0 += 4 * C.ngw) { f32x4 v[4][4];
#pragma unroll
        for (int q = 0; q < 4; ++q) { const int r = r0 + q * C.ngw; const f32x4* xr = (const f32x4*)(X + (size_t)(r < T ? r : r0) * D) + lane_;
#pragma unroll
            for (int j = 0; j < 4; ++j) v[q][j] = xr[64 * j]; }
#pragma unroll
        for (int q = 0; q < 4; ++q) { const int r = r0 + q * C.ngw; if (r >= T) break; float s = 0.f;
#pragma unroll
            for (int j = 0; j < 4; ++j) s += (v[q][j][0] * v[q][j][0] + v[q][j][1] * v[q][j][1]) + (v[q][j][2] * v[q][j][2] + v[q][j][3] * v[q][j][3]);
            s = wave_sum(s); u32x2* o = (u32x2*)(XB + (size_t)r * D) + lane_;
#pragma unroll
            for (int j = 0; j < 4; ++j) o[64 * j] = (u32x2){pk2(v[q][j][0], v[q][j][1]), pk2(v[q][j][2], v[q][j][3])};
            if (lane_ == 0) RS[r] = rsqrt_f(s * (1.0f / D) + EPS); } }
}
__device__ __forceinline__ void fox_cumsum(const Ctx& C, const float* LF, float* CUM, int bh) {
    CTX_LANE;
    LAS float* tot = (LAS float*)C.lds; const int b = bh >> 3, h = bh & 7; float v[32]; float run = 0.f;
#pragma unroll
    for (int i = 0; i < 32; ++i) { run += LF[((size_t)b * S + tid_ * 32 + i) * 8 + h]; v[i] = run; }
    tot[tid_] = run; __syncthreads();
    float off = 0.f; for (int t2 = 0; t2 < tid_; ++t2) off += tot[t2];
#pragma unroll
    for (int i = 0; i < 32; ++i) CUM[(size_t)bh * S + tid_ * 32 + i] = (off + v[i]) * LOG2E;
    __syncthreads();
}
__device__ __forceinline__ void moe_router(const Ctx& C, const Params&, int layer, int blk) {
    CTX_LANE;
    WS_OPAQUE;
    const float* XF = P.out; bf16_t* XB = WSP(bf16_t, OFF_XB); float* RS1 = WSP(float, SM_RS1);
    int* EID = WSP(int, SM_EID); float* GATE = WSP(float, SM_GATE); int* RANK = WSP(int, SM_RANK); int* CNT = WSP(int, SM_CNT);
    const float* wrg = P.in[I_W_RG] + (size_t)layer * 1024 * 4; const float* wre = P.in[I_W_RE] + (size_t)layer * 1024 * 32; const float* lnf = P.in[I_LN_FFN] + layer * 1024;
    LAS float* lg = (LAS float*)C.lds;
    LAS float* rsl = (LAS float*)(C.lds + 128 * 40 * 4);
    LAS int* eidl = (LAS int*)(C.lds + 128 * 40 * 4 + 512);
    LAS float* slab = (LAS float*)(C.lds + 32768);
    const int l15 = lane_ & 15, kg = lane_ >> 4, kbase = 128 * C.wave + 8 * kg;
    bf16x8 bh[3][4], bl[3][4];
#pragma unroll
    for (int nt = 0; nt < 3; ++nt) { const int col = 16 * nt + l15; const int cc = col < 36 ? col : 35; const float* wp = cc < 4 ? wrg + cc : wre + (cc - 4); const int wst = cc < 4 ? 4 : 32; const float wz = col < 36 ? 1.f : 0.f;
#pragma unroll
        for (int ks = 0; ks < 4; ++ks) { float wf[8]; unsigned hp[4], lp[4];
#pragma unroll
            for (int j = 0; j < 8; ++j) { const int k = kbase + 32 * ks + j; wf[j] = lnf[k] * wp[(size_t)k * wst] * wz; }
#pragma unroll
            for (int j = 0; j < 4; ++j) { hp[j] = pk2(wf[2 * j], wf[2 * j + 1]); lp[j] = pk2(wf[2 * j] - bflo(hp[j]), wf[2 * j + 1] - bfhi(hp[j])); }
            bh[nt][ks] = __builtin_bit_cast(bf16x8, (u32x4){hp[0], hp[1], hp[2], hp[3]}); bl[nt][ks] = __builtin_bit_cast(bf16x8, (u32x4){lp[0], lp[1], lp[2], lp[3]}); } }
    f32x4 xa[8], xb[8];
#define RT_LOADX(dst, mt) do { const float* xp = XF + (size_t)(blk * 128 + 16 * (mt) + l15) * D + kbase; _Pragma("unroll") for (int ks = 0; ks < 4; ++ks) { dst[2 * ks] = *(const f32x4*)(xp + 32 * ks); dst[2 * ks + 1] = *(const f32x4*)(xp + 32 * ks + 4); } } while (0)
#define RT_TILE(src, mt) do { f32x4 acc[3] = {{0.f, 0.f, 0.f, 0.f}, {0.f, 0.f, 0.f, 0.f}, {0.f, 0.f, 0.f, 0.f}}; float ss = 0.f; \
        _Pragma("unroll") for (int ks = 0; ks < 4; ++ks) { const f32x4 v0 = src[2 * ks], v1 = src[2 * ks + 1]; unsigned hp[4], lp[4]; \
            hp[0] = pk2(v0[0], v0[1]); hp[1] = pk2(v0[2], v0[3]); hp[2] = pk2(v1[0], v1[1]); hp[3] = pk2(v1[2], v1[3]); \
            lp[0] = pk2(v0[0] - bflo(hp[0]), v0[1] - bfhi(hp[0])); lp[1] = pk2(v0[2] - bflo(hp[1]), v0[3] - bfhi(hp[1])); lp[2] = pk2(v1[0] - bflo(hp[2]), v1[1] - bfhi(hp[2])); lp[3] = pk2(v1[2] - bflo(hp[3]), v1[3] - bfhi(hp[3])); \
            ss += (v0[0] * v0[0] + v0[1] * v0[1]) + (v0[2] * v0[2] + v0[3] * v0[3]) + (v1[0] * v1[0] + v1[1] * v1[1]) + (v1[2] * v1[2] + v1[3] * v1[3]); \
            const bf16x8 ah = __builtin_bit_cast(bf16x8, (u32x4){hp[0], hp[1], hp[2], hp[3]}), al = __builtin_bit_cast(bf16x8, (u32x4){lp[0], lp[1], lp[2], lp[3]}); \
            *(u32x4*)(XB + (size_t)(blk * 128 + 16 * (mt) + l15) * D + kbase + 32 * ks) = (u32x4){hp[0], hp[1], hp[2], hp[3]}; \
            _Pragma("unroll") for (int nt = 0; nt < 3; ++nt) { acc[nt] = __builtin_amdgcn_mfma_f32_16x16x32_bf16(ah, bh[nt][ks], acc[nt], 0, 0, 0); acc[nt] = __builtin_amdgcn_mfma_f32_16x16x32_bf16(ah, bl[nt][ks], acc[nt], 0, 0, 0); \
                acc[nt] = __builtin_amdgcn_mfma_f32_16x16x32_bf16(al, bh[nt][ks], acc[nt], 0, 0, 0); } } \
        ss += __shfl_xor(ss, 16); ss += __shfl_xor(ss, 32); \
        LAS float* sl = slab + (size_t)(C.wave * 64 + 16 * ((mt) & 3)) * 40; \
        _Pragma("unroll") for (int nt = 0; nt < 3; ++nt) { const int col = 16 * nt + l15; if (col < 36) { _Pragma("unroll") for (int r = 0; r < 4; ++r) sl[(4 * kg + r) * 40 + col] = acc[nt][r]; } } \
        if (kg == 0) sl[l15 * 40 + 36] = ss; } while (0)
    RT_LOADX(xa, 0);
    for (int half = 0; half < 2; ++half) {
        RT_LOADX(xb, 4 * half + 1); RT_TILE(xa, 4 * half + 0);
        RT_LOADX(xa, 4 * half + 2); RT_TILE(xb, 4 * half + 1);
        RT_LOADX(xb, 4 * half + 3); RT_TILE(xa, 4 * half + 2);
        if (half == 0) RT_LOADX(xa, 4); RT_TILE(xb, 4 * half + 3);
        __syncthreads();
        for (int it = tid_; it < 64 * 37; it += 512) { const int tt = it / 37, c = it % 37; float sm = 0.f;
#pragma unroll
            for (int w8 = 0; w8 < 8; ++w8) sm += slab[(size_t)(w8 * 64 + tt) * 40 + c];
            lg[(half * 64 + tt) * 40 + c] = sm; }
        __syncthreads();
    }
#undef RT_LOADX
#undef RT_TILE
    if (tid_ < 128) { const float rs = rsqrt_f(lg[tid_ * 40 + 36] * (1.0f / D) + EPS); rsl[tid_] = rs; RS1[blk * 128 + tid_] = rs; }
    __syncthreads();
    if (tid_ < 128) { const int tt = tid_, t = blk * 128 + tt; const float rs = rsl[tt]; const float* brg = P.in[I_B_RG] + layer * 4; const float* bre = P.in[I_B_RE] + layer * 32;
        float gl[4]; int gs = 0;
#pragma unroll
        for (int o = 0; o < 4; ++o) { gl[o] = lg[tt * 40 + o] * rs + brg[o]; if (gl[o] > gl[gs]) gs = o; }
        float gsum = 0.f;
#pragma unroll
        for (int o = 0; o < 4; ++o) gsum += __expf(gl[o] - gl[gs]);
        const float pg = 1.0f / gsum;
        float el[8]; int j1 = 0;
#pragma unroll
        for (int j = 0; j < 8; ++j) { el[j] = lg[tt * 40 + 4 + 8 * gs + j] * rs + bre[8 * gs + j]; if (el[j] > el[j1]) j1 = j; }
        int j2 = (j1 == 0) ? 1 : 0;
#pragma unroll
        for (int j = 0; j < 8; ++j) if (j != j1 && el[j] > el[j2]) j2 = j;
        const float e2 = __expf(el[j2] - el[j1]), den = 1.0f / (1.0f + e2);
        const int ea = 8 * gs + j1, eb = 8 * gs + j2;
        EID[t * 2] = ea; EID[t * 2 + 1] = eb; GATE[t * 2] = pg * den; GATE[t * 2 + 1] = pg * e2 * den; eidl[2 * tt] = ea; eidl[2 * tt + 1] = eb; }
    __syncthreads();
    if (tid_ < 256) { const int me = eidl[tid_]; int rk = 0; for (int a = 0; a < tid_; ++a) rk += (eidl[a] == me) ? 1 : 0; RANK[blk * 256 + tid_] = rk; }
    if (tid_ < 32) { int c = 0; for (int a = 0; a < 256; ++a) c += (eidl[a] == tid_) ? 1 : 0; CNT[blk * 32 + tid_] = c; }
    __syncthreads();
}
__device__ __forceinline__ void moe_scatter(const Ctx& C, const Params&, int blk) {
    CTX_LANE;
    WS_OPAQUE;
    const int* CNT = WSP(int, SM_CNT); const int* EID = WSP(int, SM_EID); const float* GATE = WSP(float, SM_GATE); const int* RANK = WSP(int, SM_RANK); const float* RS1 = WSP(float, SM_RS1);
    int* TSLOT = WSP(int, SM_TSLOT); int* STOK = WSP(int, SM_STOK); float* SW = WSP(float, SM_SW); float* SR = WSP(float, SM_SR); int* TILEE = WSP(int, SM_TILEE);
    const bf16_t* XB = WSP(bf16_t, OFF_XB); bf16_t* XS = WSP(bf16_t, A_XS);
    LAS int* part = (LAS int*)C.lds;
    LAS int* tot = part + 1024;
    LAS int* slotl = tot + 128;
    { const int e = tid_ & 31, pt = tid_ >> 5; int s = 0, pre = 0;
        for (int b = pt * 16; b < pt * 16 + 16; ++b) { const int c = ld_i(CNT + b * 32 + e); s += c; if (b < blk) pre += c; }
        part[pt * 32 + e] = s; part[512 + pt * 32 + e] = pre; }
    __syncthreads();
    if (tid_ < 32) { int s = 0, pre = 0; for (int pt = 0; pt < 16; ++pt) { s += part[pt * 32 + tid_]; pre += part[512 + pt * 32 + tid_]; } tot[tid_] = s; tot[32 + tid_] = pre; }
    __syncthreads();
    if (tid_ == 0) { int ps = 0; for (int e = 0; e < 32; ++e) { tot[64 + e] = ps; ps += (tot[e] + 255) & ~255; } tot[96] = ps; }
    __syncthreads();
    if (tid_ < 256) { const int a = blk * 256 + tid_, t = a >> 1, e = EID[a]; const int slot = tot[64 + e] + tot[32 + e] + RANK[a];
        slotl[tid_] = slot; TSLOT[a] = slot; STOK[slot] = t; SW[slot] = GATE[a]; SR[slot] = RS1[t]; }
    __syncthreads();
    for (int i0 = C.wave * 32; i0 < C.wave * 32 + 32; i0 += 8) { u32x4 ra[8], rb[8];
#pragma unroll
        for (int q = 0; q < 8; ++q) { const int t = (blk * 256 + i0 + q) >> 1; const u32x4* sp = (const u32x4*)(XB + (size_t)t * D) + lane_; ra[q] = sp[0]; rb[q] = sp[64]; }
#pragma unroll
        for (int q = 0; q < 8; ++q) { const int slot = slotl[i0 + q]; u32x4* d = (u32x4*)(XS + (size_t)slot * D) + lane_; d[0] = ra[q]; d[64] = rb[q]; } }
    if (blk < 32) { const int e = blk, beg = tot[64 + e] + tot[e], end = tot[64 + e] + ((tot[e] + 255) & ~255);
        for (int sl = beg + C.wave; sl < end; sl += 8) { u32x4* d = (u32x4*)(XS + (size_t)sl * D) + lane_; d[0] = (u32x4){0u, 0u, 0u, 0u}; d[64] = (u32x4){0u, 0u, 0u, 0u}; if (lane_ == 0) { STOK[sl] = -1; SW[sl] = 0.f; SR[sl] = 0.f; } } }
    if (blk == 0 && tid_ < 32) { const int e = tid_, t0 = tot[64 + e] >> 8, nt = ((tot[e] + 255) & ~255) >> 8; for (int i = 0; i < nt; ++i) TILEE[t0 + i] = e; if (e == 0) TILEE[300] = tot[96] >> 8; }
    __syncthreads();
}
template <int MODE> __device__ __forceinline__ void moe_combine(const Ctx& C, const Params&, float* RS, const float* gainf) {
    CTX_LANE;
    WS_OPAQUE;
    float* XF = P.out; bf16_t* XB = WSP(bf16_t, OFF_XB); const bf16_t* YS = WSP(bf16_t, A_XS); const int* TSLOT = WSP(int, SM_TSLOT);
    for (int t0 = C.gw; t0 < T; t0 += 2 * C.ngw) { f32x4 v[2][4]; u32x2 ya[2][4], yb[2][4];
#pragma unroll
        for (int q = 0; q < 2; ++q) { const int t = t0 + q * C.ngw; const int sa = ld_i(TSLOT + 2 * t), sb = ld_i(TSLOT + 2 * t + 1); const f32x4* xr = (const f32x4*)(XF + (size_t)t * D) + lane_;
            const u32x2* pa = (const u32x2*)(YS + (size_t)sa * D) + lane_; const u32x2* pb = (const u32x2*)(YS + (size_t)sb * D) + lane_;
#pragma unroll
            for (int j = 0; j < 4; ++j) { v[q][j] = xr[64 * j]; ya[q][j] = pa[64 * j]; yb[q][j] = pb[64 * j]; } }
#pragma unroll
        for (int q = 0; q < 2; ++q) { const int t = t0 + q * C.ngw; f32x4* xr = (f32x4*)(XF + (size_t)t * D) + lane_; float s = 0.f;
#pragma unroll
            for (int j = 0; j < 4; ++j) { const u32x2 a = ya[q][j], b = yb[q][j];
                v[q][j][0] += bflo(a.x) + bflo(b.x); v[q][j][1] += bfhi(a.x) + bfhi(b.x); v[q][j][2] += bflo(a.y) + bflo(b.y); v[q][j][3] += bfhi(a.y) + bfhi(b.y);
                s += (v[q][j][0] * v[q][j][0] + v[q][j][1] * v[q][j][1]) + (v[q][j][2] * v[q][j][2] + v[q][j][3] * v[q][j][3]); }
            s = wave_sum(s); const float rs = rsqrt_f(s * (1.0f / D) + EPS);
            if (MODE == 0) { u32x2* o = (u32x2*)(XB + (size_t)t * D) + lane_;
#pragma unroll
                for (int j = 0; j < 4; ++j) { xr[64 * j] = v[q][j]; o[64 * j] = (u32x2){pk2(v[q][j][0], v[q][j][1]), pk2(v[q][j][2], v[q][j][3])}; }
                if (lane_ == 0) RS[t] = rs; }
            else { const f32x4* gr = (const f32x4*)gainf + lane_;
#pragma unroll
                for (int j = 0; j < 4; ++j) xr[64 * j] = v[q][j] * rs * gr[64 * j]; } } }
}

constexpr int LDS_BYTES = 147456;
constexpr int LDS_MISC = LDS_BYTES - 256;
constexpr int NPHASE = 23;

__global__ void __launch_bounds__(512, 2) fwd_kernel(Params Pkern) {
    extern __shared__ __attribute__((aligned(16))) unsigned char lds_raw[];
    LAS unsigned char* lds = (LAS unsigned char*)lds_raw;
    Ctx C; { const int t0_ = threadIdx.x; C.wave = __builtin_amdgcn_readfirstlane(t0_ >> 6); } C.G = gridDim.x;
    C.vcu = (C.G % 8 == 0) ? ((int)blockIdx.x % 8) * (C.G / 8) + (int)blockIdx.x / 8 : (int)blockIdx.x;
    C.gw = C.vcu * 8 + C.wave; C.ngw = C.G * 8; C.lds = lds;
    const int bx = blockIdx.x;
    { const int l0 = lane_id_opaque(); if (C.wave == 0) ((LAS unsigned*)(lds + LDS_MISC))[l0] = 0u; }
    __syncthreads();
    const unsigned xcc = xb_xcc_id();
    if (Pkern.use_bar) { const bool t0 = (C.wave == 0) && (lane_id_opaque() == 0); (void)xcd_barrier_post((unsigned*)(Pkern.ws + OFF_CTL) + 4096, (volatile LAS unsigned*)(lds + LDS_MISC), t0); }
    const int lo = Pkern.ph_lo, hi = Pkern.ph_hi;
    const Params& P = Pkern;
#ifndef PH_MASK
#define PH_MASK 0x7fffffu
#endif
#define IN(k) ((((unsigned)PH_MASK >> (k)) & 1u) && lo <= (k) && (k) < hi)
#ifndef PROBE_MASK
#define PROBE_MASK 0u
#endif
#ifdef PROBE_T
#define STAMP(i) do { if (bx == 0 && C.wave == 0 && lane_id_opaque() == 0) ((volatile LAS unsigned long long*)(lds + LDS_MISC + 64))[(i)] = __builtin_amdgcn_s_memrealtime(); } while (0)
#else
#define STAMP(i) do { } while (0)
#endif
#define REP(k) for (int rep_ = 0; rep_ < ((((unsigned)PROBE_MASK >> (k)) & 1u) ? 2 : 1); ++rep_)
#define SEAM(k) do { if (IN(k) && IN((k) + 1)) { P_OPAQUE; XcdBarrier bar; bar.bar = (unsigned*)(P.ws + OFF_CTL) + 4096; bar.x = xcc; bar.st = (volatile LAS unsigned*)(lds + LDS_MISC); \
        const bool t0 = (C.wave == 0) && (lane_id_opaque() == 0); xcd_barrier(bar, t0); } STAMP((k) + 1); } while (0)

    STAMP(0);
    if (IN(0)) REP(0) { WS_OPAQUE; convert_mixer(C, P); convert_moe(C, P, 0); make_rope(C, P); rows_to_bf16(C, P.in[I_X], WSP(bf16_t, OFF_XB), WSP(float, SM_RS0)); __syncthreads(); }
    SEAM(0);
    if (IN(1)) REP(1) {
        { WS_OPAQUE; DenseSched Sd; Sd.init(WSP(bf16_t, OFF_XB), 1024, WSP(bf16_t, W_A1), 1024, 128, 6, C.G, bx);
          EpiA1a E{WSP(float, SM_RS0), WSP(bf16_t, A_Z), WSP(float, SM_PQ), WSP(float, SM_PKV), WSP(bf16_t, A_KA), WSP(float, SM_LF), P.in[I_B_F], WSP(bf16_t, A_QF), WSP(bf16_t, A_KF), WSP(f32x2, OFF_ROPE)};
          pg8::gemm_phase(C.wave, lds, pg8::Dims{1024, 1024, 1024}, Sd, E); }
        { WS_OPAQUE; DenseSched Sd; Sd.init(WSP(bf16_t, W_A1V), 1024, WSP(bf16_t, OFF_XB), 1024, 2, 128, C.G, bx);
          EpiVT<0> E{WSP(float, SM_RS0), WSP(bf16_t, A_VTF), (size_t)T};
          pg8::gemm_phase(C.wave, lds, pg8::Dims{1024, 1024, 1024}, Sd, E); }
    }
    SEAM(1);
    if (IN(2)) REP(2) {
        if (C.vcu < 16) { WS_OPAQUE; fox_cumsum(C, WSP(float, SM_LF), WSP(float, SM_CUM), C.vcu); }
        { WS_OPAQUE; fox_knorm(C.gw, C.ngw, lane_id_opaque(), WSP(bf16_t, A_KF), WSP(float, SM_KNRM)); }
        { WS_OPAQUE; DenseSched Sd; Sd.init(WSP(bf16_t, A_Z), 512, WSP(bf16_t, W_A2), 256, 128, 4, C.G, bx);
          EpiA2q E{WSP(float, SM_PQ), WSP(bf16_t, A_QA), WSP(f32x2, OFF_ROPE)};
          pg8::gemm_phase(C.wave, lds, pg8::Dims{512, 256, 256}, Sd, E); }
        { WS_OPAQUE; DenseSched Sd; Sd.init(WSP(bf16_t, A_Z) + 256, 512, WSP(bf16_t, W_A2) + (size_t)1024 * 256, 256, 128, 2, C.G, bx);
          EpiA2k E{WSP(float, SM_PKV), WSP(bf16_t, A_KA)};
          pg8::gemm_phase(C.wave, lds, pg8::Dims{512, 256, 256}, Sd, E); }
        { WS_OPAQUE; DenseSched Sd; Sd.init(WSP(bf16_t, W_A2V), 256, WSP(bf16_t, A_Z) + 256, 512, 2, 128, C.G, bx);
          EpiVT<1> E{WSP(float, SM_PKV), WSP(bf16_t, A_VTA), (size_t)T};
          pg8::gemm_phase(C.wave, lds, pg8::Dims{256, 512, 256}, Sd, E); }
    }
    SEAM(2);
    if (IN(3)) REP(3) {
        const int bh = C.vcu >> 4, s4 = C.vcu & 15, b = bh >> 3, h = bh & 7;
        REP(23) { WS_OPAQUE; bf16_t* AO = WSP(bf16_t, OFF_XB);
          for (int i = 0; i < 4; ++i) { const int qb = (i == 0) ? s4 : (i == 1) ? 31 - s4 : (i == 2) ? 32 + s4 : 63 - s4;
            attn_unit<96, false>(C.wave, lds, WSP(bf16_t, A_QA) + (size_t)b * S * 768 + h * 96, 768, WSP(bf16_t, A_KA) + (size_t)b * S * 768 + h * 96, 768,
                                 WSP(bf16_t, A_VTA) + ((size_t)h * (T / 64) + (size_t)b * (S / 64)) * 4096, nullptr, nullptr, AO + (size_t)b * S * 1024 + h * 64, 1024, qb); } }
        REP(24) { WS_OPAQUE; bf16_t* AO = WSP(bf16_t, OFF_XB);
          for (int i = 0; i < 4; ++i) { const int qb = (i == 0) ? s4 : (i == 1) ? 31 - s4 : (i == 2) ? 32 + s4 : 63 - s4;
            attn_unit<64, true>(C.wave, lds, WSP(bf16_t, A_QF) + (size_t)b * S * 512 + h * 64, 512, WSP(bf16_t, A_KF) + (size_t)b * S * 512 + h * 64, 512,
                                WSP(bf16_t, A_VTF) + ((size_t)h * (T / 64) + (size_t)b * (S / 64)) * 4096, WSP(float, SM_CUM) + (size_t)bh * S, WSP(float, SM_KNRM) + bh * 256, AO + (size_t)b * S * 1024 + 512 + h * 64, 1024, qb); } }
    }
    SEAM(3);
    if (IN(4)) REP(4) { WS_OPAQUE; DenseSched Sd; Sd.init(WSP(bf16_t, OFF_XB), 1024, WSP(bf16_t, W_OE), 1024, 128, 4, C.G, bx); EpiRes E{P.in[I_X], P.out};
        pg8::gemm_phase(C.wave, lds, pg8::Dims{1024, 1024, 1024}, Sd, E); }
    SEAM(4);

#define MOE_PHASES(layer, pb) do { \
        if (IN(pb)) REP(pb) moe_router(C, P, layer, bx); \
        SEAM(pb); \
        if (IN((pb) + 1)) REP((pb) + 1) moe_scatter(C, P, bx); \
        SEAM((pb) + 1); \
        if (IN((pb) + 2)) REP((pb) + 2) { WS_OPAQUE; MoeSched Sm; Sm.init(WSP(bf16_t, A_XS), 1024, WSP(bf16_t, OFF_WGU), 1024, 1024, WSP(int, SM_TILEE), C.G, bx); EpiM3 E{WSP(float, SM_SR), WSP(bf16_t, A_HID)}; \
            pg8::gemm_phase(C.wave, lds, pg8::Dims{1024, 1024, 1024}, Sm, E); } \
        SEAM((pb) + 2); \
        if (IN((pb) + 3)) REP((pb) + 3) { WS_OPAQUE; MoeSched Sm; Sm.init(WSP(bf16_t, A_HID), 512, WSP(bf16_t, OFF_WDN), 512, 1024, WSP(int, SM_TILEE), C.G, bx); EpiM4 E{WSP(float, SM_SW), WSP(bf16_t, A_XS)}; \
            pg8::gemm_phase(C.wave, lds, pg8::Dims{512, 512, 512}, Sm, E); } \
        SEAM((pb) + 3); } while (0)
#define RET_PHASES(bb, p0) do { \
        if (IN(p0)) REP(p0) { \
            { WS_OPAQUE; DenseSched Sd; Sd.init(WSP(bf16_t, OFF_XB) + (size_t)(bb) * S * 1024, 1024, WSP(bf16_t, W_B1), 1024, 64, 4, C.G, bx); EpiB1q E{WSP(float, SM_RS2) + (bb) * S, WSP(bf16_t, A_QX), WSP(f32x2, OFF_ROPE)}; \
              pg8::gemm_phase(C.wave, lds, pg8::Dims{1024, 1024, 1024}, Sd, E); } \
            { WS_OPAQUE; DenseSched Sd; Sd.init(WSP(bf16_t, W_B1) + (size_t)1024 * 1024, 1024, WSP(bf16_t, OFF_XB) + (size_t)(bb) * S * 1024, 1024, 4, 64, C.G, bx); EpiB1k E{WSP(float, SM_RS2) + (bb) * S, WSP(bf16_t, A_KN), WSP(bf16_t, A_KZT), WSP(f32x2, OFF_ROPE), lds + 131072}; \
              pg8::gemm_phase(C.wave, lds, pg8::Dims{1024, 1024, 1024}, Sd, E); } \
            { WS_OPAQUE; DenseSched Sd; Sd.init(WSP(bf16_t, W_B1) + (size_t)2048 * 1024, 1024, WSP(bf16_t, OFF_XB) + (size_t)(bb) * S * 1024, 1024, 8, 64, C.G, bx); EpiB1v E{WSP(float, SM_RS2) + (bb) * S, WSP(bf16_t, A_VT)}; \
              pg8::gemm_phase(C.wave, lds, pg8::Dims{1024, 1024, 1024}, Sd, E); } \
        } \
        SEAM(p0); \
        if (IN((p0) + 1)) REP((p0) + 1) { WS_OPAQUE; ret_local(C.wave, lds, WSP(bf16_t, A_KZT), WSP(bf16_t, A_VT), WSP(f32x4, A_L), C.vcu); } \
        SEAM((p0) + 1); \
        if (IN((p0) + 2)) REP((p0) + 2) { WS_OPAQUE; ret_scan(C.wave, lds, WSP(bf16_t, A_QX), WSP(bf16_t, A_KN), WSP(bf16_t, A_KZT), WSP(bf16_t, A_VT), WSP(f32x4, A_L), \
                                 WSP(bf16_t, A_O) + (size_t)(bb) * S * 2048, WSP(float, SM_PO) + (size_t)(bb) * S * 16, C.vcu); } \
        SEAM((p0) + 2); } while (0)

    MOE_PHASES(0, 5);
    if (IN(9)) { WS_OPAQUE; moe_combine<0>(C, P, WSP(float, SM_RS2), nullptr); convert_moe(C, P, 1); __syncthreads(); }
    SEAM(9);
    RET_PHASES(0, 10);
    RET_PHASES(1, 13);
    if (IN(16)) { WS_OPAQUE; DenseSched Sd; Sd.init(WSP(bf16_t, OFF_XB), 1024, WSP(bf16_t, W_B1) + (size_t)4096 * 1024, 1024, 128, 8, C.G, bx); EpiG E{WSP(float, SM_RS2), WSP(float, SM_PO), WSP(bf16_t, A_O)};
        pg8::gemm_phase(C.wave, lds, pg8::Dims{1024, 1024, 1024}, Sd, E); }
    SEAM(16);
    if (IN(17)) { WS_OPAQUE; DenseSched Sd; Sd.init(WSP(bf16_t, A_O), 2048, WSP(bf16_t, W_OO), 2048, 128, 4, C.G, bx); EpiRes E{P.out, P.out};
        pg8::gemm_phase(C.wave, lds, pg8::Dims{2048, 2048, 2048}, Sd, E); }
    SEAM(17);
    MOE_PHASES(1, 18);
#undef MOE_PHASES
#undef RET_PHASES
    if (IN(22)) { P_OPAQUE; moe_combine<1>(C, P, nullptr, P.in[I_LN_F]); }
#ifdef PROBE_T
    __syncthreads();
    if (bx == 0 && C.wave == 0 && lane_id_opaque() == 0) { volatile LAS unsigned long long* st_ = (volatile LAS unsigned long long*)(lds + LDS_MISC + 64);
        const unsigned long long tend = __builtin_amdgcn_s_memrealtime(); const unsigned long long tb = (PROBE_T == 22) ? tend : st_[PROBE_T + 1]; const unsigned long long dt = tb - st_[PROBE_T];
        while (__builtin_amdgcn_s_memrealtime() - tend < 8ull * dt) __builtin_amdgcn_s_sleep(8); }
#endif
#undef IN
#undef SEAM
}

extern "C" void kernel_launch(void* const* d_in, const int* in_sizes, int n_in, void* d_out, int out_size, void* d_ws, size_t ws_size, hipStream_t stream) {
    static int ready = 0;
    if (ready == 0) {
        if (n_in != 21 || out_size != T * D || ws_size < WS_NEED) { fprintf(stderr, "kernel_launch: unexpected shapes (n_in %d, out %d, ws %zu < %zu)\n", n_in, out_size, ws_size, (size_t)WS_NEED); ready = -1; return; }
        if (hipFuncSetAttribute((const void*)fwd_kernel, hipFuncAttributeMaxDynamicSharedMemorySize, LDS_BYTES) != hipSuccess) { fprintf(stderr, "kernel_launch: hipFuncSetAttribute failed\n"); ready = -1; return; }
        int per_cu = 0; (void)hipOccupancyMaxActiveBlocksPerMultiprocessor(&per_cu, (const void*)fwd_kernel, 512, LDS_BYTES); (void)hipGetLastError();
        if (per_cu < 1) fprintf(stderr, "kernel_launch: occupancy query reports %d blocks per CU\n", per_cu);
        ready = 1;
    }
    if (ready < 0) return;
    (void)hipMemsetAsync((char*)d_ws + OFF_CTL, 0, CTL_BYTES, stream);
    Params p{};
    for (int i = 0; i < 21; ++i) p.in[i] = (const float*)d_in[i];
    p.out = (float*)d_out; p.ws = (unsigned char*)d_ws; p.pad = 0;
#if N_LAUNCH_MODE == 1
    for (int ph = 0; ph < NPHASE; ++ph) { p.ph_lo = ph; p.ph_hi = ph + 1; p.use_bar = 0; hipLaunchKernelGGL(fwd_kernel, dim3(256), dim3(512), LDS_BYTES, stream, p); }
#else
    p.ph_lo = 0; p.ph_hi = NPHASE; p.use_bar = 1;
    hipLaunchKernelGGL(fwd_kernel, dim3(256), dim3(512), LDS_BYTES, stream, p);
#endif
}
```

```cpp
#include <hip/hip_runtime.h>
#include <cstdio>
#include <cstdint>

#ifndef N_LAUNCH_MODE
#define N_LAUNCH_MODE 0
#endif

#define LAS __attribute__((address_space(3)))
#define GAS __attribute__((address_space(1)))
typedef unsigned short bf16_t;
typedef short bf16x8 __attribute__((ext_vector_type(8)));
typedef float f32x2 __attribute__((ext_vector_type(2)));
typedef float f32x4 __attribute__((ext_vector_type(4)));
typedef float f32x16 __attribute__((ext_vector_type(16)));
typedef unsigned u32x2 __attribute__((ext_vector_type(2)));
typedef unsigned u32x4 __attribute__((ext_vector_type(4)));

constexpr int T = 32768, S = 16384, D = 1024;
constexpr float EPS = 1e-6f;
constexpr float LOG2E = 1.4426950408889634f;
constexpr int CAP = 65536 + 32 * 256;
constexpr int NSEG = 16, SEGC = 16;

constexpr size_t MiB = 1u << 20;
constexpr size_t OFF_CTL = 0, CTL_BYTES = 1 * MiB;
constexpr size_t OFF_SMALL = 1 * MiB;
constexpr size_t SM_RS0 = OFF_SMALL, SM_RS1 = SM_RS0 + T * 4, SM_RS2 = SM_RS1 + T * 4, SM_PQ = SM_RS2 + T * 4, SM_PKV = SM_PQ + (size_t)T * 16,
                 SM_LF = SM_PKV + (size_t)T * 16, SM_CUM = SM_LF + (size_t)T * 32, SM_EID = SM_CUM + (size_t)T * 32  ,
                 SM_GATE = SM_EID + (size_t)T * 8, SM_RANK = SM_GATE + (size_t)T * 8, SM_TSLOT = SM_RANK + (size_t)T * 8, SM_CNT = SM_TSLOT + (size_t)T * 8,
                 SM_STOK = SM_CNT + 256 * 32 * 4, SM_SW = SM_STOK + (size_t)CAP * 4, SM_SR = SM_SW + (size_t)CAP * 4, SM_TILEE = SM_SR + (size_t)CAP * 4,
                 SM_PO = SM_TILEE + 4096, SM_KNRM = SM_PO + (size_t)T * 64, SM_END = SM_KNRM + 16 * 256 * 4;
static_assert(SM_END <= 11 * MiB, "small region");
constexpr size_t OFF_ROPE = 11 * MiB;
constexpr size_t OFF_WMIX = 27 * MiB;
constexpr size_t W_A1 = OFF_WMIX, W_A1V = W_A1 + 3 * MiB, W_A2 = W_A1V + 1 * MiB, W_A2V = W_A2 + 768 * 1024, W_OE = W_A2V + 256 * 1024,
                 W_B1 = W_OE + 2 * MiB, W_OO = W_B1 + 12 * MiB, W_MIXEND = W_OO + 4 * MiB;
static_assert(W_MIXEND <= 51 * MiB, "mixer weights");
constexpr size_t OFF_WGU = 51 * MiB, OFF_WDN = OFF_WGU + 64 * MiB;
constexpr size_t OFF_XB = 147 * MiB;
constexpr size_t OFF_ACT = 211 * MiB;
constexpr size_t WS_NEED = OFF_ACT + 320 * MiB;
constexpr size_t A_Z = OFF_ACT, A_QF = A_Z + 32 * MiB, A_KF = A_QF + 32 * MiB, A_VTF = A_KF + 32 * MiB, A_QA = A_VTF + 32 * MiB, A_KA = A_QA + 48 * MiB, A_VTA = A_KA + 48 * MiB;
constexpr size_t A_XS = OFF_ACT, A_HID = OFF_ACT + 144 * MiB;
constexpr size_t A_QX = OFF_ACT, A_KN = A_QX + 32 * MiB, A_KZT = A_KN + 32 * MiB, A_VT = A_KZT + 32 * MiB, A_L = A_VT + 64 * MiB, A_O = A_L + 32 * MiB;
static_assert(A_O + 128 * MiB <= WS_NEED && A_HID + 72 * MiB <= WS_NEED && A_VTA + 32 * MiB <= WS_NEED, "act map");

__device__ __forceinline__ unsigned f2bf(float f) { unsigned u = __builtin_bit_cast(unsigned, f); return (u + 0x7fffu + ((u >> 16) & 1u)) >> 16; }
__device__ __forceinline__ unsigned pk2(float lo, float hi) { unsigned r; asm volatile("v_cvt_pk_bf16_f32 %0, %1, %2" : "=v"(r) : "v"(lo), "v"(hi)); return r; }
__device__ __forceinline__ float bf2f(unsigned short b) { return __builtin_bit_cast(float, ((unsigned)b) << 16); }
__device__ __forceinline__ float bflo(unsigned w) { return __builtin_bit_cast(float, w << 16); }
__device__ __forceinline__ float bfhi(unsigned w) { return __builtin_bit_cast(float, w & 0xffff0000u); }
__device__ __forceinline__ float wave_sum(float v) {
#pragma unroll
    for (int o = 1; o < 64; o <<= 1) v += __shfl_xor(v, o);
    return v;
}
__device__ __forceinline__ int lane_id_opaque() { unsigned z = 0u; asm volatile("" : "+s"(z)); int l = (int)__builtin_amdgcn_mbcnt_hi(~0u, __builtin_amdgcn_mbcnt_lo(~0u, z)); asm volatile("" : "+v"(l)); return l; }
__device__ __forceinline__ int ld_i(const int* p) { return __hip_atomic_load(p, __ATOMIC_RELAXED, __HIP_MEMORY_SCOPE_AGENT); }
__device__ __forceinline__ float rsqrt_f(float x) { return 1.0f / sqrtf(x); }

#define XB_TMO      128
#define XB_XCNT(j)  (256  + 64 * (j))
#define XB_XSUB(j)  (1280 + 64 * (j))
#define XB_XGEN(j)  (2304 + 64 * (j))
#define XB_TOP      3328
#define XB_TOPGEN   3392
#define XCD_BAR_WORDS 3456
#define XB_SPIN_CAP (1u << 18)
__device__ __forceinline__ unsigned xb_ld(unsigned* p)              { return __hip_atomic_load(p, __ATOMIC_RELAXED, __HIP_MEMORY_SCOPE_AGENT); }
__device__ __forceinline__ unsigned xb_add(unsigned* p, unsigned v) { return __hip_atomic_fetch_add(p, v, __ATOMIC_RELAXED, __HIP_MEMORY_SCOPE_AGENT); }
__device__ __forceinline__ unsigned xb_xcc_id() { return (unsigned)__builtin_amdgcn_s_getreg((3 << 11) | 20) & 0xFu; }
#define XB_SPIN(cond, bar) do { unsigned _sp = 0; while (cond) { __builtin_amdgcn_s_sleep(1); \
    if ((++_sp & 255u) == 0u) { if (xb_ld(&(bar)[XB_TMO])) break; if (_sp > XB_SPIN_CAP) { atomicAdd(&(bar)[XB_TMO], 1u); break; } } } } while (0)
struct XcdBarrier { unsigned* bar; unsigned x; volatile LAS unsigned* st; };
__device__ __forceinline__ XcdBarrier xcd_barrier_post(unsigned* bar, volatile LAS unsigned* st, bool t0) {
    XcdBarrier b; b.bar = bar; b.x = xb_xcc_id(); b.st = st;
    if (t0) (void)xb_add(&bar[XB_XCNT(b.x)], 1u);
    return b;
}
__device__ __forceinline__ void xcd_barrier_complete(unsigned* bar, unsigned x, unsigned& nloc, unsigned& nx) {
    const unsigned G = gridDim.x * gridDim.y * gridDim.z;
    unsigned sum, cnt, mine, sp = 0u;
    for (;;) {
        sum = 0u; cnt = 0u; mine = 0u;
#pragma unroll
        for (unsigned j = 0; j < 16; ++j) { const unsigned c = xb_ld(&bar[XB_XCNT(j)]); sum += c; cnt += (c > 0u) ? 1u : 0u; mine = (j == x) ? c : mine; }
        if (sum == G) break;
        __builtin_amdgcn_s_sleep(1);
        if ((++sp & 255u) == 0u) { if (xb_ld(&bar[XB_TMO])) break; if (sp > XB_SPIN_CAP) { atomicAdd(&bar[XB_TMO], 1u); break; } }
    }
    nloc = mine > 0u ? mine : 1u; nx = cnt > 0u ? cnt : 1u;
}
__device__ __forceinline__ void xcd_barrier(const XcdBarrier& b, bool t0) {
    asm volatile("s_waitcnt vmcnt(0)" ::: "memory");
    __syncthreads();
    if (t0) {
        unsigned* bar = b.bar;
        __builtin_amdgcn_s_waitcnt(0);
        unsigned nloc = b.st[0], nx = b.st[1];
        if (nloc == 0u) { xcd_barrier_complete(bar, b.x, nloc, nx); b.st[0] = nloc; b.st[1] = nx; }
        const unsigned old = xb_add(&bar[XB_XSUB(b.x)], 1u);
        const unsigned gen = old / nloc;
        if (old + 1u == (gen + 1u) * nloc) {
            __builtin_amdgcn_fence(__ATOMIC_RELEASE, "agent");
            asm volatile("s_waitcnt vmcnt(0)" ::: "memory");
            const unsigned og = xb_add(&bar[XB_TOP], 1u);
            const unsigned tg = og / nx;
            if (og + 1u == (tg + 1u) * nx) xb_add(&bar[XB_TOPGEN], 1u);
            else XB_SPIN(xb_ld(&bar[XB_TOPGEN]) == tg, bar);
            __builtin_amdgcn_fence(__ATOMIC_ACQUIRE, "agent");
            xb_add(&bar[XB_XGEN(b.x)], 1u);
            asm volatile("s_waitcnt vmcnt(0)" ::: "memory");
        } else {
            XB_SPIN(xb_ld(&bar[XB_XGEN(b.x)]) == gen, bar);
            __builtin_amdgcn_fence(__ATOMIC_ACQUIRE, "agent");
            asm volatile("s_waitcnt vmcnt(0)" ::: "memory");
        }
    }
    __syncthreads();
}

namespace pg8 {
constexpr int BM = 256, BK = 64, HALF = 128, HTB = HALF * BK * 2, STAGE_BYTES = 8 * HTB, NXCD = 8, WGM = 8;
__device__ __forceinline__ int lds_byte(int r, int c) { const int st = (r >> 4) * 2 + (c >> 5), rr = r & 15, cc = c & 31, ob = rr * 64 + cc * 2; return st * 1024 + (ob ^ (((ob >> 9) & 1) << 5)); }
__device__ __forceinline__ void stage_rc(int b, int& R, int& C) { const int st = b / 1024, sb = b % 1024, swz = sb ^ (((sb >> 9) & 1) << 5); R = (st >> 1) * 16 + swz / 64; C = (st & 1) * 32 + (swz % 64) / 2; }
__device__ __forceinline__ int perm32(int rho) { const int n = rho >> 4, i = rho & 15; return 8 * (i >> 2) + 4 * n + (i & 3); }
struct Unit { int pm, pn, aux; };
struct Dims { int lda, ldb, K; };
struct DenseOrder {
    int nM, nN, nwg, G, c;
    __device__ __forceinline__ void init(int nM_, int nN_, int G_, int c_) { nM = nM_; nN = nN_; nwg = nM * nN; G = G_; c = c_; }
    __device__ __forceinline__ bool tile(int i, Unit& u) const {
        const long L = (long)i * G + c; if (L >= nwg) return false;
        int wgid = (int)L; { const int q = nwg / NXCD, r = nwg % NXCD, xcd = wgid % NXCD, off = wgid / NXCD; wgid = (xcd < r ? xcd * (q + 1) : r * (q + 1) + (xcd - r) * q) + off; }
        const int nig = WGM * nN, gid = wgid / nig, fm = gid * WGM, gsz = (nM - fm) < WGM ? (nM - fm) : WGM;
        u.pm = fm + ((wgid % nig) % gsz); u.pn = (wgid % nig) / gsz; u.aux = 0; return true;
    }
};

template <class Epi, class Sched>
__device__ __forceinline__ void gemm_phase(int wave_, LAS unsigned char* lds, const Dims g, const Sched& S, const Epi& E) {
    const int tid = wave_ * 64 + lane_id_opaque();
    const int wid = __builtin_amdgcn_readfirstlane(tid >> 6), lane = tid & 63, wr = wid >> 2, wc = wid & 3, fr = lane & 15, fq = lane >> 4;
    const int K = g.K, nt = K / BK;
    unsigned voffA[2], voffB[2];
#pragma unroll
    for (int i = 0; i < 2; ++i) { int R, C; stage_rc(tid * 16 + i * 8192, R, C); const int Rb = Epi::PERM ? ((R & ~31) + perm32(R & 31)) : R;
        voffA[i] = (unsigned)(R * g.lda + C) * 2u; voffB[i] = (unsigned)(Rb * g.ldb + C) * 2u; }
    const size_t kstep = (size_t)(BK * 2);
    const size_t hstepA = (size_t)HALF * g.lda * 2, hstepB = (size_t)HALF * g.ldb * 2;
    const unsigned ldsw = (unsigned)wid * 1024u;
    const int aoff = lds_byte(wr * 64 + fr, fq * 8), boff = lds_byte(wc * 32 + fr, fq * 8);
#define PG8_SA(b, h) (((b) * 2 + (h)) * HTB)
#define PG8_SB(b, h) ((4 + (b) * 2 + (h)) * HTB)
#define PG8_STAGE(bufoff, gbase, voff) do { _Pragma("unroll") for (int _i = 0; _i < 2; ++_i) \
        __builtin_amdgcn_global_load_lds((const unsigned*)((const char*)(gbase) + (voff)[_i]), (LAS unsigned*)(lds + (bufoff) + ldsw + _i * 8192), 16, 0, 0); } while (0)
#define PG8_LDA(dst, b, h) do { _Pragma("unroll") for (int m = 0; m < 4; ++m) _Pragma("unroll") for (int k = 0; k < 2; ++k) dst[m][k] = *(const LAS bf16x8*)(lds + PG8_SA(b, h) + aoff + m * 2048 + k * 1024); } while (0)
#define PG8_LDB(dst, b, h) do { _Pragma("unroll") for (int n = 0; n < 2; ++n) _Pragma("unroll") for (int k = 0; k < 2; ++k) dst[n][k] = *(const LAS bf16x8*)(lds + PG8_SB(b, h) + boff + n * 2048 + k * 1024); } while (0)
#define PG8_MMA(ai, bj, At, Bt) do { __builtin_amdgcn_s_setprio(1); _Pragma("unroll") for (int m = 0; m < 4; ++m) _Pragma("unroll") for (int n = 0; n < 2; ++n) _Pragma("unroll") for (int k = 0; k < 2; ++k) \
        acc[ai][bj][m][n] = __builtin_amdgcn_mfma_f32_16x16x32_bf16(Bt[n][k], At[m][k], acc[ai][bj][m][n], 0, 0, 0); __builtin_amdgcn_s_setprio(0); } while (0)
#define PG8_WAIT_V(n) asm volatile("s_waitcnt vmcnt(" #n ")" ::: "memory")
#define PG8_WAIT_L(n) asm volatile("s_waitcnt lgkmcnt(" #n ")" ::: "memory")
#define PG8_BAR __builtin_amdgcn_s_barrier()
#define PG8_SCHED __builtin_amdgcn_sched_barrier(0)
    Unit cur, nxt; int ui = 0;
    if (!S.next(0, cur)) return;
    f32x4 acc[2][2][4][2];
#pragma unroll
    for (int a = 0; a < 2; ++a)
#pragma unroll
        for (int b = 0; b < 2; ++b)
#pragma unroll
            for (int m = 0; m < 4; ++m)
#pragma unroll
                for (int n = 0; n < 2; ++n) acc[a][b][m][n] = (f32x4){0.f, 0.f, 0.f, 0.f};
    bf16x8 At[4][2], B0[2][2], B1[2][2];
    const char* cA; const char* cB; S.ptrs(cur, cA, cB);
    PG8_STAGE(PG8_SB(0, 0), cB, voffB); PG8_STAGE(PG8_SB(0, 1), cB + hstepB, voffB); PG8_STAGE(PG8_SA(0, 0), cA, voffA); PG8_STAGE(PG8_SA(0, 1), cA + hstepA, voffA);
    if (wr == 1) PG8_BAR;
    PG8_WAIT_V(2); PG8_BAR;
    PG8_STAGE(PG8_SB(1, 0), cB + kstep, voffB); PG8_STAGE(PG8_SA(1, 0), cA + kstep, voffA); PG8_STAGE(PG8_SB(1, 1), cB + hstepB + kstep, voffB);
    PG8_WAIT_V(6); PG8_BAR;
    for (;;) {
        const bool has_next = S.next(ui + 1, nxt);
        const char* nA = cA; const char* nB = cB; if (has_next) S.ptrs(nxt, nA, nB);
        for (int t = 0; t < nt; t += 2) {
            const bool last = (t == nt - 2);
            const char* a1 = cA + (size_t)(t + 1) * kstep;
            const char* a2 = last ? nA : cA + (size_t)(t + 2) * kstep; const char* b2 = last ? nB : cB + (size_t)(t + 2) * kstep;
            const char* a3 = a2 + kstep; const char* b3 = b2 + kstep;
            PG8_LDB(B0, 0, 0); PG8_LDB(B1, 0, 1); PG8_SCHED; PG8_LDA(At, 0, 0); PG8_STAGE(PG8_SA(1, 1), a1 + hstepA, voffA);
            PG8_WAIT_V(8); PG8_WAIT_L(0); PG8_BAR; PG8_MMA(0, 0, At, B0); PG8_MMA(0, 1, At, B1); PG8_BAR; PG8_SCHED;
            PG8_LDA(At, 0, 1); PG8_STAGE(PG8_SB(0, 0), b2, voffB); PG8_STAGE(PG8_SB(0, 1), b2 + hstepB, voffB); PG8_STAGE(PG8_SA(0, 0), a2, voffA);
            PG8_WAIT_V(8); PG8_WAIT_L(0); PG8_BAR; PG8_MMA(1, 0, At, B0); PG8_MMA(1, 1, At, B1); PG8_BAR; PG8_SCHED;
            PG8_LDB(B0, 1, 0); PG8_LDB(B1, 1, 1); PG8_SCHED; PG8_LDA(At, 1, 0); PG8_STAGE(PG8_SA(0, 1), a2 + hstepA, voffA);
            PG8_WAIT_V(8); PG8_WAIT_L(0); PG8_BAR; PG8_MMA(0, 0, At, B0); PG8_MMA(0, 1, At, B1); PG8_BAR; PG8_SCHED;
            PG8_LDA(At, 1, 1); PG8_STAGE(PG8_SB(1, 0), b3, voffB); PG8_STAGE(PG8_SB(1, 1), b3 + hstepB, voffB); PG8_STAGE(PG8_SA(1, 0), a3, voffA);
            PG8_WAIT_V(8); PG8_WAIT_L(0); PG8_BAR; PG8_MMA(1, 0, At, B0); PG8_MMA(1, 1, At, B1); PG8_BAR; PG8_SCHED;
        }
        if (wr == 0) PG8_BAR;
        { int fr2 = fr, fq2 = fq; asm volatile("" : "+v"(fr2), "+v"(fq2)); E(acc, cur, wr, wc, fr2, fq2); }
        if (!has_next) break;
#pragma unroll
        for (int a = 0; a < 2; ++a)
#pragma unroll
            for (int b = 0; b < 2; ++b)
#pragma unroll
                for (int m = 0; m < 4; ++m)
#pragma unroll
                    for (int n = 0; n < 2; ++n) acc[a][b][m][n] = (f32x4){0.f, 0.f, 0.f, 0.f};
        cur = nxt; cA = nA; cB = nB; ++ui;
        if (wr == 1) PG8_BAR;
    }
    PG8_WAIT_V(0);
    PG8_BAR;
#undef PG8_SA
#undef PG8_SB
#undef PG8_STAGE
#undef PG8_LDA
#undef PG8_LDB
#undef PG8_MMA
#undef PG8_WAIT_V
#undef PG8_WAIT_L
#undef PG8_BAR
#undef PG8_SCHED
}
}
using pg8::Unit;

struct Params {
    const float* in[21];
    float* out;
    unsigned char* ws;
    int ph_lo, ph_hi;
    int use_bar, pad;
};
enum { I_X = 0, I_LN_MIX_E, I_W_IN_E, I_LN_Q, I_W_UQ, I_LN_KV, I_W_UKV, I_B_F, I_W_OUT_E, I_LN_MIX_O, I_W_IN_O, I_W_OUT_O, I_LN_FFN, I_W_RG, I_B_RG, I_W_RE, I_B_RE, I_W_GATE, I_W_UP, I_W_DOWN, I_LN_F };

#define WSP(T_, off) ((T_*)(ws_ + (off)))
typedef const Params __attribute__((address_space(4)))* KParams;
#define P_OPAQUE KParams Pk_ = (KParams)__builtin_amdgcn_kernarg_segment_ptr(); asm volatile("" : "+s"(Pk_)); const Params& P = *(const Params*)Pk_
#define WS_OPAQUE P_OPAQUE; unsigned char* ws_ = P.ws

__device__ __forceinline__ float log2_gamma(int h) { return __builtin_log2f(1.0f - __builtin_exp2f(-5.0f - (float)h)); }

struct DenseSched {
    pg8::DenseOrder O; const char* A; const char* B; size_t astep, bstep;
    __device__ __forceinline__ void init(const void* A_, int lda, const void* B_, int ldb, int nM, int nN, int G, int c) {
        O.init(nM, nN, G, c); A = (const char*)A_; B = (const char*)B_; astep = (size_t)256 * lda * 2; bstep = (size_t)256 * ldb * 2; }
    __device__ __forceinline__ bool next(int i, Unit& u) const { return O.tile(i, u); }
    __device__ __forceinline__ void ptrs(const Unit& u, const char*& a, const char*& b) const { a = A + (size_t)u.pm * astep; b = B + (size_t)u.pn * bstep; }
};
struct MoeSched {
    const char* A; const char* B; const int* tilee; size_t astep, estep, bstep; int ntile, G, c;
    __device__ __forceinline__ void init(const void* A_, int lda, const void* B_, int ldb, size_t expert_rows, const int* tilee_, int G_, int c_) {
        A = (const char*)A_; B = (const char*)B_; tilee = tilee_; astep = (size_t)256 * lda * 2; bstep = (size_t)256 * ldb * 2; estep = expert_rows * ldb * 2; G = G_; c = c_;
        ntile = __builtin_amdgcn_readfirstlane(ld_i(tilee_ + 300)); }
    __device__ __forceinline__ bool next(int i, Unit& u) const { const int L = i * G + c; if (L >= ntile * 4) return false; u.pm = L >> 2; u.pn = L & 3; u.aux = __builtin_amdgcn_readfirstlane(ld_i(tilee + (L >> 2))); return true; }
    __device__ __forceinline__ void ptrs(const Unit& u, const char*& a, const char*& b) const { a = A + (size_t)u.pm * astep; b = B + (size_t)u.aux * estep + (size_t)u.pn * bstep; }
};

typedef const f32x4 (&AccRef)[2][2][4][2];
#define EPI_LOOP_AI_M for (int ai = 0; ai < 2; ++ai) _Pragma("unroll") for (int m = 0; m < 4; ++m)
#define EPI_LOOP_BJ_N for (int bj = 0; bj < 2; ++bj) _Pragma("unroll") for (int n = 0; n < 2; ++n)

struct EpiA1a {
    static constexpr bool PERM = false;
    const float* rs0; bf16_t* Z; float* PQ; float* PKV; bf16_t* KA; float* LF; const float* bf; bf16_t* QF; bf16_t* KF; const f32x2* rope;
    __device__ __forceinline__ void operator()(AccRef acc, const Unit& u, int wr, int wc, int fr, int fq) const {
        const int row0 = u.pm * 256 + wr * 64 + fr; float rsv[2][4];
#pragma unroll
        EPI_LOOP_AI_M rsv[ai][m] = rs0[row0 + ai * 128 + m * 16];
        if (u.pn <= 1) {
            const int zc = u.pn * 256 + wc * 32 + 4 * fq;
#pragma unroll
            EPI_LOOP_AI_M { const int r = row0 + ai * 128 + m * 16; const float rs = rsv[ai][m]; float ss = 0.f; f32x4 v[2][2];
#pragma unroll
                EPI_LOOP_BJ_N { v[bj][n] = acc[ai][bj][m][n] * rs; u32x2 w; w.x = pk2(v[bj][n][0], v[bj][n][1]); w.y = pk2(v[bj][n][2], v[bj][n][3]);
                    *(u32x2*)(Z + (size_t)r * 512 + zc + bj * 128 + n * 16) = w;
                    if (u.pn == 0 || bj == 0) ss += (v[bj][n][0] * v[bj][n][0] + v[bj][n][1] * v[bj][n][1]) + (v[bj][n][2] * v[bj][n][2] + v[bj][n][3] * v[bj][n][3]); }
                ss += __shfl_xor(ss, 16); ss += __shfl_xor(ss, 32);
                if (fq == 0) { if (u.pn == 0) PQ[(size_t)r * 4 + wc] = ss; else PKV[(size_t)r * 4 + wc] = ss; }
                if (u.pn == 1 && wc == 0) {
                    const int pos = r & (S - 1); const f32x4 x1 = v[1][0], x2 = v[1][1]; f32x4 o1, o2;
#pragma unroll
                    for (int j = 0; j < 4; ++j) { const f32x2 cs = rope[(size_t)pos * 128 + 8 * (4 * fq + j)]; o1[j] = x1[j] * cs.x - x2[j] * cs.y; o2[j] = x1[j] * cs.y + x2[j] * cs.x; }
                    u32x2 w1, w2; w1.x = pk2(o1[0], o1[1]); w1.y = pk2(o1[2], o1[3]); w2.x = pk2(o2[0], o2[1]); w2.y = pk2(o2[2], o2[3]);
#pragma unroll
                    for (int hh = 0; hh < 8; ++hh) { bf16_t* kp = KA + (size_t)r * 768 + hh * 96 + 64 + 4 * fq; *(u32x2*)kp = w1; *(u32x2*)(kp + 16) = w2; }
                }
                if (u.pn == 1 && wc == 1 && fq < 2) {
                    const f32x4 f = v[1][0]; f32x4 o;
#pragma unroll
                    for (int j = 0; j < 4; ++j) { const float x = f[j] + bf[4 * fq + j]; o[j] = fminf(x, 0.f) - log1pf(__expf(-fabsf(x))); }
                    *(f32x4*)(LF + (size_t)r * 8 + 4 * fq) = o;
                }
            }
        } else {
            const bool isq = u.pn < 4; bf16_t* dst = isq ? QF : KF; const int cc = (isq ? (u.pn - 2) : (u.pn - 4)) * 256 + wc * 32 + 4 * fq; const float sc = isq ? (0.125f * LOG2E) : 1.0f;
#pragma unroll
            EPI_LOOP_AI_M { const int r = row0 + ai * 128 + m * 16; const float rs = rsv[ai][m] * sc;
#pragma unroll
                EPI_LOOP_BJ_N { const f32x4 v = acc[ai][bj][m][n] * rs; u32x2 w; w.x = pk2(v[0], v[1]); w.y = pk2(v[2], v[3]); *(u32x2*)(dst + (size_t)r * 512 + cc + bj * 128 + n * 16) = w; } }
        }
    }
};
template <int MODE> struct EpiVT {
    static constexpr bool PERM = true;
    const float* rs; bf16_t* OUT; size_t ldo;
    __device__ __forceinline__ float cs(int t) const { if (MODE == 0) return rs[t]; const f32x4 p = *(const f32x4*)(rs + (size_t)t * 4); return rsqrt_f(((p[0] + p[1]) + (p[2] + p[3])) * (1.0f / 128.0f) + EPS); }
    __device__ __forceinline__ void operator()(AccRef acc, const Unit& u, int wr, int wc, int fr, int fq) const {
        const int f0 = u.pm * 256 + wr * 64 + fr, t0 = u.pn * 256 + wc * 32 + 8 * fq;
#pragma unroll
        for (int bj = 0; bj < 2; ++bj) { float c[8];
#pragma unroll
            for (int j = 0; j < 8; ++j) c[j] = cs(t0 + bj * 128 + j);
#pragma unroll
            EPI_LOOP_AI_M { const f32x4 a = acc[ai][bj][m][0], b = acc[ai][bj][m][1]; u32x4 w;
                w.x = pk2(a[0] * c[0], a[1] * c[1]); w.y = pk2(a[2] * c[2], a[3] * c[3]); w.z = pk2(b[0] * c[4], b[1] * c[5]); w.w = pk2(b[2] * c[6], b[3] * c[7]);
                const int f_ = f0 + ai * 128 + m * 16, t_ = t0 + bj * 128;
                *(u32x4*)(OUT + (((size_t)(f_ >> 6) * (T / 64) + (t_ >> 6)) * 64 + (f_ & 63)) * 64 + (t_ & 63)) = w; } }
    }
};
struct EpiA2q {
    static constexpr bool PERM = false;
    const float* PQ; bf16_t* QA; const f32x2* rope;
    __device__ __forceinline__ void operator()(AccRef acc, const Unit& u, int wr, int wc, int fr, int fq) const {
        if (wc == 3) return;
        const int row0 = u.pm * 256 + wr * 64 + fr; const float SCA = 0.10206207261596577f * LOG2E;
#pragma unroll
        for (int ai = 0; ai < 2; ++ai) { f32x2 csv[4][4]; f32x4 pv[2][4];
#pragma unroll
            for (int m = 0; m < 4; ++m) pv[ai][m] = *(const f32x4*)(PQ + (size_t)(row0 + ai * 128 + m * 16) * 4);
            if (wc == 2) {
#pragma unroll
                for (int m = 0; m < 4; ++m)
#pragma unroll
                    for (int j = 0; j < 4; ++j) csv[m][j] = rope[(size_t)((row0 + ai * 128 + m * 16) & (S - 1)) * 128 + 8 * (4 * fq + j)]; }
#pragma unroll
            for (int m = 0; m < 4; ++m) { const int r = row0 + ai * 128 + m * 16; const f32x4 p = pv[ai][m];
                const float rs = rsqrt_f(((p[0] + p[1]) + (p[2] + p[3])) * (1.0f / 256.0f) + EPS) * SCA;
#pragma unroll
                for (int bj = 0; bj < 2; ++bj) { const int hh = 2 * u.pn + bj; bf16_t* qp = QA + (size_t)r * 768 + hh * 96 + wc * 32 + 4 * fq; f32x4 x1 = acc[ai][bj][m][0] * rs, x2 = acc[ai][bj][m][1] * rs;
                    if (wc == 2) {
#pragma unroll
                        for (int j = 0; j < 4; ++j) { const f32x2 cs = csv[m][j]; const float a = x1[j], b = x2[j]; x1[j] = a * cs.x - b * cs.y; x2[j] = a * cs.y + b * cs.x; } }
                    *(u32x2*)qp = (u32x2){pk2(x1[0], x1[1]), pk2(x1[2], x1[3])}; *(u32x2*)(qp + 16) = (u32x2){pk2(x2[0], x2[1]), pk2(x2[2], x2[3])}; } } }
    }
};
struct EpiA2k {
    static constexpr bool PERM = false;
    const float* PKV; bf16_t* KA;
    __device__ __forceinline__ void operator()(AccRef acc, const Unit& u, int wr, int wc, int fr, int fq) const {
        const int row0 = u.pm * 256 + wr * 64 + fr; f32x4 pv[2][4];
#pragma unroll
        EPI_LOOP_AI_M pv[ai][m] = *(const f32x4*)(PKV + (size_t)(row0 + ai * 128 + m * 16) * 4);
#pragma unroll
        EPI_LOOP_AI_M { const int r = row0 + ai * 128 + m * 16; const f32x4 p = pv[ai][m];
            const float rs = rsqrt_f(((p[0] + p[1]) + (p[2] + p[3])) * (1.0f / 128.0f) + EPS);
#pragma unroll
            EPI_LOOP_BJ_N { const int hh = 4 * u.pn + 2 * bj + (wc >> 1), dd = 32 * (wc & 1) + 16 * n + 4 * fq; const f32x4 v = acc[ai][bj][m][n] * rs;
                *(u32x2*)(KA + (size_t)r * 768 + hh * 96 + dd) = (u32x2){pk2(v[0], v[1]), pk2(v[2], v[3])}; } }
    }
};
struct EpiRes {
    static constexpr bool PERM = false;
    const float* base; float* outp;
    __device__ __forceinline__ void operator()(AccRef acc, const Unit& u, int wr, int wc, int fr, int fq) const {
        const int row0 = u.pm * 256 + wr * 64 + fr, col0 = u.pn * 256 + wc * 32 + 4 * fq;
#pragma unroll
        for (int ai = 0; ai < 2; ++ai) { f32x4 b[4][2][2];
#pragma unroll
            for (int m = 0; m < 4; ++m)
#pragma unroll
                EPI_LOOP_BJ_N b[m][bj][n] = *(const f32x4*)(base + (size_t)(row0 + ai * 128 + m * 16) * D + col0 + bj * 128 + n * 16);
#pragma unroll
            for (int m = 0; m < 4; ++m)
#pragma unroll
                EPI_LOOP_BJ_N *(f32x4*)(outp + (size_t)(row0 + ai * 128 + m * 16) * D + col0 + bj * 128 + n * 16) = b[m][bj][n] + acc[ai][bj][m][n]; }
    }
};
struct EpiB1q {
    static constexpr bool PERM = false;
    const float* rs2; bf16_t* QX; const f32x2* rope;
    __device__ __forceinline__ void operator()(AccRef acc, const Unit& u, int wr, int wc, int fr, int fq) const {
        const int row0 = u.pm * 256 + wr * 64 + fr; const float l2g = log2_gamma(u.pn); float rsv[2][4];
#pragma unroll
        EPI_LOOP_AI_M rsv[ai][m] = rs2[row0 + ai * 128 + m * 16];
#pragma unroll
        for (int ai = 0; ai < 2; ++ai)
#pragma unroll
            for (int mp = 0; mp < 2; ++mp) { f32x4 ca[2][2], cb[2][2];
#pragma unroll
                for (int mm = 0; mm < 2; ++mm)
#pragma unroll
                    for (int n = 0; n < 2; ++n) { const int pos = row0 + ai * 128 + (2 * mp + mm) * 16, i0 = wc * 32 + 16 * n + 4 * fq; ca[mm][n] = *(const f32x4*)(rope + (size_t)pos * 128 + i0); cb[mm][n] = *(const f32x4*)(rope + (size_t)pos * 128 + i0 + 2); }
#pragma unroll
                for (int mm = 0; mm < 2; ++mm) { const int m = 2 * mp + mm, pos = row0 + ai * 128 + m * 16; const float rs = rsv[ai][m] * __builtin_exp2f((float)((pos & 63) + 1) * l2g);
#pragma unroll
                    for (int n = 0; n < 2; ++n) { const int i0 = wc * 32 + 16 * n + 4 * fq; const f32x4 x1 = acc[ai][0][m][n] * rs, x2 = acc[ai][1][m][n] * rs; f32x4 o1, o2;
                        const float cc[4] = {ca[mm][n][0], ca[mm][n][2], cb[mm][n][0], cb[mm][n][2]}, sn[4] = {ca[mm][n][1], ca[mm][n][3], cb[mm][n][1], cb[mm][n][3]};
#pragma unroll
                        for (int j = 0; j < 4; ++j) { o1[j] = x1[j] * cc[j] - x2[j] * sn[j]; o2[j] = x1[j] * sn[j] + x2[j] * cc[j]; }
                        bf16_t* qp = QX + (size_t)pos * 1024 + u.pn * 256 + i0; *(u32x2*)qp = (u32x2){pk2(o1[0], o1[1]), pk2(o1[2], o1[3])}; *(u32x2*)(qp + 128) = (u32x2){pk2(o2[0], o2[1]), pk2(o2[2], o2[3])}; } } }
    }
};
__device__ __forceinline__ int rho_of_d(int d) { const int lo = d & 31; return (d & ~31) | (((lo >> 2) & 1) << 4) | ((lo >> 3) << 2) | (lo & 3); }
struct EpiB1k {
    static constexpr bool PERM = true;
    const float* rs2; bf16_t* KN; bf16_t* KZT; const f32x2* rope; LAS unsigned char* scr;
    __device__ __forceinline__ void operator()(AccRef acc, const Unit& u, int wr, int wc, int fr, int fq) const {
        const int h = u.pm, t0 = u.pn * 256 + wc * 32 + 8 * fq; const float l2g = log2_gamma(h);
        LAS unsigned char* my = scr + (wr * 4 + wc) * 1024; const int lane = fq * 16 + fr;
#pragma unroll
        for (int bj = 0; bj < 2; ++bj) { const int tb = t0 + bj * 128; float rs[8], zt[8];
#pragma unroll
            for (int j = 0; j < 8; ++j) { rs[j] = rs2[tb + j] * 0.0625f; zt[j] = __builtin_exp2f((float)(63 - ((tb + j) & 63)) * l2g); }
            const int chunk = tb >> 6, c0 = tb & 63;
            f32x2 csv[4][8];
#pragma unroll
            for (int m = 0; m < 4; ++m)
#pragma unroll
                for (int j = 0; j < 8; ++j) csv[m][j] = rope[(size_t)(tb + j) * 128 + wr * 64 + m * 16 + fr];
#pragma unroll
            for (int m = 0; m < 4; ++m) { const int d = wr * 64 + m * 16 + fr; float k1[8], k2[8];
#pragma unroll
                for (int j = 0; j < 8; ++j) { const f32x2 cs = csv[m][j]; const float x1 = acc[0][bj][m][j >> 2][j & 3] * rs[j], x2 = acc[1][bj][m][j >> 2][j & 3] * rs[j];
                    k1[j] = x1 * cs.x - x2 * cs.y; k2[j] = x1 * cs.y + x2 * cs.x; }
                const int rho = rho_of_d(d); u32x4 w1, w2;
                w1.x = pk2(k1[0] * zt[0], k1[1] * zt[1]); w1.y = pk2(k1[2] * zt[2], k1[3] * zt[3]); w1.z = pk2(k1[4] * zt[4], k1[5] * zt[5]); w1.w = pk2(k1[6] * zt[6], k1[7] * zt[7]);
                w2.x = pk2(k2[0] * zt[0], k2[1] * zt[1]); w2.y = pk2(k2[2] * zt[2], k2[3] * zt[3]); w2.z = pk2(k2[4] * zt[4], k2[5] * zt[5]); w2.w = pk2(k2[6] * zt[6], k2[7] * zt[7]);
                bf16_t* zp = KZT + (((size_t)(h * 256 + chunk) * 256 + rho) * 64 + c0); *(u32x4*)zp = w1; *(u32x4*)(zp + 128 * 64) = w2;
#pragma unroll
                for (int half = 0; half < 2; ++half) { const float* kk = half ? k2 : k1;
#pragma unroll
                    for (int j = 0; j < 8; ++j) *(LAS bf16_t*)(my + (8 * fq + j) * 32 + fr * 2) = (bf16_t)f2bf(kk[j]);
                    asm volatile("s_waitcnt lgkmcnt(0)" ::: "memory");
                    const u32x4 v = *(const LAS u32x4*)(my + (lane >> 1) * 32 + (lane & 1) * 16);
                    const int tok = u.pn * 256 + wc * 32 + bj * 128 + (lane >> 1);
                    *(u32x4*)(KN + (size_t)tok * 1024 + h * 256 + half * 128 + wr * 64 + m * 16 + (lane & 1) * 8) = v;
                    asm volatile("s_waitcnt lgkmcnt(0)" ::: "memory"); } } }
    }
};
struct EpiB1v {
    static constexpr bool PERM = true;
    const float* rs2; bf16_t* VT;
    __device__ __forceinline__ void operator()(AccRef acc, const Unit& u, int wr, int wc, int fr, int fq) const {
        const int h = u.pm >> 1, e0 = (u.pm & 1) * 256 + wr * 64 + fr, t0 = u.pn * 256 + wc * 32 + 8 * fq;
#pragma unroll
        for (int bj = 0; bj < 2; ++bj) { const int tb = t0 + bj * 128; float c[8];
#pragma unroll
            for (int j = 0; j < 8; ++j) c[j] = rs2[tb + j];
            const int chunk = tb >> 6, c0 = tb & 63;
#pragma unroll
            EPI_LOOP_AI_M { const f32x4 a = acc[ai][bj][m][0], b = acc[ai][bj][m][1]; u32x4 w;
                w.x = pk2(a[0] * c[0], a[1] * c[1]); w.y = pk2(a[2] * c[2], a[3] * c[3]); w.z = pk2(b[0] * c[4], b[1] * c[5]); w.w = pk2(b[2] * c[6], b[3] * c[7]);
                *(u32x4*)(VT + (((size_t)(h * 256 + chunk) * 512 + e0 + ai * 128 + m * 16) * 64 + c0)) = w; } }
    }
};
struct EpiG {
    static constexpr bool PERM = true;
    const float* rs2; const float* PO; bf16_t* O;
    __device__ __forceinline__ void operator()(AccRef acc, const Unit& u, int wr, int wc, int fr, int fq) const {
        const int row0 = u.pm * 256 + wr * 64 + fr, col0 = u.pn * 256 + wc * 32 + 8 * fq, head = u.pn >> 1;
        f32x4 pv[2][4]; float rsv[2][4];
#pragma unroll
        EPI_LOOP_AI_M { const int r = row0 + ai * 128 + m * 16; pv[ai][m] = *(const f32x4*)(PO + (size_t)r * 16 + head * 4); rsv[ai][m] = rs2[r]; }
#pragma unroll
        for (int ai = 0; ai < 2; ++ai) { u32x4 ov[4][2];
#pragma unroll
            for (int m = 0; m < 4; ++m)
#pragma unroll
                for (int bj = 0; bj < 2; ++bj) ov[m][bj] = *(const u32x4*)(O + (size_t)(row0 + ai * 128 + m * 16) * 2048 + col0 + bj * 128);
#pragma unroll
            for (int m = 0; m < 4; ++m) { const f32x4 p = pv[ai][m]; const float ro = rsqrt_f(((p[0] + p[1]) + (p[2] + p[3])) * (1.0f / 512.0f) + EPS), rs = rsv[ai][m];
#pragma unroll
                for (int bj = 0; bj < 2; ++bj) { const u32x4 o4 = ov[m][bj]; const float o[8] = {bflo(o4.x), bfhi(o4.x), bflo(o4.y), bfhi(o4.y), bflo(o4.z), bfhi(o4.z), bflo(o4.w), bfhi(o4.w)}; float a[8];
#pragma unroll
                    for (int j = 0; j < 8; ++j) { const float g = acc[ai][bj][m][j >> 2][j & 3] * rs; a[j] = o[j] * ro * g / (1.0f + __expf(-g)); }
                    *(u32x4*)(O + (size_t)(row0 + ai * 128 + m * 16) * 2048 + col0 + bj * 128) = (u32x4){pk2(a[0], a[1]), pk2(a[2], a[3]), pk2(a[4], a[5]), pk2(a[6], a[7])}; } } }
    }
};
struct EpiM3 {
    static constexpr bool PERM = true;
    const float* SR; bf16_t* HID;
    __device__ __forceinline__ void operator()(AccRef acc, const Unit& u, int wr, int wc, int fr, int fq) const {
        const int row0 = u.pm * 256 + wr * 64 + fr, col0 = u.pn * 128 + wc * 32 + 8 * fq; float rsv[2][4];
#pragma unroll
        EPI_LOOP_AI_M rsv[ai][m] = SR[row0 + ai * 128 + m * 16];
#pragma unroll
        EPI_LOOP_AI_M { const int r = row0 + ai * 128 + m * 16; const float rs = rsv[ai][m]; float hh[8];
#pragma unroll
            for (int j = 0; j < 8; ++j) { const float g = acc[ai][0][m][j >> 2][j & 3] * rs, up = acc[ai][1][m][j >> 2][j & 3] * rs; hh[j] = g / (1.0f + __expf(-g)) * up; }
            u32x4 w; w.x = pk2(hh[0], hh[1]); w.y = pk2(hh[2], hh[3]); w.z = pk2(hh[4], hh[5]); w.w = pk2(hh[6], hh[7]); *(u32x4*)(HID + (size_t)r * 512 + col0) = w; }
    }
};
struct EpiM4 {
    static constexpr bool PERM = true;
    const float* SW; bf16_t* YS;
    __device__ __forceinline__ void operator()(AccRef acc, const Unit& u, int wr, int wc, int fr, int fq) const {
        const int row0 = u.pm * 256 + wr * 64 + fr, col0 = u.pn * 256 + wc * 32 + 8 * fq; float swv[2][4];
#pragma unroll
        EPI_LOOP_AI_M swv[ai][m] = SW[row0 + ai * 128 + m * 16];
#pragma unroll
        EPI_LOOP_AI_M { const int r = row0 + ai * 128 + m * 16; const float sw = swv[ai][m];
#pragma unroll
            for (int bj = 0; bj < 2; ++bj) { const f32x4 a = acc[ai][bj][m][0] * sw, b = acc[ai][bj][m][1] * sw; u32x4 w; w.x = pk2(a[0], a[1]); w.y = pk2(a[2], a[3]); w.z = pk2(b[0], b[1]); w.w = pk2(b[2], b[3]);
                *(u32x4*)(YS + (size_t)r * 1024 + col0 + bj * 128) = w; } }
    }
};

__device__ __forceinline__ int crow(int r, int hi) { return (r & 3) + 8 * (r >> 2) + 4 * hi; }
template <int DQK, bool FOX>
__device__ __forceinline__ void attn_unit(int wave_, LAS unsigned char* L, const bf16_t* Qb, int ldq, const bf16_t* Kb, int ldk, const bf16_t* Vtb, const float* cum, const float* knrm, bf16_t* Ob, int ldo, int qb) {
    constexpr int KP = DQK + 8, KBYTES = 64 * KP * 2, VBYTES = 64 * 136, BUF = KBYTES + VBYTES + 256, NS = DQK / 16, KCH = DQK / 8;
    constexpr int XOFF = 3 * BUF;
    constexpr float THR = 8.0f;
    const int tid = wave_ * 64 + lane_id_opaque();
    const int lane = tid & 63, w = wave_, r32 = lane & 31, hi = lane >> 5;
    const int R0 = 256 * qb + 32 * w, q = R0 + r32, NT = 4 * qb + 4, jmax = 4 * qb + (w >> 1);
    bf16x8 qf[NS];
#pragma unroll
    for (int s = 0; s < NS; ++s) qf[s] = *(const bf16x8*)(Qb + (size_t)q * ldq + 16 * s + 8 * hi);
    const float cq = FOX ? cum[q] : 0.f;
    int j0 = 0;
    if (FOX) {
        float n2 = 0.f;
#pragma unroll
        for (int s = 0; s < NS; ++s)
#pragma unroll
            for (int e = 0; e < 8; ++e) { const float x = bf2f((unsigned short)qf[s][e]); n2 += x * x; }
        n2 += __shfl_xor(n2, 32);
#pragma unroll
        for (int o = 1; o < 32; o <<= 1) n2 = fmaxf(n2, __shfl_xor(n2, o));
        LAS float* xs = (LAS float*)(L + XOFF); LAS int* xj = (LAS int*)(L + XOFF + 32);
        if (lane == 0) xs[w] = n2;
        if (tid == 0) xj[0] = 4 * qb;
        __syncthreads();
        float qn = xs[0];
#pragma unroll
        for (int i = 1; i < 8; ++i) qn = fmaxf(qn, xs[i]);
        qn = sqrtf(qn) * 1.01f;
        if (tid < NT) { const float bound = qn * knrm[tid] * 1.01f + cum[256 * qb] - cum[64 * tid + 63]; if (bound >= -160.0f) atomicMin((int*)xj, tid); }
        __syncthreads();
        j0 = xj[0];
    }
    f32x16 o0 = {}, o1 = {}; float mhat = 0.f, lrun = 0.f;
    const int kr0 = tid / KCH, kc0 = tid % KCH, kr1 = (tid + 512) / KCH, kc1 = (tid + 512) % KCH; const bool has1 = (tid + 512) < 64 * KCH;
    const int ve = tid >> 3, vc = tid & 7;
    u32x4 kreg0A, kreg1A = {}, vregA, kreg0B, kreg1B = {}, vregB; float ckregA = 0.f, ckregB = 0.f;
    const int kr1c = has1 ? kr1 : kr0, kc1c = has1 ? kc1 : kc0; const int ckl = tid & 63;
#define ATT_SLOT(i) (((i) % 3) * BUF)
#define ATT_LOADK(j, X) do { const int j_ = (j) < NT ? (j) : NT - 1; kreg0##X = *(const u32x4*)(Kb + (size_t)(64 * j_ + kr0) * ldk + kc0 * 8); if (DQK > 64) kreg1##X = *(const u32x4*)(Kb + (size_t)(64 * j_ + kr1c) * ldk + kc1c * 8); \
        if (FOX) ckreg##X = cum[64 * j_ + ckl]; } while (0)
#define ATT_LOADV(j, X) do { const int j_ = (j) < NT ? (j) : NT - 1; vreg##X = *(const u32x4*)(Vtb + (size_t)j_ * 4096 + ve * 64 + vc * 8); } while (0)
#define ATT_WRITEK(bo, X) do { *(LAS u32x4*)(L + (bo) + kr0 * (KP * 2) + kc0 * 16) = kreg0##X; if (DQK > 64) { if (has1) *(LAS u32x4*)(L + (bo) + kr1 * (KP * 2) + kc1 * 16) = kreg1##X; } \
        if (FOX && tid < 64) *(LAS float*)(L + (bo) + KBYTES + VBYTES + tid * 4) = ckreg##X; } while (0)
#define ATT_WRITEV(bo, X) do { *(LAS u32x2*)(L + (bo) + KBYTES + ve * 136 + vc * 16) = (u32x2){vreg##X.x, vreg##X.y}; *(LAS u32x2*)(L + (bo) + KBYTES + ve * 136 + vc * 16 + 8) = (u32x2){vreg##X.z, vreg##X.w}; } while (0)
    bf16x8 kf[2 * NS]; f32x4 ckv[8]; u32x2 vfr[16]; f32x16 s0, s1; u32x4 pw[4]; float rm = 0.f;
#define ATT_QK_ISSUE(bo) do { \
        _Pragma("unroll") for (int s = 0; s < NS; ++s) { kf[2 * s] = *(const LAS bf16x8*)(L + (bo) + r32 * (KP * 2) + (16 * s + 8 * hi) * 2); kf[2 * s + 1] = *(const LAS bf16x8*)(L + (bo) + (32 + r32) * (KP * 2) + (16 * s + 8 * hi) * 2); } \
        if (FOX) { _Pragma("unroll") for (int g = 0; g < 4; ++g) { ckv[g] = *(const LAS f32x4*)(L + (bo) + KBYTES + VBYTES + (8 * g + 4 * hi) * 4); ckv[4 + g] = *(const LAS f32x4*)(L + (bo) + KBYTES + VBYTES + (32 + 8 * g + 4 * hi) * 4); } } } while (0)
#define ATT_QK_MMA(S0, S1) do { \
        if (FOX) { const float cqm = cq - mhat; \
            _Pragma("unroll") for (int g = 0; g < 4; ++g) { _Pragma("unroll") for (int e = 0; e < 4; ++e) { S0[4 * g + e] = cqm - ckv[g][e]; S1[4 * g + e] = cqm - ckv[4 + g][e]; } } \
        } else { _Pragma("unroll") for (int r = 0; r < 16; ++r) { S0[r] = -mhat; S1[r] = -mhat; } } \
        _Pragma("unroll") for (int s = 0; s < NS; ++s) { S0 = __builtin_amdgcn_mfma_f32_32x32x16_bf16(kf[2 * s], qf[s], S0, 0, 0, 0); S1 = __builtin_amdgcn_mfma_f32_32x32x16_bf16(kf[2 * s + 1], qf[s], S1, 0, 0, 0); } } while (0)
#define ATT_PV_ISSUE(bo) do { _Pragma("unroll") for (int ks = 0; ks < 4; ++ks) { const LAS unsigned char* vb = L + (bo) + KBYTES + r32 * 136 + 32 * ks + 8 * hi; \
            vfr[4 * ks] = *(const LAS u32x2*)(vb); vfr[4 * ks + 1] = *(const LAS u32x2*)(vb + 16); vfr[4 * ks + 2] = *(const LAS u32x2*)(vb + 32 * 136); vfr[4 * ks + 3] = *(const LAS u32x2*)(vb + 32 * 136 + 16); } } while (0)
#define ATT_PV_MMA() do { _Pragma("unroll") for (int ks = 0; ks < 4; ++ks) { \
            const bf16x8 va = __builtin_bit_cast(bf16x8, (u32x4){vfr[4 * ks].x, vfr[4 * ks].y, vfr[4 * ks + 1].x, vfr[4 * ks + 1].y}), vbb = __builtin_bit_cast(bf16x8, (u32x4){vfr[4 * ks + 2].x, vfr[4 * ks + 2].y, vfr[4 * ks + 3].x, vfr[4 * ks + 3].y}), pf = __builtin_bit_cast(bf16x8, pw[ks]); \
            o0 = __builtin_amdgcn_mfma_f32_32x32x16_bf16(va, pf, o0, 0, 0, 0); o1 = __builtin_amdgcn_mfma_f32_32x32x16_bf16(vbb, pf, o1, 0, 0, 0); } } while (0)
#define ATT_M(t) do { const int t_ = (t); const bool doPV = (t_ - 1 >= j0) && (t_ - 1 <= jmax), doQK = (t_ < NT) && (t_ <= jmax); \
        if (doPV) { ATT_PV_ISSUE(ATT_SLOT(t_ - 1)); __builtin_amdgcn_sched_barrier(0); asm volatile("s_waitcnt lgkmcnt(0)" ::: "memory"); __builtin_amdgcn_sched_barrier(0); ATT_PV_MMA(); } \
        if (doQK) { ATT_QK_ISSUE(ATT_SLOT(t_)); __builtin_amdgcn_sched_barrier(0); asm volatile("s_waitcnt lgkmcnt(0)" ::: "memory"); __builtin_amdgcn_sched_barrier(0); ATT_QK_MMA(s0, s1); } } while (0)
#define ATT_X(t, X) do { const int t_ = (t); \
        if (t_ <= jmax) { \
            if (FOX && t_ == jmax) { _Pragma("unroll") for (int r = 0; r < 16; ++r) { const int kg = 64 * t_ + crow(r, hi); if (kg > q) s0[r] = -1e30f; if (kg + 32 > q) s1[r] = -1e30f; } } \
            float mx_ = fmaxf(fmaxf(s0[0], s1[0]), fmaxf(s0[1], s1[1])); \
            _Pragma("unroll") for (int r = 2; r < 16; r += 2) mx_ = fmaxf(mx_, fmaxf(fmaxf(s0[r], s1[r]), fmaxf(s0[r + 1], s1[r + 1]))); \
            rm = fmaxf(mx_, __shfl_xor(mx_, 32)); \
            if (__any(rm > THR)) { const float dl = fmaxf(rm, 0.f), f = __builtin_amdgcn_exp2f(-dl); mhat += dl; lrun *= f; \
                _Pragma("unroll") for (int r = 0; r < 16; ++r) { s0[r] -= dl; s1[r] -= dl; o0[r] *= f; o1[r] *= f; } } \
            float ls0 = 0.f, ls1 = 0.f; \
            _Pragma("unroll") for (int r = 0; r < 16; ++r) { s0[r] = __builtin_amdgcn_exp2f(s0[r]); s1[r] = __builtin_amdgcn_exp2f(s1[r]); ls0 += s0[r]; ls1 += s1[r]; } \
            lrun += ls0 + ls1; \
            _Pragma("unroll") for (int ks = 0; ks < 4; ++ks) { const int b_ = 8 * (ks & 1); \
                if (ks < 2) pw[ks] = (u32x4){pk2(s0[b_], s0[b_ + 1]), pk2(s0[b_ + 2], s0[b_ + 3]), pk2(s0[b_ + 4], s0[b_ + 5]), pk2(s0[b_ + 6], s0[b_ + 7])}; \
                else        pw[ks] = (u32x4){pk2(s1[b_], s1[b_ + 1]), pk2(s1[b_ + 2], s1[b_ + 3]), pk2(s1[b_ + 4], s1[b_ + 5]), pk2(s1[b_ + 6], s1[b_ + 7])}; } } \
        if (t_ + 2 < NT) ATT_WRITEK(ATT_SLOT(t_ + 2), X); \
        if (t_ + 1 < NT) ATT_WRITEV(ATT_SLOT(t_ + 1), X); \
        ATT_LOADK(t_ + 4, X); ATT_LOADV(t_ + 3, X); } while (0)
    ATT_LOADK(j0, A); ATT_LOADV(j0, A); ATT_LOADK(j0 + 1, B);
    ATT_WRITEK(ATT_SLOT(j0), A); ATT_WRITEV(ATT_SLOT(j0), A); ATT_WRITEK(ATT_SLOT(j0 + 1), B);
    ATT_LOADK(j0 + 2, A); ATT_LOADV(j0 + 1, A); ATT_LOADK(j0 + 3, B); ATT_LOADV(j0 + 2, B);
    __syncthreads();
    const int grp = w >> 2;
    if (grp == 1) __syncthreads();
    for (int t = j0; t < NT; t += 2) {
        ATT_M(t); __syncthreads(); ATT_X(t, A); __syncthreads();
        if (t + 1 < NT) { ATT_M(t + 1); __syncthreads(); ATT_X(t + 1, B); __syncthreads(); }
    }
    ATT_M(NT);
    if (grp == 0) __syncthreads();
    __syncthreads();
#undef ATT_SLOT
#undef ATT_LOADK
#undef ATT_LOADV
#undef ATT_WRITEK
#undef ATT_WRITEV
#undef ATT_QK_ISSUE
#undef ATT_QK_MMA
#undef ATT_PV_ISSUE
#undef ATT_PV_MMA
#undef ATT_M
#undef ATT_X
    const float inv = 1.0f / (lrun + __shfl_xor(lrun, 32));
    bf16_t* op = Ob + (size_t)q * ldo + 4 * hi;
#pragma unroll
    for (int g = 0; g < 4; ++g) { u32x2 w0, w1; w0.x = pk2(o0[4 * g] * inv, o0[4 * g + 1] * inv); w0.y = pk2(o0[4 * g + 2] * inv, o0[4 * g + 3] * inv);
        w1.x = pk2(o1[4 * g] * inv, o1[4 * g + 1] * inv); w1.y = pk2(o1[4 * g + 2] * inv, o1[4 * g + 3] * inv);
        *(u32x2*)(op + 8 * g) = w0; *(u32x2*)(op + 32 + 8 * g) = w1; }
}
__device__ __forceinline__ void fox_knorm(int gw, int ngw, int lane, const bf16_t* KF, float* KNRM) {
    for (int it = gw; it < 16 * 256; it += ngw) { const int bh = it >> 8, j = it & 255, b = bh >> 3, h = bh & 7;
        const u32x4* kp = (const u32x4*)(KF + ((size_t)b * S + 64 * j + lane) * 512 + h * 64); float n2 = 0.f;
#pragma unroll
        for (int c = 0; c < 8; ++c) { const u32x4 v = kp[c]; const unsigned ww[4] = {v.x, v.y, v.z, v.w};
#pragma unroll
            for (int e = 0; e < 4; ++e) { const float a = bflo(ww[e]), bb = bfhi(ww[e]); n2 += a * a + bb * bb; } }
#pragma unroll
        for (int o = 1; o < 64; o <<= 1) n2 = fmaxf(n2, __shfl_xor(n2, o));
        if (lane == 0) KNRM[it] = sqrtf(n2); }
}

constexpr int RT_KZP = 144;
constexpr int RT_QP = 528;
constexpr int RT_OFF_KZ = 0, RT_OFF_Q = 256 * RT_KZP, RT_OFF_K = RT_OFF_Q + 64 * RT_QP, RT_OFF_P = RT_OFF_K + 64 * RT_QP, RT_OFF_SS = RT_OFF_P + 64 * RT_KZP, RT_OFF_OT = RT_OFF_SS + 64 * 8 * 4, RT_LDS = RT_OFF_OT + 64 * 272;
static_assert(RT_LDS <= 147456 - 256, "retention LDS");

__device__ __forceinline__ void ret_local(int wave_, LAS unsigned char* L, const bf16_t* KZT, const bf16_t* VT, f32x4* Lout, int u) {
    const int tid = wave_ * 64 + lane_id_opaque();
    const int lane = tid & 63, w = __builtin_amdgcn_readfirstlane(tid >> 6), l15 = lane & 15, g = lane >> 4;
    const int h = u >> 6, seg = (u >> 2) & 15, eb = u & 3, E0 = eb * 128 + w * 16;
    const float gc = __builtin_exp2f(64.0f * log2_gamma(h));
    f32x4 st[16];
#pragma unroll
    for (int i = 0; i < 16; ++i) st[i] = (f32x4){0.f, 0.f, 0.f, 0.f};
    u32x4 kz[4];
    const bf16_t* kzb = KZT + (size_t)(h * 256 + seg * SEGC) * 256 * 64;
#define R1_LOAD(ci) do { _Pragma("unroll") for (int i = 0; i < 4; ++i) kz[i] = *(const u32x4*)(kzb + (size_t)(ci) * 16384 + (size_t)(tid + 512 * i) * 8); } while (0)
#define R1_WRITE() do { _Pragma("unroll") for (int i = 0; i < 4; ++i) { const int id = tid + 512 * i; *(LAS u32x4*)(L + RT_OFF_KZ + (id >> 3) * RT_KZP + (id & 7) * 16) = kz[i]; } } while (0)
    R1_LOAD(0);
    for (int ci = 0; ci < SEGC; ++ci) {
        R1_WRITE(); __syncthreads();
        if (ci + 1 < SEGC) R1_LOAD(ci + 1);
        const bf16_t* vp = VT + ((size_t)(h * 256 + seg * SEGC + ci) * 512 + E0 + l15) * 64 + 8 * g;
        const bf16x8 vf0 = *(const bf16x8*)vp, vf1 = *(const bf16x8*)(vp + 32);
        if (ci > 0) {
#pragma unroll
            for (int i = 0; i < 16; ++i) st[i] *= gc; }
#pragma unroll
        for (int dt = 0; dt < 16; ++dt) { const LAS unsigned char* ap = L + RT_OFF_KZ + (16 * dt + l15) * RT_KZP + 16 * g;
            st[dt] = __builtin_amdgcn_mfma_f32_16x16x32_bf16(*(const LAS bf16x8*)ap, vf0, st[dt], 0, 0, 0);
            st[dt] = __builtin_amdgcn_mfma_f32_16x16x32_bf16(*(const LAS bf16x8*)(ap + 64), vf1, st[dt], 0, 0, 0); }
        __syncthreads();
    }
#undef R1_LOAD
#undef R1_WRITE
    f32x4* lo = Lout + ((size_t)(u * 8 + w) * 16) * 64 + lane;
#pragma unroll
    for (int dt = 0; dt < 16; ++dt) lo[dt * 64] = st[dt];
}

__device__ __forceinline__ void ret_scan(int wave_, LAS unsigned char* L, const bf16_t* QX, const bf16_t* KN, const bf16_t* KZT, const bf16_t* VT, const f32x4* Lin, bf16_t* O  , float* PO  , int u) {
    const int tid = wave_ * 64 + lane_id_opaque();
    const int lane = tid & 63, w = __builtin_amdgcn_readfirstlane(tid >> 6), l15 = lane & 15, g = lane >> 4;
    const int h = u >> 6, seg = (u >> 2) & 15, eb = u & 3, E0 = eb * 128 + w * 16;
    const float l2g = log2_gamma(h), gc = __builtin_exp2f(64.0f * l2g);
    f32x4 st[16];
#pragma unroll
    for (int i = 0; i < 16; ++i) st[i] = (f32x4){0.f, 0.f, 0.f, 0.f};
    if (seg > 0) { f32x4 la[8], lb[8];
#define R2_LOADL(dst, j, h8) do { const int uj_ = (u & ~(15 << 2)) | ((j) << 2); const f32x4* li_ = Lin + ((size_t)(uj_ * 8 + w) * 16 + 8 * (h8)) * 64 + lane; _Pragma("unroll") for (int dt = 0; dt < 8; ++dt) dst[dt] = li_[dt * 64]; } while (0)
#define R2_ACCL(src, j, h8) do { const float wj_ = __builtin_exp2f((float)(64 * SEGC * (seg - 1 - (j))) * l2g); _Pragma("unroll") for (int dt = 0; dt < 8; ++dt) st[8 * (h8) + dt] += src[dt] * wj_; } while (0)
        R2_LOADL(la, 0, 0); R2_LOADL(lb, 0, 1);
        for (int j = 0; j < seg; ++j) {
            R2_ACCL(la, j, 0); if (j + 1 < seg) R2_LOADL(la, j + 1, 0);
            R2_ACCL(lb, j, 1); if (j + 1 < seg) R2_LOADL(lb, j + 1, 1);
        }
#undef R2_LOADL
#undef R2_ACCL
    }
    u32x4 kz[4], qx[4], kn[4];
    const bf16_t* kzb = KZT + (size_t)(h * 256 + seg * SEGC) * 256 * 64;
    const bf16_t* qb = QX + (size_t)(seg * SEGC * 64) * 1024 + h * 256; const bf16_t* kb = KN + (size_t)(seg * SEGC * 64) * 1024 + h * 256;
#define R2_LOADKZ(ci) do { _Pragma("unroll") for (int i = 0; i < 4; ++i) { const int id = tid + 512 * i; kz[i] = *(const u32x4*)(kzb + (size_t)(ci) * 16384 + (size_t)id * 8); } } while (0)
#define R2_LOADQK(ci) do { _Pragma("unroll") for (int i = 0; i < 4; ++i) { const int id = tid + 512 * i; \
        qx[i] = *(const u32x4*)(qb + (size_t)((ci) * 64 + (id >> 5)) * 1024 + (id & 31) * 8); kn[i] = *(const u32x4*)(kb + (size_t)((ci) * 64 + (id >> 5)) * 1024 + (id & 31) * 8); } } while (0)
#define R2_WRITE() do { _Pragma("unroll") for (int i = 0; i < 4; ++i) { const int id = tid + 512 * i; *(LAS u32x4*)(L + RT_OFF_KZ + (id >> 3) * RT_KZP + (id & 7) * 16) = kz[i]; \
        *(LAS u32x4*)(L + RT_OFF_Q + (id >> 5) * RT_QP + (id & 31) * 16) = qx[i]; *(LAS u32x4*)(L + RT_OFF_K + (id >> 5) * RT_QP + (id & 31) * 16) = kn[i]; } } while (0)
    R2_LOADKZ(0); R2_LOADQK(0);
    const int tr = w >> 1;
    const bf16_t* vp0 = VT + ((size_t)(h * 256 + seg * SEGC) * 512 + E0 + l15) * 64 + 8 * g;
    bf16x8 vn0 = *(const bf16x8*)vp0, vn1 = *(const bf16x8*)(vp0 + 32);
    for (int ci = 0; ci < SEGC; ++ci) {
        R2_WRITE(); __syncthreads();
        const bf16x8 vf0 = vn0, vf1 = vn1;
        if (ci + 1 < SEGC) { R2_LOADKZ(ci + 1); R2_LOADQK(ci + 1); vn0 = *(const bf16x8*)(vp0 + (size_t)(ci + 1) * 32768); vn1 = *(const bf16x8*)(vp0 + (size_t)(ci + 1) * 32768 + 32); }
        const int chunk = seg * SEGC + ci;
#pragma unroll
        for (int t2 = 0; t2 < 2; ++t2) { const int tc = 2 * (w & 1) + t2; f32x4 pa = {0.f, 0.f, 0.f, 0.f};
            if (tc <= tr) {
#pragma unroll
                for (int ks = 0; ks < 8; ++ks) pa = __builtin_amdgcn_mfma_f32_16x16x32_bf16(*(const LAS bf16x8*)(L + RT_OFF_Q + (16 * tr + l15) * RT_QP + 64 * ks + 16 * g),
                                                                                           *(const LAS bf16x8*)(L + RT_OFF_K + (16 * tc + l15) * RT_QP + 64 * ks + 16 * g), pa, 0, 0, 0);
                const int cp = 16 * tc + l15; const float dk = __builtin_exp2f(-(float)(cp + 1) * l2g);
#pragma unroll
                for (int r = 0; r < 4; ++r) { const int c = 16 * tr + 4 * g + r; pa[r] = (c >= cp) ? pa[r] * dk : 0.f; } }
#pragma unroll
            for (int r = 0; r < 4; ++r) *(LAS bf16_t*)(L + RT_OFF_P + (16 * tr + 4 * g + r) * RT_KZP + (16 * tc + l15) * 2) = (bf16_t)f2bf(pa[r]); }
        __syncthreads();
        f32x4 oa[4];
#pragma unroll
        for (int mt = 0; mt < 4; ++mt) oa[mt] = (f32x4){0.f, 0.f, 0.f, 0.f};
#pragma unroll
        for (int ks = 0; ks < 8; ++ks) { const bf16x8 sbk = __builtin_bit_cast(bf16x8, (u32x4){pk2(st[2 * ks][0], st[2 * ks][1]), pk2(st[2 * ks][2], st[2 * ks][3]), pk2(st[2 * ks + 1][0], st[2 * ks + 1][1]), pk2(st[2 * ks + 1][2], st[2 * ks + 1][3])});
#pragma unroll
            for (int mt = 0; mt < 4; ++mt) oa[mt] = __builtin_amdgcn_mfma_f32_16x16x32_bf16(*(const LAS bf16x8*)(L + RT_OFF_Q + (16 * mt + l15) * RT_QP + 64 * ks + 16 * g), sbk, oa[mt], 0, 0, 0); }
#pragma unroll
        for (int mt = 0; mt < 4; ++mt) {
            oa[mt] = __builtin_amdgcn_mfma_f32_16x16x32_bf16(*(const LAS bf16x8*)(L + RT_OFF_P + (16 * mt + l15) * RT_KZP + 16 * g), vf0, oa[mt], 0, 0, 0);
            oa[mt] = __builtin_amdgcn_mfma_f32_16x16x32_bf16(*(const LAS bf16x8*)(L + RT_OFF_P + (16 * mt + l15) * RT_KZP + 64 + 16 * g), vf1, oa[mt], 0, 0, 0); }
#pragma unroll
        for (int i = 0; i < 16; ++i) st[i] *= gc;
#pragma unroll
        for (int dt = 0; dt < 16; ++dt) { const LAS unsigned char* ap = L + RT_OFF_KZ + (16 * dt + l15) * RT_KZP + 16 * g;
            st[dt] = __builtin_amdgcn_mfma_f32_16x16x32_bf16(*(const LAS bf16x8*)ap, vf0, st[dt], 0, 0, 0);
            st[dt] = __builtin_amdgcn_mfma_f32_16x16x32_bf16(*(const LAS bf16x8*)(ap + 64), vf1, st[dt], 0, 0, 0); }
#pragma unroll
        for (int mt = 0; mt < 4; ++mt) {
#pragma unroll
            for (int r = 0; r < 4; ++r) { const int c = 16 * mt + 4 * g + r; *(LAS bf16_t*)(L + RT_OFF_OT + c * 272 + (16 * w + l15) * 2) = (bf16_t)f2bf(oa[mt][r]); } }
        __syncthreads();
#pragma unroll
        for (int i = 0; i < 2; ++i) { const int id = tid + 512 * i, row = id >> 4, ch = id & 15;
            const u32x4 v = *(const LAS u32x4*)(L + RT_OFF_OT + row * 272 + ch * 16);
            *(u32x4*)(O + (size_t)(chunk * 64 + row) * 2048 + h * 512 + eb * 128 + ch * 8) = v;
            const float e0 = bflo(v.x), e1 = bfhi(v.x), e2 = bflo(v.y), e3 = bfhi(v.y), e4 = bflo(v.z), e5 = bfhi(v.z), e6 = bflo(v.w), e7 = bfhi(v.w);
            float ss = ((e0 * e0 + e1 * e1) + (e2 * e2 + e3 * e3)) + ((e4 * e4 + e5 * e5) + (e6 * e6 + e7 * e7));
            ss += __shfl_xor(ss, 1); ss += __shfl_xor(ss, 2); ss += __shfl_xor(ss, 4); ss += __shfl_xor(ss, 8);
            if (ch == 0) PO[(size_t)(chunk * 64 + row) * 16 + h * 4 + eb] = ss; }
    }
#undef R2_LOADKZ
#undef R2_LOADQK
#undef R2_WRITE
}

struct Ctx { int wave, vcu, G, gw, ngw; LAS unsigned char* lds; };
#define CTX_LANE const int lane_ = lane_id_opaque(), tid_ = C.wave * 64 + lane_

__device__ __forceinline__ void tr_item(const float* W, int ldw, int k0, int n0, int nvalid, const float* gain, bf16_t* dst, int ldd, LAS float* scr, int lane) {
    float vv[32]; const int nn_ = lane & 31, kh_ = lane >> 5;
#pragma unroll
    for (int i = 0; i < 32; ++i) vv[i] = (nn_ < nvalid) ? W[(size_t)(k0 + 2 * i + kh_) * ldw + n0 + nn_] : 0.f;
    if (gain) {
#pragma unroll
        for (int i = 0; i < 32; ++i) vv[i] *= gain[k0 + 2 * i + kh_]; }
#pragma unroll
    for (int i = 0; i < 32; ++i) scr[(2 * i + kh_) * 33 + nn_] = vv[i];
    asm volatile("s_waitcnt lgkmcnt(0)" ::: "memory");
    const int c = lane & 7;
#pragma unroll
    for (int j = 0; j < 4; ++j) { const int n = (lane >> 3) + 8 * j; const LAS float* s = scr + (8 * c) * 33 + n;
        u32x4 o; o.x = pk2(s[0], s[33]); o.y = pk2(s[2 * 33], s[3 * 33]); o.z = pk2(s[4 * 33], s[5 * 33]); o.w = pk2(s[6 * 33], s[7 * 33]);
        if (n < nvalid) *(u32x4*)(dst + (size_t)n * ldd + 8 * c) = o; }
    asm volatile("s_waitcnt lgkmcnt(0)" ::: "memory");
}
__device__ __forceinline__ void zero_rows(const Ctx& C, bf16_t* base, size_t pitch_el, int nrows, int col0, int ncol) {
    CTX_LANE;
    const int per = ncol / 8; const long n = (long)nrows * per;
    for (long i = (long)C.gw * 64 + lane_; i < n; i += (long)C.ngw * 64) { const long r = i / per; const int c = (int)(i % per); *(u32x4*)(base + (size_t)r * pitch_el + col0 + c * 8) = (u32x4){0u, 0u, 0u, 0u}; }
}
__device__ __forceinline__ void convert_moe(const Ctx& C, const Params&, int layer) {
    CTX_LANE;
    WS_OPAQUE;
    LAS float* scr = (LAS float*)(C.lds + C.wave * 16384);
    bf16_t* GU = WSP(bf16_t, OFF_WGU); bf16_t* DN = WSP(bf16_t, OFF_WDN); const float* gain = P.in[I_LN_FFN] + layer * 1024;
    for (int it = C.gw; it < 32 * 768; it += C.ngw) { const int e = it / 768, r = it % 768;
        if (r < 512) { const int up = r >> 8, rr = r & 255, kb = rr >> 4, nb = rr & 15, n0 = 32 * nb; const float* W = (up ? P.in[I_W_UP] : P.in[I_W_GATE]) + (size_t)(layer * 32 + e) * 1024 * 512;
            const int drow = 256 * (n0 >> 7) + (n0 & 127) + up * 128;
            tr_item(W, 512, 64 * kb, n0, 32, gain, GU + ((size_t)(e * 1024 + drow) * 1024 + 64 * kb), 1024, scr, lane_); }
        else { const int rr = r - 512, kb = rr >> 5, nb = rr & 31; const float* W = P.in[I_W_DOWN] + (size_t)(layer * 32 + e) * 512 * 1024;
            tr_item(W, 1024, 64 * kb, 32 * nb, 32, nullptr, DN + ((size_t)(e * 1024 + 32 * nb) * 512 + 64 * kb), 512, scr, lane_); } }
}
__device__ __forceinline__ void convert_mixer(const Ctx& C, const Params&) {
    CTX_LANE;
    WS_OPAQUE;
    LAS float* scr = (LAS float*)(C.lds + C.wave * 16384);
    bf16_t* WA1 = WSP(bf16_t, W_A1); bf16_t* WA1V = WSP(bf16_t, W_A1V); bf16_t* WA2 = WSP(bf16_t, W_A2); bf16_t* WA2V = WSP(bf16_t, W_A2V);
    bf16_t* WOE = WSP(bf16_t, W_OE); bf16_t* WB1 = WSP(bf16_t, W_B1); bf16_t* WOO = WSP(bf16_t, W_OO);
    constexpr int N1 = 16 * 62, N2 = 4 * 24, N3 = 2 * 32, N4 = 16 * 32, N5 = 16 * 192, N6 = 32 * 32, NT_ = N1 + N2 + N3 + N4 + N5 + N6;
    for (int it = C.gw; it < NT_; it += C.ngw) { int r = it;
        if (r < N1) { const int kb = r / 62, nb = r % 62, n0 = 32 * nb, k0 = 64 * kb; bf16_t* dst; int nv = 32;
            if (n0 < 416) dst = WA1 + (size_t)n0 * 1024; else if (n0 < 928) dst = WA1 + (size_t)(512 + n0 - 416) * 1024; else if (n0 < 1440) dst = WA1 + (size_t)(1024 + n0 - 928) * 1024;
            else if (n0 < 1952) dst = WA1V + (size_t)(n0 - 1440) * 1024; else { dst = WA1 + (size_t)416 * 1024; nv = 8; }
            tr_item(P.in[I_W_IN_E], 1960, k0, n0, nv, P.in[I_LN_MIX_E], dst + k0, 1024, scr, lane_); continue; } r -= N1;
        if (r < N2) { const int kb = r / 24, nb = r % 24, n0 = 32 * nb, hh = n0 / 96, off = n0 % 96;
            tr_item(P.in[I_W_UQ], 768, 64 * kb, n0, 32, P.in[I_LN_Q], WA2 + (size_t)(128 * hh + off) * 256 + 64 * kb, 256, scr, lane_); continue; } r -= N2;
        if (r < N3) { const int kb = r / 32, nb = r % 32, n0 = 32 * nb, hh = n0 / 128, off = n0 % 128;
            bf16_t* dst = off < 64 ? WA2 + (size_t)(1024 + 64 * hh + off) * 256 : WA2V + (size_t)(64 * hh + off - 64) * 256;
            tr_item(P.in[I_W_UKV], 1024, 64 * kb, n0, 32, P.in[I_LN_KV], dst + 64 * kb, 256, scr, lane_); continue; } r -= N3;
        if (r < N4) { const int kb = r / 32, nb = r % 32; tr_item(P.in[I_W_OUT_E], 1024, 64 * kb, 32 * nb, 32, nullptr, WOE + (size_t)(32 * nb) * 1024 + 64 * kb, 1024, scr, lane_); continue; } r -= N4;
        if (r < N5) { const int kb = r / 192, nb = r % 192; tr_item(P.in[I_W_IN_O], 6144, 64 * kb, 32 * nb, 32, P.in[I_LN_MIX_O], WB1 + (size_t)(32 * nb) * 1024 + 64 * kb, 1024, scr, lane_); continue; } r -= N5;
        { const int kb = r / 32, nb = r % 32; tr_item(P.in[I_W_OUT_O], 1024, 64 * kb, 32 * nb, 32, nullptr, WOO + (size_t)(32 * nb) * 2048 + 64 * kb, 2048, scr, lane_); } }
    zero_rows(C, WA1 + (size_t)424 * 1024, 1024, 88, 0, 1024);
    for (int hh = 0; hh < 8; ++hh) zero_rows(C, WA2 + (size_t)(128 * hh + 96) * 256, 256, 32, 0, 256);
    zero_rows(C, WA2 + (size_t)1024 * 256, 256, 512, 128, 128);
    zero_rows(C, WA2V, 256, 512, 128, 128);
}
__device__ __forceinline__ void make_rope(const Ctx& C, const Params&) {
    CTX_LANE;
    WS_OPAQUE;
    f32x2* rope = WSP(f32x2, OFF_ROPE);
    for (int i = C.gw * 64 + lane_; i < S * 128; i += C.ngw * 64) { const int pos = i >> 7, k = i & 127; const float inv = __builtin_exp2f(-(float)k * (13.287712379549449f / 128.0f));
        const float ang = (float)pos * inv; const double a = (double)ang; rope[i] = (f32x2){(float)cos(a), (float)sin(a)}; }
}
__device__ __forceinline__ void rows_to_bf16(const Ctx& C, const float* X, bf16_t* XB, float* RS) {
    CTX_LANE;
    for (int r0 = C.gw; r0 < T; r0 += 4 * C.ngw) { f32x4 v[4][4];
#pragma unroll
        for (int q = 0; q < 4; ++q) { const int r = r0 + q * C.ngw; const f32x4* xr = (const f32x4*)(X + (size_t)(r < T ? r : r0) * D) + lane_;
#pragma unroll
            for (int j = 0; j < 4; ++j) v[q][j] = xr[64 * j]; }
#pragma unroll
        for (int q = 0; q < 4; ++q) { const int r = r0 + q * C.ngw; if (r >= T) break; float s = 0.f;
#pragma unroll
            for (int j = 0; j < 4; ++j) s += (v[q][j][0] * v[q][j][0] + v[q][j][1] * v[q][j][1]) + (v[q][j][2] * v[q][j][2] + v[q][j][3] * v[q][j][3]);
            s = wave_sum(s); u32x2* o = (u32x2*)(XB + (size_t)r * D) + lane_;
#pragma unroll
            for (int j = 0; j < 4; ++j) o[64 * j] = (u32x2){pk2(v[q][j][0], v[q][j][1]), pk2(v[q][j][2], v[q][j][3])};
            if (lane_ == 0) RS[r] = rsqrt_f(s * (1.0f / D) + EPS); } }
}
__device__ __forceinline__ void fox_cumsum(const Ctx& C, const float* LF, float* CUM, int bh) {
    CTX_LANE;
    LAS float* tot = (LAS float*)C.lds; const int b = bh >> 3, h = bh & 7; float v[32]; float run = 0.f;
#pragma unroll
    for (int i = 0; i < 32; ++i) { run += LF[((size_t)b * S + tid_ * 32 + i) * 8 + h]; v[i] = run; }
    tot[tid_] = run; __syncthreads();
    float off = 0.f; for (int t2 = 0; t2 < tid_; ++t2) off += tot[t2];
#pragma unroll
    for (int i = 0; i < 32; ++i) CUM[(size_t)bh * S + tid_ * 32 + i] = (off + v[i]) * LOG2E;
    __syncthreads();
}
__device__ __forceinline__ void moe_router(const Ctx& C, const Params&, int layer, int blk) {
    CTX_LANE;
    WS_OPAQUE;
    const float* XF = P.out; bf16_t* XB = WSP(bf16_t, OFF_XB); float* RS1 = WSP(float, SM_RS1);
    int* EID = WSP(int, SM_EID); float* GATE = WSP(float, SM_GATE); int* RANK = WSP(int, SM_RANK); int* CNT = WSP(int, SM_CNT);
    const float* wrg = P.in[I_W_RG] + (size_t)layer * 1024 * 4; const float* wre = P.in[I_W_RE] + (size_t)layer * 1024 * 32; const float* lnf = P.in[I_LN_FFN] + layer * 1024;
    LAS float* lg = (LAS float*)C.lds;
    LAS float* rsl = (LAS float*)(C.lds + 128 * 40 * 4);
    LAS int* eidl = (LAS int*)(C.lds + 128 * 40 * 4 + 512);
    LAS float* slab = (LAS float*)(C.lds + 32768);
    const int l15 = lane_ & 15, kg = lane_ >> 4, kbase = 128 * C.wave + 8 * kg;
    bf16x8 bh[3][4], bl[3][4];
#pragma unroll
    for (int nt = 0; nt < 3; ++nt) { const int col = 16 * nt + l15; const int cc = col < 36 ? col : 35; const float* wp = cc < 4 ? wrg + cc : wre + (cc - 4); const int wst = cc < 4 ? 4 : 32; const float wz = col < 36 ? 1.f : 0.f;
#pragma unroll
        for (int ks = 0; ks < 4; ++ks) { float wf[8]; unsigned hp[4], lp[4];
#pragma unroll
            for (int j = 0; j < 8; ++j) { const int k = kbase + 32 * ks + j; wf[j] = lnf[k] * wp[(size_t)k * wst] * wz; }
#pragma unroll
            for (int j = 0; j < 4; ++j) { hp[j] = pk2(wf[2 * j], wf[2 * j + 1]); lp[j] = pk2(wf[2 * j] - bflo(hp[j]), wf[2 * j + 1] - bfhi(hp[j])); }
            bh[nt][ks] = __builtin_bit_cast(bf16x8, (u32x4){hp[0], hp[1], hp[2], hp[3]}); bl[nt][ks] = __builtin_bit_cast(bf16x8, (u32x4){lp[0], lp[1], lp[2], lp[3]}); } }
    f32x4 xa[8], xb[8];
#define RT_LOADX(dst, mt) do { const float* xp = XF + (size_t)(blk * 128 + 16 * (mt) + l15) * D + kbase; _Pragma("unroll") for (int ks = 0; ks < 4; ++ks) { dst[2 * ks] = *(const f32x4*)(xp + 32 * ks); dst[2 * ks + 1] = *(const f32x4*)(xp + 32 * ks + 4); } } while (0)
#define RT_TILE(src, mt) do { f32x4 acc[3] = {{0.f, 0.f, 0.f, 0.f}, {0.f, 0.f, 0.f, 0.f}, {0.f, 0.f, 0.f, 0.f}}; float ss = 0.f; \
        _Pragma("unroll") for (int ks = 0; ks < 4; ++ks) { const f32x4 v0 = src[2 * ks], v1 = src[2 * ks + 1]; unsigned hp[4], lp[4]; \
            hp[0] = pk2(v0[0], v0[1]); hp[1] = pk2(v0[2], v0[3]); hp[2] = pk2(v1[0], v1[1]); hp[3] = pk2(v1[2], v1[3]); \
            lp[0] = pk2(v0[0] - bflo(hp[0]), v0[1] - bfhi(hp[0])); lp[1] = pk2(v0[2] - bflo(hp[1]), v0[3] - bfhi(hp[1])); lp[2] = pk2(v1[0] - bflo(hp[2]), v1[1] - bfhi(hp[2])); lp[3] = pk2(v1[2] - bflo(hp[3]), v1[3] - bfhi(hp[3])); \
            ss += (v0[0] * v0[0] + v0[1] * v0[1]) + (v0[2] * v0[2] + v0[3] * v0[3]) + (v1[0] * v1[0] + v1[1] * v1[1]) + (v1[2] * v1[2] + v1[3] * v1[3]); \
            const bf16x8 ah = __builtin_bit_cast(bf16x8, (u32x4){hp[0], hp[1], hp[2], hp[3]}), al = __builtin_bit_cast(bf16x8, (u32x4){lp[0], lp[1], lp[2], lp[3]}); \
            *(u32x4*)(XB + (size_t)(blk * 128 + 16 * (mt) + l15) * D + kbase + 32 * ks) = (u32x4){hp[0], hp[1], hp[2], hp[3]}; \
            _Pragma("unroll") for (int nt = 0; nt < 3; ++nt) { acc[nt] = __builtin_amdgcn_mfma_f32_16x16x32_bf16(ah, bh[nt][ks], acc[nt], 0, 0, 0); acc[nt] = __builtin_amdgcn_mfma_f32_16x16x32_bf16(ah, bl[nt][ks], acc[nt], 0, 0, 0); \
                acc[nt] = __builtin_amdgcn_mfma_f32_16x16x32_bf16(al, bh[nt][ks], acc[nt], 0, 0, 0); } } \
        ss += __shfl_xor(ss, 16); ss += __shfl_xor(ss, 32); \
        LAS float* sl = slab + (size_t)(C.wave * 64 + 16 * ((mt) & 3)) * 40; \
        _Pragma("unroll") for (int nt = 0; nt < 3; ++nt) { const int col = 16 * nt + l15; if (col < 36) { _Pragma("unroll") for (int r = 0; r < 4; ++r) sl[(4 * kg + r) * 40 + col] = acc[nt][r]; } } \
        if (kg == 0) sl[l15 * 40 + 36] = ss; } while (0)
    RT_LOADX(xa, 0);
    for (int half = 0; half < 2; ++half) {
        RT_LOADX(xb, 4 * half + 1); RT_TILE(xa, 4 * half + 0);
        RT_LOADX(xa, 4 * half + 2); RT_TILE(xb, 4 * half + 1);
        RT_LOADX(xb, 4 * half + 3); RT_TILE(xa, 4 * half + 2);
        if (half == 0) RT_LOADX(xa, 4); RT_TILE(xb, 4 * half + 3);
        __syncthreads();
        for (int it = tid_; it < 64 * 37; it += 512) { const int tt = it / 37, c = it % 37; float sm = 0.f;
#pragma unroll
            for (int w8 = 0; w8 < 8; ++w8) sm += slab[(size_t)(w8 * 64 + tt) * 40 + c];
            lg[(half * 64 + tt) * 40 + c] = sm; }
        __syncthreads();
    }
#undef RT_LOADX
#undef RT_TILE
    if (tid_ < 128) { const float rs = rsqrt_f(lg[tid_ * 40 + 36] * (1.0f / D) + EPS); rsl[tid_] = rs; RS1[blk * 128 + tid_] = rs; }
    __syncthreads();
    if (tid_ < 128) { const int tt = tid_, t = blk * 128 + tt; const float rs = rsl[tt]; const float* brg = P.in[I_B_RG] + layer * 4; const float* bre = P.in[I_B_RE] + layer * 32;
        float gl[4]; int gs = 0;
#pragma unroll
        for (int o = 0; o < 4; ++o) { gl[o] = lg[tt * 40 + o] * rs + brg[o]; if (gl[o] > gl[gs]) gs = o; }
        float gsum = 0.f;
#pragma unroll
        for (int o = 0; o < 4; ++o) gsum += __expf(gl[o] - gl[gs]);
        const float pg = 1.0f / gsum;
        float el[8]; int j1 = 0;
#pragma unroll
        for (int j = 0; j < 8; ++j) { el[j] = lg[tt * 40 + 4 + 8 * gs + j] * rs + bre[8 * gs + j]; if (el[j] > el[j1]) j1 = j; }
        int j2 = (j1 == 0) ? 1 : 0;
#pragma unroll
        for (int j = 0; j < 8; ++j) if (j != j1 && el[j] > el[j2]) j2 = j;
        const float e2 = __expf(el[j2] - el[j1]), den = 1.0f / (1.0f + e2);
        const int ea = 8 * gs + j1, eb = 8 * gs + j2;
        EID[t * 2] = ea; EID[t * 2 + 1] = eb; GATE[t * 2] = pg * den; GATE[t * 2 + 1] = pg * e2 * den; eidl[2 * tt] = ea; eidl[2 * tt + 1] = eb; }
    __syncthreads();
    if (tid_ < 256) { const int me = eidl[tid_]; int rk = 0; for (int a = 0; a < tid_; ++a) rk += (eidl[a] == me) ? 1 : 0; RANK[blk * 256 + tid_] = rk; }
    if (tid_ < 32) { int c = 0; for (int a = 0; a < 256; ++a) c += (eidl[a] == tid_) ? 1 : 0; CNT[blk * 32 + tid_] = c; }
    __syncthreads();
}
__device__ __forceinline__ void moe_scatter(const Ctx& C, const Params&, int blk) {
    CTX_LANE;
    WS_OPAQUE;
    const int* CNT = WSP(int, SM_CNT); const int* EID = WSP(int, SM_EID); const float* GATE = WSP(float, SM_GATE); const int* RANK = WSP(int, SM_RANK); const float* RS1 = WSP(float, SM_RS1);
    int* TSLOT = WSP(int, SM_TSLOT); int* STOK = WSP(int, SM_STOK); float* SW = WSP(float, SM_SW); float* SR = WSP(float, SM_SR); int* TILEE = WSP(int, SM_TILEE);
    const bf16_t* XB = WSP(bf16_t, OFF_XB); bf16_t* XS = WSP(bf16_t, A_XS);
    LAS int* part = (LAS int*)C.lds;
    LAS int* tot = part + 1024;
    LAS int* slotl = tot + 128;
    { const int e = tid_ & 31, pt = tid_ >> 5; int s = 0, pre = 0;
        for (int b = pt * 16; b < pt * 16 + 16; ++b) { const int c = ld_i(CNT + b * 32 + e); s += c; if (b < blk) pre += c; }
        part[pt * 32 + e] = s; part[512 + pt * 32 + e] = pre; }
    __syncthreads();
    if (tid_ < 32) { int s = 0, pre = 0; for (int pt = 0; pt < 16; ++pt) { s += part[pt * 32 + tid_]; pre += part[512 + pt * 32 + tid_]; } tot[tid_] = s; tot[32 + tid_] = pre; }
    __syncthreads();
    if (tid_ == 0) { int ps = 0; for (int e = 0; e < 32; ++e) { tot[64 + e] = ps; ps += (tot[e] + 255) & ~255; } tot[96] = ps; }
    __syncthreads();
    if (tid_ < 256) { const int a = blk * 256 + tid_, t = a >> 1, e = EID[a]; const int slot = tot[64 + e] + tot[32 + e] + RANK[a];
        slotl[tid_] = slot; TSLOT[a] = slot; STOK[slot] = t; SW[slot] = GATE[a]; SR[slot] = RS1[t]; }
    __syncthreads();
    for (int i0 = C.wave * 32; i0 < C.wave * 32 + 32; i0 += 8) { u32x4 ra[8], rb[8];
#pragma unroll
        for (int q = 0; q < 8; ++q) { const int t = (blk * 256 + i0 + q) >> 1; const u32x4* sp = (const u32x4*)(XB + (size_t)t * D) + lane_; ra[q] = sp[0]; rb[q] = sp[64]; }
#pragma unroll
        for (int q = 0; q < 8; ++q) { const int slot = slotl[i0 + q]; u32x4* d = (u32x4*)(XS + (size_t)slot * D) + lane_; d[0] = ra[q]; d[64] = rb[q]; } }
    if (blk < 32) { const int e = blk, beg = tot[64 + e] + tot[e], end = tot[64 + e] + ((tot[e] + 255) & ~255);
        for (int sl = beg + C.wave; sl < end; sl += 8) { u32x4* d = (u32x4*)(XS + (size_t)sl * D) + lane_; d[0] = (u32x4){0u, 0u, 0u, 0u}; d[64] = (u32x4){0u, 0u, 0u, 0u}; if (lane_ == 0) { STOK[sl] = -1; SW[sl] = 0.f; SR[sl] = 0.f; } } }
    if (blk == 0 && tid_ < 32) { const int e = tid_, t0 = tot[64 + e] >> 8, nt = ((tot[e] + 255) & ~255) >> 8; for (int i = 0; i < nt; ++i) TILEE[t0 + i] = e; if (e == 0) TILEE[300] = tot[96] >> 8; }
    __syncthreads();
}
template <int MODE> __device__ __forceinline__ void moe_combine(const Ctx& C, const Params&, float* RS, const float* gainf) {
    CTX_LANE;
    WS_OPAQUE;
    float* XF = P.out; bf16_t* XB = WSP(bf16_t, OFF_XB); const bf16_t* YS = WSP(bf16_t, A_XS); const int* TSLOT = WSP(int, SM_TSLOT);
    for (int t0 = C.gw; t0 < T; t0 += 2 * C.ngw) { f32x4 v[2][4]; u32x2 ya[2][4], yb[2][4];
#pragma unroll
        for (int q = 0; q < 2; ++q) { const int t = t0 + q * C.ngw; const int sa = ld_i(TSLOT + 2 * t), sb = ld_i(TSLOT + 2 * t + 1); const f32x4* xr = (const f32x4*)(XF + (size_t)t * D) + lane_;
            const u32x2* pa = (const u32x2*)(YS + (size_t)sa * D) + lane_; const u32x2* pb = (const u32x2*)(YS + (size_t)sb * D) + lane_;
#pragma unroll
            for (int j = 0; j < 4; ++j) { v[q][j] = xr[64 * j]; ya[q][j] = pa[64 * j]; yb[q][j] = pb[64 * j]; } }
#pragma unroll
        for (int q = 0; q < 2; ++q) { const int t = t0 + q * C.ngw; f32x4* xr = (f32x4*)(XF + (size_t)t * D) + lane_; float s = 0.f;
#pragma unroll
            for (int j = 0; j < 4; ++j) { const u32x2 a = ya[q][j], b = yb[q][j];
                v[q][j][0] += bflo(a.x) + bflo(b.x); v[q][j][1] += bfhi(a.x) + bfhi(b.x); v[q][j][2] += bflo(a.y) + bflo(b.y); v[q][j][3] += bfhi(a.y) + bfhi(b.y);
                s += (v[q][j][0] * v[q][j][0] + v[q][j][1] * v[q][j][1]) + (v[q][j][2] * v[q][j][2] + v[q][j][3] * v[q][j][3]); }
            s = wave_sum(s); const float rs = rsqrt_f(s * (1.0f / D) + EPS);
            if (MODE == 0) { u32x2* o = (u32x2*)(XB + (size_t)t * D) + lane_;
#pragma unroll
                for (int j = 0; j < 4; ++j) { xr[64 * j] = v[q][j]; o[64 * j] = (u32x2){pk2(v[q][j][0], v[q][j][1]), pk2(v[q][j][2], v[q][j][3])}; }
                if (lane_ == 0) RS[t] = rs; }
            else { const f32x4* gr = (const f32x4*)gainf + lane_;
#pragma unroll
                for (int j = 0; j < 4; ++j) xr[64 * j] = v[q][j] * rs * gr[64 * j]; } } }
}

constexpr int LDS_BYTES = 147456;
constexpr int LDS_MISC = LDS_BYTES - 256;
constexpr int NPHASE = 23;

__global__ void __launch_bounds__(512, 2) fwd_kernel(Params Pkern) {
    extern __shared__ __attribute__((aligned(16))) unsigned char lds_raw[];
    LAS unsigned char* lds = (LAS unsigned char*)lds_raw;
    Ctx C; { const int t0_ = threadIdx.x; C.wave = __builtin_amdgcn_readfirstlane(t0_ >> 6); } C.G = gridDim.x;
    C.vcu = (C.G % 8 == 0) ? ((int)blockIdx.x % 8) * (C.G / 8) + (int)blockIdx.x / 8 : (int)blockIdx.x;
    C.gw = C.vcu * 8 + C.wave; C.ngw = C.G * 8; C.lds = lds;
    const int bx = blockIdx.x;
    { const int l0 = lane_id_opaque(); if (C.wave == 0) ((LAS unsigned*)(lds + LDS_MISC))[l0] = 0u; }
    __syncthreads();
    const unsigned xcc = xb_xcc_id();
    if (Pkern.use_bar) { const bool t0 = (C.wave == 0) && (lane_id_opaque() == 0); (void)xcd_barrier_post((unsigned*)(Pkern.ws + OFF_CTL) + 4096, (volatile LAS unsigned*)(lds + LDS_MISC), t0); }
    const int lo = Pkern.ph_lo, hi = Pkern.ph_hi;
    const Params& P = Pkern;
#ifndef PH_MASK
#define PH_MASK 0x7fffffu
#endif
#define IN(k) ((((unsigned)PH_MASK >> (k)) & 1u) && lo <= (k) && (k) < hi)
#ifndef PROBE_MASK
#define PROBE_MASK 0u
#endif
#ifdef PROBE_T
#define STAMP(i) do { if (bx == 0 && C.wave == 0 && lane_id_opaque() == 0) ((volatile LAS unsigned long long*)(lds + LDS_MISC + 64))[(i)] = __builtin_amdgcn_s_memrealtime(); } while (0)
#else
#define STAMP(i) do { } while (0)
#endif
#define REP(k) for (int rep_ = 0; rep_ < ((((unsigned)PROBE_MASK >> (k)) & 1u) ? 2 : 1); ++rep_)
#define SEAM(k) do { if (IN(k) && IN((k) + 1)) { P_OPAQUE; XcdBarrier bar; bar.bar = (unsigned*)(P.ws + OFF_CTL) + 4096; bar.x = xcc; bar.st = (volatile LAS unsigned*)(lds + LDS_MISC); \
        const bool t0 = (C.wave == 0) && (lane_id_opaque() == 0); xcd_barrier(bar, t0); } STAMP((k) + 1); } while (0)

    STAMP(0);
    if (IN(0)) REP(0) { WS_OPAQUE; convert_mixer(C, P); convert_moe(C, P, 0); make_rope(C, P); rows_to_bf16(C, P.in[I_X], WSP(bf16_t, OFF_XB), WSP(float, SM_RS0)); __syncthreads(); }
    SEAM(0);
    if (IN(1)) REP(1) {
        { WS_OPAQUE; DenseSched Sd; Sd.init(WSP(bf16_t, OFF_XB), 1024, WSP(bf16_t, W_A1), 1024, 128, 6, C.G, bx);
          EpiA1a E{WSP(float, SM_RS0), WSP(bf16_t, A_Z), WSP(float, SM_PQ), WSP(float, SM_PKV), WSP(bf16_t, A_KA), WSP(float, SM_LF), P.in[I_B_F], WSP(bf16_t, A_QF), WSP(bf16_t, A_KF), WSP(f32x2, OFF_ROPE)};
          pg8::gemm_phase(C.wave, lds, pg8::Dims{1024, 1024, 1024}, Sd, E); }
        { WS_OPAQUE; DenseSched Sd; Sd.init(WSP(bf16_t, W_A1V), 1024, WSP(bf16_t, OFF_XB), 1024, 2, 128, C.G, bx);
          EpiVT<0> E{WSP(float, SM_RS0), WSP(bf16_t, A_VTF), (size_t)T};
          pg8::gemm_phase(C.wave, lds, pg8::Dims{1024, 1024, 1024}, Sd, E); }
    }
    SEAM(1);
    if (IN(2)) REP(2) {
        if (C.vcu < 16) { WS_OPAQUE; fox_cumsum(C, WSP(float, SM_LF), WSP(float, SM_CUM), C.vcu); }
        { WS_OPAQUE; fox_knorm(C.gw, C.ngw, lane_id_opaque(), WSP(bf16_t, A_KF), WSP(float, SM_KNRM)); }
        { WS_OPAQUE; DenseSched Sd; Sd.init(WSP(bf16_t, A_Z), 512, WSP(bf16_t, W_A2), 256, 128, 4, C.G, bx);
          EpiA2q E{WSP(float, SM_PQ), WSP(bf16_t, A_QA), WSP(f32x2, OFF_ROPE)};
          pg8::gemm_phase(C.wave, lds, pg8::Dims{512, 256, 256}, Sd, E); }
        { WS_OPAQUE; DenseSched Sd; Sd.init(WSP(bf16_t, A_Z) + 256, 512, WSP(bf16_t, W_A2) + (size_t)1024 * 256, 256, 128, 2, C.G, bx);
          EpiA2k E{WSP(float, SM_PKV), WSP(bf16_t, A_KA)};
          pg8::gemm_phase(C.wave, lds, pg8::Dims{512, 256, 256}, Sd, E); }
        { WS_OPAQUE; DenseSched Sd; Sd.init(WSP(bf16_t, W_A2V), 256, WSP(bf16_t, A_Z) + 256, 512, 2, 128, C.G, bx);
          EpiVT<1> E{WSP(float, SM_PKV), WSP(bf16_t, A_VTA), (size_t)T};
          pg8::gemm_phase(C.wave, lds, pg8::Dims{256, 512, 256}, Sd, E); }
    }
    SEAM(2);
    if (IN(3)) REP(3) {
        const int bh = C.vcu >> 4, s4 = C.vcu & 15, b = bh >> 3, h = bh & 7;
        REP(23) { WS_OPAQUE; bf16_t* AO = WSP(bf16_t, OFF_XB);
          for (int i = 0; i < 4; ++i) { const int qb = (i == 0) ? s4 : (i == 1) ? 31 - s4 : (i == 2) ? 32 + s4 : 63 - s4;
            attn_unit<96, false>(C.wave, lds, WSP(bf16_t, A_QA) + (size_t)b * S * 768 + h * 96, 768, WSP(bf16_t, A_KA) + (size_t)b * S * 768 + h * 96, 768,
                                 WSP(bf16_t, A_VTA) + ((size_t)h * (T / 64) + (size_t)b * (S / 64)) * 4096, nullptr, nullptr, AO + (size_t)b * S * 1024 + h * 64, 1024, qb); } }
        REP(24) { WS_OPAQUE; bf16_t* AO = WSP(bf16_t, OFF_XB);
          for (int i = 0; i < 4; ++i) { const int qb = (i == 0) ? s4 : (i == 1) ? 31 - s4 : (i == 2) ? 32 + s4 : 63 - s4;
            attn_unit<64, true>(C.wave, lds, WSP(bf16_t, A_QF) + (size_t)b * S * 512 + h * 64, 512, WSP(bf16_t, A_KF) + (size_t)b * S * 512 + h * 64, 512,
                                WSP(bf16_t, A_VTF) + ((size_t)h * (T / 64) + (size_t)b * (S / 64)) * 4096, WSP(float, SM_CUM) + (size_t)bh * S, WSP(float, SM_KNRM) + bh * 256, AO + (size_t)b * S * 1024 + 512 + h * 64, 1024, qb); } }
    }
    SEAM(3);
    if (IN(4)) REP(4) { WS_OPAQUE; DenseSched Sd; Sd.init(WSP(bf16_t, OFF_XB), 1024, WSP(bf16_t, W_OE), 1024, 128, 4, C.G, bx); EpiRes E{P.in[I_X], P.out};
        pg8::gemm_phase(C.wave, lds, pg8::Dims{1024, 1024, 1024}, Sd, E); }
    SEAM(4);

#define MOE_PHASES(layer, pb) do { \
        if (IN(pb)) REP(pb) moe_router(C, P, layer, bx); \
        SEAM(pb); \
        if (IN((pb) + 1)) REP((pb) + 1) moe_scatter(C, P, bx); \
        SEAM((pb) + 1); \
        if (IN((pb) + 2)) REP((pb) + 2) { WS_OPAQUE; MoeSched Sm; Sm.init(WSP(bf16_t, A_XS), 1024, WSP(bf16_t, OFF_WGU), 1024, 1024, WSP(int, SM_TILEE), C.G, bx); EpiM3 E{WSP(float, SM_SR), WSP(bf16_t, A_HID)}; \
            pg8::gemm_phase(C.wave, lds, pg8::Dims{1024, 1024, 1024}, Sm, E); } \
        SEAM((pb) + 2); \
        if (IN((pb) + 3)) REP((pb) + 3) { WS_OPAQUE; MoeSched Sm; Sm.init(WSP(bf16_t, A_HID), 512, WSP(bf16_t, OFF_WDN), 512, 1024, WSP(int, SM_TILEE), C.G, bx); EpiM4 E{WSP(float, SM_SW), WSP(bf16_t, A_XS)}; \
            pg8::gemm_phase(C.wave, lds, pg8::Dims{512, 512, 512}, Sm, E); } \
        SEAM((pb) + 3); } while (0)
#define RET_PHASES(bb, p0) do { \
        if (IN(p0)) REP(p0) { \
            { WS_OPAQUE; DenseSched Sd; Sd.init(WSP(bf16_t, OFF_XB) + (size_t)(bb) * S * 1024, 1024, WSP(bf16_t, W_B1), 1024, 64, 4, C.G, bx); EpiB1q E{WSP(float, SM_RS2) + (bb) * S, WSP(bf16_t, A_QX), WSP(f32x2, OFF_ROPE)}; \
              pg8::gemm_phase(C.wave, lds, pg8::Dims{1024, 1024, 1024}, Sd, E); } \
            { WS_OPAQUE; DenseSched Sd; Sd.init(WSP(bf16_t, W_B1) + (size_t)1024 * 1024, 1024, WSP(bf16_t, OFF_XB) + (size_t)(bb) * S * 1024, 1024, 4, 64, C.G, bx); EpiB1k E{WSP(float, SM_RS2) + (bb) * S, WSP(bf16_t, A_KN), WSP(bf16_t, A_KZT), WSP(f32x2, OFF_ROPE), lds + 131072}; \
              pg8::gemm_phase(C.wave, lds, pg8::Dims{1024, 1024, 1024}, Sd, E); } \
            { WS_OPAQUE; DenseSched Sd; Sd.init(WSP(bf16_t, W_B1) + (size_t)2048 * 1024, 1024, WSP(bf16_t, OFF_XB) + (size_t)(bb) * S * 1024, 1024, 8, 64, C.G, bx); EpiB1v E{WSP(float, SM_RS2) + (bb) * S, WSP(bf16_t, A_VT)}; \
              pg8::gemm_phase(C.wave, lds, pg8::Dims{1024, 1024, 1024}, Sd, E); } \
        } \
        SEAM(p0); \
        if (IN((p0) + 1)) REP((p0) + 1) { WS_OPAQUE; ret_local(C.wave, lds, WSP(bf16_t, A_KZT), WSP(bf16_t, A_VT), WSP(f32x4, A_L), C.vcu); } \
        SEAM((p0) + 1); \
        if (IN((p0) + 2)) REP((p0) + 2) { WS_OPAQUE; ret_scan(C.wave, lds, WSP(bf16_t, A_QX), WSP(bf16_t, A_KN), WSP(bf16_t, A_KZT), WSP(bf16_t, A_VT), WSP(f32x4, A_L), \
                                 WSP(bf16_t, A_O) + (size_t)(bb) * S * 2048, WSP(float, SM_PO) + (size_t)(bb) * S * 16, C.vcu); } \
        SEAM((p0) + 2); } while (0)

    MOE_PHASES(0, 5);
    if (IN(9)) { WS_OPAQUE; moe_combine<0>(C, P, WSP(float, SM_RS2), nullptr); convert_moe(C, P, 1); __syncthreads(); }
    SEAM(9);
    RET_PHASES(0, 10);
    RET_PHASES(1, 13);
    if (IN(16)) { WS_OPAQUE; DenseSched Sd; Sd.init(WSP(bf16_t, OFF_XB), 1024, WSP(bf16_t, W_B1) + (size_t)4096 * 1024, 1024, 128, 8, C.G, bx); EpiG E{WSP(float, SM_RS2), WSP(float, SM_PO), WSP(bf16_t, A_O)};
        pg8::gemm_phase(C.wave, lds, pg8::Dims{1024, 1024, 1024}, Sd, E); }
    SEAM(16);
    if (IN(17)) { WS_OPAQUE; DenseSched Sd; Sd.init(WSP(bf16_t, A_O), 2048, WSP(bf16_t, W_OO), 2048, 128, 4, C.G, bx); EpiRes E{P.out, P.out};
        pg8::gemm_phase(C.wave, lds, pg8::Dims{2048, 2048, 2048}, Sd, E); }
    SEAM(17);
    MOE_PHASES(1, 18);
#undef MOE_PHASES
#undef RET_PHASES
    if (IN(22)) { P_OPAQUE; moe_combine<1>(C, P, nullptr, P.in[I_LN_F]); }
#ifdef PROBE_T
    __syncthreads();
    if (bx == 0 && C.wave == 0 && lane_id_opaque() == 0) { volatile LAS unsigned long long* st_ = (volatile LAS unsigned long long*)(lds + LDS_MISC + 64);
        const unsigned long long tend = __builtin_amdgcn_s_memrealtime(); const unsigned long long tb = (PROBE_T == 22) ? tend : st_[PROBE_T + 1]; const unsigned long long dt = tb - st_[PROBE_T];
        while (__builtin_amdgcn_s_memrealtime() - tend < 8ull * dt) __builtin_amdgcn_s_sleep(8); }
#endif
#undef IN
#undef SEAM
}

extern "C" void kernel_launch(void* const* d_in, const int* in_sizes, int n_in, void* d_out, int out_size, void* d_ws, size_t ws_size, hipStream_t stream) {
    static int ready = 0;
    if (ready == 0) {
        if (n_in != 21 || out_size != T * D || ws_size < WS_NEED) { fprintf(stderr, "kernel_launch: unexpected shapes (n_in %d, out %d, ws %zu < %zu)\n", n_in, out_size, ws_size, (size_t)WS_NEED); ready = -1; return; }
        if (hipFuncSetAttribute((const void*)fwd_kernel, hipFuncAttributeMaxDynamicSharedMemorySize, LDS_BYTES) != hipSuccess) { fprintf(stderr, "kernel_launch: hipFuncSetAttribute failed\n"); ready = -1; return; }
        int per_cu = 0; (void)hipOccupancyMaxActiveBlocksPerMultiprocessor(&per_cu, (const void*)fwd_kernel, 512, LDS_BYTES); (void)hipGetLastError();
        if (per_cu < 1) fprintf(stderr, "kernel_launch: occupancy query reports %d blocks per CU\n", per_cu);
        ready = 1;
    }
    if (ready < 0) return;
    (void)hipMemsetAsync((char*)d_ws + OFF_CTL, 0, CTL_BYTES, stream);
    Params p{};
    for (int i = 0; i < 21; ++i) p.in[i] = (const float*)d_in[i];
    p.out = (float*)d_out; p.ws = (unsigned char*)d_ws; p.pad = 0;
#if N_LAUNCH_MODE == 1
    for (int ph = 0; ph < NPHASE; ++ph) { p.ph_lo = ph; p.ph_hi = ph + 1; p.use_bar = 0; hipLaunchKernelGGL(fwd_kernel, dim3(256), dim3(512), LDS_BYTES, stream, p); }
#else
    p.ph_lo = 0; p.ph_hi = NPHASE; p.use_bar = 1;
    hipLaunchKernelGGL(fwd_kernel, dim3(256), dim3(512), LDS_BYTES, stream, p);
#endif
}
```

```cpp
#include <hip/hip_runtime.h>
#include <cstdio>
#include <cstdint>

#ifndef N_LAUNCH_MODE
#define N_LAUNCH_MODE 0
#endif

#define LAS __attribute__((address_space(3)))
#define GAS __attribute__((address_space(1)))
typedef unsigned short bf16_t;
typedef short bf16x8 __attribute__((ext_vector_type(8)));
typedef float f32x2 __attribute__((ext_vector_type(2)));
typedef float f32x4 __attribute__((ext_vector_type(4)));
typedef float f32x16 __attribute__((ext_vector_type(16)));
typedef unsigned u32x2 __attribute__((ext_vector_type(2)));
typedef unsigned u32x4 __attribute__((ext_vector_type(4)));

constexpr int T = 32768, S = 16384, D = 1024;
constexpr float EPS = 1e-6f;
constexpr float LOG2E = 1.4426950408889634f;
constexpr int CAP = 65536 + 32 * 256;
constexpr int LDO = 2112;
constexpr int NSEG = 16, SEGC = 16;

constexpr size_t MiB = 1u << 20;
constexpr size_t OFF_CTL = 0, CTL_BYTES = 1 * MiB;
constexpr size_t OFF_SMALL = 1 * MiB;
constexpr size_t SM_RS0 = OFF_SMALL, SM_RS1 = SM_RS0 + T * 4, SM_RS2 = SM_RS1 + T * 4, SM_PQ = SM_RS2 + T * 4, SM_PKV = SM_PQ + (size_t)T * 16,
                 SM_LF = SM_PKV + (size_t)T * 16, SM_CUM = SM_LF + (size_t)T * 32, SM_EID = SM_CUM + (size_t)T * 32  ,
                 SM_GATE = SM_EID + (size_t)T * 8, SM_RANK = SM_GATE + (size_t)T * 8, SM_TSLOT = SM_RANK + (size_t)T * 8, SM_CNT = SM_TSLOT + (size_t)T * 8,
                 SM_STOK = SM_CNT + 256 * 32 * 4, SM_SW = SM_STOK + (size_t)CAP * 4, SM_SR = SM_SW + (size_t)CAP * 4, SM_TILEE = SM_SR + (size_t)CAP * 4,
                 SM_PO = SM_TILEE + 4096, SM_KNRM = SM_PO + (size_t)T * 64, SM_END = SM_KNRM + 16 * 256 * 4;
static_assert(SM_END <= 11 * MiB, "small region");
constexpr size_t OFF_ROPE = 11 * MiB;
constexpr size_t OFF_WMIX = 27 * MiB;
constexpr size_t W_A1 = OFF_WMIX, W_A1V = W_A1 + 3 * MiB, W_A2 = W_A1V + 1 * MiB, W_A2V = W_A2 + 768 * 1024, W_OE = W_A2V + 256 * 1024,
                 W_B1 = W_OE + 2 * MiB, W_OO = W_B1 + 12 * MiB, W_MIXEND = W_OO + (size_t)1024 * LDO * 2;
static_assert(W_MIXEND <= 51 * MiB, "mixer weights");
constexpr size_t OFF_WGU = 51 * MiB, OFF_WDN = OFF_WGU + 64 * MiB;
constexpr size_t OFF_XB = 147 * MiB;
constexpr size_t OFF_ACT = 211 * MiB;
constexpr size_t WS_NEED = OFF_ACT + 325 * MiB;
constexpr size_t A_Z = OFF_ACT, A_QF = A_Z + 32 * MiB, A_KF = A_QF + 32 * MiB, A_VTF = A_KF + 32 * MiB, A_QA = A_VTF + 32 * MiB, A_KA = A_QA + 48 * MiB, A_VTA = A_KA + 48 * MiB;
constexpr size_t A_XS = OFF_ACT, A_HID = OFF_ACT + 144 * MiB;
constexpr size_t A_QX = OFF_ACT, A_KN = A_QX + 32 * MiB, A_KZT = A_KN + 32 * MiB, A_VT = A_KZT + 32 * MiB, A_L = A_VT + 64 * MiB, A_O = A_L + 32 * MiB;
static_assert(A_O + (size_t)T * LDO * 2 <= WS_NEED && A_HID + 72 * MiB <= WS_NEED && A_VTA + 32 * MiB <= WS_NEED, "act map");

__device__ __forceinline__ unsigned f2bf(float f) { unsigned u = __builtin_bit_cast(unsigned, f); return (u + 0x7fffu + ((u >> 16) & 1u)) >> 16; }
__device__ __forceinline__ unsigned pk2(float lo, float hi) { unsigned r; asm volatile("v_cvt_pk_bf16_f32 %0, %1, %2" : "=v"(r) : "v"(lo), "v"(hi)); return r; }
__device__ __forceinline__ float bf2f(unsigned short b) { return __builtin_bit_cast(float, ((unsigned)b) << 16); }
__device__ __forceinline__ float bflo(unsigned w) { return __builtin_bit_cast(float, w << 16); }
__device__ __forceinline__ float bfhi(unsigned w) { return __builtin_bit_cast(float, w & 0xffff0000u); }
__device__ __forceinline__ float wave_sum(float v) {
#pragma unroll
    for (int o = 1; o < 64; o <<= 1) v += __shfl_xor(v, o);
    return v;
}
__device__ __forceinline__ int lane_id_opaque() { unsigned z = 0u; asm volatile("" : "+s"(z)); int l = (int)__builtin_amdgcn_mbcnt_hi(~0u, __builtin_amdgcn_mbcnt_lo(~0u, z)); asm volatile("" : "+v"(l)); return l; }
__device__ __forceinline__ int ld_i(const int* p) { return __hip_atomic_load(p, __ATOMIC_RELAXED, __HIP_MEMORY_SCOPE_AGENT); }
__device__ __forceinline__ float rsqrt_f(float x) { return 1.0f / sqrtf(x); }

#define XB_TMO      128
#define XB_XCNT(j)  (256  + 64 * (j))
#define XB_XSUB(j)  (1280 + 64 * (j))
#define XB_XGEN(j)  (2304 + 64 * (j))
#define XB_TOP      3328
#define XB_TOPGEN   3392
#define XCD_BAR_WORDS 3456
#define XB_SPIN_CAP (1u << 18)
__device__ __forceinline__ unsigned xb_ld(unsigned* p)              { return __hip_atomic_load(p, __ATOMIC_RELAXED, __HIP_MEMORY_SCOPE_AGENT); }
__device__ __forceinline__ unsigned xb_add(unsigned* p, unsigned v) { return __hip_atomic_fetch_add(p, v, __ATOMIC_RELAXED, __HIP_MEMORY_SCOPE_AGENT); }
__device__ __forceinline__ unsigned xb_xcc_id() { return (unsigned)__builtin_amdgcn_s_getreg((3 << 11) | 20) & 0xFu; }
#define XB_SPIN(cond, bar) do { unsigned _sp = 0; while (cond) { __builtin_amdgcn_s_sleep(1); \
    if ((++_sp & 255u) == 0u) { if (xb_ld(&(bar)[XB_TMO])) break; if (_sp > XB_SPIN_CAP) { atomicAdd(&(bar)[XB_TMO], 1u); break; } } } } while (0)
struct XcdBarrier { unsigned* bar; unsigned x; volatile LAS unsigned* st; };
__device__ __forceinline__ XcdBarrier xcd_barrier_post(unsigned* bar, volatile LAS unsigned* st, bool t0) {
    XcdBarrier b; b.bar = bar; b.x = xb_xcc_id(); b.st = st;
    if (t0) (void)xb_add(&bar[XB_XCNT(b.x)], 1u);
    return b;
}
__device__ __forceinline__ void xcd_barrier_complete(unsigned* bar, unsigned x, unsigned& nloc, unsigned& nx) {
    const unsigned G = gridDim.x * gridDim.y * gridDim.z;
    unsigned sum, cnt, mine, sp = 0u;
    for (;;) {
        sum = 0u; cnt = 0u; mine = 0u;
#pragma unroll
        for (unsigned j = 0; j < 16; ++j) { const unsigned c = xb_ld(&bar[XB_XCNT(j)]); sum += c; cnt += (c > 0u) ? 1u : 0u; mine = (j == x) ? c : mine; }
        if (sum == G) break;
        __builtin_amdgcn_s_sleep(1);
        if ((++sp & 255u) == 0u) { if (xb_ld(&bar[XB_TMO])) break; if (sp > XB_SPIN_CAP) { atomicAdd(&bar[XB_TMO], 1u); break; } }
    }
    nloc = mine > 0u ? mine : 1u; nx = cnt > 0u ? cnt : 1u;
}
__device__ __forceinline__ void xcd_barrier(const XcdBarrier& b, bool t0) {
    asm volatile("s_waitcnt vmcnt(0)" ::: "memory");
    __syncthreads();
    if (t0) {
        unsigned* bar = b.bar;
        __builtin_amdgcn_s_waitcnt(0);
        unsigned nloc = b.st[0], nx = b.st[1];
        if (nloc == 0u) { xcd_barrier_complete(bar, b.x, nloc, nx); b.st[0] = nloc; b.st[1] = nx; }
        const unsigned old = xb_add(&bar[XB_XSUB(b.x)], 1u);
        const unsigned gen = old / nloc;
        if (old + 1u == (gen + 1u) * nloc) {
            __builtin_amdgcn_fence(__ATOMIC_RELEASE, "agent");
            asm volatile("s_waitcnt vmcnt(0)" ::: "memory");
            const unsigned og = xb_add(&bar[XB_TOP], 1u);
            const unsigned tg = og / nx;
            if (og + 1u == (tg + 1u) * nx) xb_add(&bar[XB_TOPGEN], 1u);
            else XB_SPIN(xb_ld(&bar[XB_TOPGEN]) == tg, bar);
            __builtin_amdgcn_fence(__ATOMIC_ACQUIRE, "agent");
            xb_add(&bar[XB_XGEN(b.x)], 1u);
            asm volatile("s_waitcnt vmcnt(0)" ::: "memory");
        } else {
            XB_SPIN(xb_ld(&bar[XB_XGEN(b.x)]) == gen, bar);
            __builtin_amdgcn_fence(__ATOMIC_ACQUIRE, "agent");
            asm volatile("s_waitcnt vmcnt(0)" ::: "memory");
        }
    }
    __syncthreads();
}

namespace pg8 {
constexpr int BM = 256, BK = 64, HALF = 128, HTB = HALF * BK * 2, STAGE_BYTES = 8 * HTB, NXCD = 8, WGM = 8;
__device__ __forceinline__ int lds_byte(int r, int c) { const int st = (r >> 4) * 2 + (c >> 5), rr = r & 15, cc = c & 31, ob = rr * 64 + cc * 2; return st * 1024 + (ob ^ (((ob >> 9) & 1) << 5)); }
__device__ __forceinline__ void stage_rc(int b, int& R, int& C) { const int st = b / 1024, sb = b % 1024, swz = sb ^ (((sb >> 9) & 1) << 5); R = (st >> 1) * 16 + swz / 64; C = (st & 1) * 32 + (swz % 64) / 2; }
__device__ __forceinline__ int perm32(int rho) { const int n = rho >> 4, i = rho & 15; return 8 * (i >> 2) + 4 * n + (i & 3); }
struct Unit { int pm, pn, aux; };
struct Dims { int lda, ldb, K; };
struct DenseOrder {
    int nM, nN, nwg, G, c;
    __device__ __forceinline__ void init(int nM_, int nN_, int G_, int c_) { nM = nM_; nN = nN_; nwg = nM * nN; G = G_; c = c_; }
    __device__ __forceinline__ bool tile(int i, Unit& u) const {
        const long L = (long)i * G + c; if (L >= nwg) return false;
        int wgid = (int)L; { const int q = nwg / NXCD, r = nwg % NXCD, xcd = wgid % NXCD, off = wgid / NXCD; wgid = (xcd < r ? xcd * (q + 1) : r * (q + 1) + (xcd - r) * q) + off; }
        const int nig = WGM * nN, gid = wgid / nig, fm = gid * WGM, gsz = (nM - fm) < WGM ? (nM - fm) : WGM;
        u.pm = fm + ((wgid % nig) % gsz); u.pn = (wgid % nig) / gsz; u.aux = 0; return true;
    }
};

template <class Epi, class Sched>
__device__ __forceinline__ void gemm_phase(int wave_, LAS unsigned char* lds, const Dims g, const Sched& S, const Epi& E) {
    const int tid = wave_ * 64 + lane_id_opaque();
    const int wid = __builtin_amdgcn_readfirstlane(tid >> 6), lane = tid & 63, wr = wid >> 2, wc = wid & 3, fr = lane & 15, fq = lane >> 4;
    const int K = g.K, nt = K / BK;
    unsigned voffA[2], voffB[2];
#pragma unroll
    for (int i = 0; i < 2; ++i) { int R, C; stage_rc(tid * 16 + i * 8192, R, C); const int Rb = Epi::PERM ? ((R & ~31) + perm32(R & 31)) : R;
        voffA[i] = (unsigned)(R * g.lda + C) * 2u; voffB[i] = (unsigned)(Rb * g.ldb + C) * 2u; }
    const size_t kstep = (size_t)(BK * 2);
    const size_t hstepA = (size_t)HALF * g.lda * 2, hstepB = (size_t)HALF * g.ldb * 2;
    const unsigned ldsw = (unsigned)wid * 1024u;
    const int aoff = lds_byte(wr * 64 + fr, fq * 8), boff = lds_byte(wc * 32 + fr, fq * 8);
#define PG8_SA(b, h) (((b) * 2 + (h)) * HTB)
#define PG8_SB(b, h) ((4 + (b) * 2 + (h)) * HTB)
#define PG8_STAGE(bufoff, gbase, voff) do { _Pragma("unroll") for (int _i = 0; _i < 2; ++_i) \
        __builtin_amdgcn_global_load_lds((const unsigned*)((const char*)(gbase) + (voff)[_i]), (LAS unsigned*)(lds + (bufoff) + ldsw + _i * 8192), 16, 0, 0); } while (0)
#define PG8_LDA(dst, b, h) do { _Pragma("unroll") for (int m = 0; m < 4; ++m) _Pragma("unroll") for (int k = 0; k < 2; ++k) dst[m][k] = *(const LAS bf16x8*)(lds + PG8_SA(b, h) + aoff + m * 2048 + k * 1024); } while (0)
#define PG8_LDB(dst, b, h) do { _Pragma("unroll") for (int n = 0; n < 2; ++n) _Pragma("unroll") for (int k = 0; k < 2; ++k) dst[n][k] = *(const LAS bf16x8*)(lds + PG8_SB(b, h) + boff + n * 2048 + k * 1024); } while (0)
#define PG8_MMA(ai, bj, At, Bt) do { __builtin_amdgcn_s_setprio(1); _Pragma("unroll") for (int m = 0; m < 4; ++m) _Pragma("unroll") for (int n = 0; n < 2; ++n) _Pragma("unroll") for (int k = 0; k < 2; ++k) \
        acc[ai][bj][m][n] = __builtin_amdgcn_mfma_f32_16x16x32_bf16(Bt[n][k], At[m][k], acc[ai][bj][m][n], 0, 0, 0); __builtin_amdgcn_s_setprio(0); } while (0)
#define PG8_WAIT_V(n) asm volatile("s_waitcnt vmcnt(" #n ")" ::: "memory")
#define PG8_WAIT_L(n) asm volatile("s_waitcnt lgkmcnt(" #n ")" ::: "memory")
#define PG8_BAR __builtin_amdgcn_s_barrier()
#define PG8_SCHED __builtin_amdgcn_sched_barrier(0)
    Unit cur, nxt; int ui = 0;
    if (!S.next(0, cur)) return;
    f32x4 acc[2][2][4][2];
#pragma unroll
    for (int a = 0; a < 2; ++a)
#pragma unroll
        for (int b = 0; b < 2; ++b)
#pragma unroll
            for (int m = 0; m < 4; ++m)
#pragma unroll
                for (int n = 0; n < 2; ++n) acc[a][b][m][n] = (f32x4){0.f, 0.f, 0.f, 0.f};
    bf16x8 At[4][2], B0[2][2], B1[2][2];
    const char* cA; const char* cB; S.ptrs(cur, cA, cB);
    PG8_STAGE(PG8_SB(0, 0), cB, voffB); PG8_STAGE(PG8_SB(0, 1), cB + hstepB, voffB); PG8_STAGE(PG8_SA(0, 0), cA, voffA); PG8_STAGE(PG8_SA(0, 1), cA + hstepA, voffA);
    if (wr == 1) PG8_BAR;
    PG8_WAIT_V(2); PG8_BAR;
    PG8_STAGE(PG8_SB(1, 0), cB + kstep, voffB); PG8_STAGE(PG8_SA(1, 0), cA + kstep, voffA); PG8_STAGE(PG8_SB(1, 1), cB + hstepB + kstep, voffB);
    PG8_WAIT_V(6); PG8_BAR;
    for (;;) {
        const bool has_next = S.next(ui + 1, nxt);
        const char* nA = cA; const char* nB = cB; if (has_next) S.ptrs(nxt, nA, nB);
        for (int t = 0; t < nt; t += 2) {
            const bool last = (t == nt - 2);
            const char* a1 = cA + (size_t)(t + 1) * kstep;
            const char* a2 = last ? nA : cA + (size_t)(t + 2) * kstep; const char* b2 = last ? nB : cB + (size_t)(t + 2) * kstep;
            const char* a3 = a2 + kstep; const char* b3 = b2 + kstep;
            PG8_LDB(B0, 0, 0); PG8_LDB(B1, 0, 1); PG8_SCHED; PG8_LDA(At, 0, 0); PG8_STAGE(PG8_SA(1, 1), a1 + hstepA, voffA);
            PG8_WAIT_V(8); PG8_WAIT_L(0); PG8_BAR; PG8_MMA(0, 0, At, B0); PG8_MMA(0, 1, At, B1); PG8_BAR; PG8_SCHED;
            PG8_LDA(At, 0, 1); PG8_STAGE(PG8_SB(0, 0), b2, voffB); PG8_STAGE(PG8_SB(0, 1), b2 + hstepB, voffB); PG8_STAGE(PG8_SA(0, 0), a2, voffA);
            PG8_WAIT_V(8); PG8_WAIT_L(0); PG8_BAR; PG8_MMA(1, 0, At, B0); PG8_MMA(1, 1, At, B1); PG8_BAR; PG8_SCHED;
            PG8_LDB(B0, 1, 0); PG8_LDB(B1, 1, 1); PG8_SCHED; PG8_LDA(At, 1, 0); PG8_STAGE(PG8_SA(0, 1), a2 + hstepA, voffA);
            PG8_WAIT_V(8); PG8_WAIT_L(0); PG8_BAR; PG8_MMA(0, 0, At, B0); PG8_MMA(0, 1, At, B1); PG8_BAR; PG8_SCHED;
            PG8_LDA(At, 1, 1); PG8_STAGE(PG8_SB(1, 0), b3, voffB); PG8_STAGE(PG8_SB(1, 1), b3 + hstepB, voffB); PG8_STAGE(PG8_SA(1, 0), a3, voffA);
            PG8_WAIT_V(8); PG8_WAIT_L(0); PG8_BAR; PG8_MMA(1, 0, At, B0); PG8_MMA(1, 1, At, B1); PG8_BAR; PG8_SCHED;
        }
        if (wr == 0) PG8_BAR;
        { int fr2 = fr, fq2 = fq; asm volatile("" : "+v"(fr2), "+v"(fq2)); E(acc, cur, wr, wc, fr2, fq2); }
        if (!has_next) break;
#pragma unroll
        for (int a = 0; a < 2; ++a)
#pragma unroll
            for (int b = 0; b < 2; ++b)
#pragma unroll
                for (int m = 0; m < 4; ++m)
#pragma unroll
                    for (int n = 0; n < 2; ++n) acc[a][b][m][n] = (f32x4){0.f, 0.f, 0.f, 0.f};
        cur = nxt; cA = nA; cB = nB; ++ui;
        if (wr == 1) PG8_BAR;
    }
    PG8_WAIT_V(0);
    PG8_BAR;
#undef PG8_SA
#undef PG8_SB
#undef PG8_STAGE
#undef PG8_LDA
#undef PG8_LDB
#undef PG8_MMA
#undef PG8_WAIT_V
#undef PG8_WAIT_L
#undef PG8_BAR
#undef PG8_SCHED
}
}
using pg8::Unit;

struct Params {
    const float* in[21];
    float* out;
    unsigned char* ws;
    int ph_lo, ph_hi;
    int use_bar, pad;
};
enum { I_X = 0, I_LN_MIX_E, I_W_IN_E, I_LN_Q, I_W_UQ, I_LN_KV, I_W_UKV, I_B_F, I_W_OUT_E, I_LN_MIX_O, I_W_IN_O, I_W_OUT_O, I_LN_FFN, I_W_RG, I_B_RG, I_W_RE, I_B_RE, I_W_GATE, I_W_UP, I_W_DOWN, I_LN_F };

#define WSP(T_, off) ((T_*)(ws_ + (off)))
typedef const Params __attribute__((address_space(4)))* KParams;
#define P_OPAQUE KParams Pk_ = (KParams)__builtin_amdgcn_kernarg_segment_ptr(); asm volatile("" : "+s"(Pk_)); const Params& P = *(const Params*)Pk_
#define WS_OPAQUE P_OPAQUE; unsigned char* ws_ = P.ws

__device__ __forceinline__ float log2_gamma(int h) { return __builtin_log2f(1.0f - __builtin_exp2f(-5.0f - (float)h)); }

struct DenseSched {
    pg8::DenseOrder O; const char* A; const char* B; size_t astep, bstep;
    __device__ __forceinline__ void init(const void* A_, int lda, const void* B_, int ldb, int nM, int nN, int G, int c) {
        O.init(nM, nN, G, c); A = (const char*)A_; B = (const char*)B_; astep = (size_t)256 * lda * 2; bstep = (size_t)256 * ldb * 2; }
    __device__ __forceinline__ bool next(int i, Unit& u) const { return O.tile(i, u); }
    __device__ __forceinline__ void ptrs(const Unit& u, const char*& a, const char*& b) const { a = A + (size_t)u.pm * astep; b = B + (size_t)u.pn * bstep; }
};
struct MoeSched {
    const char* A; const char* B; size_t astep, estep, bstep; int ntile, c; int ex[5];
    __device__ __forceinline__ int tile_of(int i) const { return i * 64 + (c & 7) * 8 + (c >> 5); }
    __device__ __forceinline__ void init(const void* A_, int lda, const void* B_, int ldb, size_t expert_rows, const int* tilee, int G_, int c_) {
        A = (const char*)A_; B = (const char*)B_; astep = (size_t)256 * lda * 2; bstep = (size_t)256 * ldb * 2; estep = expert_rows * ldb * 2; c = c_; (void)G_;
        ntile = __builtin_amdgcn_readfirstlane(ld_i(tilee + 300));
#pragma unroll
        for (int i = 0; i < 5; ++i) { const int t = tile_of(i); ex[i] = __builtin_amdgcn_readfirstlane(ld_i(tilee + (t < 300 ? t : 299))); } }
    __device__ __forceinline__ bool next(int i, Unit& u) const { if (i >= 5) return false; const int tile = tile_of(i); if (tile >= ntile) return false; u.pm = tile; u.pn = (c >> 3) & 3;
        u.aux = (i == 0) ? ex[0] : (i == 1) ? ex[1] : (i == 2) ? ex[2] : (i == 3) ? ex[3] : ex[4]; return true; }
    __device__ __forceinline__ void ptrs(const Unit& u, const char*& a, const char*& b) const { a = A + (size_t)u.pm * astep; b = B + (size_t)u.aux * estep + (size_t)u.pn * bstep; }
};

typedef const f32x4 (&AccRef)[2][2][4][2];
#define EPI_LOOP_AI_M for (int ai = 0; ai < 2; ++ai) _Pragma("unroll") for (int m = 0; m < 4; ++m)
#define EPI_LOOP_BJ_N for (int bj = 0; bj < 2; ++bj) _Pragma("unroll") for (int n = 0; n < 2; ++n)

struct EpiA1a {
    static constexpr bool PERM = false;
    const float* rs0; bf16_t* Z; float* PQ; float* PKV; bf16_t* KA; float* LF; const float* bf; bf16_t* QF; bf16_t* KF; const f32x2* rope;
    __device__ __forceinline__ void operator()(AccRef acc, const Unit& u, int wr, int wc, int fr, int fq) const {
        const int row0 = u.pm * 256 + wr * 64 + fr; float rsv[2][4];
#pragma unroll
        EPI_LOOP_AI_M rsv[ai][m] = rs0[row0 + ai * 128 + m * 16];
        if (u.pn <= 1) {
            const int zc = u.pn * 256 + wc * 32 + 4 * fq;
#pragma unroll
            EPI_LOOP_AI_M { const int r = row0 + ai * 128 + m * 16; const float rs = rsv[ai][m]; float ss = 0.f; f32x4 v[2][2];
#pragma unroll
                EPI_LOOP_BJ_N { v[bj][n] = acc[ai][bj][m][n] * rs; u32x2 w; w.x = pk2(v[bj][n][0], v[bj][n][1]); w.y = pk2(v[bj][n][2], v[bj][n][3]);
                    *(u32x2*)(Z + (size_t)r * 512 + zc + bj * 128 + n * 16) = w;
                    if (u.pn == 0 || bj == 0) ss += (v[bj][n][0] * v[bj][n][0] + v[bj][n][1] * v[bj][n][1]) + (v[bj][n][2] * v[bj][n][2] + v[bj][n][3] * v[bj][n][3]); }
                ss += __shfl_xor(ss, 16); ss += __shfl_xor(ss, 32);
                if (fq == 0) { if (u.pn == 0) PQ[(size_t)r * 4 + wc] = ss; else PKV[(size_t)r * 4 + wc] = ss; }
                if (u.pn == 1 && wc == 0) {
                    const int pos = r & (S - 1); const f32x4 x1 = v[1][0], x2 = v[1][1]; f32x4 o1, o2;
#pragma unroll
                    for (int j = 0; j < 4; ++j) { const f32x2 cs = rope[(size_t)pos * 128 + 8 * (4 * fq + j)]; o1[j] = x1[j] * cs.x - x2[j] * cs.y; o2[j] = x1[j] * cs.y + x2[j] * cs.x; }
                    u32x2 w1, w2; w1.x = pk2(o1[0], o1[1]); w1.y = pk2(o1[2], o1[3]); w2.x = pk2(o2[0], o2[1]); w2.y = pk2(o2[2], o2[3]);
#pragma unroll
                    for (int hh = 0; hh < 8; ++hh) { bf16_t* kp = KA + (size_t)r * 768 + hh * 96 + 64 + 4 * fq; *(u32x2*)kp = w1; *(u32x2*)(kp + 16) = w2; }
                }
                if (u.pn == 1 && wc == 1 && fq < 2) {
                    const f32x4 f = v[1][0]; f32x4 o;
#pragma unroll
                    for (int j = 0; j < 4; ++j) { const float x = f[j] + bf[4 * fq + j]; o[j] = fminf(x, 0.f) - log1pf(__expf(-fabsf(x))); }
                    *(f32x4*)(LF + (size_t)r * 8 + 4 * fq) = o;
                }
            }
        } else {
            const bool isq = u.pn < 4; bf16_t* dst = isq ? QF : KF; const int cc = (isq ? (u.pn - 2) : (u.pn - 4)) * 256 + wc * 32 + 4 * fq; const float sc = isq ? (0.125f * LOG2E) : 1.0f;
#pragma unroll
            EPI_LOOP_AI_M { const int r = row0 + ai * 128 + m * 16; const float rs = rsv[ai][m] * sc;
#pragma unroll
                EPI_LOOP_BJ_N { const f32x4 v = acc[ai][bj][m][n] * rs; u32x2 w; w.x = pk2(v[0], v[1]); w.y = pk2(v[2], v[3]); *(u32x2*)(dst + (size_t)r * 512 + cc + bj * 128 + n * 16) = w; } }
        }
    }
};
template <int MODE> struct EpiVT {
    static constexpr bool PERM = true;
    const float* rs; bf16_t* OUT; size_t ldo;
    __device__ __forceinline__ float cs(int t) const { if (MODE == 0) return rs[t]; const f32x4 p = *(const f32x4*)(rs + (size_t)t * 4); return rsqrt_f(((p[0] + p[1]) + (p[2] + p[3])) * (1.0f / 128.0f) + EPS); }
    __device__ __forceinline__ void operator()(AccRef acc, const Unit& u, int wr, int wc, int fr, int fq) const {
        const int f0 = u.pm * 256 + wr * 64 + fr, t0 = u.pn * 256 + wc * 32 + 8 * fq;
#pragma unroll
        for (int bj = 0; bj < 2; ++bj) { float c[8];
#pragma unroll
            for (int j = 0; j < 8; ++j) c[j] = cs(t0 + bj * 128 + j);
#pragma unroll
            EPI_LOOP_AI_M { const f32x4 a = acc[ai][bj][m][0], b = acc[ai][bj][m][1]; u32x4 w;
                w.x = pk2(a[0] * c[0], a[1] * c[1]); w.y = pk2(a[2] * c[2], a[3] * c[3]); w.z = pk2(b[0] * c[4], b[1] * c[5]); w.w = pk2(b[2] * c[6], b[3] * c[7]);
                const int f_ = f0 + ai * 128 + m * 16, t_ = t0 + bj * 128;
                *(u32x4*)(OUT + (((size_t)(f_ >> 6) * (T / 64) + (t_ >> 6)) * 64 + (f_ & 63)) * 64 + (t_ & 63)) = w; } }
    }
};
struct EpiA2q {
    static constexpr bool PERM = false;
    const float* PQ; bf16_t* QA; const f32x2* rope;
    __device__ __forceinline__ void operator()(AccRef acc, const Unit& u, int wr, int wc, int fr, int fq) const {
        if (wc == 3) return;
        const int row0 = u.pm * 256 + wr * 64 + fr; const float SCA = 0.10206207261596577f * LOG2E;
#pragma unroll
        for (int ai = 0; ai < 2; ++ai) { f32x2 csv[4][4]; f32x4 pv[2][4];
#pragma unroll
            for (int m = 0; m < 4; ++m) pv[ai][m] = *(const f32x4*)(PQ + (size_t)(row0 + ai * 128 + m * 16) * 4);
            if (wc == 2) {
#pragma unroll
                for (int m = 0; m < 4; ++m)
#pragma unroll
                    for (int j = 0; j < 4; ++j) csv[m][j] = rope[(size_t)((row0 + ai * 128 + m * 16) & (S - 1)) * 128 + 8 * (4 * fq + j)]; }
#pragma unroll
            for (int m = 0; m < 4; ++m) { const int r = row0 + ai * 128 + m * 16; const f32x4 p = pv[ai][m];
                const float rs = rsqrt_f(((p[0] + p[1]) + (p[2] + p[3])) * (1.0f / 256.0f) + EPS) * SCA;
#pragma unroll
                for (int bj = 0; bj < 2; ++bj) { const int hh = 2 * u.pn + bj; bf16_t* qp = QA + (size_t)r * 768 + hh * 96 + wc * 32 + 4 * fq; f32x4 x1 = acc[ai][bj][m][0] * rs, x2 = acc[ai][bj][m][1] * rs;
                    if (wc == 2) {
#pragma unroll
                        for (int j = 0; j < 4; ++j) { const f32x2 cs = csv[m][j]; const float a = x1[j], b = x2[j]; x1[j] = a * cs.x - b * cs.y; x2[j] = a * cs.y + b * cs.x; } }
                    *(u32x2*)qp = (u32x2){pk2(x1[0], x1[1]), pk2(x1[2], x1[3])}; *(u32x2*)(qp + 16) = (u32x2){pk2(x2[0], x2[1]), pk2(x2[2], x2[3])}; } } }
    }
};
struct EpiA2k {
    static constexpr bool PERM = false;
    const float* PKV; bf16_t* KA;
    __device__ __forceinline__ void operator()(AccRef acc, const Unit& u, int wr, int wc, int fr, int fq) const {
        const int row0 = u.pm * 256 + wr * 64 + fr; f32x4 pv[2][4];
#pragma unroll
        EPI_LOOP_AI_M pv[ai][m] = *(const f32x4*)(PKV + (size_t)(row0 + ai * 128 + m * 16) * 4);
#pragma unroll
        EPI_LOOP_AI_M { const int r = row0 + ai * 128 + m * 16; const f32x4 p = pv[ai][m];
            const float rs = rsqrt_f(((p[0] + p[1]) + (p[2] + p[3])) * (1.0f / 128.0f) + EPS);
#pragma unroll
            EPI_LOOP_BJ_N { const int hh = 4 * u.pn + 2 * bj + (wc >> 1), dd = 32 * (wc & 1) + 16 * n + 4 * fq; const f32x4 v = acc[ai][bj][m][n] * rs;
                *(u32x2*)(KA + (size_t)r * 768 + hh * 96 + dd) = (u32x2){pk2(v[0], v[1]), pk2(v[2], v[3])}; } }
    }
};
template <bool BASE_F32> struct EpiRes {
    static constexpr bool PERM = true;
    const void* base; bf16_t* outp;
    __device__ __forceinline__ void operator()(AccRef acc, const Unit& u, int wr, int wc, int fr, int fq) const {
        const int row0 = u.pm * 256 + wr * 64 + fr, col0 = u.pn * 256 + wc * 32 + 8 * fq;
#pragma unroll
        for (int ai = 0; ai < 2; ++ai) {
            if (BASE_F32) { f32x4 b[4][2][2];
#pragma unroll
                for (int m = 0; m < 4; ++m)
#pragma unroll
                    EPI_LOOP_BJ_N b[m][bj][n] = *(const f32x4*)((const float*)base + (size_t)(row0 + ai * 128 + m * 16) * D + col0 + bj * 128 + n * 4);
#pragma unroll
                for (int m = 0; m < 4; ++m)
#pragma unroll
                    for (int bj = 0; bj < 2; ++bj) { const f32x4 v0 = b[m][bj][0] + acc[ai][bj][m][0], v1 = b[m][bj][1] + acc[ai][bj][m][1];
                        *(u32x4*)(outp + (size_t)(row0 + ai * 128 + m * 16) * D + col0 + bj * 128) = (u32x4){pk2(v0[0], v0[1]), pk2(v0[2], v0[3]), pk2(v1[0], v1[1]), pk2(v1[2], v1[3])}; }
            } else { u32x4 b[4][2];
#pragma unroll
                for (int m = 0; m < 4; ++m)
#pragma unroll
                    for (int bj = 0; bj < 2; ++bj) b[m][bj] = *(const u32x4*)((const bf16_t*)base + (size_t)(row0 + ai * 128 + m * 16) * D + col0 + bj * 128);
#pragma unroll
                for (int m = 0; m < 4; ++m)
#pragma unroll
                    for (int bj = 0; bj < 2; ++bj) { const u32x4 w = b[m][bj]; const f32x4 a0 = acc[ai][bj][m][0], a1 = acc[ai][bj][m][1];
                        *(u32x4*)(outp + (size_t)(row0 + ai * 128 + m * 16) * D + col0 + bj * 128) = (u32x4){pk2(bflo(w.x) + a0[0], bfhi(w.x) + a0[1]), pk2(bflo(w.y) + a0[2], bfhi(w.y) + a0[3]), pk2(bflo(w.z) + a1[0], bfhi(w.z) + a1[1]), pk2(bflo(w.w) + a1[2], bfhi(w.w) + a1[3])}; } } }
    }
};
struct EpiB1q {
    static constexpr bool PERM = false;
    const float* rs2; bf16_t* QX; const f32x2* rope;
    __device__ __forceinline__ void operator()(AccRef acc, const Unit& u, int wr, int wc, int fr, int fq) const {
        const int row0 = u.pm * 256 + wr * 64 + fr; const float l2g = log2_gamma(u.pn); float rsv[2][4];
#pragma unroll
        EPI_LOOP_AI_M rsv[ai][m] = rs2[row0 + ai * 128 + m * 16];
#pragma unroll
        for (int ai = 0; ai < 2; ++ai)
#pragma unroll
            for (int mp = 0; mp < 2; ++mp) { f32x4 ca[2][2], cb[2][2];
#pragma unroll
                for (int mm = 0; mm < 2; ++mm)
#pragma unroll
                    for (int n = 0; n < 2; ++n) { const int pos = row0 + ai * 128 + (2 * mp + mm) * 16, i0 = wc * 32 + 16 * n + 4 * fq; ca[mm][n] = *(const f32x4*)(rope + (size_t)pos * 128 + i0); cb[mm][n] = *(const f32x4*)(rope + (size_t)pos * 128 + i0 + 2); }
#pragma unroll
                for (int mm = 0; mm < 2; ++mm) { const int m = 2 * mp + mm, pos = row0 + ai * 128 + m * 16; const float rs = rsv[ai][m] * __builtin_exp2f((float)((pos & 63) + 1) * l2g);
#pragma unroll
                    for (int n = 0; n < 2; ++n) { const int i0 = wc * 32 + 16 * n + 4 * fq; const f32x4 x1 = acc[ai][0][m][n] * rs, x2 = acc[ai][1][m][n] * rs; f32x4 o1, o2;
                        const float cc[4] = {ca[mm][n][0], ca[mm][n][2], cb[mm][n][0], cb[mm][n][2]}, sn[4] = {ca[mm][n][1], ca[mm][n][3], cb[mm][n][1], cb[mm][n][3]};
#pragma unroll
                        for (int j = 0; j < 4; ++j) { o1[j] = x1[j] * cc[j] - x2[j] * sn[j]; o2[j] = x1[j] * sn[j] + x2[j] * cc[j]; }
                        bf16_t* qp = QX + (size_t)pos * 1024 + u.pn * 256 + i0; *(u32x2*)qp = (u32x2){pk2(o1[0], o1[1]), pk2(o1[2], o1[3])}; *(u32x2*)(qp + 128) = (u32x2){pk2(o2[0], o2[1]), pk2(o2[2], o2[3])}; } } }
    }
};
__device__ __forceinline__ int rho_of_d(int d) { const int lo = d & 31; return (d & ~31) | (((lo >> 2) & 1) << 4) | ((lo >> 3) << 2) | (lo & 3); }
struct EpiB1k {
    static constexpr bool PERM = true;
    const float* rs2; bf16_t* KN; bf16_t* KZT; const f32x2* rope; LAS unsigned char* scr;
    __device__ __forceinline__ void operator()(AccRef acc, const Unit& u, int wr, int wc, int fr, int fq) const {
        const int h = u.pm, t0 = u.pn * 256 + wc * 32 + 8 * fq; const float l2g = log2_gamma(h);
        LAS unsigned char* my = scr + (wr * 4 + wc) * 1024; const int lane = fq * 16 + fr;
#pragma unroll
        for (int bj = 0; bj < 2; ++bj) { const int tb = t0 + bj * 128; float rs[8], zt[8];
#pragma unroll
            for (int j = 0; j < 8; ++j) { rs[j] = rs2[tb + j] * 0.0625f; zt[j] = __builtin_exp2f((float)(63 - ((tb + j) & 63)) * l2g); }
            const int chunk = tb >> 6, c0 = tb & 63;
            f32x2 csv[4][8];
#pragma unroll
            for (int m = 0; m < 4; ++m)
#pragma unroll
                for (int j = 0; j < 8; ++j) csv[m][j] = rope[(size_t)(tb + j) * 128 + wr * 64 + m * 16 + fr];
#pragma unroll
            for (int m = 0; m < 4; ++m) { const int d = wr * 64 + m * 16 + fr; float k1[8], k2[8];
#pragma unroll
                for (int j = 0; j < 8; ++j) { const f32x2 cs = csv[m][j]; const float x1 = acc[0][bj][m][j >> 2][j & 3] * rs[j], x2 = acc[1][bj][m][j >> 2][j & 3] * rs[j];
                    k1[j] = x1 * cs.x - x2 * cs.y; k2[j] = x1 * cs.y + x2 * cs.x; }
                const int rho = rho_of_d(d); u32x4 w1, w2;
                w1.x = pk2(k1[0] * zt[0], k1[1] * zt[1]); w1.y = pk2(k1[2] * zt[2], k1[3] * zt[3]); w1.z = pk2(k1[4] * zt[4], k1[5] * zt[5]); w1.w = pk2(k1[6] * zt[6], k1[7] * zt[7]);
                w2.x = pk2(k2[0] * zt[0], k2[1] * zt[1]); w2.y = pk2(k2[2] * zt[2], k2[3] * zt[3]); w2.z = pk2(k2[4] * zt[4], k2[5] * zt[5]); w2.w = pk2(k2[6] * zt[6], k2[7] * zt[7]);
                bf16_t* zp = KZT + (((size_t)(h * 256 + chunk) * 256 + rho) * 64 + c0); *(u32x4*)zp = w1; *(u32x4*)(zp + 128 * 64) = w2;
#pragma unroll
                for (int half = 0; half < 2; ++half) { const float* kk = half ? k2 : k1;
#pragma unroll
                    for (int j = 0; j < 8; ++j) *(LAS bf16_t*)(my + (8 * fq + j) * 32 + fr * 2) = (bf16_t)f2bf(kk[j]);
                    asm volatile("s_waitcnt lgkmcnt(0)" ::: "memory");
                    const u32x4 v = *(const LAS u32x4*)(my + (lane >> 1) * 32 + (lane & 1) * 16);
                    const int tok = u.pn * 256 + wc * 32 + bj * 128 + (lane >> 1);
                    *(u32x4*)(KN + (size_t)tok * 1024 + h * 256 + half * 128 + wr * 64 + m * 16 + (lane & 1) * 8) = v;
                    asm volatile("s_waitcnt lgkmcnt(0)" ::: "memory"); } } }
    }
};
struct EpiB1v {
    static constexpr bool PERM = true;
    const float* rs2; bf16_t* VT;
    __device__ __forceinline__ void operator()(AccRef acc, const Unit& u, int wr, int wc, int fr, int fq) const {
        const int h = u.pm >> 1, e0 = (u.pm & 1) * 256 + wr * 64 + fr, t0 = u.pn * 256 + wc * 32 + 8 * fq;
#pragma unroll
        for (int bj = 0; bj < 2; ++bj) { const int tb = t0 + bj * 128; float c[8];
#pragma unroll
            for (int j = 0; j < 8; ++j) c[j] = rs2[tb + j];
            const int chunk = tb >> 6, c0 = tb & 63;
#pragma unroll
            EPI_LOOP_AI_M { const f32x4 a = acc[ai][bj][m][0], b = acc[ai][bj][m][1]; u32x4 w;
                w.x = pk2(a[0] * c[0], a[1] * c[1]); w.y = pk2(a[2] * c[2], a[3] * c[3]); w.z = pk2(b[0] * c[4], b[1] * c[5]); w.w = pk2(b[2] * c[6], b[3] * c[7]);
                *(u32x4*)(VT + (((size_t)(h * 256 + chunk) * 512 + e0 + ai * 128 + m * 16) * 64 + c0)) = w; } }
    }
};
struct EpiG {
    static constexpr bool PERM = true;
    const float* rs2; const float* PO; bf16_t* O;
    __device__ __forceinline__ void operator()(AccRef acc, const Unit& u, int wr, int wc, int fr, int fq) const {
        const int row0 = u.pm * 256 + wr * 64 + fr, col0 = u.pn * 256 + wc * 32 + 8 * fq, head = u.pn >> 1;
        f32x4 pv[2][4]; float rsv[2][4];
#pragma unroll
        EPI_LOOP_AI_M { const int r = row0 + ai * 128 + m * 16; pv[ai][m] = *(const f32x4*)(PO + (size_t)r * 16 + head * 4); rsv[ai][m] = rs2[r]; }
#pragma unroll
        for (int ai = 0; ai < 2; ++ai) { u32x4 ov[4][2];
#pragma unroll
            for (int m = 0; m < 4; ++m)
#pragma unroll
                for (int bj = 0; bj < 2; ++bj) ov[m][bj] = *(const u32x4*)(O + (size_t)(row0 + ai * 128 + m * 16) * LDO + col0 + bj * 128);
#pragma unroll
            for (int m = 0; m < 4; ++m) { const f32x4 p = pv[ai][m]; const float ro = rsqrt_f(((p[0] + p[1]) + (p[2] + p[3])) * (1.0f / 512.0f) + EPS), rs = rsv[ai][m];
#pragma unroll
                for (int bj = 0; bj < 2; ++bj) { const u32x4 o4 = ov[m][bj]; const float o[8] = {bflo(o4.x), bfhi(o4.x), bflo(o4.y), bfhi(o4.y), bflo(o4.z), bfhi(o4.z), bflo(o4.w), bfhi(o4.w)}; float a[8];
#pragma unroll
                    for (int j = 0; j < 8; ++j) { const float g = acc[ai][bj][m][j >> 2][j & 3] * rs; a[j] = o[j] * ro * g / (1.0f + __expf(-g)); }
                    *(u32x4*)(O + (size_t)(row0 + ai * 128 + m * 16) * LDO + col0 + bj * 128) = (u32x4){pk2(a[0], a[1]), pk2(a[2], a[3]), pk2(a[4], a[5]), pk2(a[6], a[7])}; } } }
    }
};
struct EpiM3 {
    static constexpr bool PERM = true;
    const float* SR; bf16_t* HID;
    __device__ __forceinline__ void operator()(AccRef acc, const Unit& u, int wr, int wc, int fr, int fq) const {
        const int row0 = u.pm * 256 + wr * 64 + fr, col0 = u.pn * 128 + wc * 32 + 8 * fq; float rsv[2][4];
#pragma unroll
        EPI_LOOP_AI_M rsv[ai][m] = SR[row0 + ai * 128 + m * 16];
#pragma unroll
        EPI_LOOP_AI_M { const int r = row0 + ai * 128 + m * 16; const float rs = rsv[ai][m]; float hh[8];
#pragma unroll
            for (int j = 0; j < 8; ++j) { const float g = acc[ai][0][m][j >> 2][j & 3] * rs, up = acc[ai][1][m][j >> 2][j & 3] * rs; hh[j] = g / (1.0f + __expf(-g)) * up; }
            u32x4 w; w.x = pk2(hh[0], hh[1]); w.y = pk2(hh[2], hh[3]); w.z = pk2(hh[4], hh[5]); w.w = pk2(hh[6], hh[7]); *(u32x4*)(HID + (size_t)r * 512 + col0) = w; }
    }
};
struct EpiM4 {
    static constexpr bool PERM = true;
    const float* SW; bf16_t* YS;
    __device__ __forceinline__ void operator()(AccRef acc, const Unit& u, int wr, int wc, int fr, int fq) const {
        const int row0 = u.pm * 256 + wr * 64 + fr, col0 = u.pn * 256 + wc * 32 + 8 * fq; float swv[2][4];
#pragma unroll
        EPI_LOOP_AI_M swv[ai][m] = SW[row0 + ai * 128 + m * 16];
#pragma unroll
        EPI_LOOP_AI_M { const int r = row0 + ai * 128 + m * 16; const float sw = swv[ai][m];
#pragma unroll
            for (int bj = 0; bj < 2; ++bj) { const f32x4 a = acc[ai][bj][m][0] * sw, b = acc[ai][bj][m][1] * sw; u32x4 w; w.x = pk2(a[0], a[1]); w.y = pk2(a[2], a[3]); w.z = pk2(b[0], b[1]); w.w = pk2(b[2], b[3]);
                *(u32x4*)(YS + (size_t)r * 1024 + col0 + bj * 128) = w; } }
    }
};

__device__ __forceinline__ int crow(int r, int hi) { return (r & 3) + 8 * (r >> 2) + 4 * hi; }
template <int DQK, bool FOX>
__device__ __forceinline__ void attn_unit(int wave_, LAS unsigned char* L, const bf16_t* Qb, int ldq, const bf16_t* Kb, int ldk, const bf16_t* Vtb, const float* cum, const float* knrm, bf16_t* Ob, int ldo, int qb) {
    constexpr int KP = DQK + 8, KBYTES = 64 * KP * 2, VBYTES = 64 * 136, BUF = KBYTES + VBYTES + 256, NS = DQK / 16, KCH = DQK / 8;
    constexpr int XOFF = 3 * BUF;
    constexpr float THR = 8.0f;
    const int tid = wave_ * 64 + lane_id_opaque();
    const int lane = tid & 63, w = wave_, r32 = lane & 31, hi = lane >> 5;
    const int R0 = 256 * qb + 32 * w, q = R0 + r32, NT = 4 * qb + 4, jmax = 4 * qb + (w >> 1);
    bf16x8 qf[NS];
#pragma unroll
    for (int s = 0; s < NS; ++s) qf[s] = *(const bf16x8*)(Qb + (size_t)q * ldq + 16 * s + 8 * hi);
    const float cq = FOX ? cum[q] : 0.f;
    int j0 = 0;
    if (FOX) {
        float n2 = 0.f;
#pragma unroll
        for (int s = 0; s < NS; ++s)
#pragma unroll
            for (int e = 0; e < 8; ++e) { const float x = bf2f((unsigned short)qf[s][e]); n2 += x * x; }
        n2 += __shfl_xor(n2, 32);
#pragma unroll
        for (int o = 1; o < 32; o <<= 1) n2 = fmaxf(n2, __shfl_xor(n2, o));
        LAS float* xs = (LAS float*)(L + XOFF); LAS int* xj = (LAS int*)(L + XOFF + 32);
        if (lane == 0) xs[w] = n2;
        if (tid == 0) xj[0] = 4 * qb;
        __syncthreads();
        float qn = xs[0];
#pragma unroll
        for (int i = 1; i < 8; ++i) qn = fmaxf(qn, xs[i]);
        qn = sqrtf(qn) * 1.01f;
        if (tid < NT) { const float bound = qn * knrm[tid] * 1.01f + cum[256 * qb] - cum[64 * tid + 63]; if (bound >= -160.0f) atomicMin((int*)xj, tid); }
        __syncthreads();
        j0 = xj[0];
    }
    f32x16 o0 = {}, o1 = {}; float mhat = 0.f, lrun = 0.f;
    const int kr0 = tid / KCH, kc0 = tid % KCH, kr1 = (tid + 512) / KCH, kc1 = (tid + 512) % KCH; const bool has1 = (tid + 512) < 64 * KCH;
    const int ve = tid >> 3, vc = tid & 7;
    u32x4 kreg0A, kreg1A = {}, vregA, kreg0B, kreg1B = {}, vregB; float ckregA = 0.f, ckregB = 0.f;
    const int kr1c = has1 ? kr1 : kr0, kc1c = has1 ? kc1 : kc0; const int ckl = tid & 63;
#define ATT_SLOT(i) (((i) % 3) * BUF)
#define ATT_LOADK(j, X) do { const int j_ = (j) < NT ? (j) : NT - 1; kreg0##X = *(const u32x4*)(Kb + (size_t)(64 * j_ + kr0) * ldk + kc0 * 8); if (DQK > 64) kreg1##X = *(const u32x4*)(Kb + (size_t)(64 * j_ + kr1c) * ldk + kc1c * 8); \
        if (FOX) ckreg##X = cum[64 * j_ + ckl]; } while (0)
#define ATT_LOADV(j, X) do { const int j_ = (j) < NT ? (j) : NT - 1; vreg##X = *(const u32x4*)(Vtb + (size_t)j_ * 4096 + ve * 64 + vc * 8); } while (0)
#define ATT_WRITEK(bo, X) do { *(LAS u32x4*)(L + (bo) + kr0 * (KP * 2) + kc0 * 16) = kreg0##X; if (DQK > 64) { if (has1) *(LAS u32x4*)(L + (bo) + kr1 * (KP * 2) + kc1 * 16) = kreg1##X; } \
        if (FOX && tid < 64) *(LAS float*)(L + (bo) + KBYTES + VBYTES + tid * 4) = ckreg##X; } while (0)
#define ATT_WRITEV(bo, X) do { *(LAS u32x2*)(L + (bo) + KBYTES + ve * 136 + vc * 16) = (u32x2){vreg##X.x, vreg##X.y}; *(LAS u32x2*)(L + (bo) + KBYTES + ve * 136 + vc * 16 + 8) = (u32x2){vreg##X.z, vreg##X.w}; } while (0)
    bf16x8 kf[2 * NS]; f32x4 ckv[8]; u32x2 vfr[16]; f32x16 s0, s1; u32x4 pw[4]; float rm = 0.f;
#define ATT_QK_ISSUE(bo) do { \
        _Pragma("unroll") for (int s = 0; s < NS; ++s) { kf[2 * s] = *(const LAS bf16x8*)(L + (bo) + r32 * (KP * 2) + (16 * s + 8 * hi) * 2); kf[2 * s + 1] = *(const LAS bf16x8*)(L + (bo) + (32 + r32) * (KP * 2) + (16 * s + 8 * hi) * 2); } \
        if (FOX) { _Pragma("unroll") for (int g = 0; g < 4; ++g) { ckv[g] = *(const LAS f32x4*)(L + (bo) + KBYTES + VBYTES + (8 * g + 4 * hi) * 4); ckv[4 + g] = *(const LAS f32x4*)(L + (bo) + KBYTES + VBYTES + (32 + 8 * g + 4 * hi) * 4); } } } while (0)
#define ATT_QK_MMA(S0, S1) do { \
        if (FOX) { const float cqm = cq - mhat; \
            _Pragma("unroll") for (int g = 0; g < 4; ++g) { _Pragma("unroll") for (int e = 0; e < 4; ++e) { S0[4 * g + e] = cqm - ckv[g][e]; S1[4 * g + e] = cqm - ckv[4 + g][e]; } } \
        } else { _Pragma("unroll") for (int r = 0; r < 16; ++r) { S0[r] = -mhat; S1[r] = -mhat; } } \
        _Pragma("unroll") for (int s = 0; s < NS; ++s) { S0 = __builtin_amdgcn_mfma_f32_32x32x16_bf16(kf[2 * s], qf[s], S0, 0, 0, 0); S1 = __builtin_amdgcn_mfma_f32_32x32x16_bf16(kf[2 * s + 1], qf[s], S1, 0, 0, 0); } } while (0)
#define ATT_PV_ISSUE(bo) do { _Pragma("unroll") for (int ks = 0; ks < 4; ++ks) { const LAS unsigned char* vb = L + (bo) + KBYTES + r32 * 136 + 32 * ks + 8 * hi; \
            vfr[4 * ks] = *(const LAS u32x2*)(vb); vfr[4 * ks + 1] = *(const LAS u32x2*)(vb + 16); vfr[4 * ks + 2] = *(const LAS u32x2*)(vb + 32 * 136); vfr[4 * ks + 3] = *(const LAS u32x2*)(vb + 32 * 136 + 16); } } while (0)
#define ATT_PV_MMA() do { _Pragma("unroll") for (int ks = 0; ks < 4; ++ks) { \
            const bf16x8 va = __builtin_bit_cast(bf16x8, (u32x4){vfr[4 * ks].x, vfr[4 * ks].y, vfr[4 * ks + 1].x, vfr[4 * ks + 1].y}), vbb = __builtin_bit_cast(bf16x8, (u32x4){vfr[4 * ks + 2].x, vfr[4 * ks + 2].y, vfr[4 * ks + 3].x, vfr[4 * ks + 3].y}), pf = __builtin_bit_cast(bf16x8, pw[ks]); \
            o0 = __builtin_amdgcn_mfma_f32_32x32x16_bf16(va, pf, o0, 0, 0, 0); o1 = __builtin_amdgcn_mfma_f32_32x32x16_bf16(vbb, pf, o1, 0, 0, 0); } } while (0)
#define ATT_M(t) do { const int t_ = (t); const bool doPV = (t_ - 1 >= j0) && (t_ - 1 <= jmax), doQK = (t_ < NT) && (t_ <= jmax); \
        if (doPV) { ATT_PV_ISSUE(ATT_SLOT(t_ - 1)); __builtin_amdgcn_sched_barrier(0); asm volatile("s_waitcnt lgkmcnt(0)" ::: "memory"); __builtin_amdgcn_sched_barrier(0); ATT_PV_MMA(); } \
        if (doQK) { ATT_QK_ISSUE(ATT_SLOT(t_)); __builtin_amdgcn_sched_barrier(0); asm volatile("s_waitcnt lgkmcnt(0)" ::: "memory"); __builtin_amdgcn_sched_barrier(0); ATT_QK_MMA(s0, s1); } } while (0)
#define ATT_X(t, X) do { const int t_ = (t); \
        if (t_ <= jmax) { \
            if (FOX && t_ == jmax) { _Pragma("unroll") for (int r = 0; r < 16; ++r) { const int kg = 64 * t_ + crow(r, hi); if (kg > q) s0[r] = -1e30f; if (kg + 32 > q) s1[r] = -1e30f; } } \
            float mx_ = fmaxf(fmaxf(s0[0], s1[0]), fmaxf(s0[1], s1[1])); \
            _Pragma("unroll") for (int r = 2; r < 16; r += 2) mx_ = fmaxf(mx_, fmaxf(fmaxf(s0[r], s1[r]), fmaxf(s0[r + 1], s1[r + 1]))); \
            rm = fmaxf(mx_, __shfl_xor(mx_, 32)); \
            if (__any(rm > THR)) { const float dl = fmaxf(rm, 0.f), f = __builtin_amdgcn_exp2f(-dl); mhat += dl; lrun *= f; \
                _Pragma("unroll") for (int r = 0; r < 16; ++r) { s0[r] -= dl; s1[r] -= dl; o0[r] *= f; o1[r] *= f; } } \
            float ls0 = 0.f, ls1 = 0.f; \
            _Pragma("unroll") for (int r = 0; r < 16; ++r) { s0[r] = __builtin_amdgcn_exp2f(s0[r]); s1[r] = __builtin_amdgcn_exp2f(s1[r]); ls0 += s0[r]; ls1 += s1[r]; } \
            lrun += ls0 + ls1; \
            _Pragma("unroll") for (int ks = 0; ks < 4; ++ks) { const int b_ = 8 * (ks & 1); \
                if (ks < 2) pw[ks] = (u32x4){pk2(s0[b_], s0[b_ + 1]), pk2(s0[b_ + 2], s0[b_ + 3]), pk2(s0[b_ + 4], s0[b_ + 5]), pk2(s0[b_ + 6], s0[b_ + 7])}; \
                else        pw[ks] = (u32x4){pk2(s1[b_], s1[b_ + 1]), pk2(s1[b_ + 2], s1[b_ + 3]), pk2(s1[b_ + 4], s1[b_ + 5]), pk2(s1[b_ + 6], s1[b_ + 7])}; } } \
        if (t_ + 2 < NT) ATT_WRITEK(ATT_SLOT(t_ + 2), X); \
        if (t_ + 1 < NT) ATT_WRITEV(ATT_SLOT(t_ + 1), X); \
        ATT_LOADK(t_ + 4, X); ATT_LOADV(t_ + 3, X); } while (0)
    ATT_LOADK(j0, A); ATT_LOADV(j0, A); ATT_LOADK(j0 + 1, B);
    ATT_WRITEK(ATT_SLOT(j0), A); ATT_WRITEV(ATT_SLOT(j0), A); ATT_WRITEK(ATT_SLOT(j0 + 1), B);
    ATT_LOADK(j0 + 2, A); ATT_LOADV(j0 + 1, A); ATT_LOADK(j0 + 3, B); ATT_LOADV(j0 + 2, B);
    __syncthreads();
    const int grp = w >> 2;
    if (grp == 1) __syncthreads();
    for (int t = j0; t < NT; t += 2) {
        ATT_M(t); __syncthreads(); ATT_X(t, A); __syncthreads();
        if (t + 1 < NT) { ATT_M(t + 1); __syncthreads(); ATT_X(t + 1, B); __syncthreads(); }
    }
    ATT_M(NT);
    if (grp == 0) __syncthreads();
    __syncthreads();
#undef ATT_SLOT
#undef ATT_LOADK
#undef ATT_LOADV
#undef ATT_WRITEK
#undef ATT_WRITEV
#undef ATT_QK_ISSUE
#undef ATT_QK_MMA
#undef ATT_PV_ISSUE
#undef ATT_PV_MMA
#undef ATT_M
#undef ATT_X
    const float inv = 1.0f / (lrun + __shfl_xor(lrun, 32));
    bf16_t* op = Ob + (size_t)q * ldo + 4 * hi;
#pragma unroll
    for (int g = 0; g < 4; ++g) { u32x2 w0, w1; w0.x = pk2(o0[4 * g] * inv, o0[4 * g + 1] * inv); w0.y = pk2(o0[4 * g + 2] * inv, o0[4 * g + 3] * inv);
        w1.x = pk2(o1[4 * g] * inv, o1[4 * g + 1] * inv); w1.y = pk2(o1[4 * g + 2] * inv, o1[4 * g + 3] * inv);
        *(u32x2*)(op + 8 * g) = w0; *(u32x2*)(op + 32 + 8 * g) = w1; }
}
__device__ __forceinline__ void fox_knorm(int gw, int ngw, int lane, const bf16_t* KF, float* KNRM) {
    for (int it = gw; it < 16 * 256; it += ngw) { const int bh = it >> 8, j = it & 255, b = bh >> 3, h = bh & 7;
        const u32x4* kp = (const u32x4*)(KF + ((size_t)b * S + 64 * j + lane) * 512 + h * 64); float n2 = 0.f;
#pragma unroll
        for (int c = 0; c < 8; ++c) { const u32x4 v = kp[c]; const unsigned ww[4] = {v.x, v.y, v.z, v.w};
#pragma unroll
            for (int e = 0; e < 4; ++e) { const float a = bflo(ww[e]), bb = bfhi(ww[e]); n2 += a * a + bb * bb; } }
#pragma unroll
        for (int o = 1; o < 64; o <<= 1) n2 = fmaxf(n2, __shfl_xor(n2, o));
        if (lane == 0) KNRM[it] = sqrtf(n2); }
}

constexpr int RT_KZP = 144;
constexpr int RT_QP = 528;
constexpr int RT_OFF_KZ = 0, RT_OFF_Q = 256 * RT_KZP, RT_OFF_K = RT_OFF_Q + 64 * RT_QP, RT_OFF_P = RT_OFF_K + 64 * RT_QP, RT_OFF_SS = RT_OFF_P + 64 * RT_KZP, RT_OFF_OT = RT_OFF_SS + 64 * 8 * 4, RT_LDS = RT_OFF_OT + 64 * 272;
static_assert(RT_LDS <= 147456 - 256, "retention LDS");

__device__ __forceinline__ void ret_local(int wave_, LAS unsigned char* L, const bf16_t* KZT, const bf16_t* VT, f32x4* Lout, int u) {
    const int tid = wave_ * 64 + lane_id_opaque();
    const int lane = tid & 63, w = __builtin_amdgcn_readfirstlane(tid >> 6), l15 = lane & 15, g = lane >> 4;
    const int h = u >> 6, seg = (u >> 2) & 15, eb = u & 3, E0 = eb * 128 + w * 16;
    const float gc = __builtin_exp2f(64.0f * log2_gamma(h));
    f32x4 st[16];
#pragma unroll
    for (int i = 0; i < 16; ++i) st[i] = (f32x4){0.f, 0.f, 0.f, 0.f};
    u32x4 kz[4];
    const bf16_t* kzb = KZT + (size_t)(h * 256 + seg * SEGC) * 256 * 64;
#define R1_LOAD(ci) do { _Pragma("unroll") for (int i = 0; i < 4; ++i) kz[i] = *(const u32x4*)(kzb + (size_t)(ci) * 16384 + (size_t)(tid + 512 * i) * 8); } while (0)
#define R1_WRITE() do { _Pragma("unroll") for (int i = 0; i < 4; ++i) { const int id = tid + 512 * i; *(LAS u32x4*)(L + RT_OFF_KZ + (id >> 3) * RT_KZP + (id & 7) * 16) = kz[i]; } } while (0)
    R1_LOAD(0);
    for (int ci = 0; ci < SEGC; ++ci) {
        R1_WRITE(); __syncthreads();
        if (ci + 1 < SEGC) R1_LOAD(ci + 1);
        const bf16_t* vp = VT + ((size_t)(h * 256 + seg * SEGC + ci) * 512 + E0 + l15) * 64 + 8 * g;
        const bf16x8 vf0 = *(const bf16x8*)vp, vf1 = *(const bf16x8*)(vp + 32);
        if (ci > 0) {
#pragma unroll
            for (int i = 0; i < 16; ++i) st[i] *= gc; }
#pragma unroll
        for (int dt = 0; dt < 16; ++dt) { const LAS unsigned char* ap = L + RT_OFF_KZ + (16 * dt + l15) * RT_KZP + 16 * g;
            st[dt] = __builtin_amdgcn_mfma_f32_16x16x32_bf16(*(const LAS bf16x8*)ap, vf0, st[dt], 0, 0, 0);
            st[dt] = __builtin_amdgcn_mfma_f32_16x16x32_bf16(*(const LAS bf16x8*)(ap + 64), vf1, st[dt], 0, 0, 0); }
        __syncthreads();
    }
#undef R1_LOAD
#undef R1_WRITE
    f32x4* lo = Lout + ((size_t)(u * 8 + w) * 16) * 64 + lane;
#pragma unroll
    for (int dt = 0; dt < 16; ++dt) lo[dt * 64] = st[dt];
}

__device__ __forceinline__ void ret_scan(int wave_, LAS unsigned char* L, const bf16_t* QX, const bf16_t* KN, const bf16_t* KZT, const bf16_t* VT, const f32x4* Lin, bf16_t* O  , float* PO  , int u) {
    const int tid = wave_ * 64 + lane_id_opaque();
    const int lane = tid & 63, w = __builtin_amdgcn_readfirstlane(tid >> 6), l15 = lane & 15, g = lane >> 4;
    const int h = u >> 6, seg = (u >> 2) & 15, eb = u & 3, E0 = eb * 128 + w * 16;
    const float l2g = log2_gamma(h), gc = __builtin_exp2f(64.0f * l2g);
    f32x4 st[16];
#pragma unroll
    for (int i = 0; i < 16; ++i) st[i] = (f32x4){0.f, 0.f, 0.f, 0.f};
    if (seg > 0) { f32x4 la[8], lb[8];
#define R2_LOADL(dst, j, h8) do { const int uj_ = (u & ~(15 << 2)) | ((j) << 2); const f32x4* li_ = Lin + ((size_t)(uj_ * 8 + w) * 16 + 8 * (h8)) * 64 + lane; _Pragma("unroll") for (int dt = 0; dt < 8; ++dt) dst[dt] = li_[dt * 64]; } while (0)
#define R2_ACCL(src, j, h8) do { const float wj_ = __builtin_exp2f((float)(64 * SEGC * (seg - 1 - (j))) * l2g); _Pragma("unroll") for (int dt = 0; dt < 8; ++dt) st[8 * (h8) + dt] += src[dt] * wj_; } while (0)
        R2_LOADL(la, 0, 0); R2_LOADL(lb, 0, 1);
        for (int j = 0; j < seg; ++j) {
            R2_ACCL(la, j, 0); if (j + 1 < seg) R2_LOADL(la, j + 1, 0);
            R2_ACCL(lb, j, 1); if (j + 1 < seg) R2_LOADL(lb, j + 1, 1);
        }
#undef R2_LOADL
#undef R2_ACCL
    }
    u32x4 kz[4], qx[4], kn[4];
    const bf16_t* kzb = KZT + (size_t)(h * 256 + seg * SEGC) * 256 * 64;
    const bf16_t* qb = QX + (size_t)(seg * SEGC * 64) * 1024 + h * 256; const bf16_t* kb = KN + (size_t)(seg * SEGC * 64) * 1024 + h * 256;
#define R2_LOADKZ(ci) do { _Pragma("unroll") for (int i = 0; i < 4; ++i) { const int id = tid + 512 * i; kz[i] = *(const u32x4*)(kzb + (size_t)(ci) * 16384 + (size_t)id * 8); } } while (0)
#define R2_LOADQK(ci) do { _Pragma("unroll") for (int i = 0; i < 4; ++i) { const int id = tid + 512 * i; \
        qx[i] = *(const u32x4*)(qb + (size_t)((ci) * 64 + (id >> 5)) * 1024 + (id & 31) * 8); kn[i] = *(const u32x4*)(kb + (size_t)((ci) * 64 + (id >> 5)) * 1024 + (id & 31) * 8); } } while (0)
#define R2_WRITE() do { _Pragma("unroll") for (int i = 0; i < 4; ++i) { const int id = tid + 512 * i; *(LAS u32x4*)(L + RT_OFF_KZ + (id >> 3) * RT_KZP + (id & 7) * 16) = kz[i]; \
        *(LAS u32x4*)(L + RT_OFF_Q + (id >> 5) * RT_QP + (id & 31) * 16) = qx[i]; *(LAS u32x4*)(L + RT_OFF_K + (id >> 5) * RT_QP + (id & 31) * 16) = kn[i]; } } while (0)
    R2_LOADKZ(0); R2_LOADQK(0);
    const int tr = w >> 1;
    const bf16_t* vp0 = VT + ((size_t)(h * 256 + seg * SEGC) * 512 + E0 + l15) * 64 + 8 * g;
    bf16x8 vn0 = *(const bf16x8*)vp0, vn1 = *(const bf16x8*)(vp0 + 32);
    for (int ci = 0; ci < SEGC; ++ci) {
        R2_WRITE(); __syncthreads();
        const bf16x8 vf0 = vn0, vf1 = vn1;
        if (ci + 1 < SEGC) { R2_LOADKZ(ci + 1); R2_LOADQK(ci + 1); vn0 = *(const bf16x8*)(vp0 + (size_t)(ci + 1) * 32768); vn1 = *(const bf16x8*)(vp0 + (size_t)(ci + 1) * 32768 + 32); }
        const int chunk = seg * SEGC + ci;
#pragma unroll
        for (int t2 = 0; t2 < 2; ++t2) { const int tc = 2 * (w & 1) + t2; f32x4 pa = {0.f, 0.f, 0.f, 0.f};
            if (tc <= tr) {
#pragma unroll
                for (int ks = 0; ks < 8; ++ks) pa = __builtin_amdgcn_mfma_f32_16x16x32_bf16(*(const LAS bf16x8*)(L + RT_OFF_Q + (16 * tr + l15) * RT_QP + 64 * ks + 16 * g),
                                                                                           *(const LAS bf16x8*)(L + RT_OFF_K + (16 * tc + l15) * RT_QP + 64 * ks + 16 * g), pa, 0, 0, 0);
                const int cp = 16 * tc + l15; const float dk = __builtin_exp2f(-(float)(cp + 1) * l2g);
#pragma unroll
                for (int r = 0; r < 4; ++r) { const int c = 16 * tr + 4 * g + r; pa[r] = (c >= cp) ? pa[r] * dk : 0.f; } }
#pragma unroll
            for (int r = 0; r < 4; ++r) *(LAS bf16_t*)(L + RT_OFF_P + (16 * tr + 4 * g + r) * RT_KZP + (16 * tc + l15) * 2) = (bf16_t)f2bf(pa[r]); }
        __syncthreads();
        f32x4 oa[4];
#pragma unroll
        for (int mt = 0; mt < 4; ++mt) oa[mt] = (f32x4){0.f, 0.f, 0.f, 0.f};
#pragma unroll
        for (int ks = 0; ks < 8; ++ks) { const bf16x8 sbk = __builtin_bit_cast(bf16x8, (u32x4){pk2(st[2 * ks][0], st[2 * ks][1]), pk2(st[2 * ks][2], st[2 * ks][3]), pk2(st[2 * ks + 1][0], st[2 * ks + 1][1]), pk2(st[2 * ks + 1][2], st[2 * ks + 1][3])});
#pragma unroll
            for (int mt = 0; mt < 4; ++mt) oa[mt] = __builtin_amdgcn_mfma_f32_16x16x32_bf16(*(const LAS bf16x8*)(L + RT_OFF_Q + (16 * mt + l15) * RT_QP + 64 * ks + 16 * g), sbk, oa[mt], 0, 0, 0); }
#pragma unroll
        for (int mt = 0; mt < 4; ++mt) {
            oa[mt] = __builtin_amdgcn_mfma_f32_16x16x32_bf16(*(const LAS bf16x8*)(L + RT_OFF_P + (16 * mt + l15) * RT_KZP + 16 * g), vf0, oa[mt], 0, 0, 0);
            oa[mt] = __builtin_amdgcn_mfma_f32_16x16x32_bf16(*(const LAS bf16x8*)(L + RT_OFF_P + (16 * mt + l15) * RT_KZP + 64 + 16 * g), vf1, oa[mt], 0, 0, 0); }
#pragma unroll
        for (int i = 0; i < 16; ++i) st[i] *= gc;
#pragma unroll
        for (int dt = 0; dt < 16; ++dt) { const LAS unsigned char* ap = L + RT_OFF_KZ + (16 * dt + l15) * RT_KZP + 16 * g;
            st[dt] = __builtin_amdgcn_mfma_f32_16x16x32_bf16(*(const LAS bf16x8*)ap, vf0, st[dt], 0, 0, 0);
            st[dt] = __builtin_amdgcn_mfma_f32_16x16x32_bf16(*(const LAS bf16x8*)(ap + 64), vf1, st[dt], 0, 0, 0); }
#pragma unroll
        for (int mt = 0; mt < 4; ++mt) {
#pragma unroll
            for (int r = 0; r < 4; ++r) { const int c = 16 * mt + 4 * g + r; *(LAS bf16_t*)(L + RT_OFF_OT + c * 272 + (16 * w + l15) * 2) = (bf16_t)f2bf(oa[mt][r]); } }
        __syncthreads();
#pragma unroll
        for (int i = 0; i < 2; ++i) { const int id = tid + 512 * i, row = id >> 4, ch = id & 15;
            const u32x4 v = *(const LAS u32x4*)(L + RT_OFF_OT + row * 272 + ch * 16);
            *(u32x4*)(O + (size_t)(chunk * 64 + row) * LDO + h * 512 + eb * 128 + ch * 8) = v;
            const float e0 = bflo(v.x), e1 = bfhi(v.x), e2 = bflo(v.y), e3 = bfhi(v.y), e4 = bflo(v.z), e5 = bfhi(v.z), e6 = bflo(v.w), e7 = bfhi(v.w);
            float ss = ((e0 * e0 + e1 * e1) + (e2 * e2 + e3 * e3)) + ((e4 * e4 + e5 * e5) + (e6 * e6 + e7 * e7));
            ss += __shfl_xor(ss, 1); ss += __shfl_xor(ss, 2); ss += __shfl_xor(ss, 4); ss += __shfl_xor(ss, 8);
            if (ch == 0) PO[(size_t)(chunk * 64 + row) * 16 + h * 4 + eb] = ss; }
    }
#undef R2_LOADKZ
#undef R2_LOADQK
#undef R2_WRITE
}

struct Ctx { int wave, vcu, G, gw, ngw; LAS unsigned char* lds; };
#define CTX_LANE const int lane_ = lane_id_opaque(), tid_ = C.wave * 64 + lane_

__device__ __forceinline__ void tr_item(const float* W, int ldw, int k0, int n0, int nvalid, const float* gain, bf16_t* dst, int ldd, LAS float* scr, int lane) {
    float vv[32]; const int nn_ = lane & 31, kh_ = lane >> 5;
#pragma unroll
    for (int i = 0; i < 32; ++i) vv[i] = (nn_ < nvalid) ? W[(size_t)(k0 + 2 * i + kh_) * ldw + n0 + nn_] : 0.f;
    if (gain) {
#pragma unroll
        for (int i = 0; i < 32; ++i) vv[i] *= gain[k0 + 2 * i + kh_]; }
#pragma unroll
    for (int i = 0; i < 32; ++i) scr[(2 * i + kh_) * 33 + nn_] = vv[i];
    asm volatile("s_waitcnt lgkmcnt(0)" ::: "memory");
    const int c = lane & 7;
#pragma unroll
    for (int j = 0; j < 4; ++j) { const int n = (lane >> 3) + 8 * j; const LAS float* s = scr + (8 * c) * 33 + n;
        u32x4 o; o.x = pk2(s[0], s[33]); o.y = pk2(s[2 * 33], s[3 * 33]); o.z = pk2(s[4 * 33], s[5 * 33]); o.w = pk2(s[6 * 33], s[7 * 33]);
        if (n < nvalid) *(u32x4*)(dst + (size_t)n * ldd + 8 * c) = o; }
    asm volatile("s_waitcnt lgkmcnt(0)" ::: "memory");
}
__device__ __forceinline__ void zero_rows(const Ctx& C, bf16_t* base, size_t pitch_el, int nrows, int col0, int ncol) {
    CTX_LANE;
    const int per = ncol / 8; const long n = (long)nrows * per;
    for (long i = (long)C.gw * 64 + lane_; i < n; i += (long)C.ngw * 64) { const long r = i / per; const int c = (int)(i % per); *(u32x4*)(base + (size_t)r * pitch_el + col0 + c * 8) = (u32x4){0u, 0u, 0u, 0u}; }
}
__device__ __forceinline__ void convert_moe(const Ctx& C, const Params&, int layer) {
    CTX_LANE;
    WS_OPAQUE;
    LAS float* scr = (LAS float*)(C.lds + C.wave * 16384);
    bf16_t* GU = WSP(bf16_t, OFF_WGU); bf16_t* DN = WSP(bf16_t, OFF_WDN); const float* gain = P.in[I_LN_FFN] + layer * 1024;
    for (int it = C.gw; it < 32 * 768; it += C.ngw) { const int e = it / 768, r = it % 768;
        if (r < 512) { const int up = r >> 8, rr = r & 255, kb = rr >> 4, nb = rr & 15, n0 = 32 * nb; const float* W = (up ? P.in[I_W_UP] : P.in[I_W_GATE]) + (size_t)(layer * 32 + e) * 1024 * 512;
            const int drow = 256 * (n0 >> 7) + (n0 & 127) + up * 128;
            tr_item(W, 512, 64 * kb, n0, 32, gain, GU + ((size_t)(e * 1024 + drow) * 1024 + 64 * kb), 1024, scr, lane_); }
        else { const int rr = r - 512, kb = rr >> 5, nb = rr & 31; const float* W = P.in[I_W_DOWN] + (size_t)(layer * 32 + e) * 512 * 1024;
            tr_item(W, 1024, 64 * kb, 32 * nb, 32, nullptr, DN + ((size_t)(e * 1024 + 32 * nb) * 512 + 64 * kb), 512, scr, lane_); } }
}
__device__ __forceinline__ void convert_mixer(const Ctx& C, const Params&) {
    CTX_LANE;
    WS_OPAQUE;
    LAS float* scr = (LAS float*)(C.lds + C.wave * 16384);
    bf16_t* WA1 = WSP(bf16_t, W_A1); bf16_t* WA1V = WSP(bf16_t, W_A1V); bf16_t* WA2 = WSP(bf16_t, W_A2); bf16_t* WA2V = WSP(bf16_t, W_A2V);
    bf16_t* WOE = WSP(bf16_t, W_OE); bf16_t* WB1 = WSP(bf16_t, W_B1); bf16_t* WOO = WSP(bf16_t, W_OO);
    constexpr int N1 = 16 * 62, N2 = 4 * 24, N3 = 2 * 32, N4 = 16 * 32, N5 = 16 * 192, N6 = 32 * 32, NT_ = N1 + N2 + N3 + N4 + N5 + N6;
    for (int it = C.gw; it < NT_; it += C.ngw) { int r = it;
        if (r < N1) { const int kb = r / 62, nb = r % 62, n0 = 32 * nb, k0 = 64 * kb; bf16_t* dst; int nv = 32;
            if (n0 < 416) dst = WA1 + (size_t)n0 * 1024; else if (n0 < 928) dst = WA1 + (size_t)(512 + n0 - 416) * 1024; else if (n0 < 1440) dst = WA1 + (size_t)(1024 + n0 - 928) * 1024;
            else if (n0 < 1952) dst = WA1V + (size_t)(n0 - 1440) * 1024; else { dst = WA1 + (size_t)416 * 1024; nv = 8; }
            tr_item(P.in[I_W_IN_E], 1960, k0, n0, nv, P.in[I_LN_MIX_E], dst + k0, 1024, scr, lane_); continue; } r -= N1;
        if (r < N2) { const int kb = r / 24, nb = r % 24, n0 = 32 * nb, hh = n0 / 96, off = n0 % 96;
            tr_item(P.in[I_W_UQ], 768, 64 * kb, n0, 32, P.in[I_LN_Q], WA2 + (size_t)(128 * hh + off) * 256 + 64 * kb, 256, scr, lane_); continue; } r -= N2;
        if (r < N3) { const int kb = r / 32, nb = r % 32, n0 = 32 * nb, hh = n0 / 128, off = n0 % 128;
            bf16_t* dst = off < 64 ? WA2 + (size_t)(1024 + 64 * hh + off) * 256 : WA2V + (size_t)(64 * hh + off - 64) * 256;
            tr_item(P.in[I_W_UKV], 1024, 64 * kb, n0, 32, P.in[I_LN_KV], dst + 64 * kb, 256, scr, lane_); continue; } r -= N3;
        if (r < N4) { const int kb = r / 32, nb = r % 32; tr_item(P.in[I_W_OUT_E], 1024, 64 * kb, 32 * nb, 32, nullptr, WOE + (size_t)(32 * nb) * 1024 + 64 * kb, 1024, scr, lane_); continue; } r -= N4;
        if (r < N5) { const int kb = r / 192, nb = r % 192; tr_item(P.in[I_W_IN_O], 6144, 64 * kb, 32 * nb, 32, P.in[I_LN_MIX_O], WB1 + (size_t)(32 * nb) * 1024 + 64 * kb, 1024, scr, lane_); continue; } r -= N5;
        { const int kb = r / 32, nb = r % 32; tr_item(P.in[I_W_OUT_O], 1024, 64 * kb, 32 * nb, 32, nullptr, WOO + (size_t)(32 * nb) * LDO + 64 * kb, LDO, scr, lane_); } }
    zero_rows(C, WA1 + (size_t)424 * 1024, 1024, 88, 0, 1024);
    for (int hh = 0; hh < 8; ++hh) zero_rows(C, WA2 + (size_t)(128 * hh + 96) * 256, 256, 32, 0, 256);
    zero_rows(C, WA2 + (size_t)1024 * 256, 256, 512, 128, 128);
    zero_rows(C, WA2V, 256, 512, 128, 128);
}
__device__ __forceinline__ void make_rope(const Ctx& C, const Params&) {
    CTX_LANE;
    WS_OPAQUE;
    f32x2* rope = WSP(f32x2, OFF_ROPE);
    for (int i = C.gw * 64 + lane_; i < S * 128; i += C.ngw * 64) { const int pos = i >> 7, k = i & 127; const float inv = __builtin_exp2f(-(float)k * (13.287712379549449f / 128.0f));
        const float ang = (float)pos * inv; const double a = (double)ang; rope[i] = (f32x2){(float)cos(a), (float)sin(a)}; }
}
__device__ __forceinline__ void rows_to_bf16(const Ctx& C, const float* X, bf16_t* XB, float* RS) {
    CTX_LANE;
    for (int r0 = C.gw; r0 < T; r0 += 4 * C.ngw) { f32x4 v[4][4];
#pragma unroll
        for (int q = 0; q < 4; ++q) { const int r = r0 + q * C.ngw; const f32x4* xr = (const f32x4*)(X + (size_t)(r < T ? r : r0) * D) + lane_;
#pragma unroll
            for (int j = 0; j < 4; ++j) v[q][j] = xr[64 * j]; }
#pragma unroll
        for (int q = 0; q < 4; ++q) { const int r = r0 + q * C.ngw; if (r >= T) break; float s = 0.f;
#pragma unroll
            for (int j = 0; j < 4; ++j) s += (v[q][j][0] * v[q][j][0] + v[q][j][1] * v[q][j][1]) + (v[q][j][2] * v[q][j][2] + v[q][j][3] * v[q][j][3]);
            s = wave_sum(s); u32x2* o = (u32x2*)(XB + (size_t)r * D) + lane_;
#pragma unroll
            for (int j = 0; j < 4; ++j) o[64 * j] = (u32x2){pk2(v[q][j][0], v[q][j][1]), pk2(v[q][j][2], v[q][j][3])};
            if (lane_ == 0) RS[r] = rsqrt_f(s * (1.0f / D) + EPS); } }
}
__device__ __forceinline__ void fox_cumsum(const Ctx& C, const float* LF, float* CUM, int bh) {
    CTX_LANE;
    LAS float* tot = (LAS float*)C.lds; const int b = bh >> 3, h = bh & 7; float v[32]; float run = 0.f;
#pragma unroll
    for (int i = 0; i < 32; ++i) { run += LF[((size_t)b * S + tid_ * 32 + i) * 8 + h]; v[i] = run; }
    tot[tid_] = run; __syncthreads();
    float off = 0.f; for (int t2 = 0; t2 < tid_; ++t2) off += tot[t2];
#pragma unroll
    for (int i = 0; i < 32; ++i) CUM[(size_t)bh * S + tid_ * 32 + i] = (off + v[i]) * LOG2E;
    __syncthreads();
}
__device__ __forceinline__ void moe_router(const Ctx& C, const Params&, int layer, int blk, const bf16_t* XSRC) {
    CTX_LANE;
    WS_OPAQUE;
    float* RS1 = WSP(float, SM_RS1);
    int* EID = WSP(int, SM_EID); float* GATE = WSP(float, SM_GATE); int* RANK = WSP(int, SM_RANK); int* CNT = WSP(int, SM_CNT);
    const float* wrg = P.in[I_W_RG] + (size_t)layer * 1024 * 4; const float* wre = P.in[I_W_RE] + (size_t)layer * 1024 * 32; const float* lnf = P.in[I_LN_FFN] + layer * 1024;
    LAS float* lg = (LAS float*)C.lds;
    LAS float* rsl = (LAS float*)(C.lds + 128 * 40 * 4);
    LAS int* eidl = (LAS int*)(C.lds + 128 * 40 * 4 + 512);
    LAS float* slab = (LAS float*)(C.lds + 32768);
    const int l15 = lane_ & 15, kg = lane_ >> 4, kbase = 128 * C.wave + 8 * kg;
    bf16x8 bh[3][4], bl[3][4];
#pragma unroll
    for (int nt = 0; nt < 3; ++nt) { const int col = 16 * nt + l15; const int cc = col < 36 ? col : 35; const float* wp = cc < 4 ? wrg + cc : wre + (cc - 4); const int wst = cc < 4 ? 4 : 32; const float wz = col < 36 ? 1.f : 0.f;
#pragma unroll
        for (int ks = 0; ks < 4; ++ks) { float wf[8]; unsigned hp[4], lp[4];
#pragma unroll
            for (int j = 0; j < 8; ++j) { const int k = kbase + 32 * ks + j; wf[j] = lnf[k] * wp[(size_t)k * wst] * wz; }
#pragma unroll
            for (int j = 0; j < 4; ++j) { hp[j] = pk2(wf[2 * j], wf[2 * j + 1]); lp[j] = pk2(wf[2 * j] - bflo(hp[j]), wf[2 * j + 1] - bfhi(hp[j])); }
            bh[nt][ks] = __builtin_bit_cast(bf16x8, (u32x4){hp[0], hp[1], hp[2], hp[3]}); bl[nt][ks] = __builtin_bit_cast(bf16x8, (u32x4){lp[0], lp[1], lp[2], lp[3]}); } }
    u32x4 xa[4], xb[4];
#define RT_LOADX(dst, mt) do { const bf16_t* xp = XSRC + (size_t)(blk * 128 + 16 * (mt) + l15) * D + kbase; _Pragma("unroll") for (int ks = 0; ks < 4; ++ks) dst[ks] = *(const u32x4*)(xp + 32 * ks); } while (0)
#define RT_TILE(src, mt) do { f32x4 acc[3] = {{0.f, 0.f, 0.f, 0.f}, {0.f, 0.f, 0.f, 0.f}, {0.f, 0.f, 0.f, 0.f}}; float ss = 0.f; \
        _Pragma("unroll") for (int ks = 0; ks < 4; ++ks) { const u32x4 v = src[ks]; \
            const float e0 = bflo(v.x), e1 = bfhi(v.x), e2 = bflo(v.y), e3 = bfhi(v.y), e4 = bflo(v.z), e5 = bfhi(v.z), e6 = bflo(v.w), e7 = bfhi(v.w); \
            ss += ((e0 * e0 + e1 * e1) + (e2 * e2 + e3 * e3)) + ((e4 * e4 + e5 * e5) + (e6 * e6 + e7 * e7)); \
            const bf16x8 ah = __builtin_bit_cast(bf16x8, v); \
            _Pragma("unroll") for (int nt = 0; nt < 3; ++nt) { acc[nt] = __builtin_amdgcn_mfma_f32_16x16x32_bf16(ah, bh[nt][ks], acc[nt], 0, 0, 0); acc[nt] = __builtin_amdgcn_mfma_f32_16x16x32_bf16(ah, bl[nt][ks], acc[nt], 0, 0, 0); } } \
        ss += __shfl_xor(ss, 16); ss += __shfl_xor(ss, 32); \
        LAS float* sl = slab + (size_t)(C.wave * 64 + 16 * ((mt) & 3)) * 40; \
        _Pragma("unroll") for (int nt = 0; nt < 3; ++nt) { const int col = 16 * nt + l15; if (col < 36) { _Pragma("unroll") for (int r = 0; r < 4; ++r) sl[(4 * kg + r) * 40 + col] = acc[nt][r]; } } \
        if (kg == 0) sl[l15 * 40 + 36] = ss; } while (0)
    RT_LOADX(xa, 0);
    for (int half = 0; half < 2; ++half) {
        RT_LOADX(xb, 4 * half + 1); RT_TILE(xa, 4 * half + 0);
        RT_LOADX(xa, 4 * half + 2); RT_TILE(xb, 4 * half + 1);
        RT_LOADX(xb, 4 * half + 3); RT_TILE(xa, 4 * half + 2);
        if (half == 0) RT_LOADX(xa, 4); RT_TILE(xb, 4 * half + 3);
        __syncthreads();
        for (int it = tid_; it < 64 * 37; it += 512) { const int tt = it / 37, c = it % 37; float sm = 0.f;
#pragma unroll
            for (int w8 = 0; w8 < 8; ++w8) sm += slab[(size_t)(w8 * 64 + tt) * 40 + c];
            lg[(half * 64 + tt) * 40 + c] = sm; }
        __syncthreads();
    }
#undef RT_LOADX
#undef RT_TILE
    if (tid_ < 128) { const float rs = rsqrt_f(lg[tid_ * 40 + 36] * (1.0f / D) + EPS); rsl[tid_] = rs; RS1[blk * 128 + tid_] = rs; }
    __syncthreads();
    if (tid_ < 128) { const int tt = tid_, t = blk * 128 + tt; const float rs = rsl[tt]; const float* brg = P.in[I_B_RG] + layer * 4; const float* bre = P.in[I_B_RE] + layer * 32;
        float gl[4]; int gs = 0;
#pragma unroll
        for (int o = 0; o < 4; ++o) { gl[o] = lg[tt * 40 + o] * rs + brg[o]; if (gl[o] > gl[gs]) gs = o; }
        float gsum = 0.f;
#pragma unroll
        for (int o = 0; o < 4; ++o) gsum += __expf(gl[o] - gl[gs]);
        const float pg = 1.0f / gsum;
        float el[8]; int j1 = 0;
#pragma unroll
        for (int j = 0; j < 8; ++j) { el[j] = lg[tt * 40 + 4 + 8 * gs + j] * rs + bre[8 * gs + j]; if (el[j] > el[j1]) j1 = j; }
        int j2 = (j1 == 0) ? 1 : 0;
#pragma unroll
        for (int j = 0; j < 8; ++j) if (j != j1 && el[j] > el[j2]) j2 = j;
        const float e2 = __expf(el[j2] - el[j1]), den = 1.0f / (1.0f + e2);
        const int ea = 8 * gs + j1, eb = 8 * gs + j2;
        EID[t * 2] = ea; EID[t * 2 + 1] = eb; GATE[t * 2] = pg * den; GATE[t * 2 + 1] = pg * e2 * den; eidl[2 * tt] = ea; eidl[2 * tt + 1] = eb; }
    __syncthreads();
    if (tid_ < 256) { const int me = eidl[tid_]; int rk = 0; for (int a = 0; a < tid_; ++a) rk += (eidl[a] == me) ? 1 : 0; RANK[blk * 256 + tid_] = rk; }
    if (tid_ < 32) { int c = 0; for (int a = 0; a < 256; ++a) c += (eidl[a] == tid_) ? 1 : 0; CNT[blk * 32 + tid_] = c; }
    __syncthreads();
}
__device__ __forceinline__ void moe_scatter(const Ctx& C, const Params&, int blk, const bf16_t* XB) {
    CTX_LANE;
    WS_OPAQUE;
    const int* CNT = WSP(int, SM_CNT); const int* EID = WSP(int, SM_EID); const float* GATE = WSP(float, SM_GATE); const int* RANK = WSP(int, SM_RANK); const float* RS1 = WSP(float, SM_RS1);
    int* TSLOT = WSP(int, SM_TSLOT); int* STOK = WSP(int, SM_STOK); float* SW = WSP(float, SM_SW); float* SR = WSP(float, SM_SR); int* TILEE = WSP(int, SM_TILEE);
    bf16_t* XS = WSP(bf16_t, A_XS);
    LAS int* part = (LAS int*)C.lds;
    LAS int* tot = part + 1024;
    LAS int* slotl = tot + 128;
    { const int e = tid_ & 31, pt = tid_ >> 5; int s = 0, pre = 0;
        for (int b = pt * 16; b < pt * 16 + 16; ++b) { const int c = ld_i(CNT + b * 32 + e); s += c; if (b < blk) pre += c; }
        part[pt * 32 + e] = s; part[512 + pt * 32 + e] = pre; }
    __syncthreads();
    if (tid_ < 32) { int s = 0, pre = 0; for (int pt = 0; pt < 16; ++pt) { s += part[pt * 32 + tid_]; pre += part[512 + pt * 32 + tid_]; } tot[tid_] = s; tot[32 + tid_] = pre; }
    __syncthreads();
    if (tid_ == 0) { int ps = 0; for (int e = 0; e < 32; ++e) { tot[64 + e] = ps; ps += (tot[e] + 255) & ~255; } tot[96] = ps; }
    __syncthreads();
    if (tid_ < 256) { const int a = blk * 256 + tid_, t = a >> 1, e = EID[a]; const int slot = tot[64 + e] + tot[32 + e] + RANK[a];
        slotl[tid_] = slot; TSLOT[a] = slot; STOK[slot] = t; SW[slot] = GATE[a]; SR[slot] = RS1[t]; }
    __syncthreads();
    for (int i0 = C.wave * 32; i0 < C.wave * 32 + 32; i0 += 8) { u32x4 ra[8], rb[8];
#pragma unroll
        for (int q = 0; q < 8; ++q) { const int t = (blk * 256 + i0 + q) >> 1; const u32x4* sp = (const u32x4*)(XB + (size_t)t * D) + lane_; ra[q] = sp[0]; rb[q] = sp[64]; }
#pragma unroll
        for (int q = 0; q < 8; ++q) { const int slot = slotl[i0 + q]; u32x4* d = (u32x4*)(XS + (size_t)slot * D) + lane_; d[0] = ra[q]; d[64] = rb[q]; } }
    if (blk < 32) { const int e = blk, beg = tot[64 + e] + tot[e], end = tot[64 + e] + ((tot[e] + 255) & ~255);
        for (int sl = beg + C.wave; sl < end; sl += 8) { u32x4* d = (u32x4*)(XS + (size_t)sl * D) + lane_; d[0] = (u32x4){0u, 0u, 0u, 0u}; d[64] = (u32x4){0u, 0u, 0u, 0u}; if (lane_ == 0) { STOK[sl] = -1; SW[sl] = 0.f; SR[sl] = 0.f; } } }
    if (blk == 0 && tid_ < 32) { const int e = tid_, t0 = tot[64 + e] >> 8, nt = ((tot[e] + 255) & ~255) >> 8; for (int i = 0; i < nt; ++i) TILEE[t0 + i] = e; if (e == 0) TILEE[300] = tot[96] >> 8; }
    __syncthreads();
}
template <int MODE> __device__ __forceinline__ void moe_combine(const Ctx& C, const Params&, const bf16_t* XSRC, float* RS, const float* gainf) {
    CTX_LANE;
    WS_OPAQUE;
    float* OUT = P.out; bf16_t* XB = WSP(bf16_t, OFF_XB); const bf16_t* YS = WSP(bf16_t, A_XS); const int* TSLOT = WSP(int, SM_TSLOT);
    for (int t0 = C.gw; t0 < T; t0 += 2 * C.ngw) { u32x2 xv[2][4], ya[2][4], yb[2][4];
#pragma unroll
        for (int q = 0; q < 2; ++q) { const int t = t0 + q * C.ngw; const int sa = ld_i(TSLOT + 2 * t), sb = ld_i(TSLOT + 2 * t + 1); const u32x2* xr = (const u32x2*)(XSRC + (size_t)t * D) + lane_;
            const u32x2* pa = (const u32x2*)(YS + (size_t)sa * D) + lane_; const u32x2* pb = (const u32x2*)(YS + (size_t)sb * D) + lane_;
#pragma unroll
            for (int j = 0; j < 4; ++j) { xv[q][j] = xr[64 * j]; ya[q][j] = pa[64 * j]; yb[q][j] = pb[64 * j]; } }
#pragma unroll
        for (int q = 0; q < 2; ++q) { const int t = t0 + q * C.ngw; f32x4 v[4]; float s = 0.f;
#pragma unroll
            for (int j = 0; j < 4; ++j) { const u32x2 x2 = xv[q][j], a = ya[q][j], b = yb[q][j];
                v[j][0] = bflo(x2.x) + (bflo(a.x) + bflo(b.x)); v[j][1] = bfhi(x2.x) + (bfhi(a.x) + bfhi(b.x)); v[j][2] = bflo(x2.y) + (bflo(a.y) + bflo(b.y)); v[j][3] = bfhi(x2.y) + (bfhi(a.y) + bfhi(b.y));
                s += (v[j][0] * v[j][0] + v[j][1] * v[j][1]) + (v[j][2] * v[j][2] + v[j][3] * v[j][3]); }
            s = wave_sum(s); const float rs = rsqrt_f(s * (1.0f / D) + EPS);
            if (MODE == 0) { u32x2* o = (u32x2*)(XB + (size_t)t * D) + lane_;
#pragma unroll
                for (int j = 0; j < 4; ++j) o[64 * j] = (u32x2){pk2(v[j][0], v[j][1]), pk2(v[j][2], v[j][3])};
                if (lane_ == 0) RS[t] = rs; }
            else { const f32x4* gr = (const f32x4*)gainf + lane_; f32x4* xo = (f32x4*)(OUT + (size_t)t * D) + lane_;
#pragma unroll
                for (int j = 0; j < 4; ++j) xo[64 * j] = v[j] * rs * gr[64 * j]; } } }
}

constexpr int LDS_BYTES = 147456;
constexpr int LDS_MISC = LDS_BYTES - 256;
constexpr int NPHASE = 23;

__global__ void __launch_bounds__(512, 2) fwd_kernel(Params Pkern) {
    extern __shared__ __attribute__((aligned(16))) unsigned char lds_raw[];
    LAS unsigned char* lds = (LAS unsigned char*)lds_raw;
    Ctx C; { const int t0_ = threadIdx.x; C.wave = __builtin_amdgcn_readfirstlane(t0_ >> 6); } C.G = gridDim.x;
    C.vcu = (C.G % 8 == 0) ? ((int)blockIdx.x % 8) * (C.G / 8) + (int)blockIdx.x / 8 : (int)blockIdx.x;
    C.gw = C.vcu * 8 + C.wave; C.ngw = C.G * 8; C.lds = lds;
    const int bx = blockIdx.x;
    { const int l0 = lane_id_opaque(); if (C.wave == 0) ((LAS unsigned*)(lds + LDS_MISC))[l0] = 0u; }
    __syncthreads();
    const unsigned xcc = xb_xcc_id();
    if (Pkern.use_bar) { const bool t0 = (C.wave == 0) && (lane_id_opaque() == 0); (void)xcd_barrier_post((unsigned*)(Pkern.ws + OFF_CTL) + 4096, (volatile LAS unsigned*)(lds + LDS_MISC), t0); }
    const int lo = Pkern.ph_lo, hi = Pkern.ph_hi;
    const Params& P = Pkern;
#ifndef PH_MASK
#define PH_MASK 0x7fffffu
#endif
#define IN(k) ((((unsigned)PH_MASK >> (k)) & 1u) && lo <= (k) && (k) < hi)
#ifndef PROBE_MASK
#define PROBE_MASK 0u
#endif
#ifdef PROBE_T
#define STAMP(i) do { if (bx == 0 && C.wave == 0 && lane_id_opaque() == 0) ((volatile LAS unsigned long long*)(lds + LDS_MISC + 64))[(i)] = __builtin_amdgcn_s_memrealtime(); } while (0)
#else
#define STAMP(i) do { } while (0)
#endif
#define REP(k) for (int rep_ = 0; rep_ < ((((unsigned)PROBE_MASK >> (k)) & 1u) ? 2 : 1); ++rep_)
#define SEAM(k) do { if (IN(k) && IN((k) + 1)) { P_OPAQUE; XcdBarrier bar; bar.bar = (unsigned*)(P.ws + OFF_CTL) + 4096; bar.x = xcc; bar.st = (volatile LAS unsigned*)(lds + LDS_MISC); \
        const bool t0 = (C.wave == 0) && (lane_id_opaque() == 0); xcd_barrier(bar, t0); } STAMP((k) + 1); } while (0)

    STAMP(0);
    if (IN(0)) REP(0) { WS_OPAQUE; convert_mixer(C, P); convert_moe(C, P, 0); make_rope(C, P); rows_to_bf16(C, P.in[I_X], WSP(bf16_t, OFF_XB), WSP(float, SM_RS0)); __syncthreads(); }
    SEAM(0);
    if (IN(1)) REP(1) {
        { WS_OPAQUE; DenseSched Sd; Sd.init(WSP(bf16_t, OFF_XB), 1024, WSP(bf16_t, W_A1), 1024, 128, 6, C.G, bx);
          EpiA1a E{WSP(float, SM_RS0), WSP(bf16_t, A_Z), WSP(float, SM_PQ), WSP(float, SM_PKV), WSP(bf16_t, A_KA), WSP(float, SM_LF), P.in[I_B_F], WSP(bf16_t, A_QF), WSP(bf16_t, A_KF), WSP(f32x2, OFF_ROPE)};
          pg8::gemm_phase(C.wave, lds, pg8::Dims{1024, 1024, 1024}, Sd, E); }
        { WS_OPAQUE; DenseSched Sd; Sd.init(WSP(bf16_t, W_A1V), 1024, WSP(bf16_t, OFF_XB), 1024, 2, 128, C.G, bx);
          EpiVT<0> E{WSP(float, SM_RS0), WSP(bf16_t, A_VTF), (size_t)T};
          pg8::gemm_phase(C.wave, lds, pg8::Dims{1024, 1024, 1024}, Sd, E); }
    }
    SEAM(1);
    if (IN(2)) REP(2) {
        if (C.vcu < 16) { WS_OPAQUE; fox_cumsum(C, WSP(float, SM_LF), WSP(float, SM_CUM), C.vcu); }
        { WS_OPAQUE; fox_knorm(C.gw, C.ngw, lane_id_opaque(), WSP(bf16_t, A_KF), WSP(float, SM_KNRM)); }
        { WS_OPAQUE; DenseSched Sd; Sd.init(WSP(bf16_t, A_Z), 512, WSP(bf16_t, W_A2), 256, 128, 4, C.G, bx);
          EpiA2q E{WSP(float, SM_PQ), WSP(bf16_t, A_QA), WSP(f32x2, OFF_ROPE)};
          pg8::gemm_phase(C.wave, lds, pg8::Dims{512, 256, 256}, Sd, E); }
        { WS_OPAQUE; DenseSched Sd; Sd.init(WSP(bf16_t, A_Z) + 256, 512, WSP(bf16_t, W_A2) + (size_t)1024 * 256, 256, 128, 2, C.G, bx);
          EpiA2k E{WSP(float, SM_PKV), WSP(bf16_t, A_KA)};
          pg8::gemm_phase(C.wave, lds, pg8::Dims{512, 256, 256}, Sd, E); }
        { WS_OPAQUE; DenseSched Sd; Sd.init(WSP(bf16_t, W_A2V), 256, WSP(bf16_t, A_Z) + 256, 512, 2, 128, C.G, bx);
          EpiVT<1> E{WSP(float, SM_PKV), WSP(bf16_t, A_VTA), (size_t)T};
          pg8::gemm_phase(C.wave, lds, pg8::Dims{256, 512, 256}, Sd, E); }
    }
    SEAM(2);
    if (IN(3)) REP(3) {
        const int bh = C.vcu >> 4, s4 = C.vcu & 15, b = bh >> 3, h = bh & 7;
        REP(23) { WS_OPAQUE; bf16_t* AO = WSP(bf16_t, OFF_XB);
          for (int i = 0; i < 4; ++i) { const int qb = (i == 0) ? s4 : (i == 1) ? 31 - s4 : (i == 2) ? 32 + s4 : 63 - s4;
            attn_unit<96, false>(C.wave, lds, WSP(bf16_t, A_QA) + (size_t)b * S * 768 + h * 96, 768, WSP(bf16_t, A_KA) + (size_t)b * S * 768 + h * 96, 768,
                                 WSP(bf16_t, A_VTA) + ((size_t)h * (T / 64) + (size_t)b * (S / 64)) * 4096, nullptr, nullptr, AO + (size_t)b * S * 1024 + h * 64, 1024, qb); } }
        REP(24) { WS_OPAQUE; bf16_t* AO = WSP(bf16_t, OFF_XB);
          for (int i = 0; i < 4; ++i) { const int qb = (i == 0) ? s4 : (i == 1) ? 31 - s4 : (i == 2) ? 32 + s4 : 63 - s4;
            attn_unit<64, true>(C.wave, lds, WSP(bf16_t, A_QF) + (size_t)b * S * 512 + h * 64, 512, WSP(bf16_t, A_KF) + (size_t)b * S * 512 + h * 64, 512,
                                WSP(bf16_t, A_VTF) + ((size_t)h * (T / 64) + (size_t)b * (S / 64)) * 4096, WSP(float, SM_CUM) + (size_t)bh * S, WSP(float, SM_KNRM) + bh * 256, AO + (size_t)b * S * 1024 + 512 + h * 64, 1024, qb); } }
    }
    SEAM(3);
    if (IN(4)) REP(4) { WS_OPAQUE; DenseSched Sd; Sd.init(WSP(bf16_t, OFF_XB), 1024, WSP(bf16_t, W_OE), 1024, 128, 4, C.G, bx); EpiRes<true> E{P.in[I_X], (bf16_t*)P.out};
        pg8::gemm_phase(C.wave, lds, pg8::Dims{1024, 1024, 1024}, Sd, E); }
    SEAM(4);

#define MOE_PHASES(layer, pb) do { \
        if (IN(pb)) REP(pb) { P_OPAQUE; moe_router(C, P, layer, bx, (layer) ? (const bf16_t*)(P.ws + OFF_XB) : (const bf16_t*)P.out); } \
        SEAM(pb); \
        if (IN((pb) + 1)) REP((pb) + 1) { P_OPAQUE; moe_scatter(C, P, bx, (layer) ? (const bf16_t*)(P.ws + OFF_XB) : (const bf16_t*)P.out); } \
        SEAM((pb) + 1); \
        if (IN((pb) + 2)) REP((pb) + 2) { WS_OPAQUE; MoeSched Sm; Sm.init(WSP(bf16_t, A_XS), 1024, WSP(bf16_t, OFF_WGU), 1024, 1024, WSP(int, SM_TILEE), C.G, bx); EpiM3 E{WSP(float, SM_SR), WSP(bf16_t, A_HID)}; \
            pg8::gemm_phase(C.wave, lds, pg8::Dims{1024, 1024, 1024}, Sm, E); } \
        SEAM((pb) + 2); \
        if (IN((pb) + 3)) REP((pb) + 3) { WS_OPAQUE; MoeSched Sm; Sm.init(WSP(bf16_t, A_HID), 512, WSP(bf16_t, OFF_WDN), 512, 1024, WSP(int, SM_TILEE), C.G, bx); EpiM4 E{WSP(float, SM_SW), WSP(bf16_t, A_XS)}; \
            pg8::gemm_phase(C.wave, lds, pg8::Dims{512, 512, 512}, Sm, E); } \
        SEAM((pb) + 3); } while (0)
#define RET_PHASES(bb, p0) do { \
        if (IN(p0)) REP(p0) { \
            { WS_OPAQUE; DenseSched Sd; Sd.init(WSP(bf16_t, OFF_XB) + (size_t)(bb) * S * 1024, 1024, WSP(bf16_t, W_B1), 1024, 64, 4, C.G, bx); EpiB1q E{WSP(float, SM_RS2) + (bb) * S, WSP(bf16_t, A_QX), WSP(f32x2, OFF_ROPE)}; \
              pg8::gemm_phase(C.wave, lds, pg8::Dims{1024, 1024, 1024}, Sd, E); } \
            { WS_OPAQUE; DenseSched Sd; Sd.init(WSP(bf16_t, W_B1) + (size_t)1024 * 1024, 1024, WSP(bf16_t, OFF_XB) + (size_t)(bb) * S * 1024, 1024, 4, 64, C.G, bx); EpiB1k E{WSP(float, SM_RS2) + (bb) * S, WSP(bf16_t, A_KN), WSP(bf16_t, A_KZT), WSP(f32x2, OFF_ROPE), lds + 131072}; \
              pg8::gemm_phase(C.wave, lds, pg8::Dims{1024, 1024, 1024}, Sd, E); } \
            { WS_OPAQUE; DenseSched Sd; Sd.init(WSP(bf16_t, W_B1) + (size_t)2048 * 1024, 1024, WSP(bf16_t, OFF_XB) + (size_t)(bb) * S * 1024, 1024, 8, 64, C.G, bx); EpiB1v E{WSP(float, SM_RS2) + (bb) * S, WSP(bf16_t, A_VT)}; \
              pg8::gemm_phase(C.wave, lds, pg8::Dims{1024, 1024, 1024}, Sd, E); } \
        } \
        SEAM(p0); \
        if (IN((p0) + 1)) REP((p0) + 1) { WS_OPAQUE; ret_local(C.wave, lds, WSP(bf16_t, A_KZT), WSP(bf16_t, A_VT), WSP(f32x4, A_L), C.vcu); } \
        SEAM((p0) + 1); \
        if (IN((p0) + 2)) REP((p0) + 2) { WS_OPAQUE; ret_scan(C.wave, lds, WSP(bf16_t, A_QX), WSP(bf16_t, A_KN), WSP(bf16_t, A_KZT), WSP(bf16_t, A_VT), WSP(f32x4, A_L), \
                                 WSP(bf16_t, A_O) + (size_t)(bb) * S * LDO, WSP(float, SM_PO) + (size_t)(bb) * S * 16, C.vcu); } \
        SEAM((p0) + 2); } while (0)

    MOE_PHASES(0, 5);
    if (IN(9)) { WS_OPAQUE; moe_combine<0>(C, P, (const bf16_t*)P.out, WSP(float, SM_RS2), nullptr); convert_moe(C, P, 1); __syncthreads(); }
    SEAM(9);
    RET_PHASES(0, 10);
    RET_PHASES(1, 13);
    if (IN(16)) { WS_OPAQUE; DenseSched Sd; Sd.init(WSP(bf16_t, OFF_XB), 1024, WSP(bf16_t, W_B1) + (size_t)4096 * 1024, 1024, 128, 8, C.G, bx); EpiG E{WSP(float, SM_RS2), WSP(float, SM_PO), WSP(bf16_t, A_O)};
        pg8::gemm_phase(C.wave, lds, pg8::Dims{1024, 1024, 1024}, Sd, E); }
    SEAM(16);
    if (IN(17)) { WS_OPAQUE; DenseSched Sd; Sd.init(WSP(bf16_t, A_O), LDO, WSP(bf16_t, W_OO), LDO, 128, 4, C.G, bx); EpiRes<false> E{WSP(bf16_t, OFF_XB), WSP(bf16_t, OFF_XB)};
        pg8::gemm_phase(C.wave, lds, pg8::Dims{LDO, LDO, 2048}, Sd, E); }
    SEAM(17);
    MOE_PHASES(1, 18);
#undef MOE_PHASES
#undef RET_PHASES
    if (IN(22)) { P_OPAQUE; moe_combine<1>(C, P, (const bf16_t*)(P.ws + OFF_XB), nullptr, P.in[I_LN_F]); }
#ifdef PROBE_T
    __syncthreads();
    if (bx == 0 && C.wave == 0 && lane_id_opaque() == 0) { volatile LAS unsigned long long* st_ = (volatile LAS unsigned long long*)(lds + LDS_MISC + 64);
        const unsigned long long tend = __builtin_amdgcn_s_memrealtime(); const unsigned long long tb = (PROBE_T == 22) ? tend : st_[PROBE_T + 1]; const unsigned long long dt = tb - st_[PROBE_T];
        while (__builtin_amdgcn_s_memrealtime() - tend < 8ull * dt) __builtin_amdgcn_s_sleep(8); }
#endif
#undef IN
#undef SEAM
}

extern "C" void kernel_launch(void* const* d_in, const int* in_sizes, int n_in, void* d_out, int out_size, void* d_ws, size_t ws_size, hipStream_t stream) {
    static int ready = 0;
    if (ready == 0) {
        if (n_in != 21 || out_size != T * D || ws_size < WS_NEED) { fprintf(stderr, "kernel_launch: unexpected shapes (n_in %d, out %d, ws %zu < %zu)\n", n_in, out_size, ws_size, (size_t)WS_NEED); ready = -1; return; }
        if (hipFuncSetAttribute((const void*)fwd_kernel, hipFuncAttributeMaxDynamicSharedMemorySize, LDS_BYTES) != hipSuccess) { fprintf(stderr, "kernel_launch: hipFuncSetAttribute failed\n"); ready = -1; return; }
        int per_cu = 0; (void)hipOccupancyMaxActiveBlocksPerMultiprocessor(&per_cu, (const void*)fwd_kernel, 512, LDS_BYTES); (void)hipGetLastError();
        if (per_cu < 1) fprintf(stderr, "kernel_launch: occupancy query reports %d blocks per CU\n", per_cu);
        ready = 1;
    }
    if (ready < 0) return;
    (void)hipMemsetAsync((char*)d_ws + OFF_CTL, 0, CTL_BYTES, stream);
    Params p{};
    for (int i = 0; i < 21; ++i) p.in[i] = (const float*)d_in[i];
    p.out = (float*)d_out; p.ws = (unsigned char*)d_ws; p.pad = 0;
#if N_LAUNCH_MODE == 1
    for (int ph = 0; ph < NPHASE; ++ph) { p.ph_lo = ph; p.ph_hi = ph + 1; p.use_bar = 0; hipLaunchKernelGGL(fwd_kernel, dim3(256), dim3(512), LDS_BYTES, stream, p); }
#else
    p.ph_lo = 0; p.ph_hi = NPHASE; p.use_bar = 1;
    hipLaunchKernelGGL(fwd_kernel, dim3(256), dim3(512), LDS_BYTES, stream, p);
#endif
}
```

```cpp
#include <hip/hip_runtime.h>
#include <cstdio>
#include <cstdint>

#ifndef N_LAUNCH_MODE
#define N_LAUNCH_MODE 0
#endif

#define LAS __attribute__((address_space(3)))
#define GAS __attribute__((address_space(1)))
typedef unsigned short bf16_t;
typedef short bf16x8 __attribute__((ext_vector_type(8)));
typedef float f32x2 __attribute__((ext_vector_type(2)));
typedef float f32x4 __attribute__((ext_vector_type(4)));
typedef float f32x16 __attribute__((ext_vector_type(16)));
typedef unsigned u32x2 __attribute__((ext_vector_type(2)));
typedef unsigned u32x4 __attribute__((ext_vector_type(4)));

constexpr int T = 32768, S = 16384, D = 1024;
constexpr float EPS = 1e-6f;
constexpr float LOG2E = 1.4426950408889634f;
constexpr int CAP = 65536 + 32 * 256;
constexpr int LDO = 2112;
constexpr int NSEG = 16, SEGC = 16;

constexpr size_t MiB = 1u << 20;
constexpr size_t OFF_CTL = 0, CTL_BYTES = 1 * MiB;
constexpr size_t OFF_SMALL = 1 * MiB;
constexpr size_t SM_RS0 = OFF_SMALL, SM_RS1 = SM_RS0 + T * 4, SM_RS2 = SM_RS1 + T * 4, SM_PQ = SM_RS2 + T * 4, SM_PKV = SM_PQ + (size_t)T * 16,
                 SM_LF = SM_PKV + (size_t)T * 16, SM_CUM = SM_LF + (size_t)T * 32, SM_EID = SM_CUM + (size_t)T * 32  ,
                 SM_GATE = SM_EID + (size_t)T * 8, SM_RANK = SM_GATE + (size_t)T * 8, SM_TSLOT = SM_RANK + (size_t)T * 8, SM_CNT = SM_TSLOT + (size_t)T * 8,
                 SM_STOK = SM_CNT + 256 * 32 * 4, SM_SW = SM_STOK + (size_t)CAP * 4, SM_SR = SM_SW + (size_t)CAP * 4, SM_TILEE = SM_SR + (size_t)CAP * 4,
                 SM_PO = SM_TILEE + 4096, SM_KNRM = SM_PO + (size_t)T * 64, SM_END = SM_KNRM + 16 * 256 * 4;
static_assert(SM_END <= 11 * MiB, "small region");
constexpr size_t OFF_ROPE = 11 * MiB;
constexpr size_t OFF_WMIX = 27 * MiB;
constexpr size_t W_A1 = OFF_WMIX, W_A1V = W_A1 + 3 * MiB, W_A2 = W_A1V + 1 * MiB, W_A2V = W_A2 + 768 * 1024, W_OE = W_A2V + 256 * 1024,
                 W_B1 = W_OE + 2 * MiB, W_OO = W_B1 + 12 * MiB, W_MIXEND = W_OO + (size_t)1024 * LDO * 2;
static_assert(W_MIXEND <= 51 * MiB, "mixer weights");
constexpr size_t OFF_WGU = 51 * MiB, OFF_WDN = OFF_WGU + 64 * MiB;
constexpr size_t OFF_XB = 147 * MiB;
constexpr size_t OFF_ACT = 211 * MiB;
constexpr size_t WS_NEED = OFF_ACT + 325 * MiB;
constexpr size_t A_Z = OFF_ACT, A_QF = A_Z + 32 * MiB, A_KF = A_QF + 32 * MiB, A_VTF = A_KF + 32 * MiB, A_QA = A_VTF + 32 * MiB, A_KA = A_QA + 48 * MiB, A_VTA = A_KA + 48 * MiB;
constexpr size_t A_XS = OFF_ACT + 4096  , A_HID = OFF_ACT + 145 * MiB;
constexpr size_t A_QX = OFF_ACT, A_KN = A_QX + 64 * MiB, A_L = A_KN + 64 * MiB, A_O = A_L + 64 * MiB, A_KZT = OFF_WGU;
static_assert(A_O + (size_t)T * LDO * 2 <= WS_NEED && A_HID + 72 * MiB <= WS_NEED && A_VTA + 32 * MiB <= WS_NEED, "act map");

__device__ __forceinline__ unsigned f2bf(float f) { unsigned u = __builtin_bit_cast(unsigned, f); return (u + 0x7fffu + ((u >> 16) & 1u)) >> 16; }
__device__ __forceinline__ unsigned pk2(float lo, float hi) { unsigned r; asm volatile("v_cvt_pk_bf16_f32 %0, %1, %2" : "=v"(r) : "v"(lo), "v"(hi)); return r; }
__device__ __forceinline__ float bf2f(unsigned short b) { return __builtin_bit_cast(float, ((unsigned)b) << 16); }
__device__ __forceinline__ float bflo(unsigned w) { return __builtin_bit_cast(float, w << 16); }
__device__ __forceinline__ float bfhi(unsigned w) { return __builtin_bit_cast(float, w & 0xffff0000u); }
__device__ __forceinline__ float wave_sum(float v) {
#pragma unroll
    for (int o = 1; o < 64; o <<= 1) v += __shfl_xor(v, o);
    return v;
}
__device__ __forceinline__ float swap32(float x) { const auto rr = __builtin_amdgcn_permlane32_swap(__builtin_bit_cast(unsigned, x), __builtin_bit_cast(unsigned, x), false, false); const bool lo = (__builtin_amdgcn_mbcnt_hi(~0u, __builtin_amdgcn_mbcnt_lo(~0u, 0u)) < 32u); return __builtin_bit_cast(float, lo ? rr[1] : rr[0]); }
__device__ __forceinline__ float swap16(float x) { const auto rr = __builtin_amdgcn_permlane16_swap(__builtin_bit_cast(unsigned, x), __builtin_bit_cast(unsigned, x), false, false); const bool ev = ((__builtin_amdgcn_mbcnt_hi(~0u, __builtin_amdgcn_mbcnt_lo(~0u, 0u)) >> 4) & 1u) == 0u; return __builtin_bit_cast(float, ev ? rr[1] : rr[0]); }
__device__ __forceinline__ int lane_id_opaque() { unsigned z = 0u; asm volatile("" : "+s"(z)); int l = (int)__builtin_amdgcn_mbcnt_hi(~0u, __builtin_amdgcn_mbcnt_lo(~0u, z)); asm volatile("" : "+v"(l)); return l; }
__device__ __forceinline__ int ld_i(const int* p) { return __hip_atomic_load(p, __ATOMIC_RELAXED, __HIP_MEMORY_SCOPE_AGENT); }
__device__ __forceinline__ float rsqrt_f(float x) { return __builtin_amdgcn_rsqf(x); }
__device__ __forceinline__ float max3_f(float a, float b, float c) { float d; asm("v_max3_f32 %0, %1, %2, %3" : "=v"(d) : "v"(a), "v"(b), "v"(c)); return d; }
__device__ __forceinline__ float add_f(float a, float b) { float d; asm("v_add_f32 %0, %1, %2" : "=v"(d) : "v"(a), "v"(b)); return d; }
__device__ __forceinline__ float rcp_f(float x) { return __builtin_amdgcn_rcpf(x); }

#define XB_TMO      128
#define XB_XCNT(j)  (256  + 64 * (j))
#define XB_XSUB(j)  (1280 + 64 * (j))
#define XB_XGEN(j)  (2304 + 64 * (j))
#define XB_TOP      3328
#define XB_TOPGEN   3392
#define XCD_BAR_WORDS 3456
#define XB_SPIN_CAP (1u << 18)
__device__ __forceinline__ unsigned xb_ld(unsigned* p)              { return __hip_atomic_load(p, __ATOMIC_RELAXED, __HIP_MEMORY_SCOPE_AGENT); }
__device__ __forceinline__ unsigned xb_add(unsigned* p, unsigned v) { return __hip_atomic_fetch_add(p, v, __ATOMIC_RELAXED, __HIP_MEMORY_SCOPE_AGENT); }
__device__ __forceinline__ unsigned xb_xcc_id() { return (unsigned)__builtin_amdgcn_s_getreg((3 << 11) | 20) & 0xFu; }
#define XB_SPIN(cond, bar) do { unsigned _sp = 0; while (cond) { __builtin_amdgcn_s_sleep(1); \
    if ((++_sp & 255u) == 0u) { if (xb_ld(&(bar)[XB_TMO])) break; if (_sp > XB_SPIN_CAP) { atomicAdd(&(bar)[XB_TMO], 1u); break; } } } } while (0)
struct XcdBarrier { unsigned* bar; unsigned x; volatile LAS unsigned* st; };
__device__ __forceinline__ XcdBarrier xcd_barrier_post(unsigned* bar, volatile LAS unsigned* st, bool t0) {
    XcdBarrier b; b.bar = bar; b.x = xb_xcc_id(); b.st = st;
    if (t0) (void)xb_add(&bar[XB_XCNT(b.x)], 1u);
    return b;
}
__device__ __forceinline__ void xcd_barrier_complete(unsigned* bar, unsigned x, unsigned& nloc, unsigned& nx) {
    const unsigned G = gridDim.x * gridDim.y * gridDim.z;
    unsigned sum, cnt, mine, sp = 0u;
    for (;;) {
        sum = 0u; cnt = 0u; mine = 0u;
#pragma unroll
        for (unsigned j = 0; j < 16; ++j) { const unsigned c = xb_ld(&bar[XB_XCNT(j)]); sum += c; cnt += (c > 0u) ? 1u : 0u; mine = (j == x) ? c : mine; }
        if (sum == G) break;
        __builtin_amdgcn_s_sleep(1);
        if ((++sp & 255u) == 0u) { if (xb_ld(&bar[XB_TMO])) break; if (sp > XB_SPIN_CAP) { atomicAdd(&bar[XB_TMO], 1u); break; } }
    }
    nloc = mine > 0u ? mine : 1u; nx = cnt > 0u ? cnt : 1u;
}
__device__ __forceinline__ void xcd_barrier(const XcdBarrier& b, bool t0) {
    asm volatile("s_waitcnt vmcnt(0)" ::: "memory");
    __syncthreads();
    if (t0) {
        unsigned* bar = b.bar;
        __builtin_amdgcn_s_waitcnt(0);
        unsigned nloc = b.st[0], nx = b.st[1];
        if (nloc == 0u) { xcd_barrier_complete(bar, b.x, nloc, nx); b.st[0] = nloc; b.st[1] = nx; }
        const unsigned old = xb_add(&bar[XB_XSUB(b.x)], 1u);
        const unsigned gen = old / nloc;
        if (old + 1u == (gen + 1u) * nloc) {
            __builtin_amdgcn_fence(__ATOMIC_RELEASE, "agent");
            asm volatile("s_waitcnt vmcnt(0)" ::: "memory");
            const unsigned og = xb_add(&bar[XB_TOP], 1u);
            const unsigned tg = og / nx;
            if (og + 1u == (tg + 1u) * nx) xb_add(&bar[XB_TOPGEN], 1u);
            else XB_SPIN(xb_ld(&bar[XB_TOPGEN]) == tg, bar);
            __builtin_amdgcn_fence(__ATOMIC_ACQUIRE, "agent");
            xb_add(&bar[XB_XGEN(b.x)], 1u);
            asm volatile("s_waitcnt vmcnt(0)" ::: "memory");
        } else {
            XB_SPIN(xb_ld(&bar[XB_XGEN(b.x)]) == gen, bar);
            __builtin_amdgcn_fence(__ATOMIC_ACQUIRE, "agent");
            asm volatile("s_waitcnt vmcnt(0)" ::: "memory");
        }
    }
    __syncthreads();
}

namespace pg8 {
constexpr int BM = 256, BK = 64, HALF = 128, HTB = HALF * BK * 2, STAGE_BYTES = 8 * HTB, NXCD = 8, WGM = 8;
__device__ __forceinline__ int lds_byte(int r, int c) { const int st = (r >> 4) * 2 + (c >> 5), rr = r & 15, cc = c & 31, ob = rr * 64 + cc * 2; return st * 1024 + (ob ^ (((ob >> 9) & 1) << 5)); }
__device__ __forceinline__ void stage_rc(int b, int& R, int& C) { const int st = b / 1024, sb = b % 1024, swz = sb ^ (((sb >> 9) & 1) << 5); R = (st >> 1) * 16 + swz / 64; C = (st & 1) * 32 + (swz % 64) / 2; }
__device__ __forceinline__ int perm32(int rho) { const int n = rho >> 4, i = rho & 15; return 8 * (i >> 2) + 4 * n + (i & 3); }
struct Unit { int pm, pn, aux; };
struct Dims { int lda, ldb, K; };
struct DenseOrder {
    int nM, nN, nwg, G, c;
    __device__ __forceinline__ void init(int nM_, int nN_, int G_, int c_) { nM = nM_; nN = nN_; nwg = nM * nN; G = G_; c = c_; }
    __device__ __forceinline__ bool tile(int i, Unit& u) const {
        const long L = (long)i * G + c; if (L >= nwg) return false;
        int wgid = (int)L; { const int q = nwg / NXCD, r = nwg % NXCD, xcd = wgid % NXCD, off = wgid / NXCD; wgid = (xcd < r ? xcd * (q + 1) : r * (q + 1) + (xcd - r) * q) + off; }
        const int nig = WGM * nN, gid = wgid / nig, fm = gid * WGM, gsz = (nM - fm) < WGM ? (nM - fm) : WGM;
        u.pm = fm + ((wgid % nig) % gsz); u.pn = (wgid % nig) / gsz; u.aux = 0; return true;
    }
};

template <class Epi, class Sched>
__device__ __forceinline__ void gemm_phase(int wave_, LAS unsigned char* lds, const Dims g, const Sched& S, const Epi& E) {
    const int tid = wave_ * 64 + lane_id_opaque();
    const int wid = __builtin_amdgcn_readfirstlane(tid >> 6), lane = tid & 63, wr = wid >> 2, wc = wid & 3, fr = lane & 15, fq = lane >> 4;
    const int K = g.K, nt = K / BK;
    unsigned voffA[2], voffB[2];
#pragma unroll
    for (int i = 0; i < 2; ++i) { int R, C; stage_rc(tid * 16 + i * 8192, R, C); const int Rb = Epi::PERM ? ((R & ~31) + perm32(R & 31)) : R;
        voffA[i] = (unsigned)(R * g.lda + C) * 2u; voffB[i] = (unsigned)(Rb * g.ldb + C) * 2u; }
    const size_t kstep = (size_t)(BK * 2);
    const size_t hstepA = (size_t)HALF * g.lda * 2, hstepB = (size_t)HALF * g.ldb * 2;
    const unsigned ldsw = (unsigned)wid * 1024u;
    const int aoff = lds_byte(wr * 64 + fr, fq * 8), boff = lds_byte(wc * 32 + fr, fq * 8);
#define PG8_SA(b, h) (((b) * 2 + (h)) * HTB)
#define PG8_SB(b, h) ((4 + (b) * 2 + (h)) * HTB)
#define PG8_STAGE(bufoff, gbase, voff) do { _Pragma("unroll") for (int _i = 0; _i < 2; ++_i) \
        __builtin_amdgcn_global_load_lds((const unsigned*)((const char*)(gbase) + (voff)[_i]), (LAS unsigned*)(lds + (bufoff) + ldsw + _i * 8192), 16, 0, 0); } while (0)
#define PG8_LDA(dst, b, h) do { _Pragma("unroll") for (int m = 0; m < 4; ++m) _Pragma("unroll") for (int k = 0; k < 2; ++k) dst[m][k] = *(const LAS bf16x8*)(lds + PG8_SA(b, h) + aoff + m * 2048 + k * 1024); } while (0)
#define PG8_LDB(dst, b, h) do { _Pragma("unroll") for (int n = 0; n < 2; ++n) _Pragma("unroll") for (int k = 0; k < 2; ++k) dst[n][k] = *(const LAS bf16x8*)(lds + PG8_SB(b, h) + boff + n * 2048 + k * 1024); } while (0)
#define PG8_MMA(ai, bj, At, Bt) do { __builtin_amdgcn_s_setprio(1); _Pragma("unroll") for (int m = 0; m < 4; ++m) _Pragma("unroll") for (int n = 0; n < 2; ++n) _Pragma("unroll") for (int k = 0; k < 2; ++k) \
        acc[ai][bj][m][n] = __builtin_amdgcn_mfma_f32_16x16x32_bf16(Bt[n][k], At[m][k], acc[ai][bj][m][n], 0, 0, 0); __builtin_amdgcn_s_setprio(0); } while (0)
#define PG8_WAIT_V(n) asm volatile("s_waitcnt vmcnt(" #n ")" ::: "memory")
#define PG8_WAIT_L(n) asm volatile("s_waitcnt lgkmcnt(" #n ")" ::: "memory")
#define PG8_BAR __builtin_amdgcn_s_barrier()
#define PG8_SCHED __builtin_amdgcn_sched_barrier(0)
    Unit cur, nxt; int ui = 0;
    if (!S.next(0, cur)) return;
    f32x4 acc[2][2][4][2];
#pragma unroll
    for (int a = 0; a < 2; ++a)
#pragma unroll
        for (int b = 0; b < 2; ++b)
#pragma unroll
            for (int m = 0; m < 4; ++m)
#pragma unroll
                for (int n = 0; n < 2; ++n) acc[a][b][m][n] = (f32x4){0.f, 0.f, 0.f, 0.f};
    bf16x8 At[4][2], B0[2][2], B1[2][2];
    unsigned vG[2][2] = {{0u, 0u}, {0u, 0u}}, vN[2][2] = {{0u, 0u}, {0u, 0u}}; LAS int* grows = (LAS int*)(lds + 131072);
    if constexpr (Sched::GATHER) { S.load_rows(grows, tid); __syncthreads();
#pragma unroll
        for (int h = 0; h < 2; ++h)
#pragma unroll
            for (int i = 0; i < 2; ++i) { int R, C; stage_rc(tid * 16 + i * 8192, R, C); vG[h][i] = (unsigned)(grows[h * 128 + R] * g.lda + C) * 2u; } }
#define PG8_STAGEA(bufoff, gbase, h, nx) do { _Pragma("unroll") for (int _i = 0; _i < 2; ++_i) { const unsigned o_ = Sched::GATHER ? ((nx) ? vN[h][_i] : vG[h][_i]) : voffA[_i]; \
        __builtin_amdgcn_global_load_lds((const unsigned*)((const char*)(gbase) + o_), (LAS unsigned*)(lds + (bufoff) + ldsw + _i * 8192), 16, 0, 0); } } while (0)
#define PG8_APTR(p, h) (Sched::GATHER ? (p) : (p) + (h) * hstepA)
    const char* cA; const char* cB; S.ptrs(cur, cA, cB);
    if constexpr (Sched::COUNTED) { S.wait(cur, wid); __syncthreads(); }
    PG8_STAGE(PG8_SB(0, 0), cB, voffB); PG8_STAGE(PG8_SB(0, 1), cB + hstepB, voffB); PG8_STAGEA(PG8_SA(0, 0), cA, 0, false); PG8_STAGEA(PG8_SA(0, 1), PG8_APTR(cA, 1), 1, false);
    if (wr == 1) PG8_BAR;
    PG8_WAIT_V(2); PG8_BAR;
    PG8_STAGE(PG8_SB(1, 0), cB + kstep, voffB); PG8_STAGEA(PG8_SA(1, 0), cA + kstep, 0, false); PG8_STAGE(PG8_SB(1, 1), cB + hstepB + kstep, voffB);
    PG8_WAIT_V(6); PG8_BAR;
    for (;;) {
        const bool has_next = S.next(ui + 1, nxt);
        const char* nA = cA; const char* nB = cB; if (has_next) S.ptrs(nxt, nA, nB);
        if constexpr (Sched::COUNTED) { if (has_next) S.wait(nxt, wid); PG8_BAR; }
        if constexpr (Sched::GATHER) {
#pragma unroll
            for (int h = 0; h < 2; ++h)
#pragma unroll
                for (int i = 0; i < 2; ++i) { int R, C; stage_rc(tid * 16 + i * 8192, R, C); vN[h][i] = has_next ? (unsigned)(grows[(ui + 1) * 256 + h * 128 + R] * g.lda + C) * 2u : vG[h][i]; } }
        for (int t = 0; t < nt; t += 2) {
            const bool last = (t == nt - 2);
            const char* a1 = cA + (size_t)(t + 1) * kstep;
            const char* a2 = last ? nA : cA + (size_t)(t + 2) * kstep; const char* b2 = last ? nB : cB + (size_t)(t + 2) * kstep;
            const char* a3 = a2 + kstep; const char* b3 = b2 + kstep;
            PG8_LDB(B0, 0, 0); PG8_LDB(B1, 0, 1); PG8_SCHED; PG8_LDA(At, 0, 0); PG8_STAGEA(PG8_SA(1, 1), PG8_APTR(a1, 1), 1, false);
            PG8_WAIT_V(8); PG8_WAIT_L(0); PG8_BAR; PG8_MMA(0, 0, At, B0); PG8_MMA(0, 1, At, B1); PG8_BAR; PG8_SCHED;
            PG8_LDA(At, 0, 1); PG8_STAGE(PG8_SB(0, 0), b2, voffB); PG8_STAGE(PG8_SB(0, 1), b2 + hstepB, voffB); PG8_STAGEA(PG8_SA(0, 0), a2, 0, last);
            PG8_WAIT_V(8); PG8_WAIT_L(0); PG8_BAR; PG8_MMA(1, 0, At, B0); PG8_MMA(1, 1, At, B1); PG8_BAR; PG8_SCHED;
            PG8_LDB(B0, 1, 0); PG8_LDB(B1, 1, 1); PG8_SCHED; PG8_LDA(At, 1, 0); PG8_STAGEA(PG8_SA(0, 1), PG8_APTR(a2, 1), 1, last);
            PG8_WAIT_V(8); PG8_WAIT_L(0); PG8_BAR; PG8_MMA(0, 0, At, B0); PG8_MMA(0, 1, At, B1); PG8_BAR; PG8_SCHED;
            PG8_LDA(At, 1, 1); PG8_STAGE(PG8_SB(1, 0), b3, voffB); PG8_STAGE(PG8_SB(1, 1), b3 + hstepB, voffB); PG8_STAGEA(PG8_SA(1, 0), a3, 0, last);
            PG8_WAIT_V(8); PG8_WAIT_L(0); PG8_BAR; PG8_MMA(1, 0, At, B0); PG8_MMA(1, 1, At, B1); PG8_BAR; PG8_SCHED;
        }
        if (wr == 0) PG8_BAR;
        { int fr2 = fr, fq2 = fq; asm volatile("" : "+v"(fr2), "+v"(fq2)); E(acc, cur, wr, wc, fr2, fq2); }
        if (!has_next) break;
#pragma unroll
        for (int a = 0; a < 2; ++a)
#pragma unroll
            for (int b = 0; b < 2; ++b)
#pragma unroll
                for (int m = 0; m < 4; ++m)
#pragma unroll
                    for (int n = 0; n < 2; ++n) acc[a][b][m][n] = (f32x4){0.f, 0.f, 0.f, 0.f};
        cur = nxt; cA = nA; cB = nB; ++ui;
        if constexpr (Sched::GATHER) { vG[0][0] = vN[0][0]; vG[0][1] = vN[0][1]; vG[1][0] = vN[1][0]; vG[1][1] = vN[1][1]; }
        if (wr == 1) PG8_BAR;
    }
    PG8_WAIT_V(0);
    PG8_BAR;
#undef PG8_STAGEA
#undef PG8_APTR
#undef PG8_SA
#undef PG8_SB
#undef PG8_STAGE
#undef PG8_LDA
#undef PG8_LDB
#undef PG8_MMA
#undef PG8_WAIT_V
#undef PG8_WAIT_L
#undef PG8_BAR
#undef PG8_SCHED
}
}
using pg8::Unit;

struct Params {
    const float* in[21];
    float* out;
    unsigned char* ws;
    int ph_lo, ph_hi;
    int use_bar, pad;
};
enum { I_X = 0, I_LN_MIX_E, I_W_IN_E, I_LN_Q, I_W_UQ, I_LN_KV, I_W_UKV, I_B_F, I_W_OUT_E, I_LN_MIX_O, I_W_IN_O, I_W_OUT_O, I_LN_FFN, I_W_RG, I_B_RG, I_W_RE, I_B_RE, I_W_GATE, I_W_UP, I_W_DOWN, I_LN_F };

#define WSP(T_, off) ((T_*)(ws_ + (off)))
typedef const Params __attribute__((address_space(4)))* KParams;
#define P_OPAQUE KParams Pk_ = (KParams)__builtin_amdgcn_kernarg_segment_ptr(); asm volatile("" : "+s"(Pk_)); const Params& P = *(const Params*)Pk_
#define WS_OPAQUE P_OPAQUE; unsigned char* ws_ = P.ws

__device__ __forceinline__ float log2_gamma(int h) { return __builtin_log2f(1.0f - __builtin_exp2f(-5.0f - (float)h)); }

struct DenseSched {
    static constexpr bool GATHER = false, COUNTED = false;
    pg8::DenseOrder O; const char* A; const char* B; size_t astep, bstep;
    __device__ __forceinline__ void init(const void* A_, int lda, const void* B_, int ldb, int nM, int nN, int G, int c) {
        O.init(nM, nN, G, c); A = (const char*)A_; B = (const char*)B_; astep = (size_t)256 * lda * 2; bstep = (size_t)256 * ldb * 2; }
    __device__ __forceinline__ bool next(int i, Unit& u) const { return O.tile(i, u); }
    __device__ __forceinline__ void ptrs(const Unit& u, const char*& a, const char*& b) const { a = A + (size_t)u.pm * astep; b = B + (size_t)u.pn * bstep; }
};
template <bool GATHER_> struct MoeSched {
    static constexpr bool GATHER = GATHER_;
    static constexpr bool COUNTED = !GATHER_; static constexpr int ROT = GATHER_ ? 0 : 2;
    const int* tcnt;
    const char* A; const char* B; size_t astep, estep, bstep; int ntile, c; int ex[5]; const int* stok;
    __device__ __forceinline__ int tile_of(int i) const { return i * 64 + ((c + ROT) & 7) * 8 + (c >> 5); }
    __device__ __forceinline__ void wait(const Unit& u, int wid) const {
        if (wid == 0) { const int* p = tcnt + u.pm * 16; unsigned sp = 0; while (ld_i(p) < 32) { __builtin_amdgcn_s_sleep(2); if (++sp > (1u << 24)) break; }
            __builtin_amdgcn_fence(__ATOMIC_ACQUIRE, "agent"); asm volatile("s_waitcnt vmcnt(0)" ::: "memory"); } }
    __device__ __forceinline__ void init(const void* A_, int lda, const void* B_, int ldb, size_t expert_rows, const int* tilee, const int* stok_, int G_, int c_) {
        A = (const char*)A_; B = (const char*)B_; astep = (size_t)256 * lda * 2; bstep = (size_t)256 * ldb * 2; estep = expert_rows * ldb * 2; c = c_; (void)G_; stok = stok_; tcnt = nullptr;
        { const int l = (int)__builtin_amdgcn_mbcnt_hi(~0u, __builtin_amdgcn_mbcnt_lo(~0u, 0u)); const int t = tile_of(l < 5 ? l : 0); const int v = ld_i(tilee + (l == 5 ? 300 : (t < 300 ? t : 299)));
          ntile = __builtin_amdgcn_readlane(v, 5);
#pragma unroll
          for (int i = 0; i < 5; ++i) ex[i] = __builtin_amdgcn_readlane(v, i); } }
    __device__ __forceinline__ bool next(int i, Unit& u) const { if (i >= 5) return false; const int tile = tile_of(i); if (tile >= ntile) return false; u.pm = tile; u.pn = (c >> 3) & 3;
        u.aux = (i == 0) ? ex[0] : (i == 1) ? ex[1] : (i == 2) ? ex[2] : (i == 3) ? ex[3] : ex[4]; return true; }
    __device__ __forceinline__ void ptrs(const Unit& u, const char*& a, const char*& b) const { a = GATHER ? A : A + (size_t)u.pm * astep; b = B + (size_t)u.aux * estep + (size_t)u.pn * bstep; }
    __device__ __forceinline__ void load_rows(LAS int* rows, int tid) const { if (tid < 256) {
#pragma unroll
            for (int i = 0; i < 5; ++i) { const int tile = tile_of(i); rows[i * 256 + tid] = (tile < ntile) ? stok[tile * 256 + tid] : 0; } } }
};

typedef const f32x4 (&AccRef)[2][2][4][2];
#define EPI_LOOP_AI_M for (int ai = 0; ai < 2; ++ai) _Pragma("unroll") for (int m = 0; m < 4; ++m)
#define EPI_LOOP_BJ_N for (int bj = 0; bj < 2; ++bj) _Pragma("unroll") for (int n = 0; n < 2; ++n)

struct EpiA1a {
    static constexpr bool PERM = false;
    const float* rs0; bf16_t* Z; float* PQ; float* PKV; bf16_t* KA; float* LF; const float* bf; bf16_t* QF; bf16_t* KF; const f32x2* rope;
    __device__ __forceinline__ void operator()(AccRef acc, const Unit& u, int wr, int wc, int fr, int fq) const {
        const int row0 = u.pm * 256 + wr * 64 + fr; float rsv[2][4];
#pragma unroll
        EPI_LOOP_AI_M rsv[ai][m] = rs0[row0 + ai * 128 + m * 16];
        if (u.pn <= 1) {
            const int zc16 = u.pn * 256 + wc * 32 + ((fq & 1) ? 16 + 4 * (fq - 1) : 4 * fq);
#pragma unroll
            EPI_LOOP_AI_M { const int r = row0 + ai * 128 + m * 16; const float rs = rsv[ai][m]; float ss = 0.f; f32x4 v[2][2]; unsigned pz_[2][2][2];
#pragma unroll
                EPI_LOOP_BJ_N { v[bj][n] = acc[ai][bj][m][n] * rs; pz_[bj][n][0] = pk2(v[bj][n][0], v[bj][n][1]); pz_[bj][n][1] = pk2(v[bj][n][2], v[bj][n][3]);
                    if (u.pn == 0 || bj == 0) ss += (v[bj][n][0] * v[bj][n][0] + v[bj][n][1] * v[bj][n][1]) + (v[bj][n][2] * v[bj][n][2] + v[bj][n][3] * v[bj][n][3]); }
                __builtin_amdgcn_sched_barrier(0); asm volatile("s_nop 1" ::: "memory"); __builtin_amdgcn_sched_barrier(0);
#pragma unroll
                for (int bj = 0; bj < 2; ++bj) { const auto r0 = __builtin_amdgcn_permlane16_swap(pz_[bj][0][0], pz_[bj][1][0], false, false); const auto r1 = __builtin_amdgcn_permlane16_swap(pz_[bj][0][1], pz_[bj][1][1], false, false);
                    *(u32x4*)(Z + (size_t)r * 512 + zc16 + bj * 128) = (u32x4){r0[0], r1[0], r0[1], r1[1]}; }
                ss += swap16(ss); ss += swap32(ss);
                if (fq == 0) { if (u.pn == 0) PQ[(size_t)r * 4 + wc] = ss; else PKV[(size_t)r * 4 + wc] = ss; }
                if (u.pn == 1 && wc == 0) {
                    const int pos = r & (S - 1); const f32x4 x1 = v[1][0], x2 = v[1][1]; f32x4 o1, o2;
#pragma unroll
                    for (int j = 0; j < 4; ++j) { const f32x2 cs = rope[(size_t)pos * 128 + 8 * (4 * fq + j)]; o1[j] = x1[j] * cs.x - x2[j] * cs.y; o2[j] = x1[j] * cs.y + x2[j] * cs.x; }
                    u32x2 w1, w2; w1.x = pk2(o1[0], o1[1]); w1.y = pk2(o1[2], o1[3]); w2.x = pk2(o2[0], o2[1]); w2.y = pk2(o2[2], o2[3]);
#pragma unroll
                    for (int hh = 0; hh < 8; ++hh) { bf16_t* kp = KA + (size_t)r * 768 + hh * 96 + 64 + 4 * fq; *(u32x2*)kp = w1; *(u32x2*)(kp + 16) = w2; }
                }
                if (u.pn == 1 && wc == 1 && fq < 2) {
                    const f32x4 f = v[1][0]; f32x4 o;
#pragma unroll
                    for (int j = 0; j < 4; ++j) { const float x = f[j] + bf[4 * fq + j]; const float e = __expf(-fabsf(x));
                        const float l1p = (e < 9.765625e-4f) ? e * (1.0f - e * (0.5f - 0.33333334f * e)) : __logf(1.0f + e); o[j] = fminf(x, 0.f) - l1p; }
                    *(f32x4*)(LF + (size_t)r * 8 + 4 * fq) = o;
                }
            }
        } else {
            const bool isq = u.pn < 4; bf16_t* dst = isq ? QF : KF; const int cc = (isq ? (u.pn - 2) : (u.pn - 4)) * 256 + wc * 32 + ((fq & 1) ? 16 + 4 * (fq - 1) : 4 * fq); const float sc = isq ? (0.125f * LOG2E) : 1.0f;
#pragma unroll
            EPI_LOOP_AI_M { const int r = row0 + ai * 128 + m * 16; const float rs = rsv[ai][m] * sc; unsigned pa_[2][2], pb_[2][2];
#pragma unroll
                for (int bj = 0; bj < 2; ++bj) { const f32x4 va = acc[ai][bj][m][0] * rs, vb = acc[ai][bj][m][1] * rs; pa_[bj][0] = pk2(va[0], va[1]); pa_[bj][1] = pk2(va[2], va[3]); pb_[bj][0] = pk2(vb[0], vb[1]); pb_[bj][1] = pk2(vb[2], vb[3]); }
                __builtin_amdgcn_sched_barrier(0); asm volatile("s_nop 1" ::: "memory"); __builtin_amdgcn_sched_barrier(0);
#pragma unroll
                for (int bj = 0; bj < 2; ++bj) { const auto r0 = __builtin_amdgcn_permlane16_swap(pa_[bj][0], pb_[bj][0], false, false); const auto r1 = __builtin_amdgcn_permlane16_swap(pa_[bj][1], pb_[bj][1], false, false);
                    *(u32x4*)(dst + (size_t)r * 512 + cc + bj * 128) = (u32x4){r0[0], r1[0], r0[1], r1[1]}; } }
        }
    }
};
template <int MODE> struct EpiVT {
    static constexpr bool PERM = true;
    const float* rs; bf16_t* OUT; size_t ldo;
    __device__ __forceinline__ float cs(int t) const { if (MODE == 0) return rs[t]; const f32x4 p = *(const f32x4*)(rs + (size_t)t * 4); return rsqrt_f(((p[0] + p[1]) + (p[2] + p[3])) * (1.0f / 128.0f) + EPS); }
    __device__ __forceinline__ void operator()(AccRef acc, const Unit& u, int wr, int wc, int fr, int fq) const {
        const int f0 = u.pm * 256 + wr * 64 + fr, t0 = u.pn * 256 + wc * 32 + 8 * fq;
#pragma unroll
        for (int bj = 0; bj < 2; ++bj) { float c[8];
#pragma unroll
            for (int j = 0; j < 8; ++j) c[j] = cs(t0 + bj * 128 + j);
#pragma unroll
            EPI_LOOP_AI_M { const f32x4 a = acc[ai][bj][m][0], b = acc[ai][bj][m][1]; u32x4 w;
                w.x = pk2(a[0] * c[0], a[1] * c[1]); w.y = pk2(a[2] * c[2], a[3] * c[3]); w.z = pk2(b[0] * c[4], b[1] * c[5]); w.w = pk2(b[2] * c[6], b[3] * c[7]);
                const int f_ = f0 + ai * 128 + m * 16, t_ = t0 + bj * 128;
                *(u32x4*)(OUT + (((size_t)(f_ >> 6) * (T / 64) + (t_ >> 6)) * 64 + (f_ & 63)) * 64 + (t_ & 63)) = w; } }
    }
};
struct EpiA2q {
    static constexpr bool PERM = false;
    const float* PQ; bf16_t* QA; const f32x2* rope;
    __device__ __forceinline__ void operator()(AccRef acc, const Unit& u, int wr, int wc, int fr, int fq) const {
        if (wc == 3) return;
        const int row0 = u.pm * 256 + wr * 64 + fr; const float SCA = 0.10206207261596577f * LOG2E;
#pragma unroll
        for (int ai = 0; ai < 2; ++ai) { f32x2 csv[4][4]; f32x4 pv[2][4];
#pragma unroll
            for (int m = 0; m < 4; ++m) pv[ai][m] = *(const f32x4*)(PQ + (size_t)(row0 + ai * 128 + m * 16) * 4);
            if (wc == 2) {
#pragma unroll
                for (int m = 0; m < 4; ++m)
#pragma unroll
                    for (int j = 0; j < 4; ++j) csv[m][j] = rope[(size_t)((row0 + ai * 128 + m * 16) & (S - 1)) * 128 + 8 * (4 * fq + j)]; }
#pragma unroll
            for (int m = 0; m < 4; ++m) { const int r = row0 + ai * 128 + m * 16; const f32x4 p = pv[ai][m];
                const float rs = rsqrt_f(((p[0] + p[1]) + (p[2] + p[3])) * (1.0f / 256.0f) + EPS) * SCA;
#pragma unroll
                for (int bj = 0; bj < 2; ++bj) { const int hh = 2 * u.pn + bj; bf16_t* qp = QA + (size_t)r * 768 + hh * 96 + wc * 32 + ((fq & 1) ? 16 + 4 * (fq - 1) : 4 * fq); f32x4 x1 = acc[ai][bj][m][0] * rs, x2 = acc[ai][bj][m][1] * rs;
                    if (wc == 2) {
#pragma unroll
                        for (int j = 0; j < 4; ++j) { const f32x2 cs = csv[m][j]; const float a = x1[j], b = x2[j]; x1[j] = a * cs.x - b * cs.y; x2[j] = a * cs.y + b * cs.x; } }
                    { const unsigned a0 = pk2(x1[0], x1[1]), a1 = pk2(x1[2], x1[3]), b0 = pk2(x2[0], x2[1]), b1 = pk2(x2[2], x2[3]);
                      __builtin_amdgcn_sched_barrier(0); asm volatile("s_nop 1" ::: "memory"); __builtin_amdgcn_sched_barrier(0);
                      const auto r0 = __builtin_amdgcn_permlane16_swap(a0, b0, false, false); const auto r1 = __builtin_amdgcn_permlane16_swap(a1, b1, false, false);
                      *(u32x4*)qp = (u32x4){r0[0], r1[0], r0[1], r1[1]}; } } } }
    }
};
struct EpiA2k {
    static constexpr bool PERM = false;
    const float* PKV; bf16_t* KA;
    __device__ __forceinline__ void operator()(AccRef acc, const Unit& u, int wr, int wc, int fr, int fq) const {
        const int row0 = u.pm * 256 + wr * 64 + fr; f32x4 pv[2][4];
#pragma unroll
        EPI_LOOP_AI_M pv[ai][m] = *(const f32x4*)(PKV + (size_t)(row0 + ai * 128 + m * 16) * 4);
#pragma unroll
        EPI_LOOP_AI_M { const int r = row0 + ai * 128 + m * 16; const f32x4 p = pv[ai][m];
            const float rs = rsqrt_f(((p[0] + p[1]) + (p[2] + p[3])) * (1.0f / 128.0f) + EPS);
#pragma unroll
            for (int bj = 0; bj < 2; ++bj) { const int hh = 4 * u.pn + 2 * bj + (wc >> 1), dd = 32 * (wc & 1) + ((fq & 1) ? 16 + 4 * (fq - 1) : 4 * fq); const f32x4 va = acc[ai][bj][m][0] * rs, vb = acc[ai][bj][m][1] * rs;
                const unsigned a0 = pk2(va[0], va[1]), a1 = pk2(va[2], va[3]), b0 = pk2(vb[0], vb[1]), b1 = pk2(vb[2], vb[3]);
                __builtin_amdgcn_sched_barrier(0); asm volatile("s_nop 1" ::: "memory"); __builtin_amdgcn_sched_barrier(0);
                const auto r0 = __builtin_amdgcn_permlane16_swap(a0, b0, false, false); const auto r1 = __builtin_amdgcn_permlane16_swap(a1, b1, false, false);
                *(u32x4*)(KA + (size_t)r * 768 + hh * 96 + dd) = (u32x4){r0[0], r1[0], r0[1], r1[1]}; } }
    }
};
template <bool BASE_F32> struct EpiRes {
    static constexpr bool PERM = true;
    const void* base; bf16_t* outp;
    __device__ __forceinline__ void operator()(AccRef acc, const Unit& u, int wr, int wc, int fr, int fq) const {
        const int row0 = u.pm * 256 + wr * 64 + fr, col0 = u.pn * 256 + wc * 32 + 8 * fq;
#pragma unroll
        for (int ai = 0; ai < 2; ++ai) {
            if (BASE_F32) { f32x4 b[4][2][2];
#pragma unroll
                for (int m = 0; m < 4; ++m)
#pragma unroll
                    EPI_LOOP_BJ_N b[m][bj][n] = __builtin_nontemporal_load((const f32x4*)((const float*)base + (size_t)(row0 + ai * 128 + m * 16) * D + col0 + bj * 128 + n * 4));
#pragma unroll
                for (int m = 0; m < 4; ++m)
#pragma unroll
                    for (int bj = 0; bj < 2; ++bj) { const f32x4 v0 = b[m][bj][0] + acc[ai][bj][m][0], v1 = b[m][bj][1] + acc[ai][bj][m][1];
                        *(u32x4*)(outp + (size_t)(row0 + ai * 128 + m * 16) * D + col0 + bj * 128) = (u32x4){pk2(v0[0], v0[1]), pk2(v0[2], v0[3]), pk2(v1[0], v1[1]), pk2(v1[2], v1[3])}; }
            } else { u32x4 b[4][2];
#pragma unroll
                for (int m = 0; m < 4; ++m)
#pragma unroll
                    for (int bj = 0; bj < 2; ++bj) b[m][bj] = *(const u32x4*)((const bf16_t*)base + (size_t)(row0 + ai * 128 + m * 16) * D + col0 + bj * 128);
#pragma unroll
                for (int m = 0; m < 4; ++m)
#pragma unroll
                    for (int bj = 0; bj < 2; ++bj) { const u32x4 w = b[m][bj]; const f32x4 a0 = acc[ai][bj][m][0], a1 = acc[ai][bj][m][1];
                        *(u32x4*)(outp + (size_t)(row0 + ai * 128 + m * 16) * D + col0 + bj * 128) = (u32x4){pk2(bflo(w.x) + a0[0], bfhi(w.x) + a0[1]), pk2(bflo(w.y) + a0[2], bfhi(w.y) + a0[3]), pk2(bflo(w.z) + a1[0], bfhi(w.z) + a1[1]), pk2(bflo(w.w) + a1[2], bfhi(w.w) + a1[3])}; } } }
    }
};
struct EpiB1q {
    static constexpr bool PERM = true;
    const float* rs2; bf16_t* QX; const f32x2* rope;
    __device__ __forceinline__ void operator()(AccRef acc, const Unit& u, int wr, int wc, int fr, int fq) const {
        const int row0 = u.pm * 256 + wr * 64 + fr, i0 = wc * 32 + 8 * fq; const float l2g = log2_gamma(u.pn); float rsv[2][4];
#pragma unroll
        EPI_LOOP_AI_M rsv[ai][m] = rs2[row0 + ai * 128 + m * 16];
#pragma unroll
        for (int ai = 0; ai < 2; ++ai)
#pragma unroll
            for (int mp = 0; mp < 2; ++mp) { f32x4 cs[2][4];
#pragma unroll
                for (int mm = 0; mm < 2; ++mm)
#pragma unroll
                    for (int q4 = 0; q4 < 4; ++q4) { const int pos = row0 + ai * 128 + (2 * mp + mm) * 16; cs[mm][q4] = *(const f32x4*)(rope + (size_t)pos * 128 + i0 + 2 * q4); }
#pragma unroll
                for (int mm = 0; mm < 2; ++mm) { const int m = 2 * mp + mm, pos = row0 + ai * 128 + m * 16; const float rs = rsv[ai][m] * __builtin_exp2f((float)((pos & 63) + 1) * l2g); float o1[8], o2[8];
#pragma unroll
                    for (int j = 0; j < 8; ++j) { const float c = cs[mm][j >> 1][2 * (j & 1)], sn = cs[mm][j >> 1][2 * (j & 1) + 1]; const float x1 = acc[ai][0][m][j >> 2][j & 3] * rs, x2 = acc[ai][1][m][j >> 2][j & 3] * rs;
                        o1[j] = x1 * c - x2 * sn; o2[j] = x1 * sn + x2 * c; }
                    bf16_t* qp = QX + (size_t)pos * 1024 + u.pn * 256 + i0;
                    *(u32x4*)qp = (u32x4){pk2(o1[0], o1[1]), pk2(o1[2], o1[3]), pk2(o1[4], o1[5]), pk2(o1[6], o1[7])}; *(u32x4*)(qp + 128) = (u32x4){pk2(o2[0], o2[1]), pk2(o2[2], o2[3]), pk2(o2[4], o2[5]), pk2(o2[6], o2[7])}; } }
    }
};
__device__ __forceinline__ int rho_of_d(int d) { const int lo = d & 31; return (d & ~31) | (((lo >> 2) & 1) << 4) | ((lo >> 3) << 2) | (lo & 3); }
struct EpiB1k {
    static constexpr bool PERM = true;
    const float* rs2; bf16_t* KN; bf16_t* KZT; const f32x2* rope; LAS unsigned char* scr;
    __device__ __forceinline__ void operator()(AccRef acc, const Unit& u, int wr, int wc, int fr, int fq) const {
        const int h = u.pm, t0 = u.pn * 256 + wc * 32 + 8 * fq; const float l2g = log2_gamma(h);
        LAS unsigned char* my = scr + (wr * 4 + wc) * 1024; const int lane = fq * 16 + fr;
#pragma unroll
        for (int bj = 0; bj < 2; ++bj) { const int tb = t0 + bj * 128; float rs[8], zt[8];
#pragma unroll
            for (int j = 0; j < 8; ++j) { rs[j] = rs2[tb + j] * 0.0625f; zt[j] = __builtin_exp2f((float)(63 - ((tb + j) & 63)) * l2g); }
            const int chunk = tb >> 6, c0 = tb & 63;
#pragma unroll
            for (int m = 0; m < 4; ++m) { const int d = wr * 64 + m * 16 + fr; float k1[8], k2[8]; f32x2 csv[8];
#pragma unroll
                for (int j = 0; j < 8; ++j) csv[j] = rope[(size_t)(tb + j) * 128 + d];
#pragma unroll
                for (int j = 0; j < 8; ++j) { const f32x2 cs = csv[j]; const float x1 = acc[0][bj][m][j >> 2][j & 3] * rs[j], x2 = acc[1][bj][m][j >> 2][j & 3] * rs[j];
                    k1[j] = x1 * cs.x - x2 * cs.y; k2[j] = x1 * cs.y + x2 * cs.x; }
                const int rho = rho_of_d(d); u32x4 w1, w2;
                w1.x = pk2(k1[0] * zt[0], k1[1] * zt[1]); w1.y = pk2(k1[2] * zt[2], k1[3] * zt[3]); w1.z = pk2(k1[4] * zt[4], k1[5] * zt[5]); w1.w = pk2(k1[6] * zt[6], k1[7] * zt[7]);
                w2.x = pk2(k2[0] * zt[0], k2[1] * zt[1]); w2.y = pk2(k2[2] * zt[2], k2[3] * zt[3]); w2.z = pk2(k2[4] * zt[4], k2[5] * zt[5]); w2.w = pk2(k2[6] * zt[6], k2[7] * zt[7]);
                bf16_t* zp = KZT + (((size_t)(h * 256 + chunk) * 256 + rho) * 64 + c0); *(u32x4*)zp = w1; *(u32x4*)(zp + 128 * 64) = w2;
#pragma unroll
                for (int half = 0; half < 2; ++half) { const float* kk = half ? k2 : k1;
#pragma unroll
                    for (int j = 0; j < 8; ++j) *(LAS bf16_t*)(my + (8 * fq + j) * 32 + fr * 2) = (bf16_t)f2bf(kk[j]);
                    asm volatile("s_waitcnt lgkmcnt(0)" ::: "memory");
                    const u32x4 v = *(const LAS u32x4*)(my + (lane >> 1) * 32 + (lane & 1) * 16);
                    const int tok = u.pn * 256 + wc * 32 + bj * 128 + (lane >> 1);
                    *(u32x4*)(KN + (size_t)tok * 1024 + h * 256 + half * 128 + wr * 64 + m * 16 + (lane & 1) * 8) = v;
                    asm volatile("s_waitcnt lgkmcnt(0)" ::: "memory"); } } }
    }
};
struct EpiB1v {
    static constexpr bool PERM = true;
    const float* rs2; bf16_t* VT;
    __device__ __forceinline__ void operator()(AccRef acc, const Unit& u, int wr, int wc, int fr, int fq) const {
        const int h = u.pm >> 1, e0 = (u.pm & 1) * 256 + wr * 64 + fr, t0 = u.pn * 256 + wc * 32 + 8 * fq;
#pragma unroll
        for (int bj = 0; bj < 2; ++bj) { const int tb = t0 + bj * 128; float c[8];
#pragma unroll
            for (int j = 0; j < 8; ++j) c[j] = rs2[tb + j];
            const int chunk = tb >> 6, c0 = tb & 63;
#pragma unroll
            EPI_LOOP_AI_M { const f32x4 a = acc[ai][bj][m][0], b = acc[ai][bj][m][1]; u32x4 w;
                w.x = pk2(a[0] * c[0], a[1] * c[1]); w.y = pk2(a[2] * c[2], a[3] * c[3]); w.z = pk2(b[0] * c[4], b[1] * c[5]); w.w = pk2(b[2] * c[6], b[3] * c[7]);
                *(u32x4*)(VT + (((size_t)(h * 256 + chunk) * 512 + e0 + ai * 128 + m * 16) * 64 + c0)) = w; } }
    }
};
struct B1Sched {
    static constexpr bool GATHER = false, COUNTED = false;
    const char* XBp; const char* Wp; int G, c;
    __device__ __forceinline__ void init(const void* xb, const void* w, int G_, int c_) { XBp = (const char*)xb; Wp = (const char*)w; G = G_; c = c_; }
    __device__ __forceinline__ bool next(int i, Unit& u) const { if (i >= 8) return false; const int bb = i >> 2, r = i & 3, kind = r == 0 ? 0 : (r == 1 ? 1 : 2);
        pg8::DenseOrder O; O.init(kind == 0 ? 64 : (kind == 1 ? 4 : 8), kind == 0 ? 4 : 64, G, c); O.tile(kind == 2 ? r - 2 : 0, u); u.aux = 4 * bb + kind; return true; }
    __device__ __forceinline__ void ptrs(const Unit& u, const char*& a, const char*& b) const { const int bb = u.aux >> 2, kind = u.aux & 3; const char* xb = XBp + (size_t)bb * S * 1024 * 2; const size_t tstep = (size_t)256 * 1024 * 2;
        if (kind == 0) { a = xb + (size_t)u.pm * tstep; b = Wp + (size_t)u.pn * tstep; }
        else { a = Wp + (size_t)(kind == 1 ? 1024 : 2048) * 1024 * 2 + (size_t)u.pm * tstep; b = xb + (size_t)u.pn * tstep; } }
};
struct EpiB1All {
    static constexpr bool PERM = true;
    const float* rs2; bf16_t* QX; bf16_t* KN; bf16_t* KZT; bf16_t* VT; const f32x2* rope; LAS unsigned char* scr;
    __device__ __forceinline__ void operator()(AccRef acc, const Unit& u, int wr, int wc, int fr, int fq) const {
        const int bb = u.aux >> 2, kind = u.aux & 3; const size_t sb = (size_t)bb * S * 1024; const float* r2 = rs2 + bb * S;
        if (kind == 0) { EpiB1q e{r2, QX + sb, rope}; e(acc, u, wr, wc, fr, fq); }
        else if (kind == 1) { EpiB1k e{r2, KN + sb, KZT + sb, rope, scr}; e(acc, u, wr, wc, fr, fq); }
        else { EpiB1v e{r2, VT + 2 * sb}; e(acc, u, wr, wc, fr, fq); }
    }
};
struct EpiG {
    static constexpr bool PERM = true;
    const float* rs2; const float* PO; bf16_t* O;
    __device__ __forceinline__ void operator()(AccRef acc, const Unit& u, int wr, int wc, int fr, int fq) const {
        const int row0 = u.pm * 256 + wr * 64 + fr, col0 = u.pn * 256 + wc * 32 + 8 * fq, head = u.pn >> 1;
        f32x4 pv[2][4]; float rsv[2][4];
#pragma unroll
        EPI_LOOP_AI_M { const int r = row0 + ai * 128 + m * 16; pv[ai][m] = *(const f32x4*)(PO + (size_t)r * 16 + head * 4); rsv[ai][m] = rs2[r]; }
#pragma unroll
        for (int ai = 0; ai < 2; ++ai) { u32x4 ov[4][2];
#pragma unroll
            for (int m = 0; m < 4; ++m)
#pragma unroll
                for (int bj = 0; bj < 2; ++bj) ov[m][bj] = *(const u32x4*)(O + (size_t)(row0 + ai * 128 + m * 16) * LDO + col0 + bj * 128);
#pragma unroll
            for (int m = 0; m < 4; ++m) { const f32x4 p = pv[ai][m]; const float ro = rsqrt_f(((p[0] + p[1]) + (p[2] + p[3])) * (1.0f / 512.0f) + EPS), rs = rsv[ai][m], k1 = -rs * LOG2E, c2 = rs * ro;
#pragma unroll
                for (int bj = 0; bj < 2; ++bj) { const u32x4 o4 = ov[m][bj]; const float o[8] = {bflo(o4.x), bfhi(o4.x), bflo(o4.y), bfhi(o4.y), bflo(o4.z), bfhi(o4.z), bflo(o4.w), bfhi(o4.w)}; float a[8];
#pragma unroll
                    for (int j = 0; j < 8; ++j) { const float av = acc[ai][bj][m][j >> 2][j & 3]; a[j] = (av * c2) * o[j] * rcp_f(1.0f + __builtin_amdgcn_exp2f(av * k1)); }
                    *(u32x4*)(O + (size_t)(row0 + ai * 128 + m * 16) * LDO + col0 + bj * 128) = (u32x4){pk2(a[0], a[1]), pk2(a[2], a[3]), pk2(a[4], a[5]), pk2(a[6], a[7])}; } } }
    }
};
struct EpiM3 {
    static constexpr bool PERM = true;
    const float* SR; bf16_t* HID; int* tcnt;
    __device__ __forceinline__ void operator()(AccRef acc, const Unit& u, int wr, int wc, int fr, int fq) const {
        const int row0 = u.pm * 256 + wr * 64 + fr, col0 = u.pn * 128 + wc * 32 + 8 * fq; float rsv[2][4];
#pragma unroll
        EPI_LOOP_AI_M rsv[ai][m] = SR[row0 + ai * 128 + m * 16];
#pragma unroll
        EPI_LOOP_AI_M { const int r = row0 + ai * 128 + m * 16; const float rs = rsv[ai][m], k1 = -rs * LOG2E, rs2_ = rs * rs; float hh[8];
#pragma unroll
            for (int j = 0; j < 8; ++j) { const float ag = acc[ai][0][m][j >> 2][j & 3], au = acc[ai][1][m][j >> 2][j & 3]; hh[j] = (ag * au) * rs2_ * rcp_f(1.0f + __builtin_amdgcn_exp2f(ag * k1)); }
            u32x4 w; w.x = pk2(hh[0], hh[1]); w.y = pk2(hh[2], hh[3]); w.z = pk2(hh[4], hh[5]); w.w = pk2(hh[6], hh[7]);
            { bf16_t* hp = HID + (size_t)r * 512 + col0; asm volatile("global_store_dwordx4 %0, %1, off sc1\n\ts_nop 1" :: "v"(hp), "v"(w) : "memory"); } }
        asm volatile("s_waitcnt vmcnt(0)" ::: "memory");
        if (fr == 0 && fq == 0) __hip_atomic_fetch_add(tcnt + u.pm * 16, 1, __ATOMIC_RELAXED, __HIP_MEMORY_SCOPE_AGENT);
    }
};
struct EpiM4 {
    static constexpr bool PERM = true;
    const float* SW; bf16_t* YS;
    __device__ __forceinline__ void operator()(AccRef acc, const Unit& u, int wr, int wc, int fr, int fq) const {
        const int row0 = u.pm * 256 + wr * 64 + fr, col0 = u.pn * 256 + wc * 32 + 8 * fq; float swv[2][4];
#pragma unroll
        EPI_LOOP_AI_M swv[ai][m] = SW[row0 + ai * 128 + m * 16];
#pragma unroll
        EPI_LOOP_AI_M { const int r = row0 + ai * 128 + m * 16; const float sw = swv[ai][m];
#pragma unroll
            for (int bj = 0; bj < 2; ++bj) { const f32x4 a = acc[ai][bj][m][0] * sw, b = acc[ai][bj][m][1] * sw; u32x4 w; w.x = pk2(a[0], a[1]); w.y = pk2(a[2], a[3]); w.z = pk2(b[0], b[1]); w.w = pk2(b[2], b[3]);
                *(u32x4*)(YS + (size_t)r * 1024 + col0 + bj * 128) = w; } }
    }
};

__device__ __forceinline__ int crow(int r, int hi) { return (r & 3) + 8 * (r >> 2) + 4 * hi; }
template <int DQK, bool FOX>
__device__ __forceinline__ void attn_unit(int wave_, LAS unsigned char* L, const bf16_t* Qb, int ldq, const bf16_t* Kb, int ldk, const bf16_t* Vtb, const float* cum, const float* knrm, bf16_t* Ob, int ldo, int qb) {
    constexpr int KP = DQK + 8, KBYTES = 64 * KP * 2, VBYTES = 64 * 136, BUF = KBYTES + VBYTES + 256, NS = DQK / 16, NSE = FOX ? 2 : 3, KCH = DQK / 8;
    constexpr int XOFF = 3 * BUF;
    constexpr float THR = 8.0f;
    const int tid = wave_ * 64 + lane_id_opaque();
    const int lane = tid & 63, w = wave_, r32 = lane & 31, hi = lane >> 5;
    const int R0 = 256 * qb + 32 * w, q = R0 + r32, NT = 4 * qb + 4, jmax = 4 * qb + (w >> 1);
    bf16x8 qf[NS];
#pragma unroll
    for (int s = 0; s < NS; ++s) qf[s] = *(const bf16x8*)(Qb + (size_t)q * ldq + 16 * s + 8 * hi);
    const float cq = FOX ? cum[q] : 0.f;
    int j0 = 0;
    if (FOX) {
        float n2 = 0.f;
#pragma unroll
        for (int s = 0; s < NS; ++s)
#pragma unroll
            for (int e = 0; e < 8; ++e) { const float x = bf2f((unsigned short)qf[s][e]); n2 += x * x; }
        n2 += __shfl_xor(n2, 32);
#pragma unroll
        for (int o = 1; o < 32; o <<= 1) n2 = fmaxf(n2, __shfl_xor(n2, o));
        LAS float* xs = (LAS float*)(L + XOFF); LAS int* xj = (LAS int*)(L + XOFF + 32);
        if (lane == 0) xs[w] = n2;
        if (tid == 0) xj[0] = 4 * qb;
        __syncthreads();
        float qn = xs[0];
#pragma unroll
        for (int i = 1; i < 8; ++i) qn = fmaxf(qn, xs[i]);
        qn = sqrtf(qn) * 1.01f;
        if (tid < NT) { const float bound = qn * knrm[tid] * 1.01f + cum[256 * qb] - cum[64 * tid + 63]; if (bound >= -160.0f) atomicMin((int*)xj, tid); }
        __syncthreads();
        j0 = xj[0];
    }
    f32x16 o0 = {}, o1 = {}; float mhat = 0.f, lrun = 0.f;
    const int kr0 = tid / KCH, kc0 = tid % KCH, kr1 = (tid + 512) / KCH, kc1 = (tid + 512) % KCH; const bool has1 = (tid + 512) < 64 * KCH;
    const int ve = tid >> 3, vc = tid & 7;
    u32x4 kreg0A, kreg1A = {}, vregA, kreg0B, kreg1B = {}, vregB; float ckregA = 0.f, ckregB = 0.f;
    const int kr1c = has1 ? kr1 : kr0, kc1c = has1 ? kc1 : kc0; const int ckl = tid & 63;
#define ATT_SLOT(i) (((i) % 3) * BUF)
#define ATT_LOADK(j, X) do { const int j_ = (j) < NT ? (j) : NT - 1; kreg0##X = *(const u32x4*)(Kb + (size_t)(64 * j_ + kr0) * ldk + kc0 * 8); if (DQK > 64) kreg1##X = *(const u32x4*)(Kb + (size_t)(64 * j_ + kr1c) * ldk + kc1c * 8); \
        if (FOX) ckreg##X = cum[64 * j_ + ckl]; } while (0)
#define ATT_LOADV(j, X) do { const int j_ = (j) < NT ? (j) : NT - 1; vreg##X = *(const u32x4*)(Vtb + (size_t)j_ * 4096 + ve * 64 + vc * 8); } while (0)
#define ATT_WRITEK(bo, X) do { *(LAS u32x4*)(L + (bo) + kr0 * (KP * 2) + kc0 * 16) = kreg0##X; if (DQK > 64) { if (has1) *(LAS u32x4*)(L + (bo) + kr1 * (KP * 2) + kc1 * 16) = kreg1##X; } \
        if (FOX && tid < 64) *(LAS float*)(L + (bo) + KBYTES + VBYTES + tid * 4) = ckreg##X; } while (0)
#define ATT_WRITEV(bo, X) do { *(LAS u32x2*)(L + (bo) + KBYTES + ve * 136 + vc * 16) = (u32x2){vreg##X.x, vreg##X.y}; *(LAS u32x2*)(L + (bo) + KBYTES + ve * 136 + vc * 16 + 8) = (u32x2){vreg##X.z, vreg##X.w}; } while (0)
    bf16x8 kf[2 * NS]; f32x4 ckv[8]; u32x2 vfr[16]; f32x16 s0, s1; u32x4 pw[4]; float rm = 0.f;
    f32x16 negm; _Pragma("unroll") for (int r = 0; r < 16; ++r) negm[r] = 0.f;
#define ATT_QK_ISSUE_A(bo) do {   \
        _Pragma("unroll") for (int s = 0; s < NSE; ++s) { kf[2 * s] = *(const LAS bf16x8*)(L + (bo) + r32 * (KP * 2) + (16 * s + 8 * hi) * 2); kf[2 * s + 1] = *(const LAS bf16x8*)(L + (bo) + (32 + r32) * (KP * 2) + (16 * s + 8 * hi) * 2); } } while (0)
#define ATT_QK_ISSUE_B(bo) do { \
        if (FOX) { _Pragma("unroll") for (int g = 0; g < 4; ++g) { ckv[g] = *(const LAS f32x4*)(L + (bo) + KBYTES + VBYTES + (8 * g + 4 * hi) * 4); ckv[4 + g] = *(const LAS f32x4*)(L + (bo) + KBYTES + VBYTES + (32 + 8 * g + 4 * hi) * 4); } } \
        _Pragma("unroll") for (int s = NSE; s < NS; ++s) { kf[2 * s] = *(const LAS bf16x8*)(L + (bo) + r32 * (KP * 2) + (16 * s + 8 * hi) * 2); kf[2 * s + 1] = *(const LAS bf16x8*)(L + (bo) + (32 + r32) * (KP * 2) + (16 * s + 8 * hi) * 2); } } while (0)
#define ATT_QK_ISSUE(bo) do { ATT_QK_ISSUE_A(bo); ATT_QK_ISSUE_B(bo); } while (0)
#define ATT_QK_MMA(S0, S1) do { \
        if (FOX) { const float cqm = cq - mhat; \
            _Pragma("unroll") for (int g = 0; g < 4; ++g) { _Pragma("unroll") for (int e = 0; e < 4; ++e) { S0[4 * g + e] = cqm - ckv[g][e]; S1[4 * g + e] = cqm - ckv[4 + g][e]; } } \
        } \
        __builtin_amdgcn_s_setprio(1); _Pragma("unroll") for (int s = 0; s < NS; ++s) { S0 = __builtin_amdgcn_mfma_f32_32x32x16_bf16(kf[2 * s], qf[s], (!FOX && s == 0) ? negm : S0, 0, 0, 0); S1 = __builtin_amdgcn_mfma_f32_32x32x16_bf16(kf[2 * s + 1], qf[s], (!FOX && s == 0) ? negm : S1, 0, 0, 0); } __builtin_amdgcn_s_setprio(0); } while (0)
#define ATT_PV_ISSUE(bo, h) do { _Pragma("unroll") for (int ks = 2 * (h); ks < 2 * (h) + 2; ++ks) { const LAS unsigned char* vb = L + (bo) + KBYTES + r32 * 136 + 32 * ks + 8 * hi; \
            vfr[4 * ks] = *(const LAS u32x2*)(vb); vfr[4 * ks + 1] = *(const LAS u32x2*)(vb + 16); vfr[4 * ks + 2] = *(const LAS u32x2*)(vb + 32 * 136); vfr[4 * ks + 3] = *(const LAS u32x2*)(vb + 32 * 136 + 16); } } while (0)
#define ATT_PV_MMA(h) do { __builtin_amdgcn_s_setprio(1); _Pragma("unroll") for (int ks = 2 * (h); ks < 2 * (h) + 2; ++ks) { \
            const bf16x8 va = __builtin_bit_cast(bf16x8, (u32x4){vfr[4 * ks].x, vfr[4 * ks].y, vfr[4 * ks + 1].x, vfr[4 * ks + 1].y}), vbb = __builtin_bit_cast(bf16x8, (u32x4){vfr[4 * ks + 2].x, vfr[4 * ks + 2].y, vfr[4 * ks + 3].x, vfr[4 * ks + 3].y}), pf = __builtin_bit_cast(bf16x8, pw[ks]); \
            o0 = __builtin_amdgcn_mfma_f32_32x32x16_bf16(va, pf, o0, 0, 0, 0); o1 = __builtin_amdgcn_mfma_f32_32x32x16_bf16(vbb, pf, o1, 0, 0, 0); } __builtin_amdgcn_s_setprio(0); } while (0)
#define ATT_M(t, X) do { const int t_ = (t); const bool doPV = (t_ - 1 >= j0) && (t_ - 1 <= jmax), doQK = (t_ < NT) && (t_ <= jmax); \
        if (doPV) { ATT_PV_ISSUE(ATT_SLOT(t_ - 1), 1); __builtin_amdgcn_sched_barrier(0); ATT_PV_MMA(1); __builtin_amdgcn_sched_barrier(0); }        \
        if (doQK) { ATT_QK_ISSUE(ATT_SLOT(t_)); __builtin_amdgcn_sched_barrier(0); ATT_QK_MMA(s0, s1); __builtin_amdgcn_sched_barrier(0); } \
          \
        if (t_ + 1 < NT) ATT_WRITEV(ATT_SLOT(t_ + 1), X); \
        ATT_LOADV(t_ + 3, X); } while (0)
#define ATT_X(t, X) do { const int t_ = (t); \
        if (t_ <= jmax) { \
            ATT_PV_ISSUE(ATT_SLOT(t_), 0); __builtin_amdgcn_sched_barrier(0);        \
            if (FOX && t_ == jmax) { asm volatile("" ::: "memory");   _Pragma("unroll") for (int r = 0; r < 16; ++r) { const int kg = 64 * t_ + crow(r, hi); if (kg > q) s0[r] = -1e30f; if (kg + 32 > q) s1[r] = -1e30f; } } \
            float m4_[4] = {max3_f(s0[0], s1[0], s0[1]), max3_f(s1[1], s0[2], s1[2]), max3_f(s0[3], s1[3], s0[4]), max3_f(s1[4], s0[5], s1[5])};        \
            _Pragma("unroll") for (int r = 6; r < 16; ++r) m4_[(r - 6) & 3] = max3_f(m4_[(r - 6) & 3], s0[r], s1[r]); \
            const float mx_ = max3_f(max3_f(m4_[0], m4_[1], m4_[2]), m4_[3], m4_[3]); \
            { const float sw_ = swap32(mx_); rm = max3_f(mx_, sw_, sw_); } \
            if (__any(rm > THR)) { const float dl = fmaxf(rm, 0.f), f = __builtin_amdgcn_exp2f(-dl); mhat += dl; lrun *= f; if (!FOX) { _Pragma("unroll") for (int r = 0; r < 16; ++r) negm[r] = -mhat; } \
                _Pragma("unroll") for (int r = 0; r < 16; ++r) { s0[r] -= dl; s1[r] -= dl; o0[r] *= f; o1[r] *= f; } } \
            _Pragma("unroll") for (int r = 0; r < 16; ++r) { s0[r] = __builtin_amdgcn_exp2f(s0[r]); s1[r] = __builtin_amdgcn_exp2f(s1[r]); } \
            __builtin_amdgcn_sched_barrier(0); asm volatile("s_nop 1" ::: "memory"); __builtin_amdgcn_sched_barrier(0);        \
            { float l4_[4] = {add_f(s0[0], s1[0]), add_f(s0[1], s1[1]), add_f(s0[2], s1[2]), add_f(s0[3], s1[3])};        \
              _Pragma("unroll") for (int r = 4; r < 16; ++r) { l4_[r & 3] = add_f(l4_[r & 3], s0[r]); l4_[(r + 2) & 3] = add_f(l4_[(r + 2) & 3], s1[r]); } \
              lrun += (l4_[0] + l4_[1]) + (l4_[2] + l4_[3]); } \
            _Pragma("unroll") for (int ks = 0; ks < 4; ++ks) { const int b_ = 8 * (ks & 1); \
                if (ks < 2) pw[ks] = (u32x4){pk2(s0[b_], s0[b_ + 1]), pk2(s0[b_ + 2], s0[b_ + 3]), pk2(s0[b_ + 4], s0[b_ + 5]), pk2(s0[b_ + 6], s0[b_ + 7])}; \
                else        pw[ks] = (u32x4){pk2(s1[b_], s1[b_ + 1]), pk2(s1[b_ + 2], s1[b_ + 3]), pk2(s1[b_ + 4], s1[b_ + 5]), pk2(s1[b_ + 6], s1[b_ + 7])}; } \
            __builtin_amdgcn_sched_barrier(0); asm volatile("s_nop 7" ::: "memory"); __builtin_amdgcn_sched_barrier(0);        \
            ATT_PV_MMA(0); __builtin_amdgcn_sched_barrier(0); }        \
          \
        if (t_ + 2 < NT) ATT_WRITEK(ATT_SLOT(t_ + 2), X); \
        ATT_LOADK(t_ + 4, X); \
        } while (0)
    ATT_LOADK(j0, A); ATT_LOADV(j0, A); ATT_LOADK(j0 + 1, B);
    ATT_WRITEK(ATT_SLOT(j0), A); ATT_WRITEV(ATT_SLOT(j0), A); ATT_WRITEK(ATT_SLOT(j0 + 1), B);
    ATT_LOADK(j0 + 2, A); ATT_LOADV(j0 + 1, A); ATT_LOADK(j0 + 3, B); ATT_LOADV(j0 + 2, B);
    __syncthreads();
    const int grp = w >> 2;
    if (grp == 1) __syncthreads();
    for (int t = j0; t < NT; t += 2) {
        ATT_M(t, A); __syncthreads(); ATT_X(t, A); __syncthreads();
        if (t + 1 < NT) { ATT_M(t + 1, B); __syncthreads(); ATT_X(t + 1, B); __syncthreads(); }
    }
    ATT_M(NT, A);
    if (grp == 0) __syncthreads();
    __syncthreads();
#undef ATT_SLOT
#undef ATT_LOADK
#undef ATT_LOADV
#undef ATT_WRITEK
#undef ATT_WRITEV
#undef ATT_QK_ISSUE
#undef ATT_QK_MMA
#undef ATT_PV_ISSUE
#undef ATT_PV_MMA
#undef ATT_M
#undef ATT_QK_ISSUE_A
#undef ATT_QK_ISSUE_B
#undef ATT_X
    const float inv = rcp_f(lrun + swap32(lrun));
    unsigned gw_[8][2];
#pragma unroll
    for (int g = 0; g < 4; ++g) { gw_[g][0] = pk2(o0[4 * g] * inv, o0[4 * g + 1] * inv); gw_[g][1] = pk2(o0[4 * g + 2] * inv, o0[4 * g + 3] * inv);
        gw_[4 + g][0] = pk2(o1[4 * g] * inv, o1[4 * g + 1] * inv); gw_[4 + g][1] = pk2(o1[4 * g + 2] * inv, o1[4 * g + 3] * inv); }
    __builtin_amdgcn_sched_barrier(0); asm volatile("s_nop 1" ::: "memory"); __builtin_amdgcn_sched_barrier(0);
    bf16_t* op = Ob + (size_t)q * ldo + 8 * hi;
#pragma unroll
    for (int k = 0; k < 8; k += 2) {
        const auto r0 = __builtin_amdgcn_permlane32_swap(gw_[k][0], gw_[k + 1][0], false, false); const auto r1 = __builtin_amdgcn_permlane32_swap(gw_[k][1], gw_[k + 1][1], false, false);
        *(u32x4*)(op + 8 * k) = (u32x4){r0[0], r1[0], r0[1], r1[1]}; }
}
__device__ __forceinline__ void fox_knorm(int gw, int ngw, int lane, const bf16_t* KF, float* KNRM) {
    for (int it = gw; it < 16 * 256; it += ngw) { const int bh = it >> 8, j = it & 255, b = bh >> 3, h = bh & 7;
        const u32x4* kp = (const u32x4*)(KF + ((size_t)b * S + 64 * j + lane) * 512 + h * 64); float n2 = 0.f;
#pragma unroll
        for (int c = 0; c < 8; ++c) { const u32x4 v = kp[c]; const unsigned ww[4] = {v.x, v.y, v.z, v.w};
#pragma unroll
            for (int e = 0; e < 4; ++e) { const float a = bflo(ww[e]), bb = bfhi(ww[e]); n2 += a * a + bb * bb; } }
#pragma unroll
        for (int o = 1; o < 64; o <<= 1) n2 = fmaxf(n2, __shfl_xor(n2, o));
        if (lane == 0) KNRM[it] = sqrtf(n2); }
}

constexpr int RT_KZP = 160;
constexpr int RT_QP = 544;
constexpr int RT_OFF_KZ = 0, RT_OFF_Q = 256 * RT_KZP, RT_OFF_K = RT_OFF_Q + 64 * RT_QP, RT_OFF_P = RT_OFF_K + 64 * RT_QP, RT_OFF_SS = RT_OFF_P + 64 * RT_KZP, RT_OFF_OT = RT_OFF_SS + 64 * 8 * 4, RT_LDS = RT_OFF_OT + 64 * 272;
static_assert(RT_LDS <= 147456 - 256, "retention LDS");

__device__ __forceinline__ void ret_local(int wave_, LAS unsigned char* L, const bf16_t* KZT, const bf16_t* VT, f32x4* Lout, int u) {
    const int tid = wave_ * 64 + lane_id_opaque();
    const int lane = tid & 63, w = __builtin_amdgcn_readfirstlane(tid >> 6), l15 = lane & 15, g = lane >> 4;
    const int h = u >> 6, seg = (u >> 2) & 15, eb = u & 3, E0 = eb * 128 + w * 16;
    const float gc = __builtin_exp2f(64.0f * log2_gamma(h));
    f32x4 st[16];
#pragma unroll
    for (int i = 0; i < 16; ++i) st[i] = (f32x4){0.f, 0.f, 0.f, 0.f};
    u32x4 kz[4];
    const bf16_t* kzb = KZT + (size_t)(h * 256 + seg * SEGC) * 256 * 64;
#define R1_LOAD(ci) do { _Pragma("unroll") for (int i = 0; i < 4; ++i) kz[i] = *(const u32x4*)(kzb + (size_t)(ci) * 16384 + (size_t)(tid + 512 * i) * 8); } while (0)
#define R1_WRITE(bo) do { _Pragma("unroll") for (int i = 0; i < 4; ++i) { const int id = tid + 512 * i; *(LAS u32x4*)(L + (bo) + (id >> 3) * RT_KZP + (id & 7) * 16) = kz[i]; } } while (0)
    R1_LOAD(0);
    const bf16_t* vp0 = VT + ((size_t)(h * 256 + seg * SEGC) * 512 + E0 + l15) * 64 + 8 * g;
    bf16x8 vn0 = *(const bf16x8*)vp0, vn1 = *(const bf16x8*)(vp0 + 32);
    for (int ci = 0; ci < SEGC; ++ci) { const int bo = (ci & 1) * (256 * RT_KZP);
        R1_WRITE(bo); __syncthreads();
        const bf16x8 vf0 = vn0, vf1 = vn1;
        if (ci + 1 < SEGC) { R1_LOAD(ci + 1); vn0 = *(const bf16x8*)(vp0 + (size_t)(ci + 1) * 32768); vn1 = *(const bf16x8*)(vp0 + (size_t)(ci + 1) * 32768 + 32); }
        if (ci > 0) {
#pragma unroll
            for (int i = 0; i < 16; ++i) st[i] *= gc; }
#pragma unroll
        for (int dt = 0; dt < 16; ++dt) st[dt] = __builtin_amdgcn_mfma_f32_16x16x32_bf16(*(const LAS bf16x8*)(L + bo + (16 * dt + l15) * RT_KZP + 16 * g), vf0, st[dt], 0, 0, 0);
#pragma unroll
        for (int dt = 0; dt < 16; ++dt) st[dt] = __builtin_amdgcn_mfma_f32_16x16x32_bf16(*(const LAS bf16x8*)(L + bo + (16 * dt + l15) * RT_KZP + 16 * g + 64), vf1, st[dt], 0, 0, 0);
    }
    __syncthreads();
#undef R1_LOAD
#undef R1_WRITE
    __builtin_amdgcn_sched_barrier(0); asm volatile("s_nop 7\n\ts_nop 7\n\ts_nop 7" ::: "memory"); __builtin_amdgcn_sched_barrier(0);
    u32x4* lo = (u32x4*)Lout + ((size_t)(u * 8 + w) * 8) * 64 + lane;
#pragma unroll
    for (int p = 0; p < 8; ++p) lo[p * 64] = (u32x4){pk2(st[2 * p][0], st[2 * p][1]), pk2(st[2 * p][2], st[2 * p][3]), pk2(st[2 * p + 1][0], st[2 * p + 1][1]), pk2(st[2 * p + 1][2], st[2 * p + 1][3])};
}

__device__ __forceinline__ void ret_scan(int wave_, LAS unsigned char* L, const bf16_t* QX, const bf16_t* KN, const bf16_t* KZT, const bf16_t* VT, const f32x4* Lin, bf16_t* O  , float* PO  , int u) {
    const int tid = wave_ * 64 + lane_id_opaque();
    const int lane = tid & 63, w = __builtin_amdgcn_readfirstlane(tid >> 6), l15 = lane & 15, g = lane >> 4;
    const int h = u >> 6, seg = (u >> 2) & 15, eb = u & 3, E0 = eb * 128 + w * 16;
    const float l2g = log2_gamma(h), gc = __builtin_exp2f(64.0f * l2g);
    f32x4 st[16];
#pragma unroll
    for (int i = 0; i < 16; ++i) st[i] = (f32x4){0.f, 0.f, 0.f, 0.f};
    if (seg > 0) {
        const u32x4* pi_ = (const u32x4*)Lin + (32 * MiB / 2 / 16) + ((size_t)(u * 8 + w) * 8) * 64 + lane;
#pragma unroll
        for (int p = 0; p < 8; ++p) { const u32x4 v_ = pi_[p * 64];
            st[2 * p] = (f32x4){bflo(v_.x), bfhi(v_.x), bflo(v_.y), bfhi(v_.y)}; st[2 * p + 1] = (f32x4){bflo(v_.z), bfhi(v_.z), bflo(v_.w), bfhi(v_.w)}; }
    }
    u32x4 kz[4], qx[4], kn[4];
    const bf16_t* kzb = KZT + (size_t)(h * 256 + seg * SEGC) * 256 * 64;
    const bf16_t* qb = QX + (size_t)(seg * SEGC * 64) * 1024 + h * 256; const bf16_t* kb = KN + (size_t)(seg * SEGC * 64) * 1024 + h * 256;
#define R2_LOADKZ(ci) do { _Pragma("unroll") for (int i = 0; i < 4; ++i) { const int id = tid + 512 * i; kz[i] = *(const u32x4*)(kzb + (size_t)(ci) * 16384 + (size_t)id * 8); } } while (0)
#define R2_LOADQK(ci) do { _Pragma("unroll") for (int i = 0; i < 4; ++i) { const int id = tid + 512 * i; \
        qx[i] = *(const u32x4*)(qb + (size_t)((ci) * 64 + (id >> 5)) * 1024 + (id & 31) * 8); kn[i] = *(const u32x4*)(kb + (size_t)((ci) * 64 + (id >> 5)) * 1024 + (id & 31) * 8); } } while (0)
#define R2_WRITE() do { _Pragma("unroll") for (int i = 0; i < 4; ++i) { const int id = tid + 512 * i; *(LAS u32x4*)(L + RT_OFF_KZ + (id >> 3) * RT_KZP + (id & 7) * 16) = kz[i]; \
        *(LAS u32x4*)(L + RT_OFF_Q + (id >> 5) * RT_QP + (id & 31) * 16) = qx[i]; *(LAS u32x4*)(L + RT_OFF_K + (id >> 5) * RT_QP + (id & 31) * 16) = kn[i]; } } while (0)
    R2_LOADKZ(0); R2_LOADQK(0);
    const int tr = w >> 1;
    const bf16_t* vp0 = VT + ((size_t)(h * 256 + seg * SEGC) * 512 + E0 + l15) * 64 + 8 * g;
    bf16x8 vn0 = *(const bf16x8*)vp0, vn1 = *(const bf16x8*)(vp0 + 32);
    for (int ci = 0; ci < SEGC; ++ci) {
        R2_WRITE(); __syncthreads();
        const bf16x8 vf0 = vn0, vf1 = vn1;
        if (ci + 1 < SEGC) { R2_LOADKZ(ci + 1); R2_LOADQK(ci + 1); vn0 = *(const bf16x8*)(vp0 + (size_t)(ci + 1) * 32768); vn1 = *(const bf16x8*)(vp0 + (size_t)(ci + 1) * 32768 + 32); }
        const int chunk = seg * SEGC + ci;
#pragma unroll
        for (int t2 = 0; t2 < 2; ++t2) { const int tc = 2 * (w & 1) + t2; f32x4 pa = {0.f, 0.f, 0.f, 0.f};
            if (tc <= tr) {
#pragma unroll
                for (int ks = 0; ks < 8; ++ks) pa = __builtin_amdgcn_mfma_f32_16x16x32_bf16(*(const LAS bf16x8*)(L + RT_OFF_Q + (16 * tr + l15) * RT_QP + 64 * ks + 16 * g),
                                                                                           *(const LAS bf16x8*)(L + RT_OFF_K + (16 * tc + l15) * RT_QP + 64 * ks + 16 * g), pa, 0, 0, 0);
                const int cp = 16 * tc + l15; const float dk = __builtin_exp2f(-(float)(cp + 1) * l2g);
#pragma unroll
                for (int r = 0; r < 4; ++r) { const int c = 16 * tr + 4 * g + r; pa[r] = (c >= cp) ? pa[r] * dk : 0.f; } }
#pragma unroll
            for (int r = 0; r < 4; ++r) *(LAS bf16_t*)(L + RT_OFF_P + (16 * tr + 4 * g + r) * RT_KZP + (16 * tc + l15) * 2) = (bf16_t)f2bf(pa[r]); }
        __syncthreads();
        f32x4 oa[4];
#pragma unroll
        for (int mt = 0; mt < 4; ++mt) oa[mt] = (f32x4){0.f, 0.f, 0.f, 0.f};
#pragma unroll
        for (int ks = 0; ks < 8; ++ks) { const bf16x8 sbk = __builtin_bit_cast(bf16x8, (u32x4){pk2(st[2 * ks][0], st[2 * ks][1]), pk2(st[2 * ks][2], st[2 * ks][3]), pk2(st[2 * ks + 1][0], st[2 * ks + 1][1]), pk2(st[2 * ks + 1][2], st[2 * ks + 1][3])});
#pragma unroll
            for (int mt = 0; mt < 4; ++mt) oa[mt] = __builtin_amdgcn_mfma_f32_16x16x32_bf16(*(const LAS bf16x8*)(L + RT_OFF_Q + (16 * mt + l15) * RT_QP + 64 * ks + 16 * g), sbk, oa[mt], 0, 0, 0); }
#pragma unroll
        for (int mt = 0; mt < 4; ++mt) oa[mt] = __builtin_amdgcn_mfma_f32_16x16x32_bf16(*(const LAS bf16x8*)(L + RT_OFF_P + (16 * mt + l15) * RT_KZP + 16 * g), vf0, oa[mt], 0, 0, 0);
#pragma unroll
        for (int mt = 0; mt < 4; ++mt) oa[mt] = __builtin_amdgcn_mfma_f32_16x16x32_bf16(*(const LAS bf16x8*)(L + RT_OFF_P + (16 * mt + l15) * RT_KZP + 64 + 16 * g), vf1, oa[mt], 0, 0, 0);
#pragma unroll
        for (int i = 0; i < 16; ++i) st[i] *= gc;
#pragma unroll
        for (int dt = 0; dt < 16; ++dt) st[dt] = __builtin_amdgcn_mfma_f32_16x16x32_bf16(*(const LAS bf16x8*)(L + RT_OFF_KZ + (16 * dt + l15) * RT_KZP + 16 * g), vf0, st[dt], 0, 0, 0);
#pragma unroll
        for (int dt = 0; dt < 16; ++dt) st[dt] = __builtin_amdgcn_mfma_f32_16x16x32_bf16(*(const LAS bf16x8*)(L + RT_OFF_KZ + (16 * dt + l15) * RT_KZP + 16 * g + 64), vf1, st[dt], 0, 0, 0);
#pragma unroll
        for (int mt = 0; mt < 4; ++mt) {
#pragma unroll
            for (int r = 0; r < 4; ++r) { const int c = 16 * mt + 4 * g + r; *(LAS bf16_t*)(L + RT_OFF_OT + c * 272 + (16 * w + l15) * 2) = (bf16_t)f2bf(oa[mt][r]); } }
        __syncthreads();
#pragma unroll
        for (int i = 0; i < 2; ++i) { const int id = tid + 512 * i, row = id >> 4, ch = id & 15;
            const u32x4 v = *(const LAS u32x4*)(L + RT_OFF_OT + row * 272 + ch * 16);
            *(u32x4*)(O + (size_t)(chunk * 64 + row) * LDO + h * 512 + eb * 128 + ch * 8) = v;
            const float e0 = bflo(v.x), e1 = bfhi(v.x), e2 = bflo(v.y), e3 = bfhi(v.y), e4 = bflo(v.z), e5 = bfhi(v.z), e6 = bflo(v.w), e7 = bfhi(v.w);
            float ss = ((e0 * e0 + e1 * e1) + (e2 * e2 + e3 * e3)) + ((e4 * e4 + e5 * e5) + (e6 * e6 + e7 * e7));
            ss += __shfl_xor(ss, 1); ss += __shfl_xor(ss, 2); ss += __shfl_xor(ss, 4); ss += __shfl_xor(ss, 8);
            if (ch == 0) PO[(size_t)(chunk * 64 + row) * 16 + h * 4 + eb] = ss; }
    }
#undef R2_LOADKZ
#undef R2_LOADQK
#undef R2_WRITE
}

struct Ctx { int wave, vcu, G, gw, ngw; LAS unsigned char* lds; };
#define CTX_LANE const int lane_ = lane_id_opaque(), tid_ = C.wave * 64 + lane_

__device__ __forceinline__ void tr_load(const float* W, int ldw, int k0, int n0, int nvalid, const float* gain, float (&vv)[32], int lane) {
    const int nn_ = lane & 31, kh_ = lane >> 5;
#pragma unroll
    for (int i = 0; i < 32; ++i) vv[i] = (nn_ < nvalid) ? __builtin_nontemporal_load(W + (size_t)(k0 + 2 * i + kh_) * ldw + n0 + nn_) : 0.f;
    if (gain) {
#pragma unroll
        for (int i = 0; i < 32; ++i) vv[i] *= gain[k0 + 2 * i + kh_]; }
}
__device__ __forceinline__ void tr_finish(const float (&vv)[32], int nvalid, bf16_t* dst, int ldd, LAS float* scr, int lane) {
    const int nn_ = lane & 31, kh_ = lane >> 5;
#pragma unroll
    for (int i = 0; i < 32; ++i) scr[(2 * i + kh_) * 33 + nn_] = vv[i];
    asm volatile("s_waitcnt lgkmcnt(0)" ::: "memory");
    const int c = lane & 7;
#pragma unroll
    for (int j = 0; j < 4; ++j) { const int n = (lane >> 3) + 8 * j; const LAS float* s = scr + (8 * c) * 33 + n;
        u32x4 o; o.x = pk2(s[0], s[33]); o.y = pk2(s[2 * 33], s[3 * 33]); o.z = pk2(s[4 * 33], s[5 * 33]); o.w = pk2(s[6 * 33], s[7 * 33]);
        if (n < nvalid) *(u32x4*)(dst + (size_t)n * ldd + 8 * c) = o; }
    asm volatile("s_waitcnt lgkmcnt(0)" ::: "memory");
}
__device__ __forceinline__ void tr_item(const float* W, int ldw, int k0, int n0, int nvalid, const float* gain, bf16_t* dst, int ldd, LAS float* scr, int lane) {
    float vv[32]; tr_load(W, ldw, k0, n0, nvalid, gain, vv, lane); tr_finish(vv, nvalid, dst, ldd, scr, lane);
}
__device__ __forceinline__ void zero_rows(const Ctx& C, bf16_t* base, size_t pitch_el, int nrows, int col0, int ncol) {
    CTX_LANE;
    const int per = ncol / 8; const long n = (long)nrows * per;
    for (long i = (long)C.gw * 64 + lane_; i < n; i += (long)C.ngw * 64) { const long r = i / per; const int c = (int)(i % per); *(u32x4*)(base + (size_t)r * pitch_el + col0 + c * 8) = (u32x4){0u, 0u, 0u, 0u}; }
}
__device__ __forceinline__ void convert_moe(const Ctx& C, const Params&, int layer) {
    CTX_LANE;
    WS_OPAQUE;
    LAS float* scr = (LAS float*)(C.lds + C.wave * 16384);
    bf16_t* GU = WSP(bf16_t, OFF_WGU); bf16_t* DN = WSP(bf16_t, OFF_WDN); const float* gain = P.in[I_LN_FFN] + layer * 1024;
#define CM_DECODE(it_, W_, ldw_, k0_, n0_, g_, dst_, ldd_) do { const int e = (it_) / 768, r = (it_) % 768; \
        if (r < 512) { const int up = r >> 8, rr = r & 255, kb = rr >> 4, nb = rr & 15, n0 = 32 * nb; W_ = (up ? P.in[I_W_UP] : P.in[I_W_GATE]) + (size_t)(layer * 32 + e) * 1024 * 512; \
            const int drow = 256 * (n0 >> 7) + (n0 & 127) + up * 128; ldw_ = 512; k0_ = 64 * kb; n0_ = n0; g_ = gain; dst_ = GU + ((size_t)(e * 1024 + drow) * 1024 + 64 * kb); ldd_ = 1024; } \
        else { const int rr = r - 512, kb = rr >> 5, nb = rr & 31; W_ = P.in[I_W_DOWN] + (size_t)(layer * 32 + e) * 512 * 1024; \
            ldw_ = 1024; k0_ = 64 * kb; n0_ = 32 * nb; g_ = nullptr; dst_ = DN + ((size_t)(e * 1024 + 32 * nb) * 512 + 64 * kb); ldd_ = 512; } } while (0)
    float va[32], vb[32]; const float* Wc; const float* gc_; bf16_t* dc; int ldwc, k0c, n0c, lddc;
    int it = C.gw;
    if (it < 32 * 768) { CM_DECODE(it, Wc, ldwc, k0c, n0c, gc_, dc, lddc); tr_load(Wc, ldwc, k0c, n0c, 32, gc_, va, lane_); }
    for (; it < 32 * 768; it += C.ngw) { const int nx = it + C.ngw; const float* Wn = Wc; const float* gn = gc_; bf16_t* dn = dc; int ldwn = ldwc, k0n = k0c, n0n = n0c, lddn = lddc;
        if (nx < 32 * 768) { CM_DECODE(nx, Wn, ldwn, k0n, n0n, gn, dn, lddn); tr_load(Wn, ldwn, k0n, n0n, 32, gn, vb, lane_); }
        tr_finish(va, 32, dc, lddc, scr, lane_);
#pragma unroll
        for (int i = 0; i < 32; ++i) va[i] = vb[i];
        Wc = Wn; gc_ = gn; dc = dn; ldwc = ldwn; k0c = k0n; n0c = n0n; lddc = lddn; }
#undef CM_DECODE
}
__device__ __forceinline__ void convert_mixer(const Ctx& C, const Params&) {
    CTX_LANE;
    WS_OPAQUE;
    LAS float* scr = (LAS float*)(C.lds + C.wave * 16384);
    bf16_t* WA1 = WSP(bf16_t, W_A1); bf16_t* WA1V = WSP(bf16_t, W_A1V); bf16_t* WA2 = WSP(bf16_t, W_A2); bf16_t* WA2V = WSP(bf16_t, W_A2V);
    bf16_t* WOE = WSP(bf16_t, W_OE); bf16_t* WB1 = WSP(bf16_t, W_B1); bf16_t* WOO = WSP(bf16_t, W_OO);
    constexpr int N1 = 16 * 62, N2 = 4 * 24, N3 = 2 * 32, N4 = 16 * 32, N5 = 16 * 192, N6 = 32 * 32, NT_ = N1 + N2 + N3 + N4 + N5 + N6;
    for (int it = C.gw; it < NT_; it += C.ngw) { int r = it;
        if (r < N1) { const int kb = r / 62, nb = r % 62, n0 = 32 * nb, k0 = 64 * kb; bf16_t* dst; int nv = 32;
            if (n0 < 416) dst = WA1 + (size_t)n0 * 1024; else if (n0 < 928) dst = WA1 + (size_t)(512 + n0 - 416) * 1024; else if (n0 < 1440) dst = WA1 + (size_t)(1024 + n0 - 928) * 1024;
            else if (n0 < 1952) dst = WA1V + (size_t)(n0 - 1440) * 1024; else { dst = WA1 + (size_t)416 * 1024; nv = 8; }
            tr_item(P.in[I_W_IN_E], 1960, k0, n0, nv, P.in[I_LN_MIX_E], dst + k0, 1024, scr, lane_); continue; } r -= N1;
        if (r < N2) { const int kb = r / 24, nb = r % 24, n0 = 32 * nb, hh = n0 / 96, off = n0 % 96;
            tr_item(P.in[I_W_UQ], 768, 64 * kb, n0, 32, P.in[I_LN_Q], WA2 + (size_t)(128 * hh + off) * 256 + 64 * kb, 256, scr, lane_); continue; } r -= N2;
        if (r < N3) { const int kb = r / 32, nb = r % 32, n0 = 32 * nb, hh = n0 / 128, off = n0 % 128;
            bf16_t* dst = off < 64 ? WA2 + (size_t)(1024 + 64 * hh + off) * 256 : WA2V + (size_t)(64 * hh + off - 64) * 256;
            tr_item(P.in[I_W_UKV], 1024, 64 * kb, n0, 32, P.in[I_LN_KV], dst + 64 * kb, 256, scr, lane_); continue; } r -= N3;
        if (r < N4) { const int kb = r / 32, nb = r % 32; tr_item(P.in[I_W_OUT_E], 1024, 64 * kb, 32 * nb, 32, nullptr, WOE + (size_t)(32 * nb) * 1024 + 64 * kb, 1024, scr, lane_); continue; } r -= N4;
        if (r < N5) { const int kb = r / 192, nb = r % 192; tr_item(P.in[I_W_IN_O], 6144, 64 * kb, 32 * nb, 32, P.in[I_LN_MIX_O], WB1 + (size_t)(32 * nb) * 1024 + 64 * kb, 1024, scr, lane_); continue; } r -= N5;
        { const int kb = r / 32, nb = r % 32; tr_item(P.in[I_W_OUT_O], 1024, 64 * kb, 32 * nb, 32, nullptr, WOO + (size_t)(32 * nb) * LDO + 64 * kb, LDO, scr, lane_); } }
    zero_rows(C, WA1 + (size_t)424 * 1024, 1024, 88, 0, 1024);
    for (int hh = 0; hh < 8; ++hh) zero_rows(C, WA2 + (size_t)(128 * hh + 96) * 256, 256, 32, 0, 256);
    zero_rows(C, WA2 + (size_t)1024 * 256, 256, 512, 128, 128);
    zero_rows(C, WA2V, 256, 512, 128, 128);
}
__device__ __forceinline__ void make_rope(const Ctx& C, const Params&) {
    CTX_LANE;
    WS_OPAQUE;
    f32x2* rope = WSP(f32x2, OFF_ROPE);
    for (int i = C.gw * 64 + lane_; i < S * 128; i += C.ngw * 64) { const int pos = i >> 7, k = i & 127; const float inv = __builtin_exp2f(-(float)k * (13.287712379549449f / 128.0f));
        const float ang = (float)pos * inv; float sn, cs; sincosf(ang, &sn, &cs); rope[i] = (f32x2){cs, sn}; }
}
__device__ __forceinline__ void rows_to_bf16(const Ctx& C, const float* X, bf16_t* XB, float* RS) {
    CTX_LANE;
    for (int r0 = C.gw; r0 < T; r0 += 8 * C.ngw) { f32x4 v[8][4];
#pragma unroll
        for (int q = 0; q < 8; ++q) { const int r = r0 + q * C.ngw; const f32x4* xr = (const f32x4*)(X + (size_t)(r < T ? r : r0) * D) + lane_;
#pragma unroll
            for (int j = 0; j < 4; ++j) v[q][j] = __builtin_nontemporal_load(xr + 64 * j); }
#pragma unroll
        for (int q = 0; q < 8; ++q) { const int r = r0 + q * C.ngw; if (r >= T) break; float s = 0.f;
#pragma unroll
            for (int j = 0; j < 4; ++j) s += (v[q][j][0] * v[q][j][0] + v[q][j][1] * v[q][j][1]) + (v[q][j][2] * v[q][j][2] + v[q][j][3] * v[q][j][3]);
            s = wave_sum(s); u32x2* o = (u32x2*)(XB + (size_t)r * D) + lane_;
#pragma unroll
            for (int j = 0; j < 4; ++j) o[64 * j] = (u32x2){pk2(v[q][j][0], v[q][j][1]), pk2(v[q][j][2], v[q][j][3])};
            if (lane_ == 0) RS[r] = rsqrt_f(s * (1.0f / D) + EPS); } }
}
__device__ __forceinline__ void fox_cumsum(const Ctx& C, const float* LF, float* CUM, int bh) {
    CTX_LANE;
    LAS float* tot = (LAS float*)C.lds; const int b = bh >> 3, h = bh & 7; float v[32]; float run = 0.f;
#pragma unroll
    for (int i = 0; i < 32; ++i) { run += LF[((size_t)b * S + tid_ * 32 + i) * 8 + h]; v[i] = run; }
    tot[tid_] = run; __syncthreads();
    float off = 0.f; for (int t2 = 0; t2 < tid_; ++t2) off += tot[t2];
#pragma unroll
    for (int i = 0; i < 32; ++i) CUM[(size_t)bh * S + tid_ * 32 + i] = (off + v[i]) * LOG2E;
    __syncthreads();
}
__device__ __forceinline__ void moe_router(const Ctx& C, const Params&, int layer, int blk, const bf16_t* XSRC) {
    CTX_LANE;
    WS_OPAQUE;
    float* RS1 = WSP(float, SM_RS1);
    int* EID = WSP(int, SM_EID); float* GATE = WSP(float, SM_GATE); int* RANK = WSP(int, SM_RANK); int* CNT = WSP(int, SM_CNT);
    const float* wrg = P.in[I_W_RG] + (size_t)layer * 1024 * 4; const float* wre = P.in[I_W_RE] + (size_t)layer * 1024 * 32; const float* lnf = P.in[I_LN_FFN] + layer * 1024;
    LAS float* lg = (LAS float*)C.lds;
    LAS float* rsl = (LAS float*)(C.lds + 128 * 40 * 4);
    LAS int* eidl = (LAS int*)(C.lds + 128 * 40 * 4 + 512);
    LAS float* slab = (LAS float*)(C.lds + 32768);
    const int l15 = lane_ & 15, kg = lane_ >> 4, kbase = 128 * C.wave + 8 * kg;
    bf16x8 bh[3][4], bl[3][4];
#pragma unroll
    for (int nt = 0; nt < 3; ++nt) { const int col = 16 * nt + l15; const int cc = col < 36 ? col : 35; const float* wp = cc < 4 ? wrg + cc : wre + (cc - 4); const int wst = cc < 4 ? 4 : 32; const float wz = col < 36 ? 1.f : 0.f;
#pragma unroll
        for (int ks = 0; ks < 4; ++ks) { float wf[8]; unsigned hp[4], lp[4];
#pragma unroll
            for (int j = 0; j < 8; ++j) { const int k = kbase + 32 * ks + j; wf[j] = lnf[k] * wp[(size_t)k * wst] * wz; }
#pragma unroll
            for (int j = 0; j < 4; ++j) { hp[j] = pk2(wf[2 * j], wf[2 * j + 1]); lp[j] = pk2(wf[2 * j] - bflo(hp[j]), wf[2 * j + 1] - bfhi(hp[j])); }
            bh[nt][ks] = __builtin_bit_cast(bf16x8, (u32x4){hp[0], hp[1], hp[2], hp[3]}); bl[nt][ks] = __builtin_bit_cast(bf16x8, (u32x4){lp[0], lp[1], lp[2], lp[3]}); } }
    u32x4 xa[4], xb[4];
#define RT_LOADX(dst, mt) do { const bf16_t* xp = XSRC + (size_t)(blk * 128 + 16 * (mt) + l15) * D + kbase; _Pragma("unroll") for (int ks = 0; ks < 4; ++ks) dst[ks] = *(const u32x4*)(xp + 32 * ks); } while (0)
#define RT_TILE(src, mt) do { f32x4 acc[3] = {{0.f, 0.f, 0.f, 0.f}, {0.f, 0.f, 0.f, 0.f}, {0.f, 0.f, 0.f, 0.f}}; float ss = 0.f; \
        _Pragma("unroll") for (int ks = 0; ks < 4; ++ks) { const u32x4 v = src[ks]; \
            const float e0 = bflo(v.x), e1 = bfhi(v.x), e2 = bflo(v.y), e3 = bfhi(v.y), e4 = bflo(v.z), e5 = bfhi(v.z), e6 = bflo(v.w), e7 = bfhi(v.w); \
            ss += ((e0 * e0 + e1 * e1) + (e2 * e2 + e3 * e3)) + ((e4 * e4 + e5 * e5) + (e6 * e6 + e7 * e7)); \
            const bf16x8 ah = __builtin_bit_cast(bf16x8, v); \
            _Pragma("unroll") for (int nt = 0; nt < 3; ++nt) { acc[nt] = __builtin_amdgcn_mfma_f32_16x16x32_bf16(ah, bh[nt][ks], acc[nt], 0, 0, 0); acc[nt] = __builtin_amdgcn_mfma_f32_16x16x32_bf16(ah, bl[nt][ks], acc[nt], 0, 0, 0); } } \
        ss += swap16(ss); ss += swap32(ss); \
        LAS float* sl = slab + (size_t)(C.wave * 64 + 16 * ((mt) & 3)) * 40; \
        _Pragma("unroll") for (int nt = 0; nt < 3; ++nt) { const int col = 16 * nt + l15; if (col < 36) { _Pragma("unroll") for (int r = 0; r < 4; ++r) sl[(4 * kg + r) * 40 + col] = acc[nt][r]; } } \
        if (kg == 0) sl[l15 * 40 + 36] = ss; } while (0)
    RT_LOADX(xa, 0);
    for (int half = 0; half < 2; ++half) {
        RT_LOADX(xb, 4 * half + 1); RT_TILE(xa, 4 * half + 0);
        RT_LOADX(xa, 4 * half + 2); RT_TILE(xb, 4 * half + 1);
        RT_LOADX(xb, 4 * half + 3); RT_TILE(xa, 4 * half + 2);
        if (half == 0) RT_LOADX(xa, 4); RT_TILE(xb, 4 * half + 3);
        __syncthreads();
        for (int it = tid_; it < 64 * 37; it += 512) { const int tt = it / 37, c = it % 37; float sm = 0.f;
#pragma unroll
            for (int w8 = 0; w8 < 8; ++w8) sm += slab[(size_t)(w8 * 64 + tt) * 40 + c];
            lg[(half * 64 + tt) * 40 + c] = sm; }
        __syncthreads();
    }
#undef RT_LOADX
#undef RT_TILE
    if (tid_ < 128) { const float rs = rsqrt_f(lg[tid_ * 40 + 36] * (1.0f / D) + EPS); rsl[tid_] = rs; RS1[blk * 128 + tid_] = rs; }
    __syncthreads();
    if (tid_ < 128) { const int tt = tid_, t = blk * 128 + tt; const float rs = rsl[tt]; const float* brg = P.in[I_B_RG] + layer * 4; const float* bre = P.in[I_B_RE] + layer * 32;
        float gl[4]; int gs = 0;
#pragma unroll
        for (int o = 0; o < 4; ++o) { gl[o] = lg[tt * 40 + o] * rs + brg[o]; if (gl[o] > gl[gs]) gs = o; }
        float gsum = 0.f;
#pragma unroll
        for (int o = 0; o < 4; ++o) gsum += __expf(gl[o] - gl[gs]);
        const float pg = 1.0f / gsum;
        float el[8]; int j1 = 0;
#pragma unroll
        for (int j = 0; j < 8; ++j) { el[j] = lg[tt * 40 + 4 + 8 * gs + j] * rs + bre[8 * gs + j]; if (el[j] > el[j1]) j1 = j; }
        int j2 = (j1 == 0) ? 1 : 0;
#pragma unroll
        for (int j = 0; j < 8; ++j) if (j != j1 && el[j] > el[j2]) j2 = j;
        const float e2 = __expf(el[j2] - el[j1]), den = 1.0f / (1.0f + e2);
        const int ea = 8 * gs + j1, eb = 8 * gs + j2;
        EID[t * 2] = ea; EID[t * 2 + 1] = eb; GATE[t * 2] = pg * den; GATE[t * 2 + 1] = pg * e2 * den; eidl[2 * tt] = ea; eidl[2 * tt + 1] = eb; }
    __syncthreads();
    if (tid_ < 256) { const int me = eidl[tid_]; int rk = 0; for (int a = 0; a < tid_; ++a) rk += (eidl[a] == me) ? 1 : 0; RANK[blk * 256 + tid_] = rk; }
    if (tid_ < 32) { int c = 0; for (int a = 0; a < 256; ++a) c += (eidl[a] == tid_) ? 1 : 0; CNT[blk * 32 + tid_] = c; }
    __syncthreads();
}
__device__ __forceinline__ void moe_scatter(const Ctx& C, const Params&, int blk, bf16_t* XS  ) {
    CTX_LANE;
    WS_OPAQUE;
    const int* CNT = WSP(int, SM_CNT); const int* EID = WSP(int, SM_EID); const float* GATE = WSP(float, SM_GATE); const int* RANK = WSP(int, SM_RANK); const float* RS1 = WSP(float, SM_RS1);
    int* TSLOT = WSP(int, SM_TSLOT); int* STOK = WSP(int, SM_STOK); float* SW = WSP(float, SM_SW); float* SR = WSP(float, SM_SR); int* TILEE = WSP(int, SM_TILEE);
    LAS int* part = (LAS int*)C.lds;
    LAS int* tot = part + 1024;
    LAS int* slotl = tot + 128;
    { const int e = tid_ & 31, pt = tid_ >> 5; int s = 0, pre = 0;
        for (int b = pt * 16; b < pt * 16 + 16; ++b) { const int c = ld_i(CNT + b * 32 + e); s += c; if (b < blk) pre += c; }
        part[pt * 32 + e] = s; part[512 + pt * 32 + e] = pre; }
    __syncthreads();
    if (tid_ < 32) { int s = 0, pre = 0; for (int pt = 0; pt < 16; ++pt) { s += part[pt * 32 + tid_]; pre += part[512 + pt * 32 + tid_]; } tot[tid_] = s; tot[32 + tid_] = pre; }
    __syncthreads();
    if (tid_ == 0) { int ps = 0; for (int e = 0; e < 32; ++e) { tot[64 + e] = ps; ps += (tot[e] + 255) & ~255; } tot[96] = ps; }
    __syncthreads();
    if (tid_ < 256) { const int a = blk * 256 + tid_, t = a >> 1, e = EID[a]; const int slot = tot[64 + e] + tot[32 + e] + RANK[a];
        slotl[tid_] = slot; TSLOT[a] = slot; STOK[slot] = t; SW[slot] = GATE[a]; SR[slot] = RS1[t]; }
    __syncthreads();
    if (blk < 32) { const int e = blk, beg = tot[64 + e] + tot[e], end = tot[64 + e] + ((tot[e] + 255) & ~255);
        for (int sl = beg + tid_; sl < end; sl += 512) { STOK[sl] = T; SW[sl] = 0.f; SR[sl] = 0.f; } }
    if (blk == 32 && tid_ < 128) ((u32x4*)(XS + (size_t)T * D))[tid_] = (u32x4){0u, 0u, 0u, 0u};
    if (blk == 0 && tid_ < 32) { const int e = tid_, t0 = tot[64 + e] >> 8, nt = ((tot[e] + 255) & ~255) >> 8; for (int i = 0; i < nt; ++i) TILEE[t0 + i] = e; if (e == 0) TILEE[300] = tot[96] >> 8; }
    __syncthreads();
}
template <int MODE> __device__ __forceinline__ void moe_combine(const Ctx& C, const Params&, const bf16_t* XSRC, float* RS, const float* gainf) {
    CTX_LANE;
    WS_OPAQUE;
    float* OUT = P.out; bf16_t* XB = WSP(bf16_t, OFF_XB); const bf16_t* YS = WSP(bf16_t, A_XS); const int* TSLOT = WSP(int, SM_TSLOT);
    int sln[4][2];
#pragma unroll
    for (int q = 0; q < 4; ++q) { const int t = C.gw + q * C.ngw; sln[q][0] = ld_i(TSLOT + 2 * t); sln[q][1] = ld_i(TSLOT + 2 * t + 1); }
    for (int t0 = C.gw; t0 < T; t0 += 4 * C.ngw) { u32x2 xv[4][4], ya[4][4], yb[4][4];
#pragma unroll
        for (int q = 0; q < 4; ++q) { const int t = t0 + q * C.ngw; const int sa = sln[q][0], sb = sln[q][1]; const u32x2* xr = (const u32x2*)(XSRC + (size_t)t * D) + lane_;
            const u32x2* pa = (const u32x2*)(YS + (size_t)sa * D) + lane_; const u32x2* pb = (const u32x2*)(YS + (size_t)sb * D) + lane_;
#pragma unroll
            for (int j = 0; j < 4; ++j) { xv[q][j] = __builtin_nontemporal_load(xr + 64 * j); ya[q][j] = __builtin_nontemporal_load(pa + 64 * j); yb[q][j] = __builtin_nontemporal_load(pb + 64 * j); } }
        if (t0 + 4 * C.ngw < T) {
#pragma unroll
            for (int q = 0; q < 4; ++q) { const int t = t0 + 4 * C.ngw + q * C.ngw; sln[q][0] = ld_i(TSLOT + 2 * t); sln[q][1] = ld_i(TSLOT + 2 * t + 1); } }
#pragma unroll
        for (int q = 0; q < 4; ++q) { const int t = t0 + q * C.ngw; f32x4 v[4]; float s = 0.f;
#pragma unroll
            for (int j = 0; j < 4; ++j) { const u32x2 x2 = xv[q][j], a = ya[q][j], b = yb[q][j];
                v[j][0] = bflo(x2.x) + (bflo(a.x) + bflo(b.x)); v[j][1] = bfhi(x2.x) + (bfhi(a.x) + bfhi(b.x)); v[j][2] = bflo(x2.y) + (bflo(a.y) + bflo(b.y)); v[j][3] = bfhi(x2.y) + (bfhi(a.y) + bfhi(b.y));
                s += (v[j][0] * v[j][0] + v[j][1] * v[j][1]) + (v[j][2] * v[j][2] + v[j][3] * v[j][3]); }
            s = wave_sum(s); const float rs = rsqrt_f(s * (1.0f / D) + EPS);
            if (MODE == 0) { u32x2* o = (u32x2*)(XB + (size_t)t * D) + lane_;
#pragma unroll
                for (int j = 0; j < 4; ++j) o[64 * j] = (u32x2){pk2(v[j][0], v[j][1]), pk2(v[j][2], v[j][3])};
                if (lane_ == 0) RS[t] = rs; }
            else { const f32x4* gr = (const f32x4*)gainf + lane_; f32x4* xo = (f32x4*)(OUT + (size_t)t * D) + lane_;
#pragma unroll
                for (int j = 0; j < 4; ++j) __builtin_nontemporal_store(v[j] * rs * gr[64 * j], xo + 64 * j); } } }
}

__device__ __forceinline__ void seg_scan(const Ctx& C, const Params&) {
    CTX_LANE;
    WS_OPAQUE;
    const int gt = C.vcu * 512 + tid_, bb = gt >> 16, rem = gt & 65535, h = rem >> 14, eb = (rem >> 12) & 3, r = rem & 4095;
    const u32x4* Lb = WSP(u32x4, A_L) + (size_t)bb * (32 * MiB / 16); u32x4* PRE = WSP(u32x4, A_L) + (size_t)bb * (32 * MiB / 16) + (32 * MiB / 2 / 16);
    const float wseg = __builtin_exp2f((float)(64 * SEGC) * log2_gamma(h));
    u32x4 lv[15];
#pragma unroll
    for (int j = 0; j < 15; ++j) lv[j] = Lb[(size_t)(h * 64 + j * 4 + eb) * 4096 + r];
    float a[8] = {0.f, 0.f, 0.f, 0.f, 0.f, 0.f, 0.f, 0.f};
#pragma unroll
    for (int j = 0; j < 15; ++j) { const u32x4 v = lv[j];
        a[0] = a[0] * wseg + bflo(v.x); a[1] = a[1] * wseg + bfhi(v.x); a[2] = a[2] * wseg + bflo(v.y); a[3] = a[3] * wseg + bfhi(v.y);
        a[4] = a[4] * wseg + bflo(v.z); a[5] = a[5] * wseg + bfhi(v.z); a[6] = a[6] * wseg + bflo(v.w); a[7] = a[7] * wseg + bfhi(v.w);
        PRE[(size_t)(h * 64 + (j + 1) * 4 + eb) * 4096 + r] = (u32x4){pk2(a[0], a[1]), pk2(a[2], a[3]), pk2(a[4], a[5]), pk2(a[6], a[7])}; }
}

constexpr int LDS_BYTES = 147456;
constexpr int LDS_MISC = LDS_BYTES - 256;
constexpr int NPHASE = 20;

__global__ void __launch_bounds__(512, 2) fwd_kernel(Params Pkern) {
    extern __shared__ __attribute__((aligned(16))) unsigned char lds_raw[];
    LAS unsigned char* lds = (LAS unsigned char*)lds_raw;
    Ctx C; { const int t0_ = threadIdx.x; C.wave = __builtin_amdgcn_readfirstlane(t0_ >> 6); } C.G = gridDim.x;
    C.vcu = (C.G % 8 == 0) ? ((int)blockIdx.x % 8) * (C.G / 8) + (int)blockIdx.x / 8 : (int)blockIdx.x;
    C.gw = C.vcu * 8 + C.wave; C.ngw = C.G * 8; C.lds = lds;
    const int bx = blockIdx.x;
    { const int l0 = lane_id_opaque(); if (C.wave == 0) ((LAS unsigned*)(lds + LDS_MISC))[l0] = 0u; }
    __syncthreads();
    const unsigned xcc = xb_xcc_id();
    if (Pkern.use_bar) { const bool t0 = (C.wave == 0) && (lane_id_opaque() == 0); (void)xcd_barrier_post((unsigned*)(Pkern.ws + OFF_CTL) + 4096, (volatile LAS unsigned*)(lds + LDS_MISC), t0); }
    const int lo = Pkern.ph_lo, hi = Pkern.ph_hi;
    const Params& P = Pkern;
#ifndef PH_MASK
#define PH_MASK 0xfffffu
#endif
#define IN(k) ((((unsigned)PH_MASK >> (k)) & 1u) && lo <= (k) && (k) < hi)
#ifndef PROBE_MASK
#define PROBE_MASK 0u
#endif
#ifdef PROBE_T
#define STAMP(i) do { if (bx == 0 && C.wave == 0 && lane_id_opaque() == 0) ((volatile LAS unsigned long long*)(lds + LDS_MISC + 64))[(i)] = __builtin_amdgcn_s_memrealtime(); } while (0)
#else
#define STAMP(i) do { } while (0)
#endif
#define REP(k) for (int rep_ = 0; rep_ < ((((unsigned)PROBE_MASK >> (k)) & 1u) ? 2 : 1); ++rep_)
#define SEAM(k) do { if (IN(k) && IN((k) + 1)) { P_OPAQUE; XcdBarrier bar; bar.bar = (unsigned*)(P.ws + OFF_CTL) + 4096; bar.x = xcc; bar.st = (volatile LAS unsigned*)(lds + LDS_MISC); \
        const bool t0 = (C.wave == 0) && (lane_id_opaque() == 0); xcd_barrier(bar, t0); } STAMP((k) + 1); } while (0)

    STAMP(0);
    if (IN(0)) REP(0) { WS_OPAQUE; convert_mixer(C, P); convert_moe(C, P, 0); make_rope(C, P); rows_to_bf16(C, P.in[I_X], WSP(bf16_t, OFF_XB), WSP(float, SM_RS0)); __syncthreads(); }
    SEAM(0);
    if (IN(1)) REP(1) {
        { WS_OPAQUE; DenseSched Sd; Sd.init(WSP(bf16_t, OFF_XB), 1024, WSP(bf16_t, W_A1), 1024, 128, 6, C.G, bx);
          EpiA1a E{WSP(float, SM_RS0), WSP(bf16_t, A_Z), WSP(float, SM_PQ), WSP(float, SM_PKV), WSP(bf16_t, A_KA), WSP(float, SM_LF), P.in[I_B_F], WSP(bf16_t, A_QF), WSP(bf16_t, A_KF), WSP(f32x2, OFF_ROPE)};
          pg8::gemm_phase(C.wave, lds, pg8::Dims{1024, 1024, 1024}, Sd, E); }
        { WS_OPAQUE; DenseSched Sd; Sd.init(WSP(bf16_t, W_A1V), 1024, WSP(bf16_t, OFF_XB), 1024, 2, 128, C.G, bx);
          EpiVT<0> E{WSP(float, SM_RS0), WSP(bf16_t, A_VTF), (size_t)T};
          pg8::gemm_phase(C.wave, lds, pg8::Dims{1024, 1024, 1024}, Sd, E); }
    }
    SEAM(1);
    if (IN(2)) REP(2) {
        if (C.vcu < 16) { WS_OPAQUE; fox_cumsum(C, WSP(float, SM_LF), WSP(float, SM_CUM), C.vcu); }
        { WS_OPAQUE; fox_knorm(C.gw, C.ngw, lane_id_opaque(), WSP(bf16_t, A_KF), WSP(float, SM_KNRM)); }
        { WS_OPAQUE; DenseSched Sd; Sd.init(WSP(bf16_t, A_Z), 512, WSP(bf16_t, W_A2), 256, 128, 4, C.G, bx);
          EpiA2q E{WSP(float, SM_PQ), WSP(bf16_t, A_QA), WSP(f32x2, OFF_ROPE)};
          pg8::gemm_phase(C.wave, lds, pg8::Dims{512, 256, 256}, Sd, E); }
        { WS_OPAQUE; DenseSched Sd; Sd.init(WSP(bf16_t, A_Z) + 256, 512, WSP(bf16_t, W_A2) + (size_t)1024 * 256, 256, 128, 2, C.G, bx);
          EpiA2k E{WSP(float, SM_PKV), WSP(bf16_t, A_KA)};
          pg8::gemm_phase(C.wave, lds, pg8::Dims{512, 256, 256}, Sd, E); }
        { WS_OPAQUE; DenseSched Sd; Sd.init(WSP(bf16_t, W_A2V), 256, WSP(bf16_t, A_Z) + 256, 512, 2, 128, C.G, bx);
          EpiVT<1> E{WSP(float, SM_PKV), WSP(bf16_t, A_VTA), (size_t)T};
          pg8::gemm_phase(C.wave, lds, pg8::Dims{256, 512, 256}, Sd, E); }
    }
    SEAM(2);
    if (IN(3)) REP(3) {
        const int bh = C.vcu >> 4, s4 = C.vcu & 15, b = bh >> 3, h = bh & 7;
        REP(23) { WS_OPAQUE; bf16_t* AO = WSP(bf16_t, OFF_XB);
          for (int i = 0; i < 4; ++i) { const int qb = (i == 0) ? s4 : (i == 1) ? 31 - s4 : (i == 2) ? 32 + s4 : 63 - s4;
            attn_unit<96, false>(C.wave, lds, WSP(bf16_t, A_QA) + (size_t)b * S * 768 + h * 96, 768, WSP(bf16_t, A_KA) + (size_t)b * S * 768 + h * 96, 768,
                                 WSP(bf16_t, A_VTA) + ((size_t)h * (T / 64) + (size_t)b * (S / 64)) * 4096, nullptr, nullptr, AO + (size_t)b * S * 1024 + h * 64, 1024, qb); } }
        REP(24) { WS_OPAQUE; bf16_t* AO = WSP(bf16_t, OFF_XB); unsigned* wctr = WSP(unsigned, OFF_CTL) + 65536 + 2 * 8192 + (C.vcu >> 5) * 16; volatile LAS int* wq = (volatile LAS int*)(lds + LDS_MISC + 48);
          (void)s4; (void)b; (void)h;
          for (;;) {
            if (C.wave == 0 && lane_id_opaque() == 0) *wq = (int)__hip_atomic_fetch_add(wctr, 1u, __ATOMIC_RELAXED, __HIP_MEMORY_SCOPE_AGENT);
            __syncthreads(); const int idx = __builtin_amdgcn_readfirstlane(*wq); __syncthreads();
            if (idx >= 128) break;
            const int qb = 63 - (idx >> 1), bh2 = 2 * (C.vcu >> 5) + (idx & 1), b2 = bh2 >> 3, h2 = bh2 & 7;
            attn_unit<64, true>(C.wave, lds, WSP(bf16_t, A_QF) + (size_t)b2 * S * 512 + h2 * 64, 512, WSP(bf16_t, A_KF) + (size_t)b2 * S * 512 + h2 * 64, 512,
                                WSP(bf16_t, A_VTF) + ((size_t)h2 * (T / 64) + (size_t)b2 * (S / 64)) * 4096, WSP(float, SM_CUM) + (size_t)bh2 * S, WSP(float, SM_KNRM) + bh2 * 256, AO + (size_t)b2 * S * 1024 + 512 + h2 * 64, 1024, qb); } }
    }
    SEAM(3);
    if (IN(4)) REP(4) { WS_OPAQUE; DenseSched Sd; Sd.init(WSP(bf16_t, OFF_XB), 1024, WSP(bf16_t, W_OE), 1024, 128, 4, C.G, bx); EpiRes<true> E{P.in[I_X], (bf16_t*)P.out};
        pg8::gemm_phase(C.wave, lds, pg8::Dims{1024, 1024, 1024}, Sd, E); }
    SEAM(4);

#define MOE_PHASES(layer, pb) do { \
        if (IN(pb)) REP(pb) { P_OPAQUE; moe_router(C, P, layer, bx, (layer) ? (const bf16_t*)(P.ws + OFF_XB) : (const bf16_t*)P.out); } \
        SEAM(pb); \
        if (IN((pb) + 1)) REP((pb) + 1) { P_OPAQUE; moe_scatter(C, P, bx, (layer) ? (bf16_t*)(P.ws + OFF_XB) : (bf16_t*)P.out); } \
        SEAM((pb) + 1); \
        if (IN((pb) + 2)) REP((pb) + 2) { WS_OPAQUE; MoeSched<true> Sm; Sm.init((layer) ? (const void*)(P.ws + OFF_XB) : (const void*)P.out, 1024, WSP(bf16_t, OFF_WGU), 1024, 1024, WSP(int, SM_TILEE), WSP(int, SM_STOK), C.G, bx); EpiM3 E{WSP(float, SM_SR), WSP(bf16_t, A_HID), WSP(int, OFF_CTL) + 65536 + (layer) * 8192}; \
            pg8::gemm_phase(C.wave, lds, pg8::Dims{1024, 1024, 1024}, Sm, E); } \
          \
        if (IN((pb) + 3)) REP((pb) + 3) { WS_OPAQUE; MoeSched<false> Sm; Sm.init(WSP(bf16_t, A_HID), 512, WSP(bf16_t, OFF_WDN), 512, 1024, WSP(int, SM_TILEE), WSP(int, SM_STOK), C.G, bx); Sm.tcnt = WSP(int, OFF_CTL) + 65536 + (layer) * 8192; EpiM4 E{WSP(float, SM_SW), WSP(bf16_t, A_XS)}; \
            pg8::gemm_phase(C.wave, lds, pg8::Dims{512, 512, 512}, Sm, E); } \
        SEAM((pb) + 3); } while (0)

    MOE_PHASES(0, 5);
    if (IN(9)) { WS_OPAQUE; moe_combine<0>(C, P, (const bf16_t*)P.out, WSP(float, SM_RS2), nullptr); }
    SEAM(9);
    if (IN(10)) REP(10) { WS_OPAQUE; B1Sched Sd; Sd.init(WSP(bf16_t, OFF_XB), WSP(bf16_t, W_B1), C.G, bx);
        EpiB1All E{WSP(float, SM_RS2), WSP(bf16_t, A_QX), WSP(bf16_t, A_KN), WSP(bf16_t, A_KZT), (bf16_t*)P.out, WSP(f32x2, OFF_ROPE), lds + 131072};
        pg8::gemm_phase(C.wave, lds, pg8::Dims{1024, 1024, 1024}, Sd, E); }
    SEAM(10);
    if (IN(11)) REP(11) for (int bb = 0; bb < 2; ++bb) { WS_OPAQUE; const int u = bb ? ((C.vcu & ~(15 << 2)) | ((15 - ((C.vcu >> 2) & 15)) << 2)) : C.vcu;
        ret_local(C.wave, lds, WSP(bf16_t, A_KZT) + (size_t)bb * S * 1024, (const bf16_t*)P.out + (size_t)bb * S * 2048, WSP(f32x4, A_L) + (size_t)bb * (32 * MiB / 16), u); }
    SEAM(11);
    if (IN(12)) { seg_scan(C, Pkern);
        { P_OPAQUE; XcdBarrier bar; bar.bar = (unsigned*)(P.ws + OFF_CTL) + 4096; bar.x = xcc; bar.st = (volatile LAS unsigned*)(lds + LDS_MISC); const bool t0 = (C.wave == 0) && (lane_id_opaque() == 0); xcd_barrier(bar, t0); } }
    if (IN(12)) REP(12) for (int bb = 0; bb < 2; ++bb) { WS_OPAQUE; const int u = bb ? ((C.vcu & ~(15 << 2)) | ((15 - ((C.vcu >> 2) & 15)) << 2)) : C.vcu;
        ret_scan(C.wave, lds, WSP(bf16_t, A_QX) + (size_t)bb * S * 1024, WSP(bf16_t, A_KN) + (size_t)bb * S * 1024, WSP(bf16_t, A_KZT) + (size_t)bb * S * 1024, (const bf16_t*)P.out + (size_t)bb * S * 2048, WSP(f32x4, A_L) + (size_t)bb * (32 * MiB / 16),
                 WSP(bf16_t, A_O) + (size_t)bb * S * LDO, WSP(float, SM_PO) + (size_t)bb * S * 16, u); }
    SEAM(12);
    if (IN(13)) { WS_OPAQUE; DenseSched Sd; Sd.init(WSP(bf16_t, OFF_XB), 1024, WSP(bf16_t, W_B1) + (size_t)4096 * 1024, 1024, 128, 8, C.G, bx); EpiG E{WSP(float, SM_RS2), WSP(float, SM_PO), WSP(bf16_t, A_O)};
        pg8::gemm_phase(C.wave, lds, pg8::Dims{1024, 1024, 1024}, Sd, E); }
    SEAM(13);
    if (IN(14)) { WS_OPAQUE; DenseSched Sd; Sd.init(WSP(bf16_t, A_O), LDO, WSP(bf16_t, W_OO), LDO, 128, 4, C.G, bx); EpiRes<false> E{WSP(bf16_t, OFF_XB), WSP(bf16_t, OFF_XB)};
        pg8::gemm_phase(C.wave, lds, pg8::Dims{LDO, LDO, 2048}, Sd, E); }
    SEAM(14);
    if (IN(15)) { convert_moe(C, P, 1); __syncthreads(); }
    MOE_PHASES(1, 15);
#undef MOE_PHASES
    if (IN(19)) { P_OPAQUE; moe_combine<1>(C, P, (const bf16_t*)(P.ws + OFF_XB), nullptr, P.in[I_LN_F]); }
#ifdef PROBE_T
    __syncthreads();
    if (bx == 0 && C.wave == 0 && lane_id_opaque() == 0) { volatile LAS unsigned long long* st_ = (volatile LAS unsigned long long*)(lds + LDS_MISC + 64);
        const unsigned long long tend = __builtin_amdgcn_s_memrealtime(); const unsigned long long tb = (PROBE_T == 19) ? tend : st_[PROBE_T + 1]; const unsigned long long dt = tb - st_[PROBE_T];
        while (__builtin_amdgcn_s_memrealtime() - tend < 8ull * dt) __builtin_amdgcn_s_sleep(8); }
#endif
#undef IN
#undef SEAM
}

extern "C" void kernel_launch(void* const* d_in, const int* in_sizes, int n_in, void* d_out, int out_size, void* d_ws, size_t ws_size, hipStream_t stream) {
    static int ready = 0;
    if (ready == 0) {
        if (n_in != 21 || out_size != T * D || ws_size < WS_NEED) { fprintf(stderr, "kernel_launch: unexpected shapes (n_in %d, out %d, ws %zu < %zu)\n", n_in, out_size, ws_size, (size_t)WS_NEED); ready = -1; return; }
        if (hipFuncSetAttribute((const void*)fwd_kernel, hipFuncAttributeMaxDynamicSharedMemorySize, LDS_BYTES) != hipSuccess) { fprintf(stderr, "kernel_launch: hipFuncSetAttribute failed\n"); ready = -1; return; }
        int per_cu = 0; (void)hipOccupancyMaxActiveBlocksPerMultiprocessor(&per_cu, (const void*)fwd_kernel, 512, LDS_BYTES); (void)hipGetLastError();
        if (per_cu < 1) fprintf(stderr, "kernel_launch: occupancy query reports %d blocks per CU\n", per_cu);
        ready = 1;
    }
    if (ready < 0) return;
    (void)hipMemsetAsync((char*)d_ws + OFF_CTL, 0, CTL_BYTES, stream);
    Params p{};
    for (int i = 0; i < 21; ++i) p.in[i] = (const float*)d_in[i];
    p.out = (float*)d_out; p.ws = (unsigned char*)d_ws; p.pad = 0;
#if N_LAUNCH_MODE == 1
    for (int ph = 0; ph < NPHASE; ++ph) { p.ph_lo = ph; p.ph_hi = ph + 1; p.use_bar = 0; hipLaunchKernelGGL(fwd_kernel, dim3(256), dim3(512), LDS_BYTES, stream, p); }
#else
    p.ph_lo = 0; p.ph_hi = NPHASE; p.use_bar = 1;
    hipLaunchKernelGGL(fwd_kernel, dim3(256), dim3(512), LDS_BYTES, stream, p);
#endif
}
```
